# Optimizing an MI355X kernel written in HIP

```python
import jax, jax.numpy as jnp
from jax import lax
import numpy as np

D_MODEL = 1024
BATCH = 16
SEQ = 256
DEPTH = 4
DEC_BATCH = 2
DEC_SEQ = 1024
PAST_LEN = 256

GRID_W = 64
NA_HEADS = 8
NA_HEAD_DIM = D_MODEL // 16
NA_WIDTH = NA_HEADS * NA_HEAD_DIM
NA_KH = 8
NA_KW = 16
POOL_WINDOWS = (2, 4, 8, 16)
POOL_GROUPS = 4
POOL_WIDTH = D_MODEL // 4
POOL_GROUP_DIM = POOL_WIDTH // POOL_GROUPS
CONV_WIDTH = D_MODEL // 4
CONV_K = 31
N_BRANCH = 3
N_IN = 3 * NA_WIDTH + POOL_WIDTH + 2 * CONV_WIDTH + N_BRANCH * D_MODEL
FFN_HIDDEN = ((8 * D_MODEL + 3 * 256 - 1) // (3 * 256)) * 256
N_MOD = 6
EPS = 1e-6
NEG_INF = -1e30

kernel_name = "hybrid_na_pool_conv_prefix_dit_step"


def _rmsnorm(x, g):
    xf = x.astype(jnp.float32)
    y = xf * lax.rsqrt(jnp.mean(xf * xf, axis=-1, keepdims=True) + EPS)
    return (y * g.astype(jnp.float32)).astype(x.dtype)


def _layernorm(x, g, b):
    xf = x.astype(jnp.float32)
    mu = jnp.mean(xf, axis=-1, keepdims=True)
    xc = xf - mu
    y = xc * lax.rsqrt(jnp.mean(xc * xc, axis=-1, keepdims=True) + EPS)
    return (y * g.astype(jnp.float32) + b.astype(jnp.float32)).astype(x.dtype)


def _modulation(cond, w_mod, b_mod):
    m = jax.nn.silu(cond) @ w_mod + b_mod
    return jnp.split(m[:, None, :], N_MOD, axis=-1)


def _split_in(u):
    B, L, _ = u.shape
    bounds = np.cumsum([NA_WIDTH, NA_WIDTH, NA_WIDTH, POOL_WIDTH, 2 * CONV_WIDTH]).tolist()
    q, k, v, p_in, c_in, g_in = jnp.split(u, bounds, axis=-1)
    shp = (B, L, NA_HEADS, NA_HEAD_DIM)
    return q.reshape(shp), k.reshape(shp), v.reshape(shp), p_in, c_in, g_in


def _context_attention(q, k, v):
    B, L, H, dh = q.shape
    s = jnp.einsum('bqhd,bkhd->bhqk', q, k).astype(jnp.float32) * (dh ** -0.5)
    p = jax.nn.softmax(s, axis=-1).astype(v.dtype)
    return jnp.einsum('bhqk,bkhd->bqhd', p, v).reshape(B, L, H * dh)


def _neighbourhood_attention(q, k, v, k_ctx, v_ctx, rpb):
    B, L, H, dh = q.shape
    rows = L // GRID_W
    kh = min(NA_KH, rows)
    r = jnp.arange(rows)
    row_start = jnp.clip(r - kh // 2, 0, rows - kh)
    row_idx = row_start[:, None] + jnp.arange(kh)[None, :]
    c = jnp.arange(GRID_W)
    col_start = jnp.clip(c - NA_KW // 2, 0, GRID_W - NA_KW)
    col_in = (c[None, :] >= col_start[:, None]) & (c[None, :] < col_start[:, None] + NA_KW)
    qg = q.reshape(B, rows, GRID_W, H, dh)
    kg = k.reshape(B, rows, GRID_W, H, dh)[:, row_idx]
    vg = v.reshape(B, rows, GRID_W, H, dh)[:, row_idx]
    scale = dh ** -0.5
    s_loc = jnp.einsum('brqhd,brjkhd->bhrqjk', qg, kg).astype(jnp.float32) * scale
    ri = (row_idx - r[:, None]) + NA_KH - 1
    ci = jnp.clip(c[None, :] - c[:, None], -(NA_KW - 1), NA_KW - 1) + NA_KW - 1
    bias = rpb[:, ri[:, None, :, None], ci[None, :, None, :]]
    s_loc = jnp.where(col_in[None, None, None, :, None, :],
                      s_loc + bias[None].astype(jnp.float32), NEG_INF)
    s_ctx = jnp.einsum('brqhd,bchd->bhrqc', qg, k_ctx).astype(jnp.float32) * scale
    n_loc = kh * GRID_W
    s = jnp.concatenate([s_loc.reshape(B, H, rows, GRID_W, n_loc), s_ctx], axis=-1)
    p = jax.nn.softmax(s, axis=-1)
    p_loc = p[..., :n_loc].reshape(B, H, rows, GRID_W, kh, GRID_W).astype(v.dtype)
    p_ctx = p[..., n_loc:].astype(v.dtype)
    o = (jnp.einsum('bhrqjk,brjkhd->brqhd', p_loc, vg)
         + jnp.einsum('bhrqc,bchd->brqhd', p_ctx, v_ctx))
    return o.reshape(B, L, H * dh)


def _pool_mixer(p_in, w_pool, pool_scale):
    B, L, C = p_in.shape
    pf = p_in.astype(jnp.float32)
    cs = jnp.concatenate([jnp.zeros((B, 1, C), jnp.float32), lax.cumsum(pf, axis=1)], axis=1)
    t = jnp.arange(L)
    outs = []
    for g, w in enumerate(POOL_WINDOWS):
        lo = jnp.clip(t - w // 2, 0, L)
        hi = jnp.clip(t - w // 2 + w, 0, L)
        seg = cs[:, :, g * POOL_GROUP_DIM:(g + 1) * POOL_GROUP_DIM]
        cnt = (hi - lo).astype(jnp.float32)[None, :, None]
        outs.append((seg[:, hi] - seg[:, lo]) / cnt)
    pooled = (jnp.concatenate(outs, axis=-1) - pf).astype(p_in.dtype)
    y = jnp.einsum('blgc,gcd->blgd', pooled.reshape(B, L, POOL_GROUPS, POOL_GROUP_DIM), w_pool)
    return y.reshape(B, L, POOL_WIDTH) * pool_scale


def _conv_mixer(c_in, w_dw, b_dw, conv_norm_g, conv_norm_b):
    a, g = jnp.split(c_in, 2, axis=-1)
    h = a * jax.nn.sigmoid(g)
    h = lax.conv_general_dilated(h, w_dw[:, None, :], window_strides=(1,),
                                 padding=[(CONV_K // 2, CONV_K // 2)],
                                 dimension_numbers=('NWC', 'WIO', 'NWC'),
                                 feature_group_count=CONV_WIDTH) + b_dw
    h = _layernorm(h, conv_norm_g, conv_norm_b)
    return jax.nn.silu(h)


def _layer(x, mod, k_ctx, v_ctx, norm1_g, norm2_g, w_in, b_gate, rpb, w_oa, w_pool, pool_scale,
           w_ob, w_dw, b_dw, conv_norm_g, conv_norm_b, w_oc, w_out, w_gu, w_down):
    shift1, scale1, gate1, shift2, scale2, gate2 = mod
    B, L, D = x.shape
    h = _rmsnorm(x, norm1_g) * (1 + scale1) + shift1
    u = h @ w_in
    q, k, v, p_in, c_in, g_in = _split_in(u)
    if k_ctx is None:
        y_a = _context_attention(q, k, v)
        kv_out = (k, v)
    else:
        y_a = _neighbourhood_attention(q, k, v, k_ctx, v_ctx, rpb)
        kv_out = None
    y_a = y_a @ w_oa
    y_b = _pool_mixer(p_in, w_pool, pool_scale) @ w_ob
    y_c = _conv_mixer(c_in, w_dw, b_dw, conv_norm_g, conv_norm_b) @ w_oc
    gates = jax.nn.sigmoid(g_in + b_gate).reshape(B, L, N_BRANCH, D)
    merged = gates[:, :, 0] * y_a + gates[:, :, 1] * y_b + gates[:, :, 2] * y_c
    x = x + gate1 * (merged @ w_out)
    h2 = _rmsnorm(x, norm2_g) * (1 + scale2) + shift2
    a, b = jnp.split(h2 @ w_gu, 2, axis=-1)
    x = x + gate2 * ((jax.nn.silu(a) * b) @ w_down)
    return x, kv_out


def setup_inputs(seed: int = 0) -> dict:
    key = jax.random.key(seed)
    ks = jax.random.split(key, 32)

    def nrm(k, shape, scale):
        return scale * jax.random.normal(k, shape, jnp.float32)

    D = D_MODEL
    kv_shape = (DEC_BATCH, DEPTH, PAST_LEN, NA_HEADS, NA_HEAD_DIM)
    return {
        "x_prompt": nrm(ks[0], (BATCH, SEQ, D), 1.0),
        "x_sample": nrm(ks[1], (DEC_BATCH, DEC_SEQ, D), 1.0),
        "cache_k": nrm(ks[2], kv_shape, 1.0),
        "cache_v": nrm(ks[3], kv_shape, 1.0),
        "c": nrm(ks[4], (DEC_BATCH, D), 1.0),
        "c_ctx": nrm(ks[5], (D,), 1.0),
        "w_mod": nrm(ks[6], (DEPTH, D, N_MOD * D), 0.5 * D ** -0.5),
        "b_mod": nrm(ks[7], (DEPTH, N_MOD * D), 0.02),
        "norm1_g": 1.0 + nrm(ks[8], (DEPTH, D), 0.05),
        "norm2_g": 1.0 + nrm(ks[9], (DEPTH, D), 0.05),
        "w_in": nrm(ks[10], (DEPTH, D, N_IN), D ** -0.5),
        "b_gate": nrm(ks[11], (DEPTH, N_BRANCH * D), 0.02),
        "rpb": nrm(ks[12], (DEPTH, NA_HEADS, 2 * NA_KH - 1, 2 * NA_KW - 1), 0.1),
        "w_oa": nrm(ks[13], (DEPTH, NA_WIDTH, D), NA_WIDTH ** -0.5),
        "w_pool": nrm(ks[14], (DEPTH, POOL_GROUPS, POOL_GROUP_DIM, POOL_GROUP_DIM), POOL_GROUP_DIM ** -0.5),
        "pool_scale": 1.0 + nrm(ks[15], (DEPTH, POOL_WIDTH), 0.05),
        "w_ob": nrm(ks[16], (DEPTH, POOL_WIDTH, D), POOL_WIDTH ** -0.5),
        "w_dw": nrm(ks[17], (DEPTH, CONV_K, CONV_WIDTH), CONV_K ** -0.5),
        "b_dw": nrm(ks[18], (DEPTH, CONV_WIDTH), 0.02),
        "conv_norm_g": 1.0 + nrm(ks[19], (DEPTH, CONV_WIDTH), 0.05),
        "conv_norm_b": nrm(ks[20], (DEPTH, CONV_WIDTH), 0.02),
        "w_oc": nrm(ks[21], (DEPTH, CONV_WIDTH, D), CONV_WIDTH ** -0.5),
        "w_out": nrm(ks[22], (DEPTH, D, D), D ** -0.5),
        "w_gu": nrm(ks[23], (DEPTH, D, 2 * FFN_HIDDEN), D ** -0.5),
        "w_down": nrm(ks[24], (DEPTH, FFN_HIDDEN, D), FFN_HIDDEN ** -0.5),
        "final_g": 1.0 + nrm(ks[25], (D,), 0.05),
    }


def reference(x_prompt, x_sample, cache_k, cache_v, c, c_ctx, w_mod, b_mod, norm1_g, norm2_g,
              w_in, b_gate, rpb, w_oa, w_pool, pool_scale, w_ob, w_dw, b_dw, conv_norm_g,
              conv_norm_b, w_oc, w_out, w_gu, w_down, final_g):
    xp = x_prompt
    xs = x_sample
    ks_out, vs_out = [], []
    for l in range(DEPTH):
        prm = dict(norm1_g=norm1_g[l], norm2_g=norm2_g[l], w_in=w_in[l], b_gate=b_gate[l],
                   rpb=rpb[l], w_oa=w_oa[l], w_pool=w_pool[l], pool_scale=pool_scale[l],
                   w_ob=w_ob[l], w_dw=w_dw[l], b_dw=b_dw[l], conv_norm_g=conv_norm_g[l],
                   conv_norm_b=conv_norm_b[l], w_oc=w_oc[l], w_out=w_out[l], w_gu=w_gu[l],
                   w_down=w_down[l])
        mod_ctx = _modulation(c_ctx[None, :], w_mod[l], b_mod[l])
        mod_lat = _modulation(c, w_mod[l], b_mod[l])
        xp, kv = _layer(xp, mod_ctx, None, None, **prm)
        xs, _ = _layer(xs, mod_lat, cache_k[:, l], cache_v[:, l], **prm)
        ks_out.append(kv[0])
        vs_out.append(kv[1])
    y_prompt = _rmsnorm(xp, final_g)
    y_sample = _rmsnorm(xs, final_g)
    new_k = jnp.stack(ks_out, axis=1)
    new_v = jnp.stack(vs_out, axis=1)
    return (y_prompt, y_sample, new_k, new_v)
```

```cpp
#include <hip/hip_runtime.h>
#include <cstdio>
#include <cstdint>

#ifndef MK_PER_PHASE
#define MK_PER_PHASE 0
#endif

#ifndef MK_REPEAT
#define MK_REPEAT 0
#endif
#define MK_REPS(bit) ((MK_REPEAT >> (bit)) & 1 ? 2 : 1)
#ifndef MK_VAR
#define MK_VAR 0
#endif

constexpr int D = 1024, MP = 4096, MS = 2048, M = MP + MS, DEPTH = 4;
constexpr int NIN = 5376, FFN = 2816, NGU = 2 * FFN, NMOD = 6 * D;
constexpr int NAW = 512, PW = 256, CW = 256, CONVK = 31;
constexpr float EPS = 1e-6f;
constexpr float LOG2E = 1.4426950408889634f;
constexpr float QSCALE = 0.125f * LOG2E;

constexpr size_t MiB = 1u << 20;
constexpr size_t WS_CTL = 0, CTL_ZERO_BYTES = 5 * MiB / 4;
constexpr int CW_BAR = 4096;
constexpr int CF_MODRAW = 16384;
constexpr int CF_C1 = CF_MODRAW + DEPTH * 3 * NMOD;
constexpr int CF_C2 = CF_C1 + DEPTH * 3 * NIN;
constexpr int CF_RSS = CF_C2 + DEPTH * 3 * NGU;
constexpr int CF_END = CF_RSS + 9 * M;
static_assert((size_t)CF_END * 4 <= CTL_ZERO_BYTES, "control region");
constexpr size_t WS_MODT = 2 * MiB;
constexpr size_t WS_WIN = 4 * MiB;
constexpr size_t WS_WGU = 46 * MiB;
constexpr size_t WS_WDN = 90 * MiB;
constexpr size_t WS_WBR = 112 * MiB;
constexpr size_t WS_WOUT = 120 * MiB;
constexpr size_t WS_X = 128 * MiB;
constexpr size_t WS_XG = 152 * MiB;
constexpr size_t WS_Q = 164 * MiB, WS_K = 170 * MiB;
constexpr size_t WS_VT = 176 * MiB;
constexpr size_t WS_KC = 182 * MiB;
constexpr size_t WS_VTC = 184 * MiB;
constexpr size_t WS_PIN = 186 * MiB;
constexpr size_t WS_CIN = 189 * MiB;
constexpr size_t WS_G = 195 * MiB;
constexpr size_t WS_ABR = 231 * MiB;
constexpr size_t WS_MF = 243 * MiB;
constexpr size_t WS_MB = 267 * MiB;
constexpr size_t WS_ACT = 279 * MiB;
constexpr size_t WS_END = 312 * MiB;
constexpr size_t VT_SAMPLE_OFF = (size_t)16 * 8 * 64 * 256;

constexpr size_t OUT_Y = 0, OUT_K = (size_t)M * D, OUT_V = OUT_K + (size_t)16 * DEPTH * 256 * 512;

#define GAS __attribute__((address_space(1)))
#define LAS __attribute__((address_space(3)))
typedef unsigned short bf16_t;
typedef short bf16x8 __attribute__((ext_vector_type(8)));
typedef float f32x4 __attribute__((ext_vector_type(4)));
typedef float f32x2 __attribute__((ext_vector_type(2)));
typedef float f32x16 __attribute__((ext_vector_type(16)));
typedef unsigned u32x4 __attribute__((ext_vector_type(4)));
typedef unsigned u32x2 __attribute__((ext_vector_type(2)));
typedef __bf16 bf16x2_t __attribute__((ext_vector_type(2)));
#define LDS_WAIT() asm volatile("s_waitcnt lgkmcnt(0)" ::: "memory")

__device__ __forceinline__ unsigned pk2(float lo, float hi) { f32x2 v = {lo, hi}; bf16x2_t b = __builtin_convertvector(v, bf16x2_t); return __builtin_bit_cast(unsigned, b); }
__device__ __forceinline__ u32x4 pk8(f32x4 a, f32x4 b) { u32x4 w; w.x = pk2(a[0], a[1]); w.y = pk2(a[2], a[3]); w.z = pk2(b[0], b[1]); w.w = pk2(b[2], b[3]); return w; }
__device__ __forceinline__ float bf_lo(unsigned w) { return __uint_as_float(w << 16); }
__device__ __forceinline__ float bf_hi(unsigned w) { return __uint_as_float(w & 0xffff0000u); }
__device__ __forceinline__ float sigmoidf_(float x) { return __builtin_amdgcn_rcpf(1.0f + __builtin_amdgcn_exp2f(-LOG2E * x)); }
__device__ __forceinline__ float wave_sum(float v) {
#pragma unroll
    for (int o = 1; o < 64; o <<= 1) v += __shfl_xor(v, o);
    return v;
}
__device__ __forceinline__ int pos_of_key(int t) { return (t & ~12) | ((t & 4) << 1) | ((t & 8) >> 1); }
__device__ __forceinline__ int mod_row_of_pm(int pm) { return pm < 16 ? 0 : 1 + ((pm - 16) >> 2); }

namespace pg8 {
constexpr int BM = 256, BK = 64, HALF = 128, HTB = HALF * BK * 2  , STAGE_BYTES = 8 * HTB, NXCD = 8, WGM = 4;
__host__ __device__ __forceinline__ int lds_byte(int r, int c) { return r * 128 + ((((c >> 3) ^ (r >> 1)) & 7) << 4) + (c & 7) * 2; }
__host__ __device__ __forceinline__ void stage_rc(int b, int& R, int& C) { R = b >> 7; C = (((b >> 4) ^ (R >> 1)) & 7) * 8; }
__host__ __device__ __forceinline__ int perm32(int rho) { const int n = rho >> 4, i = rho & 15; return 8 * (i >> 2) + 4 * n + (i & 3); }

struct Unit { int pm, pn, k0, nt, kind, half; };
struct Gemm { const bf16_t* A; const bf16_t* Bt; int lda, ldb; };

struct TileOrder {
    int nM, nN, nwg, G, c, nt;
    __device__ void init(int M_, int N_, int K_, int G_, int c_) { nM = M_ / BM; nN = N_ / BM; nwg = nM * nN; G = G_; c = c_; nt = K_ / BK; }
    __device__ bool next(int i, Unit& u) const {
        const long L = (long)i * G + c; if (L >= nwg) return false;
        int wgid = (int)L; { const int q = nwg / NXCD, r = nwg % NXCD, xcd = wgid % NXCD, off = wgid / NXCD; wgid = (xcd < r ? xcd * (q + 1) : r * (q + 1) + (xcd - r) * q) + off; }
        const int nig = WGM * nN, gid = wgid / nig, fm = gid * WGM, gsz = (nM - fm) < WGM ? (nM - fm) : WGM;
        u.pm = fm + ((wgid % nig) % gsz); u.pn = (wgid % nig) / gsz; u.k0 = 0; u.nt = nt; u.kind = 0; u.half = 0; return true;
    }
};
struct TileOrderGU {
    TileOrder base;
    __device__ void init(int M_, int N_, int K_, int G_, int c_) { base.init(M_, N_, K_, G_, c_); }
    __device__ bool next(int i, Unit& u) const {
        if (i < 2) return base.next(i, u);
        if (i > 2 || base.c >= 32 || base.G != 256) { if (base.G == 256) return false; return base.next(i, u); }
        const int c = base.c, xcd = c & 7, off = 64 + ((c >> 3) & 1);
        const int wgid = xcd * 66 + off;
        const int nig = WGM * base.nN, gid = wgid / nig, fm = gid * WGM, gsz = (base.nM - fm) < WGM ? (base.nM - fm) : WGM;
        u.pm = fm + ((wgid % nig) % gsz); u.pn = (wgid % nig) / gsz; u.k0 = 0; u.nt = base.nt; u.kind = 0; u.half = 1 + (c >> 4); return true;
    }
};
struct PanelOrder {
    int c, nseg, ka, na, kb, nb, kc, nc;
    __device__ bool next(int i, Unit& u) const {
        if (c >= 96 || i >= nseg) return false;
        const int T = (c & 7) * 12 + (c >> 3);
        u.pm = T >> 2; u.pn = T & 3; u.k0 = i == 0 ? ka : (i == 1 ? kb : kc); u.nt = i == 0 ? na : (i == 1 ? nb : nc); u.kind = i; u.half = 0; return true;
    }
};

template <class Epi, class Sched>
__device__ __forceinline__ void gemm_phase(LAS unsigned char* lds, const Gemm g, const Sched& S, const Epi& E) {
    int tid = threadIdx.x; asm volatile("" : "+v"(tid));
    const int wid = __builtin_amdgcn_readfirstlane(tid >> 6), lane = tid & 63, wr = wid >> 2, wc = wid & 3, fr = lane & 15, fq = lane >> 4;
    unsigned voffA[2], voffB[2];
#pragma unroll
    for (int i = 0; i < 2; ++i) { int R, C; stage_rc(tid * 16 + i * 8192, R, C); const int Rb = (R & ~31) + perm32(R & 31);
        voffA[i] = (unsigned)(R * g.lda + C) * 2u; voffB[i] = (unsigned)(Rb * g.ldb + C) * 2u; }
    const size_t kstep = (size_t)(BK * 2);
    const size_t hstepA = (size_t)HALF * g.lda * 2, hstepB = (size_t)HALF * g.ldb * 2;
    const size_t tstepA = 2 * hstepA, tstepB = 2 * hstepB;
    const unsigned ldsw = (unsigned)wid * 1024u;
    const int aoffk[2] = {lds_byte(wr * 64 + fr, fq * 8), lds_byte(wr * 64 + fr, fq * 8 + 32)}, boffk[2] = {lds_byte(wc * 32 + fr, fq * 8), lds_byte(wc * 32 + fr, fq * 8 + 32)};
#define PG8_SA(b, h) (((b) * 2 + (h)) * HTB)
#define PG8_SB(b, h) ((4 + (b) * 2 + (h)) * HTB)
#define PG8_STAGE(bufoff, gbase, voff) do { _Pragma("unroll") for (int _i = 0; _i < 2; ++_i) \
        __builtin_amdgcn_global_load_lds((const unsigned*)((const char*)(gbase) + (voff)[_i]), (LAS unsigned*)(lds + (bufoff) + ldsw + _i * 8192), 16, 0, 0); } while (0)
#define PG8_LDA(dst, b, h) do { _Pragma("unroll") for (int m = 0; m < 4; ++m) _Pragma("unroll") for (int k = 0; k < 2; ++k) dst[m][k] = *(const LAS bf16x8*)(lds + PG8_SA(b, h) + aoffk[k] + m * 2048); } while (0)
#define PG8_LDB(dst, b, h) do { _Pragma("unroll") for (int n = 0; n < 2; ++n) _Pragma("unroll") for (int k = 0; k < 2; ++k) dst[n][k] = *(const LAS bf16x8*)(lds + PG8_SB(b, h) + boffk[k] + n * 2048); } while (0)
#define PG8_MMA(ai, bj, At, Bt) do { __builtin_amdgcn_s_setprio(1); _Pragma("unroll") for (int m = 0; m < 4; ++m) _Pragma("unroll") for (int n = 0; n < 2; ++n) _Pragma("unroll") for (int k = 0; k < 2; ++k) \
        acc[ai][bj][m][n] = __builtin_amdgcn_mfma_f32_16x16x32_bf16(Bt[n][k], At[m][k], acc[ai][bj][m][n], 0, 0, 0); __builtin_amdgcn_s_setprio(0); } while (0)
#define PG8_WAIT_V(n) asm volatile("s_waitcnt vmcnt(" #n ")" ::: "memory")
#define PG8_WAIT_L(n) asm volatile("s_waitcnt lgkmcnt(" #n ")" ::: "memory")
#define PG8_BAR __builtin_amdgcn_s_barrier()
#define PG8_SCHED __builtin_amdgcn_sched_barrier(0)
    Unit cur, nxt; int ui = 0;
    if (!S.next(0, cur)) return;
    f32x4 acc[2][2][4][2];
#pragma unroll
    for (int a = 0; a < 2; ++a)
#pragma unroll
        for (int b = 0; b < 2; ++b)
#pragma unroll
            for (int m = 0; m < 4; ++m)
#pragma unroll
                for (int n = 0; n < 2; ++n) acc[a][b][m][n] = (f32x4){0.f, 0.f, 0.f, 0.f};
    bf16x8 At[4][2], B0[2][2], B1[2][2];
    const char* cA = (const char*)g.A + (size_t)cur.pm * tstepA + (size_t)cur.k0 * 2; const char* cB = (const char*)g.Bt + (size_t)cur.pn * tstepB + (size_t)cur.k0 * 2;
    PG8_STAGE(PG8_SB(0, 0), cB, voffB); PG8_STAGE(PG8_SB(0, 1), cB + hstepB, voffB); PG8_STAGE(PG8_SA(0, 0), cA, voffA); PG8_STAGE(PG8_SA(0, 1), cA + hstepA, voffA);
    if (wr == 1) PG8_BAR;
    PG8_WAIT_V(2); PG8_BAR;
    PG8_STAGE(PG8_SB(1, 0), cB + kstep, voffB); PG8_STAGE(PG8_SA(1, 0), cA + kstep, voffA); PG8_STAGE(PG8_SB(1, 1), cB + hstepB + kstep, voffB);
    PG8_WAIT_V(6); PG8_BAR;
    for (;;) {
        const bool has_next = S.next(ui + 1, nxt);
        const char* nA = has_next ? (const char*)g.A + (size_t)nxt.pm * tstepA + (size_t)nxt.k0 * 2 : cA; const char* nB = has_next ? (const char*)g.Bt + (size_t)nxt.pn * tstepB + (size_t)nxt.k0 * 2 : cB;
        const int nt = cur.nt;
        const bool do0 = cur.half != 2, do1 = cur.half != 1;
        for (int t = 0; t < nt; t += 2) {
            const bool last = (t == nt - 2);
            const char* a1 = cA + (size_t)(t + 1) * kstep;
            const char* a2 = last ? nA : cA + (size_t)(t + 2) * kstep; const char* b2 = last ? nB : cB + (size_t)(t + 2) * kstep;
            const char* a3 = a2 + kstep; const char* b3 = b2 + kstep;
            PG8_LDB(B0, 0, 0); PG8_LDB(B1, 0, 1); PG8_SCHED; PG8_LDA(At, 0, 0); PG8_STAGE(PG8_SA(1, 1), a1 + hstepA, voffA);
            PG8_WAIT_V(8); PG8_WAIT_L(0); PG8_BAR; if (do0) { PG8_MMA(0, 0, At, B0); PG8_MMA(0, 1, At, B1); } PG8_BAR; PG8_SCHED;
            PG8_LDA(At, 0, 1); PG8_STAGE(PG8_SB(0, 0), b2, voffB); PG8_STAGE(PG8_SB(0, 1), b2 + hstepB, voffB); PG8_STAGE(PG8_SA(0, 0), a2, voffA);
            PG8_WAIT_V(8); PG8_WAIT_L(0); PG8_BAR; if (do1) { PG8_MMA(1, 0, At, B0); PG8_MMA(1, 1, At, B1); } PG8_BAR; PG8_SCHED;
            PG8_LDB(B0, 1, 0); PG8_LDB(B1, 1, 1); PG8_SCHED; PG8_LDA(At, 1, 0); PG8_STAGE(PG8_SA(0, 1), a2 + hstepA, voffA);
            PG8_WAIT_V(8); PG8_WAIT_L(0); PG8_BAR; if (do0) { PG8_MMA(0, 0, At, B0); PG8_MMA(0, 1, At, B1); } PG8_BAR; PG8_SCHED;
            PG8_LDA(At, 1, 1); PG8_STAGE(PG8_SB(1, 0), b3, voffB); PG8_STAGE(PG8_SB(1, 1), b3 + hstepB, voffB); PG8_STAGE(PG8_SA(1, 0), a3, voffA);
            PG8_WAIT_V(8); PG8_WAIT_L(0); PG8_BAR; if (do1) { PG8_MMA(1, 0, At, B0); PG8_MMA(1, 1, At, B1); } PG8_BAR; PG8_SCHED;
        }
        if (wr == 0) PG8_BAR;
        E(acc, cur, wr, wc, fr, fq);
        if (!has_next) break;
#pragma unroll
        for (int a = 0; a < 2; ++a)
#pragma unroll
            for (int b = 0; b < 2; ++b)
#pragma unroll
                for (int m = 0; m < 4; ++m)
#pragma unroll
                    for (int n = 0; n < 2; ++n) acc[a][b][m][n] = (f32x4){0.f, 0.f, 0.f, 0.f};
        cur = nxt; cA = nA; cB = nB; ++ui;
        if (wr == 1) PG8_BAR;
    }
    PG8_WAIT_V(0);
    PG8_BAR;
#undef PG8_SA
#undef PG8_SB
#undef PG8_STAGE
#undef PG8_LDA
#undef PG8_LDB
#undef PG8_MMA
#undef PG8_WAIT_V
#undef PG8_WAIT_L
#undef PG8_BAR
#undef PG8_SCHED
}
}

typedef f32x4 Acc[2][2][4][2];

struct EpiIn {
    const float* rss; const float* c1; const float* bgate;
    bf16_t *Q, *K, *Vt, *Pin, *Cin, *G; float *outk, *outv;
    __device__ __forceinline__ void operator()(const Acc& acc, const pg8::Unit& u, int wr, int wc, int fr, int fq) const {
        const int pn = u.pn, pm = u.pm, mr = mod_row_of_pm(pm);
        const int cb = pn * 256 + wc * 32 + 8 * fq;
        f32x4 cv[2][2];
#pragma unroll
        for (int bj = 0; bj < 2; ++bj)
#pragma unroll
            for (int n = 0; n < 2; ++n) cv[bj][n] = *(const f32x4*)(c1 + (size_t)mr * NIN + cb + bj * 128 + 4 * n);
        float rinvs[2][4];
#pragma unroll
        for (int ai = 0; ai < 2; ++ai)
#pragma unroll
            for (int m = 0; m < 4; ++m) rinvs[ai][m] = rss[pm * 256 + ai * 128 + wr * 64 + m * 16 + fr];
#pragma unroll
        for (int ai = 0; ai < 2; ++ai)
#pragma unroll
            for (int m = 0; m < 4; ++m) {
                const int row = pm * 256 + ai * 128 + wr * 64 + m * 16 + fr;
                const float rinv = 1.0f / sqrtf(rinvs[ai][m] * (1.0f / D) + EPS);
#pragma unroll
                for (int bj = 0; bj < 2; ++bj) {
                    const int col = cb + bj * 128;
                    f32x4 v0 = acc[ai][bj][m][0] * rinv + cv[bj][0], v1 = acc[ai][bj][m][1] * rinv + cv[bj][1];
                    if (pn < 2) {
                        *(u32x4*)(Q + (size_t)row * NAW + col) = pk8(v0 * QSCALE, v1 * QSCALE);
                    } else if (pn < 4) {
                        const int c = col - 512;
                        *(u32x4*)(K + (size_t)row * NAW + c) = pk8(v0, v1);
                        if (pm < 16) { float* o = outk + ((size_t)(pm * DEPTH * 256 + (row & 255))) * 512 + c; __builtin_nontemporal_store(v0, (f32x4*)o); __builtin_nontemporal_store(v1, (f32x4*)(o + 4)); }
                    } else if (pn < 6) {
                        const int c = col - 1024, h = c >> 6, d = c & 63;
                        if (pm < 16) { float* o = outv + ((size_t)(pm * DEPTH * 256 + (row & 255))) * 512 + c; __builtin_nontemporal_store(v0, (f32x4*)o); __builtin_nontemporal_store(v1, (f32x4*)(o + 4)); }
                        bf16_t* vb; int L;
                        if (pm < 16) { L = 256; vb = Vt + ((size_t)((pm * 8 + h) * 64 + d)) * 256 + pos_of_key(row & 255); }
                        else { const int rs = row - MP, bs = rs >> 10; L = 1024; vb = Vt + VT_SAMPLE_OFF + ((size_t)((bs * 8 + h) * 64 + d)) * 1024 + pos_of_key(rs & 1023); }
                        const u32x4 w = pk8(v0, v1);
                        vb[0] = (bf16_t)(w.x & 0xffff); vb[(size_t)L] = (bf16_t)(w.x >> 16); vb[(size_t)2 * L] = (bf16_t)(w.y & 0xffff); vb[(size_t)3 * L] = (bf16_t)(w.y >> 16);
                        vb[(size_t)4 * L] = (bf16_t)(w.z & 0xffff); vb[(size_t)5 * L] = (bf16_t)(w.z >> 16); vb[(size_t)6 * L] = (bf16_t)(w.w & 0xffff); vb[(size_t)7 * L] = (bf16_t)(w.w >> 16);
                    } else if (pn == 6) {
                        *(u32x4*)(Pin + (size_t)row * PW + (col - 1536)) = pk8(v0, v1);
                    } else if (pn < 9) {
                        *(u32x4*)(Cin + (size_t)row * 512 + (col - 1792)) = pk8(v0, v1);
                    } else {
                        v0 += *(const f32x4*)(bgate + (col - 2304)); v1 += *(const f32x4*)(bgate + (col - 2304) + 4);
#pragma unroll
                        for (int e = 0; e < 4; ++e) { v0[e] = sigmoidf_(v0[e]); v1[e] = sigmoidf_(v1[e]); }
                        *(u32x4*)(G + (size_t)row * 3072 + (col - 2304)) = pk8(v0, v1);
                    }
                }
                asm volatile("" ::: "memory");
            }
    }
};

struct EpiBranch {
    const bf16_t* G; float* mf; bf16_t* mb;
    __device__ __forceinline__ void operator()(const Acc& acc, const pg8::Unit& u, int wr, int wc, int fr, int fq) const {
        const int cb = u.pn * 256 + wc * 32 + 8 * fq, kind = u.kind;
#pragma unroll
        for (int ai = 0; ai < 2; ++ai)
#pragma unroll
            for (int m = 0; m < 4; ++m) {
                const int row = u.pm * 256 + ai * 128 + wr * 64 + m * 16 + fr;
#pragma unroll
                for (int bj = 0; bj < 2; ++bj) {
                    const int col = cb + bj * 128;
                    const u32x4 gw = *(const u32x4*)(G + (size_t)row * 3072 + kind * 1024 + col);
                    f32x4 v0 = acc[ai][bj][m][0], v1 = acc[ai][bj][m][1];
                    v0[0] *= bf_lo(gw.x); v0[1] *= bf_hi(gw.x); v0[2] *= bf_lo(gw.y); v0[3] *= bf_hi(gw.y);
                    v1[0] *= bf_lo(gw.z); v1[1] *= bf_hi(gw.z); v1[2] *= bf_lo(gw.w); v1[3] *= bf_hi(gw.w);
                    float* sp = mf + (size_t)row * D + col;
                    if (kind > 0) { v0 += *(const f32x4*)sp; v1 += *(const f32x4*)(sp + 4); }
                    if (kind < 2) { *(f32x4*)sp = v0; *(f32x4*)(sp + 4) = v1; }
                    else *(u32x4*)(mb + (size_t)row * D + col) = pk8(v0, v1);
                }
                asm volatile("" ::: "memory");
            }
    }
};

struct EpiRes {
    float* x; bf16_t* xg; const float* gate; const float* gsn; float* rssn;
    __device__ __forceinline__ void operator()(const Acc& acc, const pg8::Unit& u, int wr, int wc, int fr, int fq) const {
        const int mr = mod_row_of_pm(u.pm), cb = u.pn * 256 + wc * 32 + 8 * fq;
        float ss[2][4];
#pragma unroll
        for (int ai = 0; ai < 2; ++ai)
#pragma unroll
            for (int m = 0; m < 4; ++m) ss[ai][m] = 0.f;
#pragma unroll
        for (int bj = 0; bj < 2; ++bj) {
            const int col = cb + bj * 128;
            const f32x4 gt0 = *(const f32x4*)(gate + (size_t)mr * 6 * D + col), gt1 = *(const f32x4*)(gate + (size_t)mr * 6 * D + col + 4);
            const f32x4 gs0 = *(const f32x4*)(gsn + (size_t)mr * 6 * D + col), gs1 = *(const f32x4*)(gsn + (size_t)mr * 6 * D + col + 4);
#pragma unroll
            for (int ai = 0; ai < 2; ++ai)
#pragma unroll
                for (int m = 0; m < 4; ++m) {
                    const int row = u.pm * 256 + ai * 128 + wr * 64 + m * 16 + fr;
                    float* xp = x + (size_t)row * D + col;
                    f32x4 x0 = *(const f32x4*)xp, x1 = *(const f32x4*)(xp + 4);
                    x0 += gt0 * acc[ai][bj][m][0]; x1 += gt1 * acc[ai][bj][m][1];
                    *(f32x4*)xp = x0; *(f32x4*)(xp + 4) = x1;
                    ss[ai][m] += (x0[0] * x0[0] + x0[1] * x0[1]) + (x0[2] * x0[2] + x0[3] * x0[3]) + (x1[0] * x1[0] + x1[1] * x1[1]) + (x1[2] * x1[2] + x1[3] * x1[3]);
                    *(u32x4*)(xg + (size_t)row * D + col) = pk8(x0 * gs0, x1 * gs1);
                    asm volatile("" ::: "memory");
                }
        }
#pragma unroll
        for (int ai = 0; ai < 2; ++ai)
#pragma unroll
            for (int m = 0; m < 4; ++m) {
                float s = ss[ai][m];
                s += __shfl_xor(s, 16); s += __shfl_xor(s, 32);
                if (fq == 0) atomicAdd(rssn + u.pm * 256 + ai * 128 + wr * 64 + m * 16 + fr, s);
            }
    }
};

struct EpiGU {
    const float* rss; const float* c2; bf16_t* act;
    __device__ __forceinline__ void operator()(const Acc& acc, const pg8::Unit& u, int wr, int wc, int fr, int fq) const {
        const int mr = mod_row_of_pm(u.pm), ca0 = u.pn * 128 + wc * 32 + 8 * fq;
        f32x4 ca[2], cbv[2];
#pragma unroll
        for (int n = 0; n < 2; ++n) { ca[n] = *(const f32x4*)(c2 + (size_t)mr * NGU + ca0 + 4 * n); cbv[n] = *(const f32x4*)(c2 + (size_t)mr * NGU + FFN + ca0 + 4 * n); }
        float rinvs[2][4];
#pragma unroll
        for (int ai = 0; ai < 2; ++ai)
#pragma unroll
            for (int m = 0; m < 4; ++m) rinvs[ai][m] = rss[u.pm * 256 + ai * 128 + wr * 64 + m * 16 + fr];
#pragma unroll
        for (int ai = 0; ai < 2; ++ai)
#pragma unroll
            for (int m = 0; m < 4; ++m) {
                if (u.half == 2 - ai) continue;
                const int row = u.pm * 256 + ai * 128 + wr * 64 + m * 16 + fr;
                const float rinv = 1.0f / sqrtf(rinvs[ai][m] * (1.0f / D) + EPS);
                f32x4 o[2];
#pragma unroll
                for (int n = 0; n < 2; ++n) {
                    const f32x4 a = acc[ai][0][m][n] * rinv + ca[n], b = acc[ai][1][m][n] * rinv + cbv[n];
#pragma unroll
                    for (int e = 0; e < 4; ++e) o[n][e] = a[e] * sigmoidf_(a[e]) * b[e];
                }
                *(u32x4*)(act + (size_t)row * FFN + ca0) = pk8(o[0], o[1]);
                asm volatile("" ::: "memory");
            }
    }
};

namespace g192 {
constexpr int TM = 192, TN = 128, BK = 64, ABYTES = TM * BK * 2, BBYTES = TN * BK * 2, SBYTES = ABYTES + BBYTES;
typedef f32x4 Acc6[6][2];
template <class Epi>
__device__ __forceinline__ void gemm(LAS unsigned char* lds, const bf16_t* A, int lda, const bf16_t* Bt, int ldb, int pm, int pn, int nt, const Epi& E) {
    int tid = threadIdx.x; asm volatile("" : "+v"(tid));
    const int wid = __builtin_amdgcn_readfirstlane(tid >> 6), lane = tid & 63, wr = wid >> 2, wc = wid & 3, fr = lane & 15, fq = lane >> 4;
    unsigned voffA[3], voffB[2];
#pragma unroll
    for (int i = 0; i < 3; ++i) { int R, C; pg8::stage_rc((wid + 8 * i) * 1024 + lane * 16, R, C); voffA[i] = (unsigned)(R * lda + C) * 2u; }
#pragma unroll
    for (int i = 0; i < 2; ++i) { int R, C; pg8::stage_rc((wid + 8 * i) * 1024 + lane * 16, R, C); const int Rb = (R & ~31) + pg8::perm32(R & 31); voffB[i] = (unsigned)(Rb * ldb + C) * 2u; }
    const char* gA = (const char*)(A + (size_t)pm * TM * lda); const char* gB = (const char*)(Bt + (size_t)pn * TN * ldb);
    const unsigned ldsw = (unsigned)wid * 1024u;
    const int aoffk[2] = {pg8::lds_byte(wr * 96 + fr, fq * 8), pg8::lds_byte(wr * 96 + fr, fq * 8 + 32)}, boffk[2] = {ABYTES + pg8::lds_byte(wc * 32 + fr, fq * 8), ABYTES + pg8::lds_byte(wc * 32 + fr, fq * 8 + 32)};
#define G192_STAGE(slot, t) do { \
        _Pragma("unroll") for (int _i = 0; _i < 3; ++_i) __builtin_amdgcn_global_load_lds((const unsigned*)(gA + (size_t)(t) * (BK * 2) + voffA[_i]), (LAS unsigned*)(lds + (slot) * SBYTES + ldsw + _i * 8192), 16, 0, 0); \
        _Pragma("unroll") for (int _i = 0; _i < 2; ++_i) __builtin_amdgcn_global_load_lds((const unsigned*)(gB + (size_t)(t) * (BK * 2) + voffB[_i]), (LAS unsigned*)(lds + (slot) * SBYTES + ABYTES + ldsw + _i * 8192), 16, 0, 0); } while (0)
#define G192_WAIT_V(n) asm volatile("s_waitcnt vmcnt(" #n ")" ::: "memory")
#define G192_WAIT_L(n) asm volatile("s_waitcnt lgkmcnt(" #n ")" ::: "memory")
    f32x4 acc[6][2], tot[6][2];
#pragma unroll
    for (int m = 0; m < 6; ++m)
#pragma unroll
        for (int n = 0; n < 2; ++n) { acc[m][n] = (f32x4){0.f, 0.f, 0.f, 0.f}; tot[m][n] = (f32x4){0.f, 0.f, 0.f, 0.f}; }
    G192_STAGE(0, 0); G192_STAGE(1, 1); G192_STAGE(2, 2);
    G192_WAIT_V(10); __builtin_amdgcn_s_barrier();
#pragma unroll 1
    for (int t = 0; t < nt; ++t) {
        const int slot = t & 3;
        if (t + 3 < nt) G192_STAGE((t + 3) & 3, t + 3);
        bf16x8 At[6][2], Bf[2][2];
        const LAS unsigned char* sb = lds + slot * SBYTES;
#pragma unroll
        for (int n = 0; n < 2; ++n)
#pragma unroll
            for (int k = 0; k < 2; ++k) Bf[n][k] = *(const LAS bf16x8*)(sb + boffk[k] + n * 2048);
#pragma unroll
        for (int m = 0; m < 6; ++m)
#pragma unroll
            for (int k = 0; k < 2; ++k) At[m][k] = *(const LAS bf16x8*)(sb + aoffk[k] + m * 2048);
        G192_WAIT_L(0);
        __builtin_amdgcn_s_setprio(1);
#pragma unroll
        for (int m = 0; m < 6; ++m)
#pragma unroll
            for (int n = 0; n < 2; ++n)
#pragma unroll
                for (int k = 0; k < 2; ++k) acc[m][n] = __builtin_amdgcn_mfma_f32_16x16x32_bf16(Bf[n][k], At[m][k], acc[m][n], 0, 0, 0);
        __builtin_amdgcn_s_setprio(0);
        if (Epi::BRANCH) { if (t == 7 || t == 11 || t == nt - 1) E.seg(acc, tot, t == 7 ? 0 : (t == 11 ? 1 : 2), pm, pn, wr, wc, fr, fq); }
        if (t + 3 < nt) G192_WAIT_V(10); else if (t + 2 < nt) G192_WAIT_V(5); else G192_WAIT_V(0);
        __builtin_amdgcn_s_barrier();
    }
    E(Epi::BRANCH ? tot : acc, pm, pn, wr, wc, fr, fq);
#undef G192_STAGE
#undef G192_WAIT_V
#undef G192_WAIT_L
}
}

struct EpiBranch192 {
    static constexpr bool BRANCH = true;
    const bf16_t* G; bf16_t* mb;
    __device__ __forceinline__ void seg(g192::Acc6& acc, g192::Acc6& tot, int kind, int pm, int pn, int wr, int wc, int fr, int fq) const {
        const int col = pn * 128 + wc * 32 + 8 * fq;
#pragma unroll
        for (int m = 0; m < 6; ++m) {
            const int row = pm * 192 + wr * 96 + m * 16 + fr;
            const u32x4 gw = *(const u32x4*)(G + (size_t)row * 3072 + kind * 1024 + col);
            f32x4 g0 = {bf_lo(gw.x), bf_hi(gw.x), bf_lo(gw.y), bf_hi(gw.y)}, g1 = {bf_lo(gw.z), bf_hi(gw.z), bf_lo(gw.w), bf_hi(gw.w)};
            tot[m][0] += g0 * acc[m][0]; tot[m][1] += g1 * acc[m][1];
            acc[m][0] = (f32x4){0.f, 0.f, 0.f, 0.f}; acc[m][1] = (f32x4){0.f, 0.f, 0.f, 0.f};
        }
    }
    __device__ __forceinline__ void operator()(const g192::Acc6& tot, int pm, int pn, int wr, int wc, int fr, int fq) const {
        const int col = pn * 128 + wc * 32 + 8 * fq;
#pragma unroll
        for (int m = 0; m < 6; ++m) { const int row = pm * 192 + wr * 96 + m * 16 + fr; *(u32x4*)(mb + (size_t)row * D + col) = pk8(tot[m][0], tot[m][1]); }
    }
};
struct EpiRes192 {
    static constexpr bool BRANCH = false;
    float* x; bf16_t* xg; const float* gate; const float* gsn; float* rssn;
    __device__ __forceinline__ void seg(g192::Acc6&, g192::Acc6&, int, int, int, int, int, int, int) const {}
    __device__ __forceinline__ void operator()(const g192::Acc6& acc, int pm, int pn, int wr, int wc, int fr, int fq) const {
        const int col = pn * 128 + wc * 32 + 8 * fq;
#pragma unroll
        for (int h = 0; h < 2; ++h) {
            f32x4 xv[3][2], gt[3][2], gs[3][2];
#pragma unroll
            for (int q = 0; q < 3; ++q) {
                const int row = pm * 192 + wr * 96 + (3 * h + q) * 16 + fr;
                const int mr = row < MP ? 0 : 1 + ((row - MP) >> 10);
                const float* gp = gate + (size_t)mr * 6 * D + col; const float* sp = gsn + (size_t)mr * 6 * D + col; const float* xp = x + (size_t)row * D + col;
                xv[q][0] = *(const f32x4*)xp; xv[q][1] = *(const f32x4*)(xp + 4);
                gt[q][0] = *(const f32x4*)gp; gt[q][1] = *(const f32x4*)(gp + 4); gs[q][0] = *(const f32x4*)sp; gs[q][1] = *(const f32x4*)(sp + 4);
            }
#pragma unroll
            for (int q = 0; q < 3; ++q) {
                const int m = 3 * h + q, row = pm * 192 + wr * 96 + m * 16 + fr;
                float* xp = x + (size_t)row * D + col;
                const f32x4 x0 = xv[q][0] + gt[q][0] * acc[m][0], x1 = xv[q][1] + gt[q][1] * acc[m][1];
                *(f32x4*)xp = x0; *(f32x4*)(xp + 4) = x1;
                float ss = (x0[0] * x0[0] + x0[1] * x0[1]) + (x0[2] * x0[2] + x0[3] * x0[3]) + (x1[0] * x1[0] + x1[1] * x1[1]) + (x1[2] * x1[2] + x1[3] * x1[3]);
                *(u32x4*)(xg + (size_t)row * D + col) = pk8(x0 * gs[q][0], x1 * gs[q][1]);
                ss += __shfl_xor(ss, 16); ss += __shfl_xor(ss, 32);
                if (fq == 0) atomicAdd(rssn + row, ss);
            }
            asm volatile("" ::: "memory");
        }
    }
};

struct AttnState { f32x16 o0, o1; float m, l; };
struct KVFrag { bf16x8 k[4], v[2][2]; };
__device__ __forceinline__ void attn_load(KVFrag& f, const bf16_t* kptr  , const bf16_t* vptr  , int vstride32  ) {
#pragma unroll
    for (int s = 0; s < 4; ++s) f.k[s] = *(const bf16x8*)(kptr + 16 * s);
#pragma unroll
    for (int dt = 0; dt < 2; ++dt)
#pragma unroll
        for (int ks = 0; ks < 2; ++ks) f.v[dt][ks] = *(const bf16x8*)(vptr + (size_t)dt * vstride32 + 16 * ks);
}
__device__ __forceinline__ void attn_tile(AttnState& st, const bf16x8 (&qf)[4], const KVFrag& f, bool local, const LAS float* rl, int cq, int cs, int ck0  ) {
    f32x16 s = {0.f, 0.f, 0.f, 0.f, 0.f, 0.f, 0.f, 0.f, 0.f, 0.f, 0.f, 0.f, 0.f, 0.f, 0.f, 0.f};
#pragma unroll
    for (int k = 0; k < 4; ++k) s = __builtin_amdgcn_mfma_f32_32x32x16_bf16(f.k[k], qf[k], s, 0, 0, 0);
    if (local) {
        const LAS float* rb = rl + (ck0 - cq + 15);
        const int d0 = ck0 - cs;
#pragma unroll
        for (int i = 0; i < 16; ++i) {
            const int o = (i & 3) + 8 * (i >> 2);
            const bool ok = (unsigned)(d0 + o) < 16u;
            s[i] = ok ? s[i] + rb[o] : -1e30f;
        }
    }
    float mx = fmaxf(fmaxf(s[0], s[1]), fmaxf(s[2], s[3]));
#pragma unroll
    for (int i = 4; i < 16; i += 4) mx = fmaxf(mx, fmaxf(fmaxf(s[i], s[i + 1]), fmaxf(s[i + 2], s[i + 3])));
    mx = fmaxf(mx, __shfl_xor(mx, 32));
    const float mo = st.m, mn = fmaxf(mo, mx);
    st.m = mn;
    float ls = 0.f;
#pragma unroll
    for (int i = 0; i < 16; ++i) { const float p = __builtin_amdgcn_exp2f(s[i] - mn); s[i] = p; ls += p; }
    if (__builtin_amdgcn_ballot_w64(mn > mo) != 0ull) {
        const float alpha = __builtin_amdgcn_exp2f(mo - mn);
        st.l *= alpha;
#pragma unroll
        for (int i = 0; i < 16; ++i) { st.o0[i] *= alpha; st.o1[i] *= alpha; }
    }
    st.l += ls;
    u32x4 w0, w1;
    w0.x = pk2(s[0], s[1]); w0.y = pk2(s[2], s[3]); w0.z = pk2(s[4], s[5]); w0.w = pk2(s[6], s[7]);
    w1.x = pk2(s[8], s[9]); w1.y = pk2(s[10], s[11]); w1.z = pk2(s[12], s[13]); w1.w = pk2(s[14], s[15]);
    const bf16x8 p0 = __builtin_bit_cast(bf16x8, w0), p1 = __builtin_bit_cast(bf16x8, w1);
    st.o0 = __builtin_amdgcn_mfma_f32_32x32x16_bf16(f.v[0][0], p0, st.o0, 0, 0, 0);
    st.o0 = __builtin_amdgcn_mfma_f32_32x32x16_bf16(f.v[0][1], p1, st.o0, 0, 0, 0);
    st.o1 = __builtin_amdgcn_mfma_f32_32x32x16_bf16(f.v[1][0], p0, st.o1, 0, 0, 0);
    st.o1 = __builtin_amdgcn_mfma_f32_32x32x16_bf16(f.v[1][1], p1, st.o1, 0, 0, 0);
}
__device__ __forceinline__ void attn_store(const AttnState& st, bf16_t* orow  , int hf) {
    const float lt = st.l + __shfl_xor(st.l, 32);
    const float inv = 1.0f / lt;
#pragma unroll
    for (int g = 0; g < 4; ++g) {
        u32x2 a, b;
        a.x = pk2(st.o0[4 * g] * inv, st.o0[4 * g + 1] * inv); a.y = pk2(st.o0[4 * g + 2] * inv, st.o0[4 * g + 3] * inv);
        b.x = pk2(st.o1[4 * g] * inv, st.o1[4 * g + 1] * inv); b.y = pk2(st.o1[4 * g + 2] * inv, st.o1[4 * g + 3] * inv);
        *(u32x2*)(orow + 8 * g + 4 * hf) = a;
        *(u32x2*)(orow + 32 + 8 * g + 4 * hf) = b;
    }
}
struct AttnPtrs { const bf16_t *Q, *K, *Vt, *Kc, *Vtc; bf16_t* Abr; };
constexpr int PA_K_BYTES = 256 * 128, PA_V_BYTES = 64 * 512;
struct StageRegs { u32x4 kv[4], vv[4]; };
__device__ __forceinline__ void attn_stage_load(StageRegs& R, const bf16_t* ksrc, const bf16_t* vsrc, int vld, int nkeys, int tid) {
    const int nch = nkeys * 8, sh = nkeys == 256 ? 5 : 3;
#pragma unroll
    for (int i = 0; i < 4; ++i) { int q = tid + 512 * i; q = q < nch ? q : nch - 1;
        R.kv[i] = *(const u32x4*)(ksrc + (size_t)(q >> 3) * NAW + 8 * (q & 7));
        R.vv[i] = *(const u32x4*)(vsrc + (size_t)(q >> sh) * vld + 8 * (q & ((1 << sh) - 1))); }
}
__device__ __forceinline__ void attn_stage_store(const StageRegs& R, int nkeys, LAS unsigned char* kl, LAS unsigned char* vl, int tid) {
    const int nch = nkeys * 8, sh = nkeys == 256 ? 5 : 3;
#pragma unroll
    for (int i = 0; i < 4; ++i) { const int q = tid + 512 * i; if (q < nch) {
        const int key = q >> 3, c = q & 7, d = q >> sh, cv = q & ((1 << sh) - 1);
        *(LAS u32x4*)(kl + key * 128 + ((c ^ (key & 7)) << 4)) = R.kv[i];
        *(LAS u32x4*)(vl + d * 512 + ((cv ^ (d & 15)) << 4)) = R.vv[i]; } }
}
__device__ __forceinline__ void attn_lds_frag(KVFrag& f, const LAS unsigned char* kl, const LAS unsigned char* vl, int kt, int r32, int hf) {
    const int key = 32 * kt + r32;
#pragma unroll
    for (int s = 0; s < 4; ++s) f.k[s] = *(const LAS bf16x8*)(kl + key * 128 + (((2 * s + hf) ^ (key & 7)) << 4));
#pragma unroll
    for (int dt = 0; dt < 2; ++dt)
#pragma unroll
        for (int ks = 0; ks < 2; ++ks) { const int d = 32 * dt + r32; f.v[dt][ks] = *(const LAS bf16x8*)(vl + d * 512 + (((4 * kt + 2 * ks + hf) ^ (d & 15)) << 4)); }
}
__device__ __forceinline__ void attn_prompt_lds(const AttnPtrs& P, const LAS unsigned char* kl, const LAS unsigned char* vl, int bh, int qt, int lane) {
    const int r32 = lane & 31, hf = lane >> 5, b = bh >> 3, h = bh & 7;
    const int qrow = b * 256 + qt * 32 + r32;
    bf16x8 qf[4];
#pragma unroll
    for (int s = 0; s < 4; ++s) qf[s] = *(const bf16x8*)(P.Q + (size_t)qrow * NAW + h * 64 + 16 * s + 8 * hf);
    AttnState st; st.m = -1e30f; st.l = 0.f;
#pragma unroll
    for (int i = 0; i < 16; ++i) { st.o0[i] = 0.f; st.o1[i] = 0.f; }
    KVFrag fa, fb;
    attn_lds_frag(fa, kl, vl, 0, r32, hf);
#pragma unroll 1
    for (int t = 0; t < 8; t += 2) {
        attn_lds_frag(fb, kl, vl, t + 1, r32, hf);
        attn_tile(st, qf, fa, false, nullptr, 0, 0, 0);
        if (t + 2 < 8) attn_lds_frag(fa, kl, vl, t + 2, r32, hf);
        attn_tile(st, qf, fb, false, nullptr, 0, 0, 0);
    }
    attn_store(st, P.Abr + (size_t)qrow * D + h * 64, hf);
}
constexpr int ATT_PART_FLOATS = 34 * 64;
__device__ __forceinline__ void attn_sample_block(const AttnPtrs& P, LAS unsigned char* kl, LAS unsigned char* vl, const LAS float* rpl, LAS float* parts, int blk, int wave, int lane) {
    const int r32 = lane & 31, hf = lane >> 5, tid = wave * 64 + lane;
    const int bs = blk >> 6, h = (blk >> 3) & 7, i2 = (blk & 7) * 2;
    const int u = wave >> 1, half = wave & 1, r = i2 + (u >> 1), qh = u & 1;
    const int qrow = MP + bs * 1024 + r * 64 + qh * 32 + r32;
    const int cq = qh * 32 + r32; int cs = cq - 8; cs = cs < 0 ? 0 : (cs > 48 ? 48 : cs);
    int rs = r - 4; rs = rs < 0 ? 0 : (rs > 8 ? 8 : rs);
    int rs0 = i2 - 4; rs0 = rs0 < 0 ? 0 : (rs0 > 8 ? 8 : rs0);
    int rs1 = i2 - 3; rs1 = rs1 < 0 ? 0 : (rs1 > 8 ? 8 : rs1);
    const int nstage = rs1 != rs0 ? 4 : 3;
    const bf16_t* kloc = P.K + (size_t)(MP + bs * 1024) * NAW + h * 64;
    const bf16_t* vloc = P.Vt + VT_SAMPLE_OFF + (size_t)((bs * 8 + h) * 64) * 1024;
    bf16x8 qf[4];
#pragma unroll
    for (int s = 0; s < 4; ++s) qf[s] = *(const bf16x8*)(P.Q + (size_t)qrow * NAW + h * 64 + 16 * s + 8 * hf);
    AttnState st; st.m = -1e30f; st.l = 0.f;
#pragma unroll
    for (int i = 0; i < 16; ++i) { st.o0[i] = 0.f; st.o1[i] = 0.f; }
    LAS float* part = parts + u * ATT_PART_FLOATS;
    StageRegs R;
    attn_stage_load(R, P.Kc + (size_t)(bs * 256) * NAW + h * 64, P.Vtc + (size_t)((bs * 8 + h) * 64) * 256, 256, 256, tid);
#pragma unroll 1
    for (int sg = 0; sg < nstage; ++sg) {
        if (sg) __syncthreads();
        const int row0 = rs0 + 4 * (sg - 1);
        attn_stage_store(R, sg == 3 ? 64 : 256, kl, vl, tid);
        { const int sn = sg + 1 < nstage ? sg + 1 : 1, rown = rs0 + 4 * (sn - 1);
          attn_stage_load(R, kloc + (size_t)(rown * 64) * NAW, vloc + rown * 64, 1024, sn == 3 ? 64 : 256, tid); }
        LDS_WAIT(); __syncthreads();
        KVFrag f;
        if (sg == 0) {
#pragma unroll 1
            for (int kt = 4 * half; kt < 4 * half + 4; ++kt) { attn_lds_frag(f, kl, vl, kt, r32, hf); attn_tile(st, qf, f, false, nullptr, 0, 0, 0); }
        } else {
            const int nt = sg == 3 ? 2 : 8;
#pragma unroll 1
            for (int kt = half * (nt >> 1); kt < (half + 1) * (nt >> 1); ++kt) {
                const int jr = row0 + (kt >> 1), ch = kt & 1;
                if (jr < rs || jr >= rs + 8) continue;
                attn_lds_frag(f, kl, vl, kt, r32, hf);
                attn_tile(st, qf, f, true, rpl + (h * 15 + (jr - r + 7)) * 31, cq, cs, ch * 32 + 4 * hf);
            }
        }
    }
    if (half == 1) {
#pragma unroll
        for (int i = 0; i < 16; ++i) { part[i * 64 + lane] = st.o0[i]; part[(16 + i) * 64 + lane] = st.o1[i]; }
        part[32 * 64 + lane] = st.m; part[33 * 64 + lane] = st.l;
    }
    LDS_WAIT(); __syncthreads();
    if (half == 0) {
        const float m1 = part[32 * 64 + lane], l1 = part[33 * 64 + lane];
        const float mn = fmaxf(st.m, m1), a0 = __builtin_amdgcn_exp2f(st.m - mn), a1 = __builtin_amdgcn_exp2f(m1 - mn);
        st.l = st.l * a0 + l1 * a1;
#pragma unroll
        for (int i = 0; i < 16; ++i) { st.o0[i] = st.o0[i] * a0 + part[i * 64 + lane] * a1; st.o1[i] = st.o1[i] * a0 + part[(16 + i) * 64 + lane] * a1; }
        attn_store(st, P.Abr + (size_t)qrow * D + h * 64, hf);
    }
}

struct PcPtrs { const bf16_t *Pin, *Cin; const float *wdw, *bdw, *cng, *cnb; bf16_t* Abr; };
__device__ __forceinline__ f32x4 ld_bf4(const bf16_t* p) { const u32x2 w = *(const u32x2*)p; return (f32x4){bf_lo(w.x), bf_hi(w.x), bf_lo(w.y), bf_hi(w.y)}; }
__device__ __forceinline__ f32x4 up_bf4(u32x2 w) { return (f32x4){bf_lo(w.x), bf_hi(w.x), bf_lo(w.y), bf_hi(w.y)}; }
__device__ __forceinline__ void pool_unit(const PcPtrs& P, int unit, int lane) {
    const int row0 = unit * 16;
    const int L = row0 < MP ? 256 : 1024;
    const int sb = row0 < MP ? (row0 & ~255) : MP + ((row0 - MP) & ~1023);
    const int hw = 1 << (lane >> 4);
#pragma unroll 1
    for (int g = 0; g < 2; ++g) {
        const int t0 = row0 - sb + 8 * g;
        u32x2 pv[24];
#pragma unroll
        for (int i = 0; i < 24; ++i) { int t = t0 - 8 + i; t = t < 0 ? 0 : (t > L - 1 ? L - 1 : t); pv[i] = *(const u32x2*)(P.Pin + (size_t)(sb + t) * PW + 4 * lane); }
#pragma unroll
        for (int tt = 0; tt < 8; ++tt) {
            f32x4 sum = {0.f, 0.f, 0.f, 0.f}; float cnt = 0.f;
#pragma unroll
            for (int o = -8; o < 8; ++o) {
                const int t = t0 + tt + o;
                const bool in = (o >= -hw) && (o < hw) && (t >= 0) && (t < L);
                const f32x4 v = up_bf4(pv[tt + o + 8]);
                sum += in ? v : (f32x4){0.f, 0.f, 0.f, 0.f}; cnt += in ? 1.f : 0.f;
            }
            const f32x4 r = sum * __builtin_amdgcn_rcpf(cnt) - up_bf4(pv[tt + 8]);
            u32x2 w; w.x = pk2(r[0], r[1]); w.y = pk2(r[2], r[3]);
            *(u32x2*)(P.Abr + (size_t)(sb + t0 + tt) * D + 512 + 4 * lane) = w;
        }
    }
}
__device__ __forceinline__ void conv_unit(const PcPtrs& P, const LAS float* wl, int unit, int lane) {
    constexpr int T = 8;
    const int row0 = unit * T;
    const int L = row0 < MP ? 256 : 1024;
    const int sb = row0 < MP ? (row0 & ~255) : MP + ((row0 - MP) & ~1023);
    const int t0 = row0 - sb;
    f32x4 acc[T];
    const f32x4 bias = *(const f32x4*)(P.bdw + 4 * lane);
#pragma unroll
    for (int tt = 0; tt < T; ++tt) acc[tt] = bias;
#pragma unroll 1
    for (int c = 0; c < 2; ++c) {
        u32x2 ar[20], gr[20];
#pragma unroll
        for (int i = 0; i < 20; ++i) {
            const int t = t0 - 15 + 20 * c + i;
            const bool ok = (t >= 0) && (t < L);
            const bf16_t* p = P.Cin + (size_t)(sb + (ok ? t : 0)) * 512 + 4 * lane;
            ar[i] = *(const u32x2*)p; gr[i] = *(const u32x2*)(p + 256);
            if (!ok) { ar[i] = (u32x2){0u, 0u}; }
        }
#pragma unroll
        for (int g4 = 0; g4 < 5; ++g4) {
            const int s0 = 20 * c + 4 * g4;
            f32x4 tp[11];
#pragma unroll
            for (int q = 0; q < 11; ++q) tp[q] = *(const LAS f32x4*)(wl + (s0 + q) * CW + 4 * lane);
#pragma unroll
            for (int i = 0; i < 4; ++i) {
                const f32x4 a = up_bf4(ar[4 * g4 + i]), g = up_bf4(gr[4 * g4 + i]);
                f32x4 hh;
#pragma unroll
                for (int e = 0; e < 4; ++e) hh[e] = a[e] * sigmoidf_(g[e]);
#pragma unroll
                for (int tt = 0; tt < T; ++tt) acc[tt] += hh * tp[i - tt + 7];
            }
            asm volatile("" ::: "memory");
        }
    }
    const f32x4 lg = *(const f32x4*)(P.cng + 4 * lane), lb = *(const f32x4*)(P.cnb + 4 * lane);
    float s1[T], s2[T];
#pragma unroll
    for (int tt = 0; tt < T; ++tt) s1[tt] = (acc[tt][0] + acc[tt][1]) + (acc[tt][2] + acc[tt][3]);
#pragma unroll
    for (int o = 1; o < 64; o <<= 1)
#pragma unroll
        for (int tt = 0; tt < T; ++tt) s1[tt] += __shfl_xor(s1[tt], o);
#pragma unroll
    for (int tt = 0; tt < T; ++tt) { const float mu = s1[tt] * (1.0f / CW); acc[tt] = acc[tt] - mu; s2[tt] = (acc[tt][0] * acc[tt][0] + acc[tt][1] * acc[tt][1]) + (acc[tt][2] * acc[tt][2] + acc[tt][3] * acc[tt][3]); }
#pragma unroll
    for (int o = 1; o < 64; o <<= 1)
#pragma unroll
        for (int tt = 0; tt < T; ++tt) s2[tt] += __shfl_xor(s2[tt], o);
#pragma unroll
    for (int tt = 0; tt < T; ++tt) {
        const float rstd = 1.0f / sqrtf(s2[tt] * (1.0f / CW) + EPS);
        f32x4 y = acc[tt] * rstd * lg + lb;
#pragma unroll
        for (int e = 0; e < 4; ++e) y[e] = y[e] * sigmoidf_(y[e]);
        u32x2 o; o.x = pk2(y[0], y[1]); o.y = pk2(y[2], y[3]);
        *(u32x2*)(P.Abr + (size_t)(row0 + tt) * D + 768 + 4 * lane) = o;
    }
}

#define XB_TMO      128
#define XB_XCNT(j)  (256  + 64 * (j))
#define XB_XSUB(j)  (1280 + 64 * (j))
#define XB_XGEN(j)  (2304 + 64 * (j))
#define XB_TOP      3328
#define XB_TOPGEN   3392
#define XCD_BAR_WORDS 3456
#define XB_SPIN_CAP (1u << 18)
__device__ __forceinline__ unsigned xb_ld(unsigned* p)              { return __hip_atomic_load(p, __ATOMIC_RELAXED, __HIP_MEMORY_SCOPE_AGENT); }
__device__ __forceinline__ unsigned xb_add(unsigned* p, unsigned v) { return __hip_atomic_fetch_add(p, v, __ATOMIC_RELAXED, __HIP_MEMORY_SCOPE_AGENT); }
__device__ __forceinline__ unsigned xb_xcc_id() { return (unsigned)__builtin_amdgcn_s_getreg((3 << 11) | 20) & 0xFu; }
#define XB_SPIN(cond, bar) do { unsigned _sp = 0; while (cond) { __builtin_amdgcn_s_sleep(1); \
    if ((++_sp & 255u) == 0u) { if (xb_ld(&(bar)[XB_TMO])) break; if (_sp > XB_SPIN_CAP) { atomicAdd(&(bar)[XB_TMO], 1u); break; } } } } while (0)
struct XcdBarrier { unsigned* bar; unsigned x; unsigned nloc, nx; };
__device__ __forceinline__ XcdBarrier xcd_barrier_post(unsigned* bar) {
    XcdBarrier b; b.bar = bar; b.x = xb_xcc_id(); b.nloc = 0u; b.nx = 0u;
    if (threadIdx.x == 0) (void)xb_add(&bar[XB_XCNT(b.x)], 1u);
    return b;
}
__device__ __forceinline__ void xcd_barrier_complete(unsigned* bar, unsigned x, unsigned& nloc, unsigned& nx) {
    const unsigned G = gridDim.x * gridDim.y * gridDim.z;
    unsigned sum, cnt, mine, sp = 0u;
    for (;;) {
        sum = 0u; cnt = 0u; mine = 0u;
#pragma unroll
        for (unsigned j = 0; j < 16; ++j) { const unsigned c = xb_ld(&bar[XB_XCNT(j)]); sum += c; cnt += (c > 0u) ? 1u : 0u; mine = (j == x) ? c : mine; }
        if (sum == G) break;
        __builtin_amdgcn_s_sleep(1);
        if ((++sp & 255u) == 0u) { if (xb_ld(&bar[XB_TMO])) break; if (sp > XB_SPIN_CAP) { atomicAdd(&bar[XB_TMO], 1u); break; } }
    }
    nloc = mine > 0u ? mine : 1u; nx = cnt > 0u ? cnt : 1u;
}
__device__ __forceinline__ void xcd_barrier(XcdBarrier& b) {
    asm volatile("s_waitcnt vmcnt(0)" ::: "memory");
    __syncthreads();
    if (threadIdx.x == 0) {
        unsigned* bar = b.bar;
        __builtin_amdgcn_s_waitcnt(0);
        unsigned nloc = b.nloc, nx = b.nx;
        if (nloc == 0u) { xcd_barrier_complete(bar, b.x, nloc, nx); b.nloc = nloc; b.nx = nx; }
        const unsigned old = xb_add(&bar[XB_XSUB(b.x)], 1u);
        const unsigned gen = old / nloc;
        if (old + 1u == (gen + 1u) * nloc) {
            __builtin_amdgcn_fence(__ATOMIC_RELEASE, "agent");
            asm volatile("s_waitcnt vmcnt(0)" ::: "memory");
            const unsigned og = xb_add(&bar[XB_TOP], 1u);
            const unsigned tg = og / nx;
            if (og + 1u == (tg + 1u) * nx) xb_add(&bar[XB_TOPGEN], 1u);
            else XB_SPIN(xb_ld(&bar[XB_TOPGEN]) == tg, bar);
            __builtin_amdgcn_fence(__ATOMIC_ACQUIRE, "agent");
            xb_add(&bar[XB_XGEN(b.x)], 1u);
            asm volatile("s_waitcnt vmcnt(0)" ::: "memory");
        } else {
            XB_SPIN(xb_ld(&bar[XB_XGEN(b.x)]) == gen, bar);
            __builtin_amdgcn_fence(__ATOMIC_ACQUIRE, "agent");
            asm volatile("s_waitcnt vmcnt(0)" ::: "memory");
        }
    }
    __syncthreads();
}

constexpr int TP_PITCH = 65, TP_BYTES = 64 * TP_PITCH * 4;
template <bool WITH_C, bool GU_PERM>
__device__ __forceinline__ void transpose_item(const float* W, int N, bf16_t* WT, int ldt, int kcol0, LAS float* scr, int item, int lane,
                                               const float* shraw  , const float* shb  , float* csum  ) {
    const int nblk = N / 64, kb = item / nblk, nb = item % nblk, k0 = 64 * kb, n0 = 64 * nb;
    {
        const int r4 = lane >> 4, c4 = lane & 15;
        f32x4 v[16];
#pragma unroll
        for (int i = 0; i < 16; ++i) v[i] = __builtin_nontemporal_load((const f32x4*)(W + (size_t)(k0 + 4 * i + r4) * N + n0 + 4 * c4));
#pragma unroll
        for (int i = 0; i < 16; ++i) { LAS float* p = scr + (4 * i + r4) * TP_PITCH + 4 * c4; p[0] = v[i][0]; p[1] = v[i][1]; p[2] = v[i][2]; p[3] = v[i][3]; }
    }
    const int c = lane & 7, nn = lane >> 3;
    f32x4 sh[3][2];
    if (WITH_C) {
#pragma unroll
        for (int r = 0; r < 3; ++r)
#pragma unroll
            for (int h = 0; h < 2; ++h) sh[r][h] = *(const f32x4*)(shraw + (size_t)r * NMOD + k0 + 8 * c + 4 * h) + *(const f32x4*)(shb + k0 + 8 * c + 4 * h);
    }
    LDS_WAIT(); asm volatile("" ::: "memory");
#pragma unroll
    for (int j = 0; j < 8; ++j) {
        const int n = 8 * j + nn; const LAS float* s = scr + (8 * c) * TP_PITCH + n;
        float w[8];
#pragma unroll
        for (int q = 0; q < 8; ++q) w[q] = s[q * TP_PITCH];
        u32x4 o; o.x = pk2(w[0], w[1]); o.y = pk2(w[2], w[3]); o.z = pk2(w[4], w[5]); o.w = pk2(w[6], w[7]);
        int nrow = n0 + n;
        if (GU_PERM) nrow = nrow < FFN ? ((nrow >> 7) * 256 + (nrow & 127)) : (((nrow - FFN) >> 7) * 256 + 128 + ((nrow - FFN) & 127));
        *(u32x4*)(WT + (size_t)nrow * ldt + kcol0 + k0 + 8 * c) = o;
        if (WITH_C) {
            float d0 = 0.f, d1 = 0.f, d2 = 0.f;
#pragma unroll
            for (int q = 0; q < 8; ++q) { d0 += sh[0][q >> 2][q & 3] * w[q]; d1 += sh[1][q >> 2][q & 3] * w[q]; d2 += sh[2][q >> 2][q & 3] * w[q]; }
#pragma unroll
            for (int x = 1; x < 8; x <<= 1) { d0 += __shfl_xor(d0, x); d1 += __shfl_xor(d1, x); d2 += __shfl_xor(d2, x); }
            if (c == 0) { atomicAdd(csum + n0 + n, d0); atomicAdd(csum + N + n0 + n, d1); atomicAdd(csum + 2 * N + n0 + n, d2); }
        }
    }
    LDS_WAIT(); asm volatile("" ::: "memory");
}

constexpr int NWAVES = 8;
constexpr int LDS_BYTES = 163840;
static_assert(8 * TP_BYTES <= LDS_BYTES, "LDS map");
constexpr int NPHASE = 2 + 6 * DEPTH + 1;

struct Args {
    const float* in[26]; float* out; unsigned char* ws; int ph_lo, ph_hi;
};

__global__ void __launch_bounds__(NWAVES * 64, 2) fwd_kernel(Args args) {
    extern __shared__ __attribute__((aligned(16))) unsigned char lds_raw[];
    LAS unsigned char* lds = (LAS unsigned char*)lds_raw;
    const int tid = threadIdx.x, lane = tid & 63, wave = __builtin_amdgcn_readfirstlane(tid >> 6);
    const int G = gridDim.x, bx = blockIdx.x;
    const int vcu = (G % 8 == 0) ? (bx % 8) * (G / 8) + bx / 8 : bx;
    const int gw = vcu * NWAVES + wave, NGW = G * NWAVES;
    unsigned char* ws = args.ws;
    float* ctlf = (float*)(ws + WS_CTL);
    const float* x_prompt = args.in[0]; const float* x_sample = args.in[1]; const float* cache_k = args.in[2]; const float* cache_v = args.in[3];
    const float* cvec = args.in[4]; const float* c_ctx = args.in[5]; const float* w_mod = args.in[6]; const float* b_mod = args.in[7];
    const float* norm1_g = args.in[8]; const float* norm2_g = args.in[9]; const float* w_in = args.in[10]; const float* b_gate = args.in[11];
    const float* rpb = args.in[12]; const float* w_oa = args.in[13]; const float* w_pool = args.in[14]; const float* pool_scale = args.in[15];
    const float* w_ob = args.in[16]; const float* w_dw = args.in[17]; const float* b_dw = args.in[18]; const float* conv_norm_g = args.in[19];
    const float* conv_norm_b = args.in[20]; const float* w_oc = args.in[21]; const float* w_out = args.in[22]; const float* w_gu = args.in[23];
    const float* w_down = args.in[24]; const float* final_g = args.in[25];
    float* MODRAW = ctlf + CF_MODRAW; float* C1 = ctlf + CF_C1; float* C2 = ctlf + CF_C2; float* RSS = ctlf + CF_RSS;
    float* MODT = (float*)(ws + WS_MODT);
    bf16_t* WIN = (bf16_t*)(ws + WS_WIN); bf16_t* WGU = (bf16_t*)(ws + WS_WGU); bf16_t* WDN = (bf16_t*)(ws + WS_WDN); bf16_t* WBR = (bf16_t*)(ws + WS_WBR); bf16_t* WOUT = (bf16_t*)(ws + WS_WOUT);
    float* X = (float*)(ws + WS_X); bf16_t* XG = (bf16_t*)(ws + WS_XG);
    bf16_t* Qb = (bf16_t*)(ws + WS_Q); bf16_t* Kb = (bf16_t*)(ws + WS_K); bf16_t* VT = (bf16_t*)(ws + WS_VT); bf16_t* KC = (bf16_t*)(ws + WS_KC); bf16_t* VTC = (bf16_t*)(ws + WS_VTC);
    bf16_t* PIN = (bf16_t*)(ws + WS_PIN); bf16_t* CIN = (bf16_t*)(ws + WS_CIN); bf16_t* GT = (bf16_t*)(ws + WS_G); bf16_t* ABR = (bf16_t*)(ws + WS_ABR);
    float* MF = (float*)(ws + WS_MF); bf16_t* MB = (bf16_t*)(ws + WS_MB); bf16_t* ACT = (bf16_t*)(ws + WS_ACT);

#if !MK_PER_PHASE
    XcdBarrier bar = xcd_barrier_post((unsigned*)(ws + WS_CTL) + CW_BAR);
#define GRID_BAR() xcd_barrier(bar)
#else
#define GRID_BAR() do {} while (0)
#endif
    const int lo = args.ph_lo, hi = args.ph_hi;
#define IN(k) (lo <= (k) && (k) < hi)
#define SEAM(k) do { if (IN(k) && IN((k) + 1)) GRID_BAR(); } while (0)

    for (int rep_ = 0; rep_ < MK_REPS(4); ++rep_) { if (rep_) GRID_BAR();
    float* MODRAW_W = rep_ ? MF : MODRAW; float* C1_W = rep_ ? MF + DEPTH * 3 * NMOD : C1; float* C2_W = rep_ ? MF + DEPTH * 3 * (NMOD + NIN) : C2;
    if (IN(0)) {
        LAS float* sil = (LAS float*)lds; LAS float* red = (LAS float*)(lds + 16384);
        for (int i = tid; i < 3 * D; i += NWAVES * 64) { const float s = i < D ? c_ctx[i] : cvec[i - D]; sil[i] = s * sigmoidf_(s); }
        __syncthreads();
        for (int it = vcu; it < DEPTH * 24 * 8; it += G) {
            const int l = it / 192, rem = it % 192, nc = rem >> 3, kq = rem & 7, k0 = kq * 128 + wave * 16, n0 = nc * 256 + 4 * lane;
            const float* wp = w_mod + ((size_t)l * D + k0) * NMOD + n0;
            f32x4 w[16];
#pragma unroll
            for (int kk = 0; kk < 16; ++kk) w[kk] = __builtin_nontemporal_load((const f32x4*)(wp + (size_t)kk * NMOD));
            f32x4 a0 = {0.f, 0.f, 0.f, 0.f}, a1 = a0, a2 = a0;
#pragma unroll
            for (int kk = 0; kk < 16; ++kk) { a0 += sil[k0 + kk] * w[kk]; a1 += sil[D + k0 + kk] * w[kk]; a2 += sil[2 * D + k0 + kk] * w[kk]; }
#pragma unroll
            for (int e = 0; e < 4; ++e) { red[(wave * 12 + e) * 64 + lane] = a0[e]; red[(wave * 12 + 4 + e) * 64 + lane] = a1[e]; red[(wave * 12 + 8 + e) * 64 + lane] = a2[e]; }
            __syncthreads();
            for (int o = tid; o < 12 * 64; o += NWAVES * 64) {
                float s = 0.f;
#pragma unroll
                for (int ww = 0; ww < 8; ++ww) s += red[ww * 768 + o];
                const int q = o >> 6, ln = o & 63, r = q >> 2, e = q & 3;
                atomicAdd(MODRAW_W + (size_t)(l * 3 + r) * NMOD + nc * 256 + 4 * ln + e, s);
            }
            __syncthreads();
        }
    }
    SEAM(0);

    if (IN(1)) {
        LAS float* scr = (LAS float*)(lds + wave * TP_BYTES);
        constexpr int I_IN = 16 * (NIN / 64), I_GU = 16 * (NGU / 64), I_DN = (FFN / 64) * 16, I_OUT = 16 * 16, I_OA = 8 * 16, I_OC = 4 * 16;
        constexpr int I_LAYER = I_IN + I_GU + I_DN + I_OUT + I_OA + I_OC;
        constexpr int I_T = DEPTH * I_LAYER;
        constexpr int I_OB = DEPTH * 16 * 4 * 8;
        constexpr int I_X = M;
        constexpr int I_KC = DEPTH * 2 * 256;
        constexpr int I_VC = DEPTH * 2 * 8 * 4;
        constexpr int I_MT = DEPTH * 3 * 6 * 4;
        constexpr int I_ALL = I_T + I_OB + I_X + I_KC + I_VC + I_MT;
        for (int it0 = gw; it0 < I_ALL; it0 += NGW) {
            int it = it0;
            if (it < I_T) {
                const int l = it / I_LAYER; int r = it % I_LAYER;
                const float* shraw1 = MODRAW + (size_t)(l * 3) * NMOD;
                const float* shraw2 = MODRAW + (size_t)(l * 3) * NMOD + 3 * D;
                if (r < I_IN) { transpose_item<true, false>(w_in + (size_t)l * D * NIN, NIN, WIN + (size_t)l * NIN * D, D, 0, scr, r, lane, shraw1, b_mod + (size_t)l * NMOD, C1_W + (size_t)(l * 3) * NIN); continue; } r -= I_IN;
                if (r < I_GU) { transpose_item<true, true>(w_gu + (size_t)l * D * NGU, NGU, WGU + (size_t)l * NGU * D, D, 0, scr, r, lane, shraw2, b_mod + (size_t)l * NMOD + 3 * D, C2_W + (size_t)(l * 3) * NGU); continue; } r -= I_GU;
                if (r < I_DN) { transpose_item<false, false>(w_down + (size_t)l * FFN * D, D, WDN + (size_t)l * D * FFN, FFN, 0, scr, r, lane, nullptr, nullptr, nullptr); continue; } r -= I_DN;
                if (r < I_OUT) { transpose_item<false, false>(w_out + (size_t)l * D * D, D, WOUT + (size_t)l * D * D, D, 0, scr, r, lane, nullptr, nullptr, nullptr); continue; } r -= I_OUT;
                if (r < I_OA) { transpose_item<false, false>(w_oa + (size_t)l * NAW * D, D, WBR + (size_t)l * D * D, D, 0, scr, r, lane, nullptr, nullptr, nullptr); continue; } r -= I_OA;
                transpose_item<false, false>(w_oc + (size_t)l * CW * D, D, WBR + (size_t)l * D * D, D, 768, scr, r, lane, nullptr, nullptr, nullptr);
                continue;
            }
            it -= I_T;
            if (it < I_OB) {
                const int l = it / 512, rem = it % 512, nch = rem >> 5, g = (rem >> 3) & 3, cc = rem & 7, n = nch * 64 + lane;
                float a[8];
#pragma unroll
                for (int c = 0; c < 8; ++c) a[c] = 0.f;
                const float* wp = w_pool + ((size_t)(l * 4 + g) * 64 + cc * 8) * 64;
                for (int d = 0; d < 64; ++d) {
                    const float wb = w_ob[((size_t)l * PW + g * 64 + d) * D + n] * pool_scale[l * PW + g * 64 + d];
#pragma unroll
                    for (int c = 0; c < 8; ++c) a[c] += wp[c * 64 + d] * wb;
                }
                u32x4 o; o.x = pk2(a[0], a[1]); o.y = pk2(a[2], a[3]); o.z = pk2(a[4], a[5]); o.w = pk2(a[6], a[7]);
                *(u32x4*)(WBR + ((size_t)l * D + n) * D + 512 + g * 64 + cc * 8) = o;
                continue;
            }
            it -= I_OB;
            if (it < I_X) {
                const int row = it, mr = row < MP ? 0 : 1 + ((row - MP) >> 10);
                const float* xr = row < MP ? x_prompt + (size_t)row * D : x_sample + (size_t)(row - MP) * D;
                float ss = 0.f;
#pragma unroll
                for (int j = 0; j < 4; ++j) {
                    const int col = 256 * j + 4 * lane;
                    const f32x4 v = *(const f32x4*)(xr + col);
                    *(f32x4*)(X + (size_t)row * D + col) = v;
                    ss += (v[0] * v[0] + v[1] * v[1]) + (v[2] * v[2] + v[3] * v[3]);
                    const f32x4 sc = *(const f32x4*)(MODRAW + (size_t)mr * NMOD + D + col) + *(const f32x4*)(b_mod + D + col);
                    const f32x4 gg = *(const f32x4*)(norm1_g + col) * (sc + 1.0f);
                    const f32x4 xs = v * gg;
                    u32x2 o; o.x = pk2(xs[0], xs[1]); o.y = pk2(xs[2], xs[3]);
                    *(u32x2*)(XG + (size_t)row * D + col) = o;
                }
                ss = wave_sum(ss);
                if (lane == 0) RSS[row] = ss;
                continue;
            }
            it -= I_X;
            if (it < I_KC) {
                const int l = it / 512, bs = (it >> 8) & 1, key = it & 255;
                const float* src = cache_k + (((size_t)(bs * DEPTH + l) * 256 + key) * 512) + 8 * lane;
                const f32x4 a = *(const f32x4*)src, b = *(const f32x4*)(src + 4);
                *(u32x4*)(KC + (((size_t)(l * 2 + bs) * 256 + key) * 512) + 8 * lane) = pk8(a, b);
                continue;
            }
            it -= I_KC;
            if (it < I_VC) {
                const int l = it / 64, bs = (it >> 5) & 1, h = (it >> 2) & 7, kb = it & 3, key = kb * 64 + lane;
                const float* src = cache_v + (((size_t)(bs * DEPTH + l) * 256 + key) * 512) + h * 64;
                bf16_t* dst = VTC + ((size_t)((l * 2 + bs) * 8 + h) * 64) * 256 + pos_of_key(key);
#pragma unroll
                for (int d4 = 0; d4 < 16; ++d4) {
                    const f32x4 v = *(const f32x4*)(src + 4 * d4);
                    const unsigned w0 = pk2(v[0], v[1]), w1 = pk2(v[2], v[3]);
                    dst[(size_t)(4 * d4 + 0) * 256] = (bf16_t)(w0 & 0xffff); dst[(size_t)(4 * d4 + 1) * 256] = (bf16_t)(w0 >> 16);
                    dst[(size_t)(4 * d4 + 2) * 256] = (bf16_t)(w1 & 0xffff); dst[(size_t)(4 * d4 + 3) * 256] = (bf16_t)(w1 >> 16);
                }
                continue;
            }
            it -= I_VC;
            {
                const int q = it & 3, which = (it >> 2) % 6, lr = it / 24, l = lr / 3, col = q * 256 + 4 * lane;
                const float* mraw = MODRAW + (size_t)lr * NMOD; const float* bm = b_mod + (size_t)l * NMOD;
                f32x4 v;
                if (which == 0) v = *(const f32x4*)(norm1_g + (size_t)l * D + col) * (*(const f32x4*)(mraw + D + col) + *(const f32x4*)(bm + D + col) + 1.0f);
                else if (which == 1) v = *(const f32x4*)(mraw + col) + *(const f32x4*)(bm + col);
                else if (which == 2) v = *(const f32x4*)(mraw + 2 * D + col) + *(const f32x4*)(bm + 2 * D + col);
                else if (which == 3) v = *(const f32x4*)(norm2_g + (size_t)l * D + col) * (*(const f32x4*)(mraw + 4 * D + col) + *(const f32x4*)(bm + 4 * D + col) + 1.0f);
                else if (which == 4) v = *(const f32x4*)(mraw + 3 * D + col) + *(const f32x4*)(bm + 3 * D + col);
                else v = *(const f32x4*)(mraw + 5 * D + col) + *(const f32x4*)(bm + 5 * D + col);
                *(f32x4*)(MODT + ((size_t)lr * 6 + which) * D + col) = v;
            }
        }
        LDS_WAIT(); __syncthreads();
    }
    }
    SEAM(1);

    for (int l = 0; l < DEPTH; ++l) {
        const int p0 = 2 + 6 * l;
        const float* modt_l = MODT + (size_t)l * 3 * 6 * D;
        for (int rep_ = 0; rep_ < MK_REPS(0); ++rep_) { if (rep_) GRID_BAR();
        if (IN(p0)) {
            pg8::Gemm g{XG, WIN + (size_t)l * NIN * D, D, D};
            pg8::TileOrder S; S.init(M, NIN, D, G, bx);
            EpiIn E{RSS + (size_t)(2 * l) * M, C1 + (size_t)(l * 3) * NIN, b_gate + (size_t)l * 3072, Qb, Kb, VT, PIN, CIN, GT,
                    args.out + OUT_K + (size_t)l * 256 * 512, args.out + OUT_V + (size_t)l * 256 * 512};
            pg8::gemm_phase<EpiIn, pg8::TileOrder>(lds, g, S, E);
        }
        }
        SEAM(p0);
        for (int rep_ = 0; rep_ < MK_REPS(1); ++rep_) { if (rep_) GRID_BAR();
        if (IN(p0 + 1)) {
            AttnPtrs AP{Qb, Kb, VT, KC + (size_t)l * 2 * 256 * 512, VTC + (size_t)l * 2 * 8 * 64 * 256, ABR};
            PcPtrs PP{PIN, CIN, w_dw + (size_t)l * CONVK * CW, b_dw + (size_t)l * CW, conv_norm_g + (size_t)l * CW, conv_norm_b + (size_t)l * CW, ABR};
            int lane_p = lane; asm volatile("" : "+v"(lane_p));
            if (vcu < 128) {
                LAS float* rpl = (LAS float*)(lds + 1024); LAS float* parts = (LAS float*)(lds + 16384);
                LAS unsigned char* kl = lds + 53248; LAS unsigned char* vl = kl + PA_K_BYTES;
                const float* rpb_l = rpb + (size_t)l * 8 * 15 * 31;
                for (int i = wave * 64 + lane_p; i < 8 * 15 * 31; i += NWAVES * 64) rpl[i] = rpb_l[i] * LOG2E;
                if (!(rep_ && MK_VAR == 1)) attn_sample_block(AP, kl, vl, rpl, parts, vcu, wave, lane_p);
                { const int pu = 256 + vcu * NWAVES + wave; if (pu < 384 && !(rep_ && (MK_VAR == 4 || MK_VAR == 5))) pool_unit(PP, pu, lane_p); }
            } else {
                LAS float* wl = (LAS float*)lds; LAS unsigned char* kl = lds + 49152; LAS unsigned char* vl = kl + PA_K_BYTES;
                const int bh = vcu - 128;
                for (int i = wave * 64 + lane_p; i < 47 * CW / 4; i += NWAVES * 64) { const int j = i / (CW / 4) - 7;
                    *(LAS f32x4*)(wl + 4 * i) = (j >= 0 && j < CONVK) ? *(const f32x4*)(PP.wdw + 4 * (i - 7 * (CW / 4))) : (f32x4){0.f, 0.f, 0.f, 0.f}; }
                { StageRegs R; attn_stage_load(R, AP.K + (size_t)((bh >> 3) * 256) * NAW + (bh & 7) * 64, AP.Vt + (size_t)(bh * 64) * 256, 256, 256, wave * 64 + lane_p); attn_stage_store(R, 256, kl, vl, wave * 64 + lane_p); }
                LDS_WAIT(); __syncthreads();
                if (!(rep_ && (MK_VAR == 2 || MK_VAR == 5))) attn_prompt_lds(AP, kl, vl, bh, wave, lane_p);
                { const int it = bh * NWAVES + wave;
                    if (it < 768) { if (!(rep_ && (MK_VAR == 3 || MK_VAR == 5))) conv_unit(PP, wl, it, lane_p); }
                    else { if (!(rep_ && (MK_VAR == 4 || MK_VAR == 5))) pool_unit(PP, it - 768, lane_p); } }
            }
            __syncthreads();
        }
        }
        SEAM(p0 + 1);
        const int t192 = (bx & 7) * 32 + (bx >> 3), pm192 = t192 >> 3, pn192 = t192 & 7;
        const bool has192 = (G == 256);
        for (int rep_ = 0; rep_ < MK_REPS(2); ++rep_) { if (rep_) GRID_BAR();
        if (IN(p0 + 2)) {
            EpiBranch192 E{GT, MB};
            if (has192) g192::gemm<EpiBranch192>(lds, ABR, D, WBR + (size_t)l * D * D, D, pm192, pn192, 16, E);
        }
        }
        SEAM(p0 + 2);
        for (int rep_ = 0; rep_ < MK_REPS(5); ++rep_) { if (rep_) GRID_BAR();
        if (IN(p0 + 3)) {
            EpiRes192 E{rep_ ? MF : X, rep_ ? ACT : XG, modt_l + 2 * D, modt_l + 3 * D, rep_ ? (float*)ABR : RSS + (size_t)(2 * l + 1) * M};
            if (has192) g192::gemm<EpiRes192>(lds, MB, D, WOUT + (size_t)l * D * D, D, pm192, pn192, 16, E);
        }
        }
        SEAM(p0 + 3);
        for (int rep_ = 0; rep_ < MK_REPS(3); ++rep_) { if (rep_) GRID_BAR();
        if (IN(p0 + 4)) {
            pg8::Gemm g{XG, WGU + (size_t)l * NGU * D, D, D};
            pg8::TileOrderGU S; S.init(M, NGU, D, G, bx);
            EpiGU E{RSS + (size_t)(2 * l + 1) * M, C2 + (size_t)(l * 3) * NGU, ACT};
            pg8::gemm_phase<EpiGU, pg8::TileOrderGU>(lds, g, S, E);
        }
        }
        SEAM(p0 + 4);
        for (int rep_ = 0; rep_ < MK_REPS(6); ++rep_) { if (rep_) GRID_BAR();
        if (IN(p0 + 5)) {
            EpiRes192 E{rep_ ? MF : X, rep_ ? MB : XG, modt_l + 5 * D, MODT + (size_t)((l + 1) % DEPTH) * 3 * 6 * D, rep_ ? (float*)ABR : RSS + (size_t)(2 * l + 2) * M};
            if (has192) g192::gemm<EpiRes192>(lds, ACT, FFN, WDN + (size_t)l * D * FFN, FFN, pm192, pn192, FFN / 64, E);
        }
        }
        SEAM(p0 + 5);
    }
    if (IN(NPHASE - 1)) {
        for (int row = gw; row < M; row += NGW) {
            const float rinv = 1.0f / sqrtf(RSS[(size_t)8 * M + row] * (1.0f / D) + EPS);
#pragma unroll
            for (int j = 0; j < 4; ++j) {
                const int col = 256 * j + 4 * lane;
                const f32x4 v = *(const f32x4*)(X + (size_t)row * D + col) * rinv * *(const f32x4*)(final_g + col);
                __builtin_nontemporal_store(v, (f32x4*)(args.out + OUT_Y + (size_t)row * D + col));
            }
        }
    }
#undef IN
#undef SEAM
}

extern "C" void kernel_launch(void* const* d_in, const int* in_sizes, int n_in, void* d_out, int out_size, void* d_ws, size_t ws_size, hipStream_t stream) {
    static int grid = 0;
    if (grid == 0) {
        if (n_in != 26 || ws_size < WS_END) { fprintf(stderr, "kernel_launch: expected 26 inputs and >= %zu bytes of workspace; got %d, %zu\n", (size_t)WS_END, n_in, ws_size); grid = -1; return; }
        int dev = 0, cus = 0;
        if (hipGetDevice(&dev) != hipSuccess || hipDeviceGetAttribute(&cus, hipDeviceAttributeMultiprocessorCount, dev) != hipSuccess) { grid = -1; return; }
        if (hipFuncSetAttribute((const void*)fwd_kernel, hipFuncAttributeMaxDynamicSharedMemorySize, LDS_BYTES) != hipSuccess) { fprintf(stderr, "kernel_launch: hipFuncSetAttribute failed\n"); grid = -1; return; }
        (void)hipGetLastError();
        grid = cus;
    }
    if (grid < 0) return;
    (void)hipMemsetAsync((char*)d_ws + WS_CTL, 0, CTL_ZERO_BYTES, stream);
    Args a{};
    for (int i = 0; i < 26; ++i) a.in[i] = (const float*)d_in[i];
    a.out = (float*)d_out; a.ws = (unsigned char*)d_ws;
#if MK_PER_PHASE
    for (int p = 0; p < NPHASE; ++p) { a.ph_lo = p; a.ph_hi = p + 1; hipLaunchKernelGGL(fwd_kernel, dim3(grid), dim3(NWAVES * 64), LDS_BYTES, stream, a); }
#else
    a.ph_lo = 0; a.ph_hi = NPHASE;
    hipLaunchKernelGGL(fwd_kernel, dim3(grid), dim3(NWAVES * 64), LDS_BYTES, stream, a);
#endif
}
```

```cpp
#include <hip/hip_runtime.h>
#include <cstdio>
#include <cstdint>

#ifndef MK_PER_PHASE
#define MK_PER_PHASE 0
#endif

#ifndef MK_REPEAT
#define MK_REPEAT 0
#endif
#define MK_REPS(bit) ((MK_REPEAT >> (bit)) & 1 ? 2 : 1)
#ifndef MK_VAR
#define MK_VAR 0
#endif

constexpr int D = 1024, MP = 4096, MS = 2048, M = MP + MS, DEPTH = 4;
constexpr int NIN = 5376, FFN = 2816, NGU = 2 * FFN, NMOD = 6 * D;
constexpr int NAW = 512, PW = 256, CW = 256, CONVK = 31;
constexpr float EPS = 1e-6f;
constexpr float LOG2E = 1.4426950408889634f;
constexpr float QSCALE = 0.125f * LOG2E;

constexpr size_t MiB = 1u << 20;
constexpr size_t WS_CTL = 0, CTL_ZERO_BYTES = 5 * MiB / 4;
constexpr int CW_BAR = 4096;
constexpr int CF_MODRAW = 16384;
constexpr int CF_C1 = CF_MODRAW + DEPTH * 3 * NMOD;
constexpr int CF_C2 = CF_C1 + DEPTH * 3 * NIN;
constexpr int CF_RSS = CF_C2 + DEPTH * 3 * NGU;
constexpr int CF_END = CF_RSS + 9 * M;
static_assert((size_t)CF_END * 4 <= CTL_ZERO_BYTES, "control region");
constexpr size_t WS_MODT = 2 * MiB;
constexpr size_t WS_WIN = 4 * MiB;
constexpr size_t WS_WGU = 46 * MiB;
constexpr size_t WS_WDN = 90 * MiB;
constexpr size_t WS_WBR = 112 * MiB;
constexpr size_t WS_WOUT = 120 * MiB;
constexpr size_t WS_X = 128 * MiB;
constexpr size_t WS_XG = 152 * MiB;
constexpr size_t WS_Q = 164 * MiB, WS_K = 170 * MiB;
constexpr size_t WS_VT = 176 * MiB;
constexpr size_t WS_KC = 182 * MiB;
constexpr size_t WS_VTC = 184 * MiB;
constexpr size_t WS_PIN = 186 * MiB;
constexpr size_t WS_CIN = 189 * MiB;
constexpr size_t WS_G = 195 * MiB;
constexpr size_t WS_ABR = 231 * MiB;
constexpr size_t WS_MF = 243 * MiB;
constexpr size_t WS_MB = 267 * MiB;
constexpr size_t WS_ACT = 279 * MiB;
constexpr size_t WS_END = 312 * MiB;
constexpr size_t VT_SAMPLE_OFF = (size_t)16 * 8 * 64 * 256;

constexpr size_t OUT_Y = 0, OUT_K = (size_t)M * D, OUT_V = OUT_K + (size_t)16 * DEPTH * 256 * 512;

#define GAS __attribute__((address_space(1)))
#define LAS __attribute__((address_space(3)))
typedef unsigned short bf16_t;
typedef short bf16x8 __attribute__((ext_vector_type(8)));
typedef float f32x4 __attribute__((ext_vector_type(4)));
typedef float f32x2 __attribute__((ext_vector_type(2)));
typedef float f32x16 __attribute__((ext_vector_type(16)));
typedef unsigned u32x4 __attribute__((ext_vector_type(4)));
typedef unsigned u32x2 __attribute__((ext_vector_type(2)));
typedef __bf16 bf16x2_t __attribute__((ext_vector_type(2)));
#define LDS_WAIT() asm volatile("s_waitcnt lgkmcnt(0)" ::: "memory")

__device__ __forceinline__ unsigned pk2(float lo, float hi) { f32x2 v = {lo, hi}; bf16x2_t b = __builtin_convertvector(v, bf16x2_t); return __builtin_bit_cast(unsigned, b); }
__device__ __forceinline__ u32x4 pk8(f32x4 a, f32x4 b) { u32x4 w; w.x = pk2(a[0], a[1]); w.y = pk2(a[2], a[3]); w.z = pk2(b[0], b[1]); w.w = pk2(b[2], b[3]); return w; }
__device__ __forceinline__ float bf_lo(unsigned w) { return __uint_as_float(w << 16); }
__device__ __forceinline__ float bf_hi(unsigned w) { return __uint_as_float(w & 0xffff0000u); }
__device__ __forceinline__ float sigmoidf_(float x) { return __builtin_amdgcn_rcpf(1.0f + __builtin_amdgcn_exp2f(-LOG2E * x)); }
__device__ __forceinline__ float wave_sum(float v) {
#pragma unroll
    for (int o = 1; o < 64; o <<= 1) v += __shfl_xor(v, o);
    return v;
}
__device__ __forceinline__ int pos_of_key(int t) { return (t & ~12) | ((t & 4) << 1) | ((t & 8) >> 1); }
__device__ __forceinline__ int mod_row_of_pm(int pm) { return pm < 16 ? 0 : 1 + ((pm - 16) >> 2); }

namespace pg8 {
constexpr int BM = 256, BK = 64, HALF = 128, HTB = HALF * BK * 2  , STAGE_BYTES = 8 * HTB, NXCD = 8, WGM = 4;
__host__ __device__ __forceinline__ int lds_byte(int r, int c) { return r * 128 + ((((c >> 3) ^ (r >> 1)) & 7) << 4) + (c & 7) * 2; }
__host__ __device__ __forceinline__ void stage_rc(int b, int& R, int& C) { R = b >> 7; C = (((b >> 4) ^ (R >> 1)) & 7) * 8; }
__host__ __device__ __forceinline__ int perm32(int rho) { const int n = rho >> 4, i = rho & 15; return 8 * (i >> 2) + 4 * n + (i & 3); }

struct Unit { int pm, pn, k0, nt, kind, half; };
struct Gemm { const bf16_t* A; const bf16_t* Bt; int lda, ldb; };

struct TileOrder {
    int nM, nN, nwg, G, c, nt;
    __device__ void init(int M_, int N_, int K_, int G_, int c_) { nM = M_ / BM; nN = N_ / BM; nwg = nM * nN; G = G_; c = c_; nt = K_ / BK; }
    __device__ bool next(int i, Unit& u) const {
        const long L = (long)i * G + c; if (L >= nwg) return false;
        int wgid = (int)L; { const int q = nwg / NXCD, r = nwg % NXCD, xcd = wgid % NXCD, off = wgid / NXCD; wgid = (xcd < r ? xcd * (q + 1) : r * (q + 1) + (xcd - r) * q) + off; }
        const int nig = WGM * nN, gid = wgid / nig, fm = gid * WGM, gsz = (nM - fm) < WGM ? (nM - fm) : WGM;
        u.pm = fm + ((wgid % nig) % gsz); u.pn = (wgid % nig) / gsz; u.k0 = 0; u.nt = nt; u.kind = 0; u.half = 0; return true;
    }
};
struct TileOrderGU {
    TileOrder base;
    __device__ void init(int M_, int N_, int K_, int G_, int c_) { base.init(M_, N_, K_, G_, c_); }
    __device__ bool next(int i, Unit& u) const {
        if (i < 2) return base.next(i, u);
        if (i > 2 || base.c >= 32 || base.G != 256) { if (base.G == 256) return false; return base.next(i, u); }
        const int c = base.c, xcd = c & 7, off = 64 + ((c >> 3) & 1);
        const int wgid = xcd * 66 + off;
        const int nig = WGM * base.nN, gid = wgid / nig, fm = gid * WGM, gsz = (base.nM - fm) < WGM ? (base.nM - fm) : WGM;
        u.pm = fm + ((wgid % nig) % gsz); u.pn = (wgid % nig) / gsz; u.k0 = 0; u.nt = base.nt; u.kind = 0; u.half = 1 + (c >> 4); return true;
    }
};
struct PanelOrder {
    int c, nseg, ka, na, kb, nb, kc, nc;
    __device__ bool next(int i, Unit& u) const {
        if (c >= 96 || i >= nseg) return false;
        const int T = (c & 7) * 12 + (c >> 3);
        u.pm = T >> 2; u.pn = T & 3; u.k0 = i == 0 ? ka : (i == 1 ? kb : kc); u.nt = i == 0 ? na : (i == 1 ? nb : nc); u.kind = i; u.half = 0; return true;
    }
};

template <class Epi, class Sched>
__device__ __forceinline__ void gemm_phase(LAS unsigned char* lds, const Gemm g, const Sched& S, const Epi& E) {
    int tid = threadIdx.x; asm volatile("" : "+v"(tid));
    const int wid = __builtin_amdgcn_readfirstlane(tid >> 6), lane = tid & 63, wr = wid >> 2, wc = wid & 3, fr = lane & 15, fq = lane >> 4;
    unsigned voffA[2], voffB[2];
#pragma unroll
    for (int i = 0; i < 2; ++i) { int R, C; stage_rc(tid * 16 + i * 8192, R, C); const int Rb = (R & ~31) + perm32(R & 31);
        voffA[i] = (unsigned)(R * g.lda + C) * 2u; voffB[i] = (unsigned)(Rb * g.ldb + C) * 2u; }
    const size_t kstep = (size_t)(BK * 2);
    const size_t hstepA = (size_t)HALF * g.lda * 2, hstepB = (size_t)HALF * g.ldb * 2;
    const size_t tstepA = 2 * hstepA, tstepB = 2 * hstepB;
    const unsigned ldsw = (unsigned)wid * 1024u;
    const int aoffk[2] = {lds_byte(wr * 64 + fr, fq * 8), lds_byte(wr * 64 + fr, fq * 8 + 32)}, boffk[2] = {lds_byte(wc * 32 + fr, fq * 8), lds_byte(wc * 32 + fr, fq * 8 + 32)};
#define PG8_SA(b, h) (((b) * 2 + (h)) * HTB)
#define PG8_SB(b, h) ((4 + (b) * 2 + (h)) * HTB)
#define PG8_STAGE(bufoff, gbase, voff) do { _Pragma("unroll") for (int _i = 0; _i < 2; ++_i) \
        __builtin_amdgcn_global_load_lds((const unsigned*)((const char*)(gbase) + (voff)[_i]), (LAS unsigned*)(lds + (bufoff) + ldsw + _i * 8192), 16, 0, 0); } while (0)
#define PG8_LDA(dst, b, h) do { _Pragma("unroll") for (int m = 0; m < 4; ++m) _Pragma("unroll") for (int k = 0; k < 2; ++k) dst[m][k] = *(const LAS bf16x8*)(lds + PG8_SA(b, h) + aoffk[k] + m * 2048); } while (0)
#define PG8_LDB(dst, b, h) do { _Pragma("unroll") for (int n = 0; n < 2; ++n) _Pragma("unroll") for (int k = 0; k < 2; ++k) dst[n][k] = *(const LAS bf16x8*)(lds + PG8_SB(b, h) + boffk[k] + n * 2048); } while (0)
#define PG8_MMA(ai, bj, At, Bt) do { __builtin_amdgcn_s_setprio(1); _Pragma("unroll") for (int m = 0; m < 4; ++m) _Pragma("unroll") for (int n = 0; n < 2; ++n) _Pragma("unroll") for (int k = 0; k < 2; ++k) \
        acc[ai][bj][m][n] = __builtin_amdgcn_mfma_f32_16x16x32_bf16(Bt[n][k], At[m][k], acc[ai][bj][m][n], 0, 0, 0); __builtin_amdgcn_s_setprio(0); } while (0)
#define PG8_WAIT_V(n) asm volatile("s_waitcnt vmcnt(" #n ")" ::: "memory")
#define PG8_WAIT_L(n) asm volatile("s_waitcnt lgkmcnt(" #n ")" ::: "memory")
#define PG8_BAR __builtin_amdgcn_s_barrier()
#define PG8_SCHED __builtin_amdgcn_sched_barrier(0)
    Unit cur, nxt; int ui = 0;
    if (!S.next(0, cur)) return;
    f32x4 acc[2][2][4][2];
#pragma unroll
    for (int a = 0; a < 2; ++a)
#pragma unroll
        for (int b = 0; b < 2; ++b)
#pragma unroll
            for (int m = 0; m < 4; ++m)
#pragma unroll
                for (int n = 0; n < 2; ++n) acc[a][b][m][n] = (f32x4){0.f, 0.f, 0.f, 0.f};
    bf16x8 At[4][2], B0[2][2], B1[2][2];
    const char* cA = (const char*)g.A + (size_t)cur.pm * tstepA + (size_t)cur.k0 * 2; const char* cB = (const char*)g.Bt + (size_t)cur.pn * tstepB + (size_t)cur.k0 * 2;
    PG8_STAGE(PG8_SB(0, 0), cB, voffB); PG8_STAGE(PG8_SB(0, 1), cB + hstepB, voffB); PG8_STAGE(PG8_SA(0, 0), cA, voffA); PG8_STAGE(PG8_SA(0, 1), cA + hstepA, voffA);
    if (wr == 1) PG8_BAR;
    PG8_WAIT_V(2); PG8_BAR;
    PG8_STAGE(PG8_SB(1, 0), cB + kstep, voffB); PG8_STAGE(PG8_SA(1, 0), cA + kstep, voffA); PG8_STAGE(PG8_SB(1, 1), cB + hstepB + kstep, voffB);
    PG8_WAIT_V(6); PG8_BAR;
    for (;;) {
        const bool has_next = S.next(ui + 1, nxt);
        const char* nA = has_next ? (const char*)g.A + (size_t)nxt.pm * tstepA + (size_t)nxt.k0 * 2 : cA; const char* nB = has_next ? (const char*)g.Bt + (size_t)nxt.pn * tstepB + (size_t)nxt.k0 * 2 : cB;
        const int nt = cur.nt;
        const bool do0 = cur.half != 2, do1 = cur.half != 1;
        for (int t = 0; t < nt; t += 2) {
            const bool last = (t == nt - 2);
            const char* a1 = cA + (size_t)(t + 1) * kstep;
            const char* a2 = last ? nA : cA + (size_t)(t + 2) * kstep; const char* b2 = last ? nB : cB + (size_t)(t + 2) * kstep;
            const char* a3 = a2 + kstep; const char* b3 = b2 + kstep;
            PG8_LDB(B0, 0, 0); PG8_LDB(B1, 0, 1); PG8_SCHED; PG8_LDA(At, 0, 0); PG8_STAGE(PG8_SA(1, 1), a1 + hstepA, voffA);
            PG8_WAIT_V(8); PG8_WAIT_L(0); PG8_BAR; if (do0) { PG8_MMA(0, 0, At, B0); PG8_MMA(0, 1, At, B1); } PG8_BAR; PG8_SCHED;
            PG8_LDA(At, 0, 1); PG8_STAGE(PG8_SB(0, 0), b2, voffB); PG8_STAGE(PG8_SB(0, 1), b2 + hstepB, voffB); PG8_STAGE(PG8_SA(0, 0), a2, voffA);
            PG8_WAIT_V(8); PG8_WAIT_L(0); PG8_BAR; if (do1) { PG8_MMA(1, 0, At, B0); PG8_MMA(1, 1, At, B1); } PG8_BAR; PG8_SCHED;
            PG8_LDB(B0, 1, 0); PG8_LDB(B1, 1, 1); PG8_SCHED; PG8_LDA(At, 1, 0); PG8_STAGE(PG8_SA(0, 1), a2 + hstepA, voffA);
            PG8_WAIT_V(8); PG8_WAIT_L(0); PG8_BAR; if (do0) { PG8_MMA(0, 0, At, B0); PG8_MMA(0, 1, At, B1); } PG8_BAR; PG8_SCHED;
            PG8_LDA(At, 1, 1); PG8_STAGE(PG8_SB(1, 0), b3, voffB); PG8_STAGE(PG8_SB(1, 1), b3 + hstepB, voffB); PG8_STAGE(PG8_SA(1, 0), a3, voffA);
            PG8_WAIT_V(8); PG8_WAIT_L(0); PG8_BAR; if (do1) { PG8_MMA(1, 0, At, B0); PG8_MMA(1, 1, At, B1); } PG8_BAR; PG8_SCHED;
        }
        if (wr == 0) PG8_BAR;
        E(acc, cur, wr, wc, fr, fq);
        if (!has_next) break;
#pragma unroll
        for (int a = 0; a < 2; ++a)
#pragma unroll
            for (int b = 0; b < 2; ++b)
#pragma unroll
                for (int m = 0; m < 4; ++m)
#pragma unroll
                    for (int n = 0; n < 2; ++n) acc[a][b][m][n] = (f32x4){0.f, 0.f, 0.f, 0.f};
        cur = nxt; cA = nA; cB = nB; ++ui;
        if (wr == 1) PG8_BAR;
    }
    PG8_WAIT_V(0);
    PG8_BAR;
#undef PG8_SA
#undef PG8_SB
#undef PG8_STAGE
#undef PG8_LDA
#undef PG8_LDB
#undef PG8_MMA
#undef PG8_WAIT_V
#undef PG8_WAIT_L
#undef PG8_BAR
#undef PG8_SCHED
}
}

typedef f32x4 Acc[2][2][4][2];

struct EpiIn {
    const float* rss; const float* c1; const float* bgate;
    bf16_t *Q, *K, *Vt, *Pin, *Cin, *G; float *outk, *outv;
    __device__ __forceinline__ void operator()(const Acc& acc, const pg8::Unit& u, int wr, int wc, int fr, int fq) const {
        const int pn = u.pn, pm = u.pm, mr = mod_row_of_pm(pm);
        const int cb = pn * 256 + wc * 32 + 8 * fq;
        f32x4 cv[2][2];
#pragma unroll
        for (int bj = 0; bj < 2; ++bj)
#pragma unroll
            for (int n = 0; n < 2; ++n) cv[bj][n] = *(const f32x4*)(c1 + (size_t)mr * NIN + cb + bj * 128 + 4 * n);
        float rinvs[2][4];
#pragma unroll
        for (int ai = 0; ai < 2; ++ai)
#pragma unroll
            for (int m = 0; m < 4; ++m) rinvs[ai][m] = rss[pm * 256 + ai * 128 + wr * 64 + m * 16 + fr];
#pragma unroll
        for (int ai = 0; ai < 2; ++ai)
#pragma unroll
            for (int m = 0; m < 4; ++m) {
                const int row = pm * 256 + ai * 128 + wr * 64 + m * 16 + fr;
                const float rinv = 1.0f / sqrtf(rinvs[ai][m] * (1.0f / D) + EPS);
#pragma unroll
                for (int bj = 0; bj < 2; ++bj) {
                    const int col = cb + bj * 128;
                    f32x4 v0 = acc[ai][bj][m][0] * rinv + cv[bj][0], v1 = acc[ai][bj][m][1] * rinv + cv[bj][1];
                    if (pn < 2) {
                        *(u32x4*)(Q + (size_t)row * NAW + col) = pk8(v0 * QSCALE, v1 * QSCALE);
                    } else if (pn < 4) {
                        const int c = col - 512;
                        *(u32x4*)(K + (size_t)row * NAW + c) = pk8(v0, v1);
                        if (pm < 16) { float* o = outk + ((size_t)(pm * DEPTH * 256 + (row & 255))) * 512 + c; __builtin_nontemporal_store(v0, (f32x4*)o); __builtin_nontemporal_store(v1, (f32x4*)(o + 4)); }
                    } else if (pn < 6) {
                        const int c = col - 1024, h = c >> 6, d = c & 63;
                        if (pm < 16) { float* o = outv + ((size_t)(pm * DEPTH * 256 + (row & 255))) * 512 + c; __builtin_nontemporal_store(v0, (f32x4*)o); __builtin_nontemporal_store(v1, (f32x4*)(o + 4)); }
                        bf16_t* vb; int L;
                        if (pm < 16) { L = 256; vb = Vt + ((size_t)((pm * 8 + h) * 64 + d)) * 256 + pos_of_key(row & 255); }
                        else { const int rs = row - MP, bs = rs >> 10; L = 1024; vb = Vt + VT_SAMPLE_OFF + ((size_t)((bs * 8 + h) * 64 + d)) * 1024 + pos_of_key(rs & 1023); }
                        const u32x4 w = pk8(v0, v1);
                        vb[0] = (bf16_t)(w.x & 0xffff); vb[(size_t)L] = (bf16_t)(w.x >> 16); vb[(size_t)2 * L] = (bf16_t)(w.y & 0xffff); vb[(size_t)3 * L] = (bf16_t)(w.y >> 16);
                        vb[(size_t)4 * L] = (bf16_t)(w.z & 0xffff); vb[(size_t)5 * L] = (bf16_t)(w.z >> 16); vb[(size_t)6 * L] = (bf16_t)(w.w & 0xffff); vb[(size_t)7 * L] = (bf16_t)(w.w >> 16);
                    } else if (pn == 6) {
                        *(u32x4*)(Pin + (size_t)row * PW + (col - 1536)) = pk8(v0, v1);
                    } else if (pn < 9) {
                        *(u32x4*)(Cin + (size_t)row * 512 + (col - 1792)) = pk8(v0, v1);
                    } else {
                        v0 += *(const f32x4*)(bgate + (col - 2304)); v1 += *(const f32x4*)(bgate + (col - 2304) + 4);
#pragma unroll
                        for (int e = 0; e < 4; ++e) { v0[e] = sigmoidf_(v0[e]); v1[e] = sigmoidf_(v1[e]); }
                        *(u32x4*)(G + (size_t)row * 3072 + (col - 2304)) = pk8(v0, v1);
                    }
                }
                asm volatile("" ::: "memory");
            }
    }
};

struct EpiBranch {
    const bf16_t* G; float* mf; bf16_t* mb;
    __device__ __forceinline__ void operator()(const Acc& acc, const pg8::Unit& u, int wr, int wc, int fr, int fq) const {
        const int cb = u.pn * 256 + wc * 32 + 8 * fq, kind = u.kind;
#pragma unroll
        for (int ai = 0; ai < 2; ++ai)
#pragma unroll
            for (int m = 0; m < 4; ++m) {
                const int row = u.pm * 256 + ai * 128 + wr * 64 + m * 16 + fr;
#pragma unroll
                for (int bj = 0; bj < 2; ++bj) {
                    const int col = cb + bj * 128;
                    const u32x4 gw = *(const u32x4*)(G + (size_t)row * 3072 + kind * 1024 + col);
                    f32x4 v0 = acc[ai][bj][m][0], v1 = acc[ai][bj][m][1];
                    v0[0] *= bf_lo(gw.x); v0[1] *= bf_hi(gw.x); v0[2] *= bf_lo(gw.y); v0[3] *= bf_hi(gw.y);
                    v1[0] *= bf_lo(gw.z); v1[1] *= bf_hi(gw.z); v1[2] *= bf_lo(gw.w); v1[3] *= bf_hi(gw.w);
                    float* sp = mf + (size_t)row * D + col;
                    if (kind > 0) { v0 += *(const f32x4*)sp; v1 += *(const f32x4*)(sp + 4); }
                    if (kind < 2) { *(f32x4*)sp = v0; *(f32x4*)(sp + 4) = v1; }
                    else *(u32x4*)(mb + (size_t)row * D + col) = pk8(v0, v1);
                }
                asm volatile("" ::: "memory");
            }
    }
};

struct EpiRes {
    float* x; bf16_t* xg; const float* gate; const float* gsn; float* rssn;
    __device__ __forceinline__ void operator()(const Acc& acc, const pg8::Unit& u, int wr, int wc, int fr, int fq) const {
        const int mr = mod_row_of_pm(u.pm), cb = u.pn * 256 + wc * 32 + 8 * fq;
        float ss[2][4];
#pragma unroll
        for (int ai = 0; ai < 2; ++ai)
#pragma unroll
            for (int m = 0; m < 4; ++m) ss[ai][m] = 0.f;
#pragma unroll
        for (int bj = 0; bj < 2; ++bj) {
            const int col = cb + bj * 128;
            const f32x4 gt0 = *(const f32x4*)(gate + (size_t)mr * 6 * D + col), gt1 = *(const f32x4*)(gate + (size_t)mr * 6 * D + col + 4);
            const f32x4 gs0 = *(const f32x4*)(gsn + (size_t)mr * 6 * D + col), gs1 = *(const f32x4*)(gsn + (size_t)mr * 6 * D + col + 4);
#pragma unroll
            for (int ai = 0; ai < 2; ++ai)
#pragma unroll
                for (int m = 0; m < 4; ++m) {
                    const int row = u.pm * 256 + ai * 128 + wr * 64 + m * 16 + fr;
                    float* xp = x + (size_t)row * D + col;
                    f32x4 x0 = *(const f32x4*)xp, x1 = *(const f32x4*)(xp + 4);
                    x0 += gt0 * acc[ai][bj][m][0]; x1 += gt1 * acc[ai][bj][m][1];
                    *(f32x4*)xp = x0; *(f32x4*)(xp + 4) = x1;
                    ss[ai][m] += (x0[0] * x0[0] + x0[1] * x0[1]) + (x0[2] * x0[2] + x0[3] * x0[3]) + (x1[0] * x1[0] + x1[1] * x1[1]) + (x1[2] * x1[2] + x1[3] * x1[3]);
                    *(u32x4*)(xg + (size_t)row * D + col) = pk8(x0 * gs0, x1 * gs1);
                    asm volatile("" ::: "memory");
                }
        }
#pragma unroll
        for (int ai = 0; ai < 2; ++ai)
#pragma unroll
            for (int m = 0; m < 4; ++m) {
                float s = ss[ai][m];
                s += __shfl_xor(s, 16); s += __shfl_xor(s, 32);
                if (fq == 0) atomicAdd(rssn + u.pm * 256 + ai * 128 + wr * 64 + m * 16 + fr, s);
            }
    }
};

struct EpiGU {
    const float* rss; const float* c2; bf16_t* act;
    __device__ __forceinline__ void operator()(const Acc& acc, const pg8::Unit& u, int wr, int wc, int fr, int fq) const {
        const int mr = mod_row_of_pm(u.pm), ca0 = u.pn * 128 + wc * 32 + 8 * fq;
        f32x4 ca[2], cbv[2];
#pragma unroll
        for (int n = 0; n < 2; ++n) { ca[n] = *(const f32x4*)(c2 + (size_t)mr * NGU + ca0 + 4 * n); cbv[n] = *(const f32x4*)(c2 + (size_t)mr * NGU + FFN + ca0 + 4 * n); }
        float rinvs[2][4];
#pragma unroll
        for (int ai = 0; ai < 2; ++ai)
#pragma unroll
            for (int m = 0; m < 4; ++m) rinvs[ai][m] = rss[u.pm * 256 + ai * 128 + wr * 64 + m * 16 + fr];
#pragma unroll
        for (int ai = 0; ai < 2; ++ai)
#pragma unroll
            for (int m = 0; m < 4; ++m) {
                if (u.half == 2 - ai) continue;
                const int row = u.pm * 256 + ai * 128 + wr * 64 + m * 16 + fr;
                const float rinv = 1.0f / sqrtf(rinvs[ai][m] * (1.0f / D) + EPS);
                f32x4 o[2];
#pragma unroll
                for (int n = 0; n < 2; ++n) {
                    const f32x4 a = acc[ai][0][m][n] * rinv + ca[n], b = acc[ai][1][m][n] * rinv + cbv[n];
#pragma unroll
                    for (int e = 0; e < 4; ++e) o[n][e] = a[e] * sigmoidf_(a[e]) * b[e];
                }
                *(u32x4*)(act + (size_t)row * FFN + ca0) = pk8(o[0], o[1]);
                asm volatile("" ::: "memory");
            }
    }
};

namespace g192 {
constexpr int TM = 192, TN = 128, BK = 64, ABYTES = TM * BK * 2, BBYTES = TN * BK * 2, SBYTES = ABYTES + BBYTES;
typedef f32x4 Acc6[6][2];
template <class Epi>
__device__ __forceinline__ void gemm(LAS unsigned char* lds, const bf16_t* A, int lda, const bf16_t* Bt, int ldb, int pm, int pn, int nt, const Epi& E) {
    int tid = threadIdx.x; asm volatile("" : "+v"(tid));
    const int wid = __builtin_amdgcn_readfirstlane(tid >> 6), lane = tid & 63, wr = wid >> 2, wc = wid & 3, fr = lane & 15, fq = lane >> 4;
    unsigned voffA[3], voffB[2];
#pragma unroll
    for (int i = 0; i < 3; ++i) { int R, C; pg8::stage_rc((wid + 8 * i) * 1024 + lane * 16, R, C); voffA[i] = (unsigned)(R * lda + C) * 2u; }
#pragma unroll
    for (int i = 0; i < 2; ++i) { int R, C; pg8::stage_rc((wid + 8 * i) * 1024 + lane * 16, R, C); const int Rb = (R & ~31) + pg8::perm32(R & 31); voffB[i] = (unsigned)(Rb * ldb + C) * 2u; }
    const char* gA = (const char*)(A + (size_t)pm * TM * lda); const char* gB = (const char*)(Bt + (size_t)pn * TN * ldb);
    const unsigned ldsw = (unsigned)wid * 1024u;
    const int aoffk[2] = {pg8::lds_byte(wr * 96 + fr, fq * 8), pg8::lds_byte(wr * 96 + fr, fq * 8 + 32)}, boffk[2] = {ABYTES + pg8::lds_byte(wc * 32 + fr, fq * 8), ABYTES + pg8::lds_byte(wc * 32 + fr, fq * 8 + 32)};
#define G192_STAGE(slot, t) do { \
        _Pragma("unroll") for (int _i = 0; _i < 3; ++_i) __builtin_amdgcn_global_load_lds((const unsigned*)(gA + (size_t)(t) * (BK * 2) + voffA[_i]), (LAS unsigned*)(lds + (slot) * SBYTES + ldsw + _i * 8192), 16, 0, 0); \
        _Pragma("unroll") for (int _i = 0; _i < 2; ++_i) __builtin_amdgcn_global_load_lds((const unsigned*)(gB + (size_t)(t) * (BK * 2) + voffB[_i]), (LAS unsigned*)(lds + (slot) * SBYTES + ABYTES + ldsw + _i * 8192), 16, 0, 0); } while (0)
#define G192_WAIT_V(n) asm volatile("s_waitcnt vmcnt(" #n ")" ::: "memory")
#define G192_WAIT_L(n) asm volatile("s_waitcnt lgkmcnt(" #n ")" ::: "memory")
    f32x4 acc[6][2], tot[6][2];
#pragma unroll
    for (int m = 0; m < 6; ++m)
#pragma unroll
        for (int n = 0; n < 2; ++n) { acc[m][n] = (f32x4){0.f, 0.f, 0.f, 0.f}; tot[m][n] = (f32x4){0.f, 0.f, 0.f, 0.f}; }
    G192_STAGE(0, 0); G192_STAGE(1, 1); G192_STAGE(2, 2);
    G192_WAIT_V(10); __builtin_amdgcn_s_barrier();
#pragma unroll 1
    for (int t = 0; t < nt; ++t) {
        const int slot = t & 3;
        if (t + 3 < nt) G192_STAGE((t + 3) & 3, t + 3);
        bf16x8 At[6][2], Bf[2][2];
        const LAS unsigned char* sb = lds + slot * SBYTES;
#pragma unroll
        for (int n = 0; n < 2; ++n)
#pragma unroll
            for (int k = 0; k < 2; ++k) Bf[n][k] = *(const LAS bf16x8*)(sb + boffk[k] + n * 2048);
#pragma unroll
        for (int m = 0; m < 6; ++m)
#pragma unroll
            for (int k = 0; k < 2; ++k) At[m][k] = *(const LAS bf16x8*)(sb + aoffk[k] + m * 2048);
        G192_WAIT_L(0);
        __builtin_amdgcn_s_setprio(1);
#pragma unroll
        for (int m = 0; m < 6; ++m)
#pragma unroll
            for (int n = 0; n < 2; ++n)
#pragma unroll
                for (int k = 0; k < 2; ++k) acc[m][n] = __builtin_amdgcn_mfma_f32_16x16x32_bf16(Bf[n][k], At[m][k], acc[m][n], 0, 0, 0);
        __builtin_amdgcn_s_setprio(0);
        if (Epi::BRANCH) { if (t == 7 || t == 11 || t == nt - 1) E.seg(acc, tot, t == 7 ? 0 : (t == 11 ? 1 : 2), pm, pn, wr, wc, fr, fq); }
        if (t + 3 < nt) G192_WAIT_V(10); else if (t + 2 < nt) G192_WAIT_V(5); else G192_WAIT_V(0);
        __builtin_amdgcn_s_barrier();
    }
    E(Epi::BRANCH ? tot : acc, pm, pn, wr, wc, fr, fq);
#undef G192_STAGE
#undef G192_WAIT_V
#undef G192_WAIT_L
}
}

struct EpiBranch192 {
    static constexpr bool BRANCH = true;
    const bf16_t* G; bf16_t* mb;
    __device__ __forceinline__ void seg(g192::Acc6& acc, g192::Acc6& tot, int kind, int pm, int pn, int wr, int wc, int fr, int fq) const {
        const int col = pn * 128 + wc * 32 + 8 * fq;
#pragma unroll
        for (int m = 0; m < 6; ++m) {
            const int row = pm * 192 + wr * 96 + m * 16 + fr;
            const u32x4 gw = *(const u32x4*)(G + (size_t)row * 3072 + kind * 1024 + col);
            f32x4 g0 = {bf_lo(gw.x), bf_hi(gw.x), bf_lo(gw.y), bf_hi(gw.y)}, g1 = {bf_lo(gw.z), bf_hi(gw.z), bf_lo(gw.w), bf_hi(gw.w)};
            tot[m][0] += g0 * acc[m][0]; tot[m][1] += g1 * acc[m][1];
            acc[m][0] = (f32x4){0.f, 0.f, 0.f, 0.f}; acc[m][1] = (f32x4){0.f, 0.f, 0.f, 0.f};
        }
    }
    __device__ __forceinline__ void operator()(const g192::Acc6& tot, int pm, int pn, int wr, int wc, int fr, int fq) const {
        const int col = pn * 128 + wc * 32 + 8 * fq;
#pragma unroll
        for (int m = 0; m < 6; ++m) { const int row = pm * 192 + wr * 96 + m * 16 + fr; *(u32x4*)(mb + (size_t)row * D + col) = pk8(tot[m][0], tot[m][1]); }
    }
};
struct EpiRes192 {
    static constexpr bool BRANCH = false;
    float* x; bf16_t* xg; const float* gate; const float* gsn; float* rssn;
    __device__ __forceinline__ void seg(g192::Acc6&, g192::Acc6&, int, int, int, int, int, int, int) const {}
    __device__ __forceinline__ void operator()(const g192::Acc6& acc, int pm, int pn, int wr, int wc, int fr, int fq) const {
        const int col = pn * 128 + wc * 32 + 8 * fq;
#pragma unroll
        for (int h = 0; h < 2; ++h) {
            f32x4 xv[3][2], gt[3][2], gs[3][2];
#pragma unroll
            for (int q = 0; q < 3; ++q) {
                const int row = pm * 192 + wr * 96 + (3 * h + q) * 16 + fr;
                const int mr = row < MP ? 0 : 1 + ((row - MP) >> 10);
                const float* gp = gate + (size_t)mr * 6 * D + col; const float* sp = gsn + (size_t)mr * 6 * D + col; const float* xp = x + (size_t)row * D + col;
                xv[q][0] = *(const f32x4*)xp; xv[q][1] = *(const f32x4*)(xp + 4);
                gt[q][0] = *(const f32x4*)gp; gt[q][1] = *(const f32x4*)(gp + 4); gs[q][0] = *(const f32x4*)sp; gs[q][1] = *(const f32x4*)(sp + 4);
            }
#pragma unroll
            for (int q = 0; q < 3; ++q) {
                const int m = 3 * h + q, row = pm * 192 + wr * 96 + m * 16 + fr;
                float* xp = x + (size_t)row * D + col;
                const f32x4 x0 = xv[q][0] + gt[q][0] * acc[m][0], x1 = xv[q][1] + gt[q][1] * acc[m][1];
                *(f32x4*)xp = x0; *(f32x4*)(xp + 4) = x1;
                float ss = (x0[0] * x0[0] + x0[1] * x0[1]) + (x0[2] * x0[2] + x0[3] * x0[3]) + (x1[0] * x1[0] + x1[1] * x1[1]) + (x1[2] * x1[2] + x1[3] * x1[3]);
                *(u32x4*)(xg + (size_t)row * D + col) = pk8(x0 * gs[q][0], x1 * gs[q][1]);
                ss += __shfl_xor(ss, 16); ss += __shfl_xor(ss, 32);
                if (fq == 0) atomicAdd(rssn + row, ss);
            }
            asm volatile("" ::: "memory");
        }
    }
};

struct AttnState { f32x16 o0, o1; float m, l; };
struct KVFrag { bf16x8 k[4], v[2][2]; };
__device__ __forceinline__ void attn_load(KVFrag& f, const bf16_t* kptr  , const bf16_t* vptr  , int vstride32  ) {
#pragma unroll
    for (int s = 0; s < 4; ++s) f.k[s] = *(const bf16x8*)(kptr + 16 * s);
#pragma unroll
    for (int dt = 0; dt < 2; ++dt)
#pragma unroll
        for (int ks = 0; ks < 2; ++ks) f.v[dt][ks] = *(const bf16x8*)(vptr + (size_t)dt * vstride32 + 16 * ks);
}
__device__ __forceinline__ void attn_tile(AttnState& st, const bf16x8 (&qf)[4], const KVFrag& f, bool local, const LAS float* rl, int cq, int cs, int ck0  ) {
    f32x16 s = {0.f, 0.f, 0.f, 0.f, 0.f, 0.f, 0.f, 0.f, 0.f, 0.f, 0.f, 0.f, 0.f, 0.f, 0.f, 0.f};
#pragma unroll
    for (int k = 0; k < 4; ++k) s = __builtin_amdgcn_mfma_f32_32x32x16_bf16(f.k[k], qf[k], s, 0, 0, 0);
    if (local) {
        const LAS float* rb = rl + (ck0 - cq + 15);
        const int d0 = ck0 - cs;
#pragma unroll
        for (int i = 0; i < 16; ++i) {
            const int o = (i & 3) + 8 * (i >> 2);
            const bool ok = (unsigned)(d0 + o) < 16u;
            s[i] = ok ? s[i] + rb[o] : -1e30f;
        }
    }
    float mx = fmaxf(fmaxf(s[0], s[1]), fmaxf(s[2], s[3]));
#pragma unroll
    for (int i = 4; i < 16; i += 4) mx = fmaxf(mx, fmaxf(fmaxf(s[i], s[i + 1]), fmaxf(s[i + 2], s[i + 3])));
    mx = fmaxf(mx, __shfl_xor(mx, 32));
    const float mo = st.m, mn = fmaxf(mo, mx);
    st.m = mn;
    float ls = 0.f;
#pragma unroll
    for (int i = 0; i < 16; ++i) { const float p = __builtin_amdgcn_exp2f(s[i] - mn); s[i] = p; ls += p; }
    if (__builtin_amdgcn_ballot_w64(mn > mo) != 0ull) {
        const float alpha = __builtin_amdgcn_exp2f(mo - mn);
        st.l *= alpha;
#pragma unroll
        for (int i = 0; i < 16; ++i) { st.o0[i] *= alpha; st.o1[i] *= alpha; }
    }
    st.l += ls;
    u32x4 w0, w1;
    w0.x = pk2(s[0], s[1]); w0.y = pk2(s[2], s[3]); w0.z = pk2(s[4], s[5]); w0.w = pk2(s[6], s[7]);
    w1.x = pk2(s[8], s[9]); w1.y = pk2(s[10], s[11]); w1.z = pk2(s[12], s[13]); w1.w = pk2(s[14], s[15]);
    const bf16x8 p0 = __builtin_bit_cast(bf16x8, w0), p1 = __builtin_bit_cast(bf16x8, w1);
    st.o0 = __builtin_amdgcn_mfma_f32_32x32x16_bf16(f.v[0][0], p0, st.o0, 0, 0, 0);
    st.o0 = __builtin_amdgcn_mfma_f32_32x32x16_bf16(f.v[0][1], p1, st.o0, 0, 0, 0);
    st.o1 = __builtin_amdgcn_mfma_f32_32x32x16_bf16(f.v[1][0], p0, st.o1, 0, 0, 0);
    st.o1 = __builtin_amdgcn_mfma_f32_32x32x16_bf16(f.v[1][1], p1, st.o1, 0, 0, 0);
}
__device__ __forceinline__ void attn_store(const AttnState& st, bf16_t* orow  , int hf) {
    const float lt = st.l + __shfl_xor(st.l, 32);
    const float inv = 1.0f / lt;
#pragma unroll
    for (int g = 0; g < 4; ++g) {
        u32x2 a, b;
        a.x = pk2(st.o0[4 * g] * inv, st.o0[4 * g + 1] * inv); a.y = pk2(st.o0[4 * g + 2] * inv, st.o0[4 * g + 3] * inv);
        b.x = pk2(st.o1[4 * g] * inv, st.o1[4 * g + 1] * inv); b.y = pk2(st.o1[4 * g + 2] * inv, st.o1[4 * g + 3] * inv);
        *(u32x2*)(orow + 8 * g + 4 * hf) = a;
        *(u32x2*)(orow + 32 + 8 * g + 4 * hf) = b;
    }
}
struct AttnPtrs { const bf16_t *Q, *K, *Vt, *Kc, *Vtc; bf16_t* Abr; };
constexpr int PA_K_BYTES = 256 * 128, PA_V_BYTES = 64 * 512;
struct StageRegs { u32x4 kv[4], vv[4]; };
__device__ __forceinline__ void attn_stage_load(StageRegs& R, const bf16_t* ksrc, const bf16_t* vsrc, int vld, int nkeys, int tid) {
    const int nch = nkeys * 8, sh = nkeys == 256 ? 5 : 3;
#pragma unroll
    for (int i = 0; i < 4; ++i) { int q = tid + 512 * i; q = q < nch ? q : nch - 1;
        R.kv[i] = *(const u32x4*)(ksrc + (size_t)(q >> 3) * NAW + 8 * (q & 7));
        R.vv[i] = *(const u32x4*)(vsrc + (size_t)(q >> sh) * vld + 8 * (q & ((1 << sh) - 1))); }
}
__device__ __forceinline__ void attn_stage_store(const StageRegs& R, int nkeys, LAS unsigned char* kl, LAS unsigned char* vl, int tid) {
    const int nch = nkeys * 8, sh = nkeys == 256 ? 5 : 3;
#pragma unroll
    for (int i = 0; i < 4; ++i) { const int q = tid + 512 * i; if (q < nch) {
        const int key = q >> 3, c = q & 7, d = q >> sh, cv = q & ((1 << sh) - 1);
        *(LAS u32x4*)(kl + key * 128 + ((c ^ (key & 7)) << 4)) = R.kv[i];
        *(LAS u32x4*)(vl + d * 512 + ((cv ^ (d & 15)) << 4)) = R.vv[i]; } }
}
__device__ __forceinline__ void attn_lds_frag(KVFrag& f, const LAS unsigned char* kl, const LAS unsigned char* vl, int kt, int r32, int hf) {
    const int key = 32 * kt + r32;
#pragma unroll
    for (int s = 0; s < 4; ++s) f.k[s] = *(const LAS bf16x8*)(kl + key * 128 + (((2 * s + hf) ^ (key & 7)) << 4));
#pragma unroll
    for (int dt = 0; dt < 2; ++dt)
#pragma unroll
        for (int ks = 0; ks < 2; ++ks) { const int d = 32 * dt + r32; f.v[dt][ks] = *(const LAS bf16x8*)(vl + d * 512 + (((4 * kt + 2 * ks + hf) ^ (d & 15)) << 4)); }
}
__device__ __forceinline__ void attn_prompt_lds(const AttnPtrs& P, const LAS unsigned char* kl, const LAS unsigned char* vl, int bh, int qt, int lane) {
    const int r32 = lane & 31, hf = lane >> 5, b = bh >> 3, h = bh & 7;
    const int qrow = b * 256 + qt * 32 + r32;
    bf16x8 qf[4];
#pragma unroll
    for (int s = 0; s < 4; ++s) qf[s] = *(const bf16x8*)(P.Q + (size_t)qrow * NAW + h * 64 + 16 * s + 8 * hf);
    AttnState st; st.m = -1e30f; st.l = 0.f;
#pragma unroll
    for (int i = 0; i < 16; ++i) { st.o0[i] = 0.f; st.o1[i] = 0.f; }
    KVFrag fa, fb;
    attn_lds_frag(fa, kl, vl, 0, r32, hf);
#pragma unroll 1
    for (int t = 0; t < 8; t += 2) {
        attn_lds_frag(fb, kl, vl, t + 1, r32, hf);
        attn_tile(st, qf, fa, false, nullptr, 0, 0, 0);
        if (t + 2 < 8) attn_lds_frag(fa, kl, vl, t + 2, r32, hf);
        attn_tile(st, qf, fb, false, nullptr, 0, 0, 0);
    }
    attn_store(st, P.Abr + (size_t)qrow * D + h * 64, hf);
}
constexpr int ATT_PART_FLOATS = 34 * 64;
__device__ __forceinline__ void attn_sample_block(const AttnPtrs& P, LAS unsigned char* kl, LAS unsigned char* vl, const LAS float* rpl, LAS float* parts, int blk, int wave, int lane) {
    const int r32 = lane & 31, hf = lane >> 5, tid = wave * 64 + lane;
    const int bs = blk >> 6, h = (blk >> 3) & 7, i2 = (blk & 7) * 2;
    const int u = wave >> 1, half = wave & 1, r = i2 + (u >> 1), qh = u & 1;
    const int qrow = MP + bs * 1024 + r * 64 + qh * 32 + r32;
    const int cq = qh * 32 + r32; int cs = cq - 8; cs = cs < 0 ? 0 : (cs > 48 ? 48 : cs);
    int rs = r - 4; rs = rs < 0 ? 0 : (rs > 8 ? 8 : rs);
    int rs0 = i2 - 4; rs0 = rs0 < 0 ? 0 : (rs0 > 8 ? 8 : rs0);
    int rs1 = i2 - 3; rs1 = rs1 < 0 ? 0 : (rs1 > 8 ? 8 : rs1);
    const int nstage = rs1 != rs0 ? 4 : 3;
    const bf16_t* kloc = P.K + (size_t)(MP + bs * 1024) * NAW + h * 64;
    const bf16_t* vloc = P.Vt + VT_SAMPLE_OFF + (size_t)((bs * 8 + h) * 64) * 1024;
    bf16x8 qf[4];
#pragma unroll
    for (int s = 0; s < 4; ++s) qf[s] = *(const bf16x8*)(P.Q + (size_t)qrow * NAW + h * 64 + 16 * s + 8 * hf);
    AttnState st; st.m = -1e30f; st.l = 0.f;
#pragma unroll
    for (int i = 0; i < 16; ++i) { st.o0[i] = 0.f; st.o1[i] = 0.f; }
    LAS float* part = parts + u * ATT_PART_FLOATS;
    StageRegs R;
    attn_stage_load(R, P.Kc + (size_t)(bs * 256) * NAW + h * 64, P.Vtc + (size_t)((bs * 8 + h) * 64) * 256, 256, 256, tid);
#pragma unroll 1
    for (int sg = 0; sg < nstage; ++sg) {
        if (sg) __syncthreads();
        const int row0 = rs0 + 4 * (sg - 1);
        attn_stage_store(R, sg == 3 ? 64 : 256, kl, vl, tid);
        { const int sn = sg + 1 < nstage ? sg + 1 : 1, rown = rs0 + 4 * (sn - 1);
          attn_stage_load(R, kloc + (size_t)(rown * 64) * NAW, vloc + rown * 64, 1024, sn == 3 ? 64 : 256, tid); }
        LDS_WAIT(); __syncthreads();
        KVFrag f;
        if (sg == 0) {
#pragma unroll 1
            for (int kt = 4 * half; kt < 4 * half + 4; ++kt) { attn_lds_frag(f, kl, vl, kt, r32, hf); attn_tile(st, qf, f, false, nullptr, 0, 0, 0); }
        } else {
            const int nt = sg == 3 ? 2 : 8;
#pragma unroll 1
            for (int kt = half * (nt >> 1); kt < (half + 1) * (nt >> 1); ++kt) {
                const int jr = row0 + (kt >> 1), ch = kt & 1;
                if (jr < rs || jr >= rs + 8) continue;
                attn_lds_frag(f, kl, vl, kt, r32, hf);
                attn_tile(st, qf, f, true, rpl + (h * 15 + (jr - r + 7)) * 31, cq, cs, ch * 32 + 4 * hf);
            }
        }
    }
    if (half == 1) {
#pragma unroll
        for (int i = 0; i < 16; ++i) { part[i * 64 + lane] = st.o0[i]; part[(16 + i) * 64 + lane] = st.o1[i]; }
        part[32 * 64 + lane] = st.m; part[33 * 64 + lane] = st.l;
    }
    LDS_WAIT(); __syncthreads();
    if (half == 0) {
        const float m1 = part[32 * 64 + lane], l1 = part[33 * 64 + lane];
        const float mn = fmaxf(st.m, m1), a0 = __builtin_amdgcn_exp2f(st.m - mn), a1 = __builtin_amdgcn_exp2f(m1 - mn);
        st.l = st.l * a0 + l1 * a1;
#pragma unroll
        for (int i = 0; i < 16; ++i) { st.o0[i] = st.o0[i] * a0 + part[i * 64 + lane] * a1; st.o1[i] = st.o1[i] * a0 + part[(16 + i) * 64 + lane] * a1; }
        attn_store(st, P.Abr + (size_t)qrow * D + h * 64, hf);
    }
}

struct PcPtrs { const bf16_t *Pin, *Cin; const float *wdw, *bdw, *cng, *cnb; bf16_t* Abr; };
__device__ __forceinline__ f32x4 ld_bf4(const bf16_t* p) { const u32x2 w = *(const u32x2*)p; return (f32x4){bf_lo(w.x), bf_hi(w.x), bf_lo(w.y), bf_hi(w.y)}; }
__device__ __forceinline__ f32x4 up_bf4(u32x2 w) { return (f32x4){bf_lo(w.x), bf_hi(w.x), bf_lo(w.y), bf_hi(w.y)}; }
__device__ __forceinline__ void pool_unit(const PcPtrs& P, int unit, int lane) {
    const int row0 = unit * 8;
    const int L = row0 < MP ? 256 : 1024;
    const int sb = row0 < MP ? (row0 & ~255) : MP + ((row0 - MP) & ~1023);
    const int hw = 1 << (lane >> 4);
    const int t0 = row0 - sb;
    u32x2 pv[24];
#pragma unroll
    for (int i = 0; i < 24; ++i) { int t = t0 - 8 + i; t = t < 0 ? 0 : (t > L - 1 ? L - 1 : t); pv[i] = *(const u32x2*)(P.Pin + (size_t)(sb + t) * PW + 4 * lane); }
#pragma unroll
    for (int tt = 0; tt < 8; ++tt) {
        f32x4 sum = {0.f, 0.f, 0.f, 0.f}; float cnt = 0.f;
#pragma unroll
        for (int o = -8; o < 8; ++o) {
            const int t = t0 + tt + o;
            const bool in = (o >= -hw) && (o < hw) && (t >= 0) && (t < L);
            const f32x4 v = up_bf4(pv[tt + o + 8]);
            sum += in ? v : (f32x4){0.f, 0.f, 0.f, 0.f}; cnt += in ? 1.f : 0.f;
        }
        const f32x4 r = sum * __builtin_amdgcn_rcpf(cnt) - up_bf4(pv[tt + 8]);
        u32x2 w; w.x = pk2(r[0], r[1]); w.y = pk2(r[2], r[3]);
        *(u32x2*)(P.Abr + (size_t)(row0 + tt) * D + 512 + 4 * lane) = w;
    }
}
__device__ __forceinline__ void conv_unit(const PcPtrs& P, const LAS float* wl, int unit, int lane) {
    constexpr int T = 8;
    const int row0 = unit * T;
    const int L = row0 < MP ? 256 : 1024;
    const int sb = row0 < MP ? (row0 & ~255) : MP + ((row0 - MP) & ~1023);
    const int t0 = row0 - sb;
    f32x4 acc[T];
    const f32x4 bias = *(const f32x4*)(P.bdw + 4 * lane);
#pragma unroll
    for (int tt = 0; tt < T; ++tt) acc[tt] = bias;
#pragma unroll 1
    for (int c = 0; c < 2; ++c) {
        u32x2 ar[20], gr[20];
#pragma unroll
        for (int i = 0; i < 20; ++i) {
            const int t = t0 - 15 + 20 * c + i;
            const bool ok = (t >= 0) && (t < L);
            const bf16_t* p = P.Cin + (size_t)(sb + (ok ? t : 0)) * 512 + 4 * lane;
            ar[i] = *(const u32x2*)p; gr[i] = *(const u32x2*)(p + 256);
            if (!ok) { ar[i] = (u32x2){0u, 0u}; }
        }
#pragma unroll
        for (int g4 = 0; g4 < 5; ++g4) {
            const int s0 = 20 * c + 4 * g4;
            f32x4 tp[11];
#pragma unroll
            for (int q = 0; q < 11; ++q) tp[q] = *(const LAS f32x4*)(wl + (s0 + q) * CW + 4 * lane);
#pragma unroll
            for (int i = 0; i < 4; ++i) {
                const f32x4 a = up_bf4(ar[4 * g4 + i]), g = up_bf4(gr[4 * g4 + i]);
                f32x4 hh;
#pragma unroll
                for (int e = 0; e < 4; ++e) hh[e] = a[e] * sigmoidf_(g[e]);
#pragma unroll
                for (int tt = 0; tt < T; ++tt) acc[tt] += hh * tp[i - tt + 7];
            }
            asm volatile("" ::: "memory");
        }
    }
    const f32x4 lg = *(const f32x4*)(P.cng + 4 * lane), lb = *(const f32x4*)(P.cnb + 4 * lane);
    float s1[T], s2[T];
#pragma unroll
    for (int tt = 0; tt < T; ++tt) s1[tt] = (acc[tt][0] + acc[tt][1]) + (acc[tt][2] + acc[tt][3]);
#pragma unroll
    for (int o = 1; o < 64; o <<= 1)
#pragma unroll
        for (int tt = 0; tt < T; ++tt) s1[tt] += __shfl_xor(s1[tt], o);
#pragma unroll
    for (int tt = 0; tt < T; ++tt) { const float mu = s1[tt] * (1.0f / CW); acc[tt] = acc[tt] - mu; s2[tt] = (acc[tt][0] * acc[tt][0] + acc[tt][1] * acc[tt][1]) + (acc[tt][2] * acc[tt][2] + acc[tt][3] * acc[tt][3]); }
#pragma unroll
    for (int o = 1; o < 64; o <<= 1)
#pragma unroll
        for (int tt = 0; tt < T; ++tt) s2[tt] += __shfl_xor(s2[tt], o);
#pragma unroll
    for (int tt = 0; tt < T; ++tt) {
        const float rstd = 1.0f / sqrtf(s2[tt] * (1.0f / CW) + EPS);
        f32x4 y = acc[tt] * rstd * lg + lb;
#pragma unroll
        for (int e = 0; e < 4; ++e) y[e] = y[e] * sigmoidf_(y[e]);
        u32x2 o; o.x = pk2(y[0], y[1]); o.y = pk2(y[2], y[3]);
        *(u32x2*)(P.Abr + (size_t)(row0 + tt) * D + 768 + 4 * lane) = o;
    }
}

#define XB_TMO      128
#define XB_XCNT(j)  (256  + 64 * (j))
#define XB_XSUB(j)  (1280 + 64 * (j))
#define XB_XGEN(j)  (2304 + 64 * (j))
#define XB_TOP      3328
#define XB_TOPGEN   3392
#define XCD_BAR_WORDS 3456
#define XB_SPIN_CAP (1u << 18)
__device__ __forceinline__ unsigned xb_ld(unsigned* p)              { return __hip_atomic_load(p, __ATOMIC_RELAXED, __HIP_MEMORY_SCOPE_AGENT); }
__device__ __forceinline__ unsigned xb_add(unsigned* p, unsigned v) { return __hip_atomic_fetch_add(p, v, __ATOMIC_RELAXED, __HIP_MEMORY_SCOPE_AGENT); }
__device__ __forceinline__ unsigned xb_xcc_id() { return (unsigned)__builtin_amdgcn_s_getreg((3 << 11) | 20) & 0xFu; }
#define XB_SPIN(cond, bar) do { unsigned _sp = 0; while (cond) { __builtin_amdgcn_s_sleep(1); \
    if ((++_sp & 255u) == 0u) { if (xb_ld(&(bar)[XB_TMO])) break; if (_sp > XB_SPIN_CAP) { atomicAdd(&(bar)[XB_TMO], 1u); break; } } } } while (0)
struct XcdBarrier { unsigned* bar; unsigned x; unsigned nloc, nx; };
__device__ __forceinline__ XcdBarrier xcd_barrier_post(unsigned* bar) {
    XcdBarrier b; b.bar = bar; b.x = xb_xcc_id(); b.nloc = 0u; b.nx = 0u;
    if (threadIdx.x == 0) (void)xb_add(&bar[XB_XCNT(b.x)], 1u);
    return b;
}
__device__ __forceinline__ void xcd_barrier_complete(unsigned* bar, unsigned x, unsigned& nloc, unsigned& nx) {
    const unsigned G = gridDim.x * gridDim.y * gridDim.z;
    unsigned sum, cnt, mine, sp = 0u;
    for (;;) {
        sum = 0u; cnt = 0u; mine = 0u;
#pragma unroll
        for (unsigned j = 0; j < 16; ++j) { const unsigned c = xb_ld(&bar[XB_XCNT(j)]); sum += c; cnt += (c > 0u) ? 1u : 0u; mine = (j == x) ? c : mine; }
        if (sum == G) break;
        __builtin_amdgcn_s_sleep(1);
        if ((++sp & 255u) == 0u) { if (xb_ld(&bar[XB_TMO])) break; if (sp > XB_SPIN_CAP) { atomicAdd(&bar[XB_TMO], 1u); break; } }
    }
    nloc = mine > 0u ? mine : 1u; nx = cnt > 0u ? cnt : 1u;
}
__device__ __forceinline__ void xcd_barrier(XcdBarrier& b) {
    asm volatile("s_waitcnt vmcnt(0)" ::: "memory");
    __syncthreads();
    if (threadIdx.x == 0) {
        unsigned* bar = b.bar;
        __builtin_amdgcn_s_waitcnt(0);
        unsigned nloc = b.nloc, nx = b.nx;
        if (nloc == 0u) { xcd_barrier_complete(bar, b.x, nloc, nx); b.nloc = nloc; b.nx = nx; }
        const unsigned old = xb_add(&bar[XB_XSUB(b.x)], 1u);
        const unsigned gen = old / nloc;
        if (old + 1u == (gen + 1u) * nloc) {
            __builtin_amdgcn_fence(__ATOMIC_RELEASE, "agent");
            asm volatile("s_waitcnt vmcnt(0)" ::: "memory");
            const unsigned og = xb_add(&bar[XB_TOP], 1u);
            const unsigned tg = og / nx;
            if (og + 1u == (tg + 1u) * nx) xb_add(&bar[XB_TOPGEN], 1u);
            else XB_SPIN(xb_ld(&bar[XB_TOPGEN]) == tg, bar);
            __builtin_amdgcn_fence(__ATOMIC_ACQUIRE, "agent");
            xb_add(&bar[XB_XGEN(b.x)], 1u);
            asm volatile("s_waitcnt vmcnt(0)" ::: "memory");
        } else {
            XB_SPIN(xb_ld(&bar[XB_XGEN(b.x)]) == gen, bar);
            __builtin_amdgcn_fence(__ATOMIC_ACQUIRE, "agent");
            asm volatile("s_waitcnt vmcnt(0)" ::: "memory");
        }
    }
    __syncthreads();
}

constexpr int TP_PITCH = 65, TP_BYTES = 64 * TP_PITCH * 4;
template <bool WITH_C, bool GU_PERM>
__device__ __forceinline__ void transpose_item(const float* W, int N, bf16_t* WT, int ldt, int kcol0, LAS float* scr, int item, int lane,
                                               const float* shraw  , const float* shb  , float* csum  ) {
    const int nblk = N / 64, kb = item / nblk, nb = item % nblk, k0 = 64 * kb, n0 = 64 * nb;
    {
        const int r4 = lane >> 4, c4 = lane & 15;
        f32x4 v[16];
#pragma unroll
        for (int i = 0; i < 16; ++i) v[i] = __builtin_nontemporal_load((const f32x4*)(W + (size_t)(k0 + 4 * i + r4) * N + n0 + 4 * c4));
#pragma unroll
        for (int i = 0; i < 16; ++i) { LAS float* p = scr + (4 * i + r4) * TP_PITCH + 4 * c4; p[0] = v[i][0]; p[1] = v[i][1]; p[2] = v[i][2]; p[3] = v[i][3]; }
    }
    const int c = lane & 7, nn = lane >> 3;
    f32x4 sh[3][2];
    if (WITH_C) {
#pragma unroll
        for (int r = 0; r < 3; ++r)
#pragma unroll
            for (int h = 0; h < 2; ++h) sh[r][h] = *(const f32x4*)(shraw + (size_t)r * NMOD + k0 + 8 * c + 4 * h) + *(const f32x4*)(shb + k0 + 8 * c + 4 * h);
    }
    LDS_WAIT(); asm volatile("" ::: "memory");
#pragma unroll
    for (int j = 0; j < 8; ++j) {
        const int n = 8 * j + nn; const LAS float* s = scr + (8 * c) * TP_PITCH + n;
        float w[8];
#pragma unroll
        for (int q = 0; q < 8; ++q) w[q] = s[q * TP_PITCH];
        u32x4 o; o.x = pk2(w[0], w[1]); o.y = pk2(w[2], w[3]); o.z = pk2(w[4], w[5]); o.w = pk2(w[6], w[7]);
        int nrow = n0 + n;
        if (GU_PERM) nrow = nrow < FFN ? ((nrow >> 7) * 256 + (nrow & 127)) : (((nrow - FFN) >> 7) * 256 + 128 + ((nrow - FFN) & 127));
        *(u32x4*)(WT + (size_t)nrow * ldt + kcol0 + k0 + 8 * c) = o;
        if (WITH_C) {
            float d0 = 0.f, d1 = 0.f, d2 = 0.f;
#pragma unroll
            for (int q = 0; q < 8; ++q) { d0 += sh[0][q >> 2][q & 3] * w[q]; d1 += sh[1][q >> 2][q & 3] * w[q]; d2 += sh[2][q >> 2][q & 3] * w[q]; }
#pragma unroll
            for (int x = 1; x < 8; x <<= 1) { d0 += __shfl_xor(d0, x); d1 += __shfl_xor(d1, x); d2 += __shfl_xor(d2, x); }
            if (c == 0) { atomicAdd(csum + n0 + n, d0); atomicAdd(csum + N + n0 + n, d1); atomicAdd(csum + 2 * N + n0 + n, d2); }
        }
    }
    LDS_WAIT(); asm volatile("" ::: "memory");
}

constexpr int NWAVES = 8;
constexpr int LDS_BYTES = 163840;
static_assert(8 * TP_BYTES <= LDS_BYTES, "LDS map");
constexpr int NPHASE = 2 + 6 * DEPTH + 1;

struct Args {
    const float* in[26]; float* out; unsigned char* ws; int ph_lo, ph_hi;
};

__global__ void __launch_bounds__(NWAVES * 64, 2) fwd_kernel(Args args) {
    extern __shared__ __attribute__((aligned(16))) unsigned char lds_raw[];
    LAS unsigned char* lds = (LAS unsigned char*)lds_raw;
    const int tid = threadIdx.x, lane = tid & 63, wave = __builtin_amdgcn_readfirstlane(tid >> 6);
    const int G = gridDim.x, bx = blockIdx.x;
    const int vcu = (G % 8 == 0) ? (bx % 8) * (G / 8) + bx / 8 : bx;
    const int gw = vcu * NWAVES + wave, NGW = G * NWAVES;
    unsigned char* ws = args.ws;
    float* ctlf = (float*)(ws + WS_CTL);
    const float* x_prompt = args.in[0]; const float* x_sample = args.in[1]; const float* cache_k = args.in[2]; const float* cache_v = args.in[3];
    const float* cvec = args.in[4]; const float* c_ctx = args.in[5]; const float* w_mod = args.in[6]; const float* b_mod = args.in[7];
    const float* norm1_g = args.in[8]; const float* norm2_g = args.in[9]; const float* w_in = args.in[10]; const float* b_gate = args.in[11];
    const float* rpb = args.in[12]; const float* w_oa = args.in[13]; const float* w_pool = args.in[14]; const float* pool_scale = args.in[15];
    const float* w_ob = args.in[16]; const float* w_dw = args.in[17]; const float* b_dw = args.in[18]; const float* conv_norm_g = args.in[19];
    const float* conv_norm_b = args.in[20]; const float* w_oc = args.in[21]; const float* w_out = args.in[22]; const float* w_gu = args.in[23];
    const float* w_down = args.in[24]; const float* final_g = args.in[25];
    float* MODRAW = ctlf + CF_MODRAW; float* C1 = ctlf + CF_C1; float* C2 = ctlf + CF_C2; float* RSS = ctlf + CF_RSS;
    float* MODT = (float*)(ws + WS_MODT);
    bf16_t* WIN = (bf16_t*)(ws + WS_WIN); bf16_t* WGU = (bf16_t*)(ws + WS_WGU); bf16_t* WDN = (bf16_t*)(ws + WS_WDN); bf16_t* WBR = (bf16_t*)(ws + WS_WBR); bf16_t* WOUT = (bf16_t*)(ws + WS_WOUT);
    float* X = (float*)(ws + WS_X); bf16_t* XG = (bf16_t*)(ws + WS_XG);
    bf16_t* Qb = (bf16_t*)(ws + WS_Q); bf16_t* Kb = (bf16_t*)(ws + WS_K); bf16_t* VT = (bf16_t*)(ws + WS_VT); bf16_t* KC = (bf16_t*)(ws + WS_KC); bf16_t* VTC = (bf16_t*)(ws + WS_VTC);
    bf16_t* PIN = (bf16_t*)(ws + WS_PIN); bf16_t* CIN = (bf16_t*)(ws + WS_CIN); bf16_t* GT = (bf16_t*)(ws + WS_G); bf16_t* ABR = (bf16_t*)(ws + WS_ABR);
    float* MF = (float*)(ws + WS_MF); bf16_t* MB = (bf16_t*)(ws + WS_MB); bf16_t* ACT = (bf16_t*)(ws + WS_ACT);

#if !MK_PER_PHASE
    XcdBarrier bar = xcd_barrier_post((unsigned*)(ws + WS_CTL) + CW_BAR);
#define GRID_BAR() xcd_barrier(bar)
#else
#define GRID_BAR() do {} while (0)
#endif
    const int lo = args.ph_lo, hi = args.ph_hi;
#define IN(k) (lo <= (k) && (k) < hi)
#define SEAM(k) do { if (IN(k) && IN((k) + 1)) GRID_BAR(); } while (0)

    for (int rep_ = 0; rep_ < MK_REPS(4); ++rep_) { if (rep_) GRID_BAR();
    float* MODRAW_W = rep_ ? MF : MODRAW; float* C1_W = rep_ ? MF + DEPTH * 3 * NMOD : C1; float* C2_W = rep_ ? MF + DEPTH * 3 * (NMOD + NIN) : C2;
    if (IN(0)) {
        LAS float* sil = (LAS float*)lds; LAS float* red = (LAS float*)(lds + 16384);
        for (int i = tid; i < 3 * D; i += NWAVES * 64) { const float s = i < D ? c_ctx[i] : cvec[i - D]; sil[i] = s * sigmoidf_(s); }
        __syncthreads();
        for (int it = vcu; it < DEPTH * 24 * 8; it += G) {
            const int l = it / 192, rem = it % 192, nc = rem >> 3, kq = rem & 7, k0 = kq * 128 + wave * 16, n0 = nc * 256 + 4 * lane;
            const float* wp = w_mod + ((size_t)l * D + k0) * NMOD + n0;
            f32x4 w[16];
#pragma unroll
            for (int kk = 0; kk < 16; ++kk) w[kk] = __builtin_nontemporal_load((const f32x4*)(wp + (size_t)kk * NMOD));
            f32x4 a0 = {0.f, 0.f, 0.f, 0.f}, a1 = a0, a2 = a0;
#pragma unroll
            for (int kk = 0; kk < 16; ++kk) { a0 += sil[k0 + kk] * w[kk]; a1 += sil[D + k0 + kk] * w[kk]; a2 += sil[2 * D + k0 + kk] * w[kk]; }
#pragma unroll
            for (int e = 0; e < 4; ++e) { red[(wave * 12 + e) * 64 + lane] = a0[e]; red[(wave * 12 + 4 + e) * 64 + lane] = a1[e]; red[(wave * 12 + 8 + e) * 64 + lane] = a2[e]; }
            __syncthreads();
            for (int o = tid; o < 12 * 64; o += NWAVES * 64) {
                float s = 0.f;
#pragma unroll
                for (int ww = 0; ww < 8; ++ww) s += red[ww * 768 + o];
                const int q = o >> 6, ln = o & 63, r = q >> 2, e = q & 3;
                atomicAdd(MODRAW_W + (size_t)(l * 3 + r) * NMOD + nc * 256 + 4 * ln + e, s);
            }
            __syncthreads();
        }
    }
    SEAM(0);

    if (IN(1)) {
        LAS float* scr = (LAS float*)(lds + wave * TP_BYTES);
        constexpr int I_IN = 16 * (NIN / 64), I_GU = 16 * (NGU / 64), I_DN = (FFN / 64) * 16, I_OUT = 16 * 16, I_OA = 8 * 16, I_OC = 4 * 16;
        constexpr int I_LAYER = I_IN + I_GU + I_DN + I_OUT + I_OA + I_OC;
        constexpr int I_T = DEPTH * I_LAYER;
        constexpr int I_OB = DEPTH * 16 * 4 * 8;
        constexpr int I_X = M;
        constexpr int I_KC = DEPTH * 2 * 256;
        constexpr int I_VC = DEPTH * 2 * 8 * 4;
        constexpr int I_MT = DEPTH * 3 * 6 * 4;
        constexpr int I_ALL = I_T + I_OB + I_X + I_KC + I_VC + I_MT;
        for (int it0 = gw; it0 < I_ALL; it0 += NGW) {
            int it = it0;
            if (it < I_T) {
                const int l = it / I_LAYER; int r = it % I_LAYER;
                const float* shraw1 = MODRAW + (size_t)(l * 3) * NMOD;
                const float* shraw2 = MODRAW + (size_t)(l * 3) * NMOD + 3 * D;
                if (r < I_IN) { transpose_item<true, false>(w_in + (size_t)l * D * NIN, NIN, WIN + (size_t)l * NIN * D, D, 0, scr, r, lane, shraw1, b_mod + (size_t)l * NMOD, C1_W + (size_t)(l * 3) * NIN); continue; } r -= I_IN;
                if (r < I_GU) { transpose_item<true, true>(w_gu + (size_t)l * D * NGU, NGU, WGU + (size_t)l * NGU * D, D, 0, scr, r, lane, shraw2, b_mod + (size_t)l * NMOD + 3 * D, C2_W + (size_t)(l * 3) * NGU); continue; } r -= I_GU;
                if (r < I_DN) { transpose_item<false, false>(w_down + (size_t)l * FFN * D, D, WDN + (size_t)l * D * FFN, FFN, 0, scr, r, lane, nullptr, nullptr, nullptr); continue; } r -= I_DN;
                if (r < I_OUT) { transpose_item<false, false>(w_out + (size_t)l * D * D, D, WOUT + (size_t)l * D * D, D, 0, scr, r, lane, nullptr, nullptr, nullptr); continue; } r -= I_OUT;
                if (r < I_OA) { transpose_item<false, false>(w_oa + (size_t)l * NAW * D, D, WBR + (size_t)l * D * D, D, 0, scr, r, lane, nullptr, nullptr, nullptr); continue; } r -= I_OA;
                transpose_item<false, false>(w_oc + (size_t)l * CW * D, D, WBR + (size_t)l * D * D, D, 768, scr, r, lane, nullptr, nullptr, nullptr);
                continue;
            }
            it -= I_T;
            if (it < I_OB) {
                const int l = it / 512, rem = it % 512, nch = rem >> 5, g = (rem >> 3) & 3, cc = rem & 7, n = nch * 64 + lane;
                float a[8];
#pragma unroll
                for (int c = 0; c < 8; ++c) a[c] = 0.f;
                const float* wp = w_pool + ((size_t)(l * 4 + g) * 64 + cc * 8) * 64;
                for (int d = 0; d < 64; ++d) {
                    const float wb = w_ob[((size_t)l * PW + g * 64 + d) * D + n] * pool_scale[l * PW + g * 64 + d];
#pragma unroll
                    for (int c = 0; c < 8; ++c) a[c] += wp[c * 64 + d] * wb;
                }
                u32x4 o; o.x = pk2(a[0], a[1]); o.y = pk2(a[2], a[3]); o.z = pk2(a[4], a[5]); o.w = pk2(a[6], a[7]);
                *(u32x4*)(WBR + ((size_t)l * D + n) * D + 512 + g * 64 + cc * 8) = o;
                continue;
            }
            it -= I_OB;
            if (it < I_X) {
                const int row = it, mr = row < MP ? 0 : 1 + ((row - MP) >> 10);
                const float* xr = row < MP ? x_prompt + (size_t)row * D : x_sample + (size_t)(row - MP) * D;
                float ss = 0.f;
#pragma unroll
                for (int j = 0; j < 4; ++j) {
                    const int col = 256 * j + 4 * lane;
                    const f32x4 v = *(const f32x4*)(xr + col);
                    *(f32x4*)(X + (size_t)row * D + col) = v;
                    ss += (v[0] * v[0] + v[1] * v[1]) + (v[2] * v[2] + v[3] * v[3]);
                    const f32x4 sc = *(const f32x4*)(MODRAW + (size_t)mr * NMOD + D + col) + *(const f32x4*)(b_mod + D + col);
                    const f32x4 gg = *(const f32x4*)(norm1_g + col) * (sc + 1.0f);
                    const f32x4 xs = v * gg;
                    u32x2 o; o.x = pk2(xs[0], xs[1]); o.y = pk2(xs[2], xs[3]);
                    *(u32x2*)(XG + (size_t)row * D + col) = o;
                }
                ss = wave_sum(ss);
                if (lane == 0) RSS[row] = ss;
                continue;
            }
            it -= I_X;
            if (it < I_KC) {
                const int l = it / 512, bs = (it >> 8) & 1, key = it & 255;
                const float* src = cache_k + (((size_t)(bs * DEPTH + l) * 256 + key) * 512) + 8 * lane;
                const f32x4 a = *(const f32x4*)src, b = *(const f32x4*)(src + 4);
                *(u32x4*)(KC + (((size_t)(l * 2 + bs) * 256 + key) * 512) + 8 * lane) = pk8(a, b);
                continue;
            }
            it -= I_KC;
            if (it < I_VC) {
                const int l = it / 64, bs = (it >> 5) & 1, h = (it >> 2) & 7, kb = it & 3, key = kb * 64 + lane;
                const float* src = cache_v + (((size_t)(bs * DEPTH + l) * 256 + key) * 512) + h * 64;
                bf16_t* dst = VTC + ((size_t)((l * 2 + bs) * 8 + h) * 64) * 256 + pos_of_key(key);
#pragma unroll
                for (int d4 = 0; d4 < 16; ++d4) {
                    const f32x4 v = *(const f32x4*)(src + 4 * d4);
                    const unsigned w0 = pk2(v[0], v[1]), w1 = pk2(v[2], v[3]);
                    dst[(size_t)(4 * d4 + 0) * 256] = (bf16_t)(w0 & 0xffff); dst[(size_t)(4 * d4 + 1) * 256] = (bf16_t)(w0 >> 16);
                    dst[(size_t)(4 * d4 + 2) * 256] = (bf16_t)(w1 & 0xffff); dst[(size_t)(4 * d4 + 3) * 256] = (bf16_t)(w1 >> 16);
                }
                continue;
            }
            it -= I_VC;
            {
                const int q = it & 3, which = (it >> 2) % 6, lr = it / 24, l = lr / 3, col = q * 256 + 4 * lane;
                const float* mraw = MODRAW + (size_t)lr * NMOD; const float* bm = b_mod + (size_t)l * NMOD;
                f32x4 v;
                if (which == 0) v = *(const f32x4*)(norm1_g + (size_t)l * D + col) * (*(const f32x4*)(mraw + D + col) + *(const f32x4*)(bm + D + col) + 1.0f);
                else if (which == 1) v = *(const f32x4*)(mraw + col) + *(const f32x4*)(bm + col);
                else if (which == 2) v = *(const f32x4*)(mraw + 2 * D + col) + *(const f32x4*)(bm + 2 * D + col);
                else if (which == 3) v = *(const f32x4*)(norm2_g + (size_t)l * D + col) * (*(const f32x4*)(mraw + 4 * D + col) + *(const f32x4*)(bm + 4 * D + col) + 1.0f);
                else if (which == 4) v = *(const f32x4*)(mraw + 3 * D + col) + *(const f32x4*)(bm + 3 * D + col);
                else v = *(const f32x4*)(mraw + 5 * D + col) + *(const f32x4*)(bm + 5 * D + col);
                *(f32x4*)(MODT + ((size_t)lr * 6 + which) * D + col) = v;
            }
        }
        LDS_WAIT(); __syncthreads();
    }
    }
    SEAM(1);

    for (int l = 0; l < DEPTH; ++l) {
        const int p0 = 2 + 6 * l;
        const float* modt_l = MODT + (size_t)l * 3 * 6 * D;
        for (int rep_ = 0; rep_ < MK_REPS(0); ++rep_) { if (rep_) GRID_BAR();
        if (IN(p0)) {
            pg8::Gemm g{XG, WIN + (size_t)l * NIN * D, D, D};
            pg8::TileOrder S; S.init(M, NIN, D, G, bx);
            EpiIn E{RSS + (size_t)(2 * l) * M, C1 + (size_t)(l * 3) * NIN, b_gate + (size_t)l * 3072, Qb, Kb, VT, PIN, CIN, GT,
                    args.out + OUT_K + (size_t)l * 256 * 512, args.out + OUT_V + (size_t)l * 256 * 512};
            pg8::gemm_phase<EpiIn, pg8::TileOrder>(lds, g, S, E);
        }
        }
        SEAM(p0);
        for (int rep_ = 0; rep_ < MK_REPS(1); ++rep_) { if (rep_) GRID_BAR();
        if (IN(p0 + 1)) {
            AttnPtrs AP{Qb, Kb, VT, KC + (size_t)l * 2 * 256 * 512, VTC + (size_t)l * 2 * 8 * 64 * 256, ABR};
            PcPtrs PP{PIN, CIN, w_dw + (size_t)l * CONVK * CW, b_dw + (size_t)l * CW, conv_norm_g + (size_t)l * CW, conv_norm_b + (size_t)l * CW, ABR};
            int lane_p = lane; asm volatile("" : "+v"(lane_p));
            if (vcu < 128) {
                LAS float* rpl = (LAS float*)(lds + 1024); LAS float* parts = (LAS float*)(lds + 16384);
                LAS unsigned char* kl = lds + 53248; LAS unsigned char* vl = kl + PA_K_BYTES;
                const float* rpb_l = rpb + (size_t)l * 8 * 15 * 31;
                for (int i = wave * 64 + lane_p; i < 8 * 15 * 31; i += NWAVES * 64) rpl[i] = rpb_l[i] * LOG2E;
                if (!(rep_ && MK_VAR == 1)) attn_sample_block(AP, kl, vl, rpl, parts, vcu, wave, lane_p);
                { const int pu = vcu * NWAVES + wave; if (pu < 768 && !(rep_ && (MK_VAR == 4 || MK_VAR == 5))) pool_unit(PP, pu, lane_p); }
            } else {
                LAS float* wl = (LAS float*)lds; LAS unsigned char* kl = lds + 49152; LAS unsigned char* vl = kl + PA_K_BYTES;
                const int bh = vcu - 128;
                for (int i = wave * 64 + lane_p; i < 47 * CW / 4; i += NWAVES * 64) { const int j = i / (CW / 4) - 7;
                    *(LAS f32x4*)(wl + 4 * i) = (j >= 0 && j < CONVK) ? *(const f32x4*)(PP.wdw + 4 * (i - 7 * (CW / 4))) : (f32x4){0.f, 0.f, 0.f, 0.f}; }
                { StageRegs R; attn_stage_load(R, AP.K + (size_t)((bh >> 3) * 256) * NAW + (bh & 7) * 64, AP.Vt + (size_t)(bh * 64) * 256, 256, 256, wave * 64 + lane_p); attn_stage_store(R, 256, kl, vl, wave * 64 + lane_p); }
                LDS_WAIT(); __syncthreads();
                if (!(rep_ && (MK_VAR == 2 || MK_VAR == 5))) attn_prompt_lds(AP, kl, vl, bh, wave, lane_p);
                { const int it = bh * NWAVES + wave;
                    if (it < 768) { if (!(rep_ && (MK_VAR == 3 || MK_VAR == 5))) conv_unit(PP, wl, it, lane_p); } }
            }
            __syncthreads();
        }
        }
        SEAM(p0 + 1);
        const int t192 = (bx & 7) * 32 + (bx >> 3), pm192 = t192 >> 3, pn192 = t192 & 7;
        const bool has192 = (G == 256);
        for (int rep_ = 0; rep_ < MK_REPS(2); ++rep_) { if (rep_) GRID_BAR();
        if (IN(p0 + 2)) {
            EpiBranch192 E{GT, MB};
            if (has192) g192::gemm<EpiBranch192>(lds, ABR, D, WBR + (size_t)l * D * D, D, pm192, pn192, 16, E);
        }
        }
        SEAM(p0 + 2);
        for (int rep_ = 0; rep_ < MK_REPS(5); ++rep_) { if (rep_) GRID_BAR();
        if (IN(p0 + 3)) {
            EpiRes192 E{rep_ ? MF : X, rep_ ? ACT : XG, modt_l + 2 * D, modt_l + 3 * D, rep_ ? (float*)ABR : RSS + (size_t)(2 * l + 1) * M};
            if (has192) g192::gemm<EpiRes192>(lds, MB, D, WOUT + (size_t)l * D * D, D, pm192, pn192, 16, E);
        }
        }
        SEAM(p0 + 3);
        for (int rep_ = 0; rep_ < MK_REPS(3); ++rep_) { if (rep_) GRID_BAR();
        if (IN(p0 + 4)) {
            pg8::Gemm g{XG, WGU + (size_t)l * NGU * D, D, D};
            pg8::TileOrderGU S; S.init(M, NGU, D, G, bx);
            EpiGU E{RSS + (size_t)(2 * l + 1) * M, C2 + (size_t)(l * 3) * NGU, ACT};
            pg8::gemm_phase<EpiGU, pg8::TileOrderGU>(lds, g, S, E);
        }
        }
        SEAM(p0 + 4);
        for (int rep_ = 0; rep_ < MK_REPS(6); ++rep_) { if (rep_) GRID_BAR();
        if (IN(p0 + 5)) {
            EpiRes192 E{rep_ ? MF : X, rep_ ? MB : XG, modt_l + 5 * D, MODT + (size_t)((l + 1) % DEPTH) * 3 * 6 * D, rep_ ? (float*)ABR : RSS + (size_t)(2 * l + 2) * M};
            if (has192) g192::gemm<EpiRes192>(lds, ACT, FFN, WDN + (size_t)l * D * FFN, FFN, pm192, pn192, FFN / 64, E);
        }
        }
        SEAM(p0 + 5);
    }
    if (IN(NPHASE - 1)) {
        for (int row = gw; row < M; row += NGW) {
            const float rinv = 1.0f / sqrtf(RSS[(size_t)8 * M + row] * (1.0f / D) + EPS);
#pragma unroll
            for (int j = 0; j < 4; ++j) {
                const int col = 256 * j + 4 * lane;
                const f32x4 v = *(const f32x4*)(X + (size_t)row * D + col) * rinv * *(const f32x4*)(final_g + col);
                __builtin_nontemporal_store(v, (f32x4*)(args.out + OUT_Y + (size_t)row * D + col));
            }
        }
    }
#undef IN
#undef SEAM
}

extern "C" void kernel_launch(void* const* d_in, const int* in_sizes, int n_in, void* d_out, int out_size, void* d_ws, size_t ws_size, hipStream_t stream) {
    static int grid = 0;
    if (grid == 0) {
        if (n_in != 26 || ws_size < WS_END) { fprintf(stderr, "kernel_launch: expected 26 inputs and >= %zu bytes of workspace; got %d, %zu\n", (size_t)WS_END, n_in, ws_size); grid = -1; return; }
        int dev = 0, cus = 0;
        if (hipGetDevice(&dev) != hipSuccess || hipDeviceGetAttribute(&cus, hipDeviceAttributeMultiprocessorCount, dev) != hipSuccess) { grid = -1; return; }
        if (hipFuncSetAttribute((const void*)fwd_kernel, hipFuncAttributeMaxDynamicSharedMemorySize, LDS_BYTES) != hipSuccess) { fprintf(stderr, "kernel_launch: hipFuncSetAttribute failed\n"); grid = -1; return; }
        (void)hipGetLastError();
        grid = cus;
    }
    if (grid < 0) return;
    (void)hipMemsetAsync((char*)d_ws + WS_CTL, 0, CTL_ZERO_BYTES, stream);
    Args a{};
    for (int i = 0; i < 26; ++i) a.in[i] = (const float*)d_in[i];
    a.out = (float*)d_out; a.ws = (unsigned char*)d_ws;
#if MK_PER_PHASE
    for (int p = 0; p < NPHASE; ++p) { a.ph_lo = p; a.ph_hi = p + 1; hipLaunchKernelGGL(fwd_kernel, dim3(grid), dim3(NWAVES * 64), LDS_BYTES, stream, a); }
#else
    a.ph_lo = 0; a.ph_hi = NPHASE;
    hipLaunchKernelGGL(fwd_kernel, dim3(grid), dim3(NWAVES * 64), LDS_BYTES, stream, a);
#endif
}
```

```cpp
#include <hip/hip_runtime.h>
#include <cstdio>
#include <cstdint>

#ifndef MK_PER_PHASE
#define MK_PER_PHASE 0
#endif

#ifndef MK_REPEAT
#define MK_REPEAT 0
#endif
#define MK_REPS(bit) ((MK_REPEAT >> (bit)) & 1 ? 2 : 1)
#ifndef MK_VAR
#define MK_VAR 0
#endif

constexpr int D = 1024, MP = 4096, MS = 2048, M = MP + MS, DEPTH = 4;
constexpr int NIN = 5376, FFN = 2816, NGU = 2 * FFN, NMOD = 6 * D;
constexpr int NAW = 512, PW = 256, CW = 256, CONVK = 31;
constexpr float EPS = 1e-6f;
constexpr float LOG2E = 1.4426950408889634f;
constexpr float QSCALE = 0.125f * LOG2E;

constexpr size_t MiB = 1u << 20;
constexpr size_t WS_CTL = 0, CTL_ZERO_BYTES = 5 * MiB / 4;
constexpr int CW_BAR = 4096;
constexpr int CF_MODRAW = 16384;
constexpr int CF_C1 = CF_MODRAW + DEPTH * 3 * NMOD;
constexpr int CF_C2 = CF_C1 + DEPTH * 3 * NIN;
constexpr int CF_RSS = CF_C2 + DEPTH * 3 * NGU;
constexpr int CF_END = CF_RSS + 9 * M;
static_assert((size_t)CF_END * 4 <= CTL_ZERO_BYTES, "control region");
constexpr size_t WS_MODT = 2 * MiB;
constexpr size_t WS_WIN = 4 * MiB;
constexpr size_t WS_WGU = 46 * MiB;
constexpr size_t WS_WDN = 90 * MiB;
constexpr size_t WS_WBR = 112 * MiB;
constexpr size_t WS_WOUT = 120 * MiB;
constexpr size_t WS_X = 128 * MiB;
constexpr size_t WS_XG = 152 * MiB;
constexpr size_t WS_Q = 164 * MiB, WS_K = 170 * MiB;
constexpr size_t WS_VT = 176 * MiB;
constexpr size_t WS_KC = 182 * MiB;
constexpr size_t WS_VTC = 184 * MiB;
constexpr size_t WS_PIN = 186 * MiB;
constexpr size_t WS_CIN = 189 * MiB;
constexpr size_t WS_G = 195 * MiB;
constexpr size_t WS_ABR = 231 * MiB;
constexpr size_t WS_MF = 243 * MiB;
constexpr size_t WS_MB = 267 * MiB;
constexpr size_t WS_ACT = 279 * MiB;
constexpr size_t WS_END = 312 * MiB;
constexpr size_t VT_SAMPLE_OFF = (size_t)16 * 8 * 64 * 256;

constexpr size_t OUT_Y = 0, OUT_K = (size_t)M * D, OUT_V = OUT_K + (size_t)16 * DEPTH * 256 * 512;

#define GAS __attribute__((address_space(1)))
#define LAS __attribute__((address_space(3)))
typedef unsigned short bf16_t;
typedef short bf16x8 __attribute__((ext_vector_type(8)));
typedef float f32x4 __attribute__((ext_vector_type(4)));
typedef float f32x2 __attribute__((ext_vector_type(2)));
typedef float f32x16 __attribute__((ext_vector_type(16)));
typedef unsigned u32x4 __attribute__((ext_vector_type(4)));
typedef unsigned u32x2 __attribute__((ext_vector_type(2)));
typedef __bf16 bf16x2_t __attribute__((ext_vector_type(2)));
#define LDS_WAIT() asm volatile("s_waitcnt lgkmcnt(0)" ::: "memory")

__device__ __forceinline__ unsigned pk2(float lo, float hi) { f32x2 v = {lo, hi}; bf16x2_t b = __builtin_convertvector(v, bf16x2_t); return __builtin_bit_cast(unsigned, b); }
__device__ __forceinline__ u32x4 pk8(f32x4 a, f32x4 b) { u32x4 w; w.x = pk2(a[0], a[1]); w.y = pk2(a[2], a[3]); w.z = pk2(b[0], b[1]); w.w = pk2(b[2], b[3]); return w; }
__device__ __forceinline__ float bf_lo(unsigned w) { return __uint_as_float(w << 16); }
__device__ __forceinline__ float bf_hi(unsigned w) { return __uint_as_float(w & 0xffff0000u); }
__device__ __forceinline__ float sigmoidf_(float x) { return __builtin_amdgcn_rcpf(1.0f + __builtin_amdgcn_exp2f(-LOG2E * x)); }
__device__ __forceinline__ float wave_sum(float v) {
#pragma unroll
    for (int o = 1; o < 64; o <<= 1) v += __shfl_xor(v, o);
    return v;
}
__device__ __forceinline__ int pos_of_key(int t) { return (t & ~12) | ((t & 4) << 1) | ((t & 8) >> 1); }
__device__ __forceinline__ int mod_row_of_pm(int pm) { return pm < 16 ? 0 : 1 + ((pm - 16) >> 2); }

namespace pg8 {
constexpr int BM = 256, BK = 64, HALF = 128, HTB = HALF * BK * 2  , STAGE_BYTES = 8 * HTB, NXCD = 8, WGM = 4;
__host__ __device__ __forceinline__ int lds_byte(int r, int c) { return r * 128 + ((((c >> 3) ^ (r >> 1)) & 7) << 4) + (c & 7) * 2; }
__host__ __device__ __forceinline__ void stage_rc(int b, int& R, int& C) { R = b >> 7; C = (((b >> 4) ^ (R >> 1)) & 7) * 8; }
__host__ __device__ __forceinline__ int perm32(int rho) { const int n = rho >> 4, i = rho & 15; return 8 * (i >> 2) + 4 * n + (i & 3); }

struct Unit { int pm, pn, k0, nt, kind, half; };
struct Gemm { const bf16_t* A; const bf16_t* Bt; int lda, ldb; };

struct TileOrder {
    int nM, nN, nwg, G, c, nt;
    __device__ void init(int M_, int N_, int K_, int G_, int c_) { nM = M_ / BM; nN = N_ / BM; nwg = nM * nN; G = G_; c = c_; nt = K_ / BK; }
    __device__ bool next(int i, Unit& u) const {
        const long L = (long)i * G + c; if (L >= nwg) return false;
        int wgid = (int)L; { const int q = nwg / NXCD, r = nwg % NXCD, xcd = wgid % NXCD, off = wgid / NXCD; wgid = (xcd < r ? xcd * (q + 1) : r * (q + 1) + (xcd - r) * q) + off; }
        const int nig = WGM * nN, gid = wgid / nig, fm = gid * WGM, gsz = (nM - fm) < WGM ? (nM - fm) : WGM;
        u.pm = fm + ((wgid % nig) % gsz); u.pn = (wgid % nig) / gsz; u.k0 = 0; u.nt = nt; u.kind = 0; u.half = 0; return true;
    }
};
struct TileOrderGU {
    TileOrder base;
    __device__ void init(int M_, int N_, int K_, int G_, int c_) { base.init(M_, N_, K_, G_, c_); }
    __device__ bool next(int i, Unit& u) const {
        if (i < 2) return base.next(i, u);
        if (i > 2 || base.c >= 32 || base.G != 256) { if (base.G == 256) return false; return base.next(i, u); }
        const int c = base.c, xcd = c & 7, off = 64 + ((c >> 3) & 1);
        const int wgid = xcd * 66 + off;
        const int nig = WGM * base.nN, gid = wgid / nig, fm = gid * WGM, gsz = (base.nM - fm) < WGM ? (base.nM - fm) : WGM;
        u.pm = fm + ((wgid % nig) % gsz); u.pn = (wgid % nig) / gsz; u.k0 = 0; u.nt = base.nt; u.kind = 0; u.half = 1 + (c >> 4); return true;
    }
};
struct PanelOrder {
    int c, nseg, ka, na, kb, nb, kc, nc;
    __device__ bool next(int i, Unit& u) const {
        if (c >= 96 || i >= nseg) return false;
        const int T = (c & 7) * 12 + (c >> 3);
        u.pm = T >> 2; u.pn = T & 3; u.k0 = i == 0 ? ka : (i == 1 ? kb : kc); u.nt = i == 0 ? na : (i == 1 ? nb : nc); u.kind = i; u.half = 0; return true;
    }
};

template <class Epi, class Sched>
__device__ __forceinline__ void gemm_phase(LAS unsigned char* lds, const Gemm g, const Sched& S, const Epi& E) {
    int tid = threadIdx.x; asm volatile("" : "+v"(tid));
    const int wid = __builtin_amdgcn_readfirstlane(tid >> 6), lane = tid & 63, wr = wid >> 2, wc = wid & 3, fr = lane & 15, fq = lane >> 4;
    unsigned voffA[2], voffB[2];
#pragma unroll
    for (int i = 0; i < 2; ++i) { int R, C; stage_rc(tid * 16 + i * 8192, R, C); const int Rb = (R & ~31) + perm32(R & 31);
        voffA[i] = (unsigned)(R * g.lda + C) * 2u; voffB[i] = (unsigned)(Rb * g.ldb + C) * 2u; }
    const size_t kstep = (size_t)(BK * 2);
    const size_t hstepA = (size_t)HALF * g.lda * 2, hstepB = (size_t)HALF * g.ldb * 2;
    const size_t tstepA = 2 * hstepA, tstepB = 2 * hstepB;
    const unsigned ldsw = (unsigned)wid * 1024u;
    const int aoffk[2] = {lds_byte(wr * 64 + fr, fq * 8), lds_byte(wr * 64 + fr, fq * 8 + 32)}, boffk[2] = {lds_byte(wc * 32 + fr, fq * 8), lds_byte(wc * 32 + fr, fq * 8 + 32)};
#define PG8_SA(b, h) (((b) * 2 + (h)) * HTB)
#define PG8_SB(b, h) ((4 + (b) * 2 + (h)) * HTB)
#define PG8_STAGE(bufoff, gbase, voff) do { _Pragma("unroll") for (int _i = 0; _i < 2; ++_i) \
        __builtin_amdgcn_global_load_lds((const unsigned*)((const char*)(gbase) + (voff)[_i]), (LAS unsigned*)(lds + (bufoff) + ldsw + _i * 8192), 16, 0, 0); } while (0)
#define PG8_LDA(dst, b, h) do { _Pragma("unroll") for (int m = 0; m < 4; ++m) _Pragma("unroll") for (int k = 0; k < 2; ++k) dst[m][k] = *(const LAS bf16x8*)(lds + PG8_SA(b, h) + aoffk[k] + m * 2048); } while (0)
#define PG8_LDB(dst, b, h) do { _Pragma("unroll") for (int n = 0; n < 2; ++n) _Pragma("unroll") for (int k = 0; k < 2; ++k) dst[n][k] = *(const LAS bf16x8*)(lds + PG8_SB(b, h) + boffk[k] + n * 2048); } while (0)
#define PG8_MMA(ai, bj, At, Bt) do { __builtin_amdgcn_s_setprio(1); _Pragma("unroll") for (int m = 0; m < 4; ++m) _Pragma("unroll") for (int n = 0; n < 2; ++n) _Pragma("unroll") for (int k = 0; k < 2; ++k) \
        acc[ai][bj][m][n] = __builtin_amdgcn_mfma_f32_16x16x32_bf16(Bt[n][k], At[m][k], acc[ai][bj][m][n], 0, 0, 0); __builtin_amdgcn_s_setprio(0); } while (0)
#define PG8_WAIT_V(n) asm volatile("s_waitcnt vmcnt(" #n ")" ::: "memory")
#define PG8_WAIT_L(n) asm volatile("s_waitcnt lgkmcnt(" #n ")" ::: "memory")
#define PG8_BAR __builtin_amdgcn_s_barrier()
#define PG8_SCHED __builtin_amdgcn_sched_barrier(0)
    Unit cur, nxt; int ui = 0;
    if (!S.next(0, cur)) return;
    f32x4 acc[2][2][4][2];
#pragma unroll
    for (int a = 0; a < 2; ++a)
#pragma unroll
        for (int b = 0; b < 2; ++b)
#pragma unroll
            for (int m = 0; m < 4; ++m)
#pragma unroll
                for (int n = 0; n < 2; ++n) acc[a][b][m][n] = (f32x4){0.f, 0.f, 0.f, 0.f};
    bf16x8 At[4][2], B0[2][2], B1[2][2];
    const char* cA = (const char*)g.A + (size_t)cur.pm * tstepA + (size_t)cur.k0 * 2; const char* cB = (const char*)g.Bt + (size_t)cur.pn * tstepB + (size_t)cur.k0 * 2;
    PG8_STAGE(PG8_SB(0, 0), cB, voffB); PG8_STAGE(PG8_SB(0, 1), cB + hstepB, voffB); PG8_STAGE(PG8_SA(0, 0), cA, voffA); PG8_STAGE(PG8_SA(0, 1), cA + hstepA, voffA);
    if (wr == 1) PG8_BAR;
    PG8_WAIT_V(2); PG8_BAR;
    PG8_STAGE(PG8_SB(1, 0), cB + kstep, voffB); PG8_STAGE(PG8_SA(1, 0), cA + kstep, voffA); PG8_STAGE(PG8_SB(1, 1), cB + hstepB + kstep, voffB);
    PG8_WAIT_V(6); PG8_BAR;
    for (;;) {
        const bool has_next = S.next(ui + 1, nxt);
        const char* nA = has_next ? (const char*)g.A + (size_t)nxt.pm * tstepA + (size_t)nxt.k0 * 2 : cA; const char* nB = has_next ? (const char*)g.Bt + (size_t)nxt.pn * tstepB + (size_t)nxt.k0 * 2 : cB;
        const int nt = cur.nt;
        const bool do0 = cur.half != 2, do1 = cur.half != 1;
        for (int t = 0; t < nt; t += 2) {
            const bool last = (t == nt - 2);
            const char* a1 = cA + (size_t)(t + 1) * kstep;
            const char* a2 = last ? nA : cA + (size_t)(t + 2) * kstep; const char* b2 = last ? nB : cB + (size_t)(t + 2) * kstep;
            const char* a3 = a2 + kstep; const char* b3 = b2 + kstep;
            PG8_LDB(B0, 0, 0); PG8_LDB(B1, 0, 1); PG8_SCHED; PG8_LDA(At, 0, 0); PG8_STAGE(PG8_SA(1, 1), a1 + hstepA, voffA);
            PG8_WAIT_V(8); PG8_WAIT_L(0); PG8_BAR; if (do0) { PG8_MMA(0, 0, At, B0); PG8_MMA(0, 1, At, B1); } PG8_BAR; PG8_SCHED;
            PG8_LDA(At, 0, 1); PG8_STAGE(PG8_SB(0, 0), b2, voffB); PG8_STAGE(PG8_SB(0, 1), b2 + hstepB, voffB); PG8_STAGE(PG8_SA(0, 0), a2, voffA);
            PG8_WAIT_V(8); PG8_WAIT_L(0); PG8_BAR; if (do1) { PG8_MMA(1, 0, At, B0); PG8_MMA(1, 1, At, B1); } PG8_BAR; PG8_SCHED;
            PG8_LDB(B0, 1, 0); PG8_LDB(B1, 1, 1); PG8_SCHED; PG8_LDA(At, 1, 0); PG8_STAGE(PG8_SA(0, 1), a2 + hstepA, voffA);
            PG8_WAIT_V(8); PG8_WAIT_L(0); PG8_BAR; if (do0) { PG8_MMA(0, 0, At, B0); PG8_MMA(0, 1, At, B1); } PG8_BAR; PG8_SCHED;
            PG8_LDA(At, 1, 1); PG8_STAGE(PG8_SB(1, 0), b3, voffB); PG8_STAGE(PG8_SB(1, 1), b3 + hstepB, voffB); PG8_STAGE(PG8_SA(1, 0), a3, voffA);
            PG8_WAIT_V(8); PG8_WAIT_L(0); PG8_BAR; if (do1) { PG8_MMA(1, 0, At, B0); PG8_MMA(1, 1, At, B1); } PG8_BAR; PG8_SCHED;
        }
        if (wr == 0) PG8_BAR;
        E(acc, cur, wr, wc, fr, fq);
        if (!has_next) break;
#pragma unroll
        for (int a = 0; a < 2; ++a)
#pragma unroll
            for (int b = 0; b < 2; ++b)
#pragma unroll
                for (int m = 0; m < 4; ++m)
#pragma unroll
                    for (int n = 0; n < 2; ++n) acc[a][b][m][n] = (f32x4){0.f, 0.f, 0.f, 0.f};
        cur = nxt; cA = nA; cB = nB; ++ui;
        if (wr == 1) PG8_BAR;
    }
    PG8_WAIT_V(0);
    PG8_BAR;
#undef PG8_SA
#undef PG8_SB
#undef PG8_STAGE
#undef PG8_LDA
#undef PG8_LDB
#undef PG8_MMA
#undef PG8_WAIT_V
#undef PG8_WAIT_L
#undef PG8_BAR
#undef PG8_SCHED
}
}

typedef f32x4 Acc[2][2][4][2];

struct EpiIn {
    const float* rss; const float* c1; const float* bgate;
    bf16_t *Q, *K, *Vt, *Pin, *Cin, *G; float *outk, *outv;
    __device__ __forceinline__ void operator()(const Acc& acc, const pg8::Unit& u, int wr, int wc, int fr, int fq) const {
        const int pn = u.pn, pm = u.pm, mr = mod_row_of_pm(pm);
        const int cb = pn * 256 + wc * 32 + 8 * fq;
        f32x4 cv[2][2];
#pragma unroll
        for (int bj = 0; bj < 2; ++bj)
#pragma unroll
            for (int n = 0; n < 2; ++n) cv[bj][n] = *(const f32x4*)(c1 + (size_t)mr * NIN + cb + bj * 128 + 4 * n);
        float rinvs[2][4];
#pragma unroll
        for (int ai = 0; ai < 2; ++ai)
#pragma unroll
            for (int m = 0; m < 4; ++m) rinvs[ai][m] = rss[pm * 256 + ai * 128 + wr * 64 + m * 16 + fr];
#pragma unroll
        for (int ai = 0; ai < 2; ++ai)
#pragma unroll
            for (int m = 0; m < 4; ++m) {
                const int row = pm * 256 + ai * 128 + wr * 64 + m * 16 + fr;
                const float rinv = 1.0f / sqrtf(rinvs[ai][m] * (1.0f / D) + EPS);
#pragma unroll
                for (int bj = 0; bj < 2; ++bj) {
                    const int col = cb + bj * 128;
                    f32x4 v0 = acc[ai][bj][m][0] * rinv + cv[bj][0], v1 = acc[ai][bj][m][1] * rinv + cv[bj][1];
                    if (pn < 2) {
                        *(u32x4*)(Q + (size_t)row * NAW + col) = pk8(v0 * QSCALE, v1 * QSCALE);
                    } else if (pn < 4) {
                        const int c = col - 512;
                        *(u32x4*)(K + (size_t)row * NAW + c) = pk8(v0, v1);
                        if (pm < 16) { float* o = outk + ((size_t)(pm * DEPTH * 256 + (row & 255))) * 512 + c; __builtin_nontemporal_store(v0, (f32x4*)o); __builtin_nontemporal_store(v1, (f32x4*)(o + 4)); }
                    } else if (pn < 6) {
                        const int c = col - 1024, h = c >> 6, d = c & 63;
                        if (pm < 16) { float* o = outv + ((size_t)(pm * DEPTH * 256 + (row & 255))) * 512 + c; __builtin_nontemporal_store(v0, (f32x4*)o); __builtin_nontemporal_store(v1, (f32x4*)(o + 4)); }
                        bf16_t* vb; int L;
                        if (pm < 16) { L = 256; vb = Vt + ((size_t)((pm * 8 + h) * 64 + d)) * 256 + pos_of_key(row & 255); }
                        else { const int rs = row - MP, bs = rs >> 10; L = 1024; vb = Vt + VT_SAMPLE_OFF + ((size_t)((bs * 8 + h) * 64 + d)) * 1024 + pos_of_key(rs & 1023); }
                        const u32x4 w = pk8(v0, v1);
                        vb[0] = (bf16_t)(w.x & 0xffff); vb[(size_t)L] = (bf16_t)(w.x >> 16); vb[(size_t)2 * L] = (bf16_t)(w.y & 0xffff); vb[(size_t)3 * L] = (bf16_t)(w.y >> 16);
                        vb[(size_t)4 * L] = (bf16_t)(w.z & 0xffff); vb[(size_t)5 * L] = (bf16_t)(w.z >> 16); vb[(size_t)6 * L] = (bf16_t)(w.w & 0xffff); vb[(size_t)7 * L] = (bf16_t)(w.w >> 16);
                    } else if (pn == 6) {
                        *(u32x4*)(Pin + (size_t)row * PW + (col - 1536)) = pk8(v0, v1);
                    } else if (pn < 9) {
                        *(u32x4*)(Cin + (size_t)row * 512 + (col - 1792)) = pk8(v0, v1);
                    } else {
                        v0 += *(const f32x4*)(bgate + (col - 2304)); v1 += *(const f32x4*)(bgate + (col - 2304) + 4);
#pragma unroll
                        for (int e = 0; e < 4; ++e) { v0[e] = sigmoidf_(v0[e]); v1[e] = sigmoidf_(v1[e]); }
                        *(u32x4*)(G + (size_t)row * 3072 + (col - 2304)) = pk8(v0, v1);
                    }
                }
                asm volatile("" ::: "memory");
            }
    }
};

struct EpiBranch {
    const bf16_t* G; float* mf; bf16_t* mb;
    __device__ __forceinline__ void operator()(const Acc& acc, const pg8::Unit& u, int wr, int wc, int fr, int fq) const {
        const int cb = u.pn * 256 + wc * 32 + 8 * fq, kind = u.kind;
#pragma unroll
        for (int ai = 0; ai < 2; ++ai)
#pragma unroll
            for (int m = 0; m < 4; ++m) {
                const int row = u.pm * 256 + ai * 128 + wr * 64 + m * 16 + fr;
#pragma unroll
                for (int bj = 0; bj < 2; ++bj) {
                    const int col = cb + bj * 128;
                    const u32x4 gw = *(const u32x4*)(G + (size_t)row * 3072 + kind * 1024 + col);
                    f32x4 v0 = acc[ai][bj][m][0], v1 = acc[ai][bj][m][1];
                    v0[0] *= bf_lo(gw.x); v0[1] *= bf_hi(gw.x); v0[2] *= bf_lo(gw.y); v0[3] *= bf_hi(gw.y);
                    v1[0] *= bf_lo(gw.z); v1[1] *= bf_hi(gw.z); v1[2] *= bf_lo(gw.w); v1[3] *= bf_hi(gw.w);
                    float* sp = mf + (size_t)row * D + col;
                    if (kind > 0) { v0 += *(const f32x4*)sp; v1 += *(const f32x4*)(sp + 4); }
                    if (kind < 2) { *(f32x4*)sp = v0; *(f32x4*)(sp + 4) = v1; }
                    else *(u32x4*)(mb + (size_t)row * D + col) = pk8(v0, v1);
                }
                asm volatile("" ::: "memory");
            }
    }
};

struct EpiRes {
    float* x; bf16_t* xg; const float* gate; const float* gsn; float* rssn;
    __device__ __forceinline__ void operator()(const Acc& acc, const pg8::Unit& u, int wr, int wc, int fr, int fq) const {
        const int mr = mod_row_of_pm(u.pm), cb = u.pn * 256 + wc * 32 + 8 * fq;
        float ss[2][4];
#pragma unroll
        for (int ai = 0; ai < 2; ++ai)
#pragma unroll
            for (int m = 0; m < 4; ++m) ss[ai][m] = 0.f;
#pragma unroll
        for (int bj = 0; bj < 2; ++bj) {
            const int col = cb + bj * 128;
            const f32x4 gt0 = *(const f32x4*)(gate + (size_t)mr * 6 * D + col), gt1 = *(const f32x4*)(gate + (size_t)mr * 6 * D + col + 4);
            const f32x4 gs0 = *(const f32x4*)(gsn + (size_t)mr * 6 * D + col), gs1 = *(const f32x4*)(gsn + (size_t)mr * 6 * D + col + 4);
#pragma unroll
            for (int ai = 0; ai < 2; ++ai)
#pragma unroll
                for (int m = 0; m < 4; ++m) {
                    const int row = u.pm * 256 + ai * 128 + wr * 64 + m * 16 + fr;
                    float* xp = x + (size_t)row * D + col;
                    f32x4 x0 = *(const f32x4*)xp, x1 = *(const f32x4*)(xp + 4);
                    x0 += gt0 * acc[ai][bj][m][0]; x1 += gt1 * acc[ai][bj][m][1];
                    *(f32x4*)xp = x0; *(f32x4*)(xp + 4) = x1;
                    ss[ai][m] += (x0[0] * x0[0] + x0[1] * x0[1]) + (x0[2] * x0[2] + x0[3] * x0[3]) + (x1[0] * x1[0] + x1[1] * x1[1]) + (x1[2] * x1[2] + x1[3] * x1[3]);
                    *(u32x4*)(xg + (size_t)row * D + col) = pk8(x0 * gs0, x1 * gs1);
                    asm volatile("" ::: "memory");
                }
        }
#pragma unroll
        for (int ai = 0; ai < 2; ++ai)
#pragma unroll
            for (int m = 0; m < 4; ++m) {
                float s = ss[ai][m];
                s += __shfl_xor(s, 16); s += __shfl_xor(s, 32);
                if (fq == 0) atomicAdd(rssn + u.pm * 256 + ai * 128 + wr * 64 + m * 16 + fr, s);
            }
    }
};

struct EpiGU {
    const float* rss; const float* c2; bf16_t* act;
    __device__ __forceinline__ void operator()(const Acc& acc, const pg8::Unit& u, int wr, int wc, int fr, int fq) const {
        const int mr = mod_row_of_pm(u.pm), ca0 = u.pn * 128 + wc * 32 + 8 * fq;
        f32x4 ca[2], cbv[2];
#pragma unroll
        for (int n = 0; n < 2; ++n) { ca[n] = *(const f32x4*)(c2 + (size_t)mr * NGU + ca0 + 4 * n); cbv[n] = *(const f32x4*)(c2 + (size_t)mr * NGU + FFN + ca0 + 4 * n); }
        float rinvs[2][4];
#pragma unroll
        for (int ai = 0; ai < 2; ++ai)
#pragma unroll
            for (int m = 0; m < 4; ++m) rinvs[ai][m] = rss[u.pm * 256 + ai * 128 + wr * 64 + m * 16 + fr];
#pragma unroll
        for (int ai = 0; ai < 2; ++ai)
#pragma unroll
            for (int m = 0; m < 4; ++m) {
                if (u.half == 2 - ai) continue;
                const int row = u.pm * 256 + ai * 128 + wr * 64 + m * 16 + fr;
                const float rinv = 1.0f / sqrtf(rinvs[ai][m] * (1.0f / D) + EPS);
                f32x4 o[2];
#pragma unroll
                for (int n = 0; n < 2; ++n) {
                    const f32x4 a = acc[ai][0][m][n] * rinv + ca[n], b = acc[ai][1][m][n] * rinv + cbv[n];
#pragma unroll
                    for (int e = 0; e < 4; ++e) o[n][e] = a[e] * sigmoidf_(a[e]) * b[e];
                }
                *(u32x4*)(act + (size_t)row * FFN + ca0) = pk8(o[0], o[1]);
                asm volatile("" ::: "memory");
            }
    }
};

namespace g192 {
constexpr int TM = 192, TN = 128, BK = 64, ABYTES = TM * BK * 2, BBYTES = TN * BK * 2, SBYTES = ABYTES + BBYTES;
typedef f32x4 Acc6[6][2];
template <class Epi>
__device__ __forceinline__ void gemm(LAS unsigned char* lds, const bf16_t* A, int lda, const bf16_t* Bt, int ldb, int pm, int pn, int nt, const Epi& E) {
    int tid = threadIdx.x; asm volatile("" : "+v"(tid));
    const int wid = __builtin_amdgcn_readfirstlane(tid >> 6), lane = tid & 63, wr = wid >> 2, wc = wid & 3, fr = lane & 15, fq = lane >> 4;
    unsigned voffA[3], voffB[2];
#pragma unroll
    for (int i = 0; i < 3; ++i) { int R, C; pg8::stage_rc((wid + 8 * i) * 1024 + lane * 16, R, C); voffA[i] = (unsigned)(R * lda + C) * 2u; }
#pragma unroll
    for (int i = 0; i < 2; ++i) { int R, C; pg8::stage_rc((wid + 8 * i) * 1024 + lane * 16, R, C); const int Rb = (R & ~31) + pg8::perm32(R & 31); voffB[i] = (unsigned)(Rb * ldb + C) * 2u; }
    const char* gA = (const char*)(A + (size_t)pm * TM * lda); const char* gB = (const char*)(Bt + (size_t)pn * TN * ldb);
    const unsigned ldsw = (unsigned)wid * 1024u;
    const int aoffk[2] = {pg8::lds_byte(wr * 96 + fr, fq * 8), pg8::lds_byte(wr * 96 + fr, fq * 8 + 32)}, boffk[2] = {ABYTES + pg8::lds_byte(wc * 32 + fr, fq * 8), ABYTES + pg8::lds_byte(wc * 32 + fr, fq * 8 + 32)};
#define G192_STAGE(slot, t) do { \
        _Pragma("unroll") for (int _i = 0; _i < 3; ++_i) __builtin_amdgcn_global_load_lds((const unsigned*)(gA + (size_t)(t) * (BK * 2) + voffA[_i]), (LAS unsigned*)(lds + (slot) * SBYTES + ldsw + _i * 8192), 16, 0, 0); \
        _Pragma("unroll") for (int _i = 0; _i < 2; ++_i) __builtin_amdgcn_global_load_lds((const unsigned*)(gB + (size_t)(t) * (BK * 2) + voffB[_i]), (LAS unsigned*)(lds + (slot) * SBYTES + ABYTES + ldsw + _i * 8192), 16, 0, 0); } while (0)
#define G192_WAIT_V(n) asm volatile("s_waitcnt vmcnt(" #n ")" ::: "memory")
#define G192_WAIT_L(n) asm volatile("s_waitcnt lgkmcnt(" #n ")" ::: "memory")
    f32x4 acc[6][2], tot[6][2];
#pragma unroll
    for (int m = 0; m < 6; ++m)
#pragma unroll
        for (int n = 0; n < 2; ++n) { acc[m][n] = (f32x4){0.f, 0.f, 0.f, 0.f}; tot[m][n] = (f32x4){0.f, 0.f, 0.f, 0.f}; }
    G192_STAGE(0, 0); G192_STAGE(1, 1); G192_STAGE(2, 2);
    G192_WAIT_V(10); __builtin_amdgcn_s_barrier();
#pragma unroll 1
    for (int t = 0; t < nt; ++t) {
        const int slot = t & 3;
        if (t + 3 < nt) G192_STAGE((t + 3) & 3, t + 3);
        bf16x8 At[6][2], Bf[2][2];
        const LAS unsigned char* sb = lds + slot * SBYTES;
#pragma unroll
        for (int n = 0; n < 2; ++n)
#pragma unroll
            for (int k = 0; k < 2; ++k) Bf[n][k] = *(const LAS bf16x8*)(sb + boffk[k] + n * 2048);
#pragma unroll
        for (int m = 0; m < 6; ++m)
#pragma unroll
            for (int k = 0; k < 2; ++k) At[m][k] = *(const LAS bf16x8*)(sb + aoffk[k] + m * 2048);
        G192_WAIT_L(0);
        __builtin_amdgcn_s_setprio(1);
#pragma unroll
        for (int m = 0; m < 6; ++m)
#pragma unroll
            for (int n = 0; n < 2; ++n)
#pragma unroll
                for (int k = 0; k < 2; ++k) acc[m][n] = __builtin_amdgcn_mfma_f32_16x16x32_bf16(Bf[n][k], At[m][k], acc[m][n], 0, 0, 0);
        __builtin_amdgcn_s_setprio(0);
        if (Epi::BRANCH) { if (t == 7 || t == 11 || t == nt - 1) E.seg(acc, tot, t == 7 ? 0 : (t == 11 ? 1 : 2), pm, pn, wr, wc, fr, fq); }
        if (t + 3 < nt) G192_WAIT_V(10); else if (t + 2 < nt) G192_WAIT_V(5); else G192_WAIT_V(0);
        __builtin_amdgcn_s_barrier();
    }
    E(Epi::BRANCH ? tot : acc, pm, pn, wr, wc, fr, fq);
#undef G192_STAGE
#undef G192_WAIT_V
#undef G192_WAIT_L
}
}

struct EpiBranch192 {
    static constexpr bool BRANCH = true;
    const bf16_t* G; bf16_t* mb;
    __device__ __forceinline__ void seg(g192::Acc6& acc, g192::Acc6& tot, int kind, int pm, int pn, int wr, int wc, int fr, int fq) const {
        const int col = pn * 128 + wc * 32 + 8 * fq;
#pragma unroll
        for (int m = 0; m < 6; ++m) {
            const int row = pm * 192 + wr * 96 + m * 16 + fr;
            const u32x4 gw = *(const u32x4*)(G + (size_t)row * 3072 + kind * 1024 + col);
            f32x4 g0 = {bf_lo(gw.x), bf_hi(gw.x), bf_lo(gw.y), bf_hi(gw.y)}, g1 = {bf_lo(gw.z), bf_hi(gw.z), bf_lo(gw.w), bf_hi(gw.w)};
            tot[m][0] += g0 * acc[m][0]; tot[m][1] += g1 * acc[m][1];
            acc[m][0] = (f32x4){0.f, 0.f, 0.f, 0.f}; acc[m][1] = (f32x4){0.f, 0.f, 0.f, 0.f};
        }
    }
    __device__ __forceinline__ void operator()(const g192::Acc6& tot, int pm, int pn, int wr, int wc, int fr, int fq) const {
        const int col = pn * 128 + wc * 32 + 8 * fq;
#pragma unroll
        for (int m = 0; m < 6; ++m) { const int row = pm * 192 + wr * 96 + m * 16 + fr; *(u32x4*)(mb + (size_t)row * D + col) = pk8(tot[m][0], tot[m][1]); }
    }
};
struct EpiRes192 {
    static constexpr bool BRANCH = false;
    float* x; bf16_t* xg; const float* gate; const float* gsn; float* rssn;
    __device__ __forceinline__ void seg(g192::Acc6&, g192::Acc6&, int, int, int, int, int, int, int) const {}
    __device__ __forceinline__ void operator()(const g192::Acc6& acc, int pm, int pn, int wr, int wc, int fr, int fq) const {
        const int col = pn * 128 + wc * 32 + 8 * fq;
#pragma unroll
        for (int h = 0; h < 2; ++h) {
            f32x4 xv[3][2], gt[3][2], gs[3][2];
#pragma unroll
            for (int q = 0; q < 3; ++q) {
                const int row = pm * 192 + wr * 96 + (3 * h + q) * 16 + fr;
                const int mr = row < MP ? 0 : 1 + ((row - MP) >> 10);
                const float* gp = gate + (size_t)mr * 6 * D + col; const float* sp = gsn + (size_t)mr * 6 * D + col; const float* xp = x + (size_t)row * D + col;
                xv[q][0] = *(const f32x4*)xp; xv[q][1] = *(const f32x4*)(xp + 4);
                gt[q][0] = *(const f32x4*)gp; gt[q][1] = *(const f32x4*)(gp + 4); gs[q][0] = *(const f32x4*)sp; gs[q][1] = *(const f32x4*)(sp + 4);
            }
#pragma unroll
            for (int q = 0; q < 3; ++q) {
                const int m = 3 * h + q, row = pm * 192 + wr * 96 + m * 16 + fr;
                float* xp = x + (size_t)row * D + col;
                const f32x4 x0 = xv[q][0] + gt[q][0] * acc[m][0], x1 = xv[q][1] + gt[q][1] * acc[m][1];
                *(f32x4*)xp = x0; *(f32x4*)(xp + 4) = x1;
                float ss = (x0[0] * x0[0] + x0[1] * x0[1]) + (x0[2] * x0[2] + x0[3] * x0[3]) + (x1[0] * x1[0] + x1[1] * x1[1]) + (x1[2] * x1[2] + x1[3] * x1[3]);
                *(u32x4*)(xg + (size_t)row * D + col) = pk8(x0 * gs[q][0], x1 * gs[q][1]);
                ss += __shfl_xor(ss, 16); ss += __shfl_xor(ss, 32);
                if (fq == 0) atomicAdd(rssn + row, ss);
            }
            asm volatile("" ::: "memory");
        }
    }
};

struct AttnState { f32x16 o0, o1; float m, l; };
struct KVFrag { bf16x8 k[4], v[2][2]; };
__device__ __forceinline__ void attn_load(KVFrag& f, const bf16_t* kptr  , const bf16_t* vptr  , int vstride32  ) {
#pragma unroll
    for (int s = 0; s < 4; ++s) f.k[s] = *(const bf16x8*)(kptr + 16 * s);
#pragma unroll
    for (int dt = 0; dt < 2; ++dt)
#pragma unroll
        for (int ks = 0; ks < 2; ++ks) f.v[dt][ks] = *(const bf16x8*)(vptr + (size_t)dt * vstride32 + 16 * ks);
}
__device__ __forceinline__ void attn_tile(AttnState& st, const bf16x8 (&qf)[4], const KVFrag& f, bool local, const LAS float* rl, int cq, int cs, int ck0  ) {
    f32x16 s = {0.f, 0.f, 0.f, 0.f, 0.f, 0.f, 0.f, 0.f, 0.f, 0.f, 0.f, 0.f, 0.f, 0.f, 0.f, 0.f};
#pragma unroll
    for (int k = 0; k < 4; ++k) s = __builtin_amdgcn_mfma_f32_32x32x16_bf16(f.k[k], qf[k], s, 0, 0, 0);
    if (local) {
        const LAS float* rb = rl + (ck0 - cq + 15);
        const int d0 = ck0 - cs;
#pragma unroll
        for (int i = 0; i < 16; ++i) {
            const int o = (i & 3) + 8 * (i >> 2);
            const bool ok = (unsigned)(d0 + o) < 16u;
            s[i] = ok ? s[i] + rb[o] : -1e30f;
        }
    }
    float mx = fmaxf(fmaxf(s[0], s[1]), fmaxf(s[2], s[3]));
#pragma unroll
    for (int i = 4; i < 16; i += 4) mx = fmaxf(mx, fmaxf(fmaxf(s[i], s[i + 1]), fmaxf(s[i + 2], s[i + 3])));
    mx = fmaxf(mx, __shfl_xor(mx, 32));
    const float mo = st.m, mn = fmaxf(mo, mx);
    st.m = mn;
    float ls = 0.f;
#pragma unroll
    for (int i = 0; i < 16; ++i) { const float p = __builtin_amdgcn_exp2f(s[i] - mn); s[i] = p; ls += p; }
    if (__builtin_amdgcn_ballot_w64(mn > mo) != 0ull) {
        const float alpha = __builtin_amdgcn_exp2f(mo - mn);
        st.l *= alpha;
#pragma unroll
        for (int i = 0; i < 16; ++i) { st.o0[i] *= alpha; st.o1[i] *= alpha; }
    }
    st.l += ls;
    u32x4 w0, w1;
    w0.x = pk2(s[0], s[1]); w0.y = pk2(s[2], s[3]); w0.z = pk2(s[4], s[5]); w0.w = pk2(s[6], s[7]);
    w1.x = pk2(s[8], s[9]); w1.y = pk2(s[10], s[11]); w1.z = pk2(s[12], s[13]); w1.w = pk2(s[14], s[15]);
    const bf16x8 p0 = __builtin_bit_cast(bf16x8, w0), p1 = __builtin_bit_cast(bf16x8, w1);
    st.o0 = __builtin_amdgcn_mfma_f32_32x32x16_bf16(f.v[0][0], p0, st.o0, 0, 0, 0);
    st.o0 = __builtin_amdgcn_mfma_f32_32x32x16_bf16(f.v[0][1], p1, st.o0, 0, 0, 0);
    st.o1 = __builtin_amdgcn_mfma_f32_32x32x16_bf16(f.v[1][0], p0, st.o1, 0, 0, 0);
    st.o1 = __builtin_amdgcn_mfma_f32_32x32x16_bf16(f.v[1][1], p1, st.o1, 0, 0, 0);
}
__device__ __forceinline__ void attn_store(const AttnState& st, bf16_t* orow  , int hf) {
    const float lt = st.l + __shfl_xor(st.l, 32);
    const float inv = 1.0f / lt;
#pragma unroll
    for (int g = 0; g < 4; ++g) {
        u32x2 a, b;
        a.x = pk2(st.o0[4 * g] * inv, st.o0[4 * g + 1] * inv); a.y = pk2(st.o0[4 * g + 2] * inv, st.o0[4 * g + 3] * inv);
        b.x = pk2(st.o1[4 * g] * inv, st.o1[4 * g + 1] * inv); b.y = pk2(st.o1[4 * g + 2] * inv, st.o1[4 * g + 3] * inv);
        *(u32x2*)(orow + 8 * g + 4 * hf) = a;
        *(u32x2*)(orow + 32 + 8 * g + 4 * hf) = b;
    }
}
struct AttnPtrs { const bf16_t *Q, *K, *Vt, *Kc, *Vtc; bf16_t* Abr; };
constexpr int PA_K_BYTES = 256 * 128, PA_V_BYTES = 64 * 512;
struct StageRegs { u32x4 kv[4], vv[4]; };
__device__ __forceinline__ void attn_stage_load(StageRegs& R, const bf16_t* ksrc, const bf16_t* vsrc, int vld, int nkeys, int tid) {
    const int nch = nkeys * 8, sh = nkeys == 256 ? 5 : 3;
#pragma unroll
    for (int i = 0; i < 4; ++i) { int q = tid + 512 * i; q = q < nch ? q : nch - 1;
        R.kv[i] = *(const u32x4*)(ksrc + (size_t)(q >> 3) * NAW + 8 * (q & 7));
        R.vv[i] = *(const u32x4*)(vsrc + (size_t)(q >> sh) * vld + 8 * (q & ((1 << sh) - 1))); }
}
__device__ __forceinline__ void attn_stage_store(const StageRegs& R, int nkeys, LAS unsigned char* kl, LAS unsigned char* vl, int tid) {
    const int nch = nkeys * 8, sh = nkeys == 256 ? 5 : 3;
#pragma unroll
    for (int i = 0; i < 4; ++i) { const int q = tid + 512 * i; if (q < nch) {
        const int key = q >> 3, c = q & 7, d = q >> sh, cv = q & ((1 << sh) - 1);
        *(LAS u32x4*)(kl + key * 128 + ((c ^ (key & 7)) << 4)) = R.kv[i];
        *(LAS u32x4*)(vl + d * 512 + ((cv ^ (d & 15)) << 4)) = R.vv[i]; } }
}
__device__ __forceinline__ void attn_lds_frag(KVFrag& f, const LAS unsigned char* kl, const LAS unsigned char* vl, int kt, int r32, int hf) {
    const int key = 32 * kt + r32;
#pragma unroll
    for (int s = 0; s < 4; ++s) f.k[s] = *(const LAS bf16x8*)(kl + key * 128 + (((2 * s + hf) ^ (key & 7)) << 4));
#pragma unroll
    for (int dt = 0; dt < 2; ++dt)
#pragma unroll
        for (int ks = 0; ks < 2; ++ks) { const int d = 32 * dt + r32; f.v[dt][ks] = *(const LAS bf16x8*)(vl + d * 512 + (((4 * kt + 2 * ks + hf) ^ (d & 15)) << 4)); }
}
__device__ __forceinline__ void attn_prompt_lds(const AttnPtrs& P, const LAS unsigned char* kl, const LAS unsigned char* vl, int bh, int qt, int lane) {
    const int r32 = lane & 31, hf = lane >> 5, b = bh >> 3, h = bh & 7;
    const int qrow = b * 256 + qt * 32 + r32;
    bf16x8 qf[4];
#pragma unroll
    for (int s = 0; s < 4; ++s) qf[s] = *(const bf16x8*)(P.Q + (size_t)qrow * NAW + h * 64 + 16 * s + 8 * hf);
    AttnState st; st.m = -1e30f; st.l = 0.f;
#pragma unroll
    for (int i = 0; i < 16; ++i) { st.o0[i] = 0.f; st.o1[i] = 0.f; }
    KVFrag fa, fb;
    attn_lds_frag(fa, kl, vl, 0, r32, hf);
#pragma unroll 1
    for (int t = 0; t < 8; t += 2) {
        attn_lds_frag(fb, kl, vl, t + 1, r32, hf);
        attn_tile(st, qf, fa, false, nullptr, 0, 0, 0);
        if (t + 2 < 8) attn_lds_frag(fa, kl, vl, t + 2, r32, hf);
        attn_tile(st, qf, fb, false, nullptr, 0, 0, 0);
    }
    attn_store(st, P.Abr + (size_t)qrow * D + h * 64, hf);
}
constexpr int ATT_PART_FLOATS = 34 * 64;
__device__ __forceinline__ void attn_sample_block(const AttnPtrs& P, LAS unsigned char* kl, LAS unsigned char* vl, const LAS float* rpl, LAS float* parts, int blk, int wave, int lane) {
    const int r32 = lane & 31, hf = lane >> 5, tid = wave * 64 + lane;
    const int bs = blk >> 6, h = (blk >> 3) & 7, i2 = (blk & 7) * 2;
    const int u = wave >> 1, half = wave & 1, r = i2 + (u >> 1), qh = u & 1;
    const int qrow = MP + bs * 1024 + r * 64 + qh * 32 + r32;
    const int cq = qh * 32 + r32; int cs = cq - 8; cs = cs < 0 ? 0 : (cs > 48 ? 48 : cs);
    int rs = r - 4; rs = rs < 0 ? 0 : (rs > 8 ? 8 : rs);
    int rs0 = i2 - 4; rs0 = rs0 < 0 ? 0 : (rs0 > 8 ? 8 : rs0);
    int rs1 = i2 - 3; rs1 = rs1 < 0 ? 0 : (rs1 > 8 ? 8 : rs1);
    const int nstage = rs1 != rs0 ? 4 : 3;
    const bf16_t* kloc = P.K + (size_t)(MP + bs * 1024) * NAW + h * 64;
    const bf16_t* vloc = P.Vt + VT_SAMPLE_OFF + (size_t)((bs * 8 + h) * 64) * 1024;
    bf16x8 qf[4];
#pragma unroll
    for (int s = 0; s < 4; ++s) qf[s] = *(const bf16x8*)(P.Q + (size_t)qrow * NAW + h * 64 + 16 * s + 8 * hf);
    AttnState st; st.m = -1e30f; st.l = 0.f;
#pragma unroll
    for (int i = 0; i < 16; ++i) { st.o0[i] = 0.f; st.o1[i] = 0.f; }
    LAS float* part = parts + u * ATT_PART_FLOATS;
    StageRegs R;
    attn_stage_load(R, P.Kc + (size_t)(bs * 256) * NAW + h * 64, P.Vtc + (size_t)((bs * 8 + h) * 64) * 256, 256, 256, tid);
#pragma unroll 1
    for (int sg = 0; sg < nstage; ++sg) {
        if (sg) __syncthreads();
        const int row0 = rs0 + 4 * (sg - 1);
        attn_stage_store(R, sg == 3 ? 64 : 256, kl, vl, tid);
        { const int sn = sg + 1 < nstage ? sg + 1 : 1, rown = rs0 + 4 * (sn - 1);
          attn_stage_load(R, kloc + (size_t)(rown * 64) * NAW, vloc + rown * 64, 1024, sn == 3 ? 64 : 256, tid); }
        LDS_WAIT(); __syncthreads();
        KVFrag f;
        if (sg == 0) {
#pragma unroll 1
            for (int kt = 4 * half; kt < 4 * half + 4; ++kt) { attn_lds_frag(f, kl, vl, kt, r32, hf); attn_tile(st, qf, f, false, nullptr, 0, 0, 0); }
        } else {
            const int nt = sg == 3 ? 2 : 8;
#pragma unroll 1
            for (int kt = half * (nt >> 1); kt < (half + 1) * (nt >> 1); ++kt) {
                const int jr = row0 + (kt >> 1), ch = kt & 1;
                if (jr < rs || jr >= rs + 8) continue;
                attn_lds_frag(f, kl, vl, kt, r32, hf);
                attn_tile(st, qf, f, true, rpl + (h * 15 + (jr - r + 7)) * 31, cq, cs, ch * 32 + 4 * hf);
            }
        }
    }
    if (half == 1) {
#pragma unroll
        for (int i = 0; i < 16; ++i) { part[i * 64 + lane] = st.o0[i]; part[(16 + i) * 64 + lane] = st.o1[i]; }
        part[32 * 64 + lane] = st.m; part[33 * 64 + lane] = st.l;
    }
    LDS_WAIT(); __syncthreads();
    if (half == 0) {
        const float m1 = part[32 * 64 + lane], l1 = part[33 * 64 + lane];
        const float mn = fmaxf(st.m, m1), a0 = __builtin_amdgcn_exp2f(st.m - mn), a1 = __builtin_amdgcn_exp2f(m1 - mn);
        st.l = st.l * a0 + l1 * a1;
#pragma unroll
        for (int i = 0; i < 16; ++i) { st.o0[i] = st.o0[i] * a0 + part[i * 64 + lane] * a1; st.o1[i] = st.o1[i] * a0 + part[(16 + i) * 64 + lane] * a1; }
        attn_store(st, P.Abr + (size_t)qrow * D + h * 64, hf);
    }
}

struct PcPtrs { const bf16_t *Pin, *Cin; const float *wdw, *bdw, *cng, *cnb; bf16_t* Abr; };
__device__ __forceinline__ f32x4 ld_bf4(const bf16_t* p) { const u32x2 w = *(const u32x2*)p; return (f32x4){bf_lo(w.x), bf_hi(w.x), bf_lo(w.y), bf_hi(w.y)}; }
__device__ __forceinline__ f32x4 up_bf4(u32x2 w) { return (f32x4){bf_lo(w.x), bf_hi(w.x), bf_lo(w.y), bf_hi(w.y)}; }
__device__ __forceinline__ void pool_unit(const PcPtrs& P, int unit, int lane) {
    const int row0 = unit * 8;
    const int L = row0 < MP ? 256 : 1024;
    const int sb = row0 < MP ? (row0 & ~255) : MP + ((row0 - MP) & ~1023);
    const int hw = 1 << (lane >> 4);
    const int t0 = row0 - sb;
    u32x2 pv[24];
#pragma unroll
    for (int i = 0; i < 24; ++i) { int t = t0 - 8 + i; t = t < 0 ? 0 : (t > L - 1 ? L - 1 : t); pv[i] = *(const u32x2*)(P.Pin + (size_t)(sb + t) * PW + 4 * lane); }
#pragma unroll
    for (int tt = 0; tt < 8; ++tt) {
        f32x4 sum = {0.f, 0.f, 0.f, 0.f}; float cnt = 0.f;
#pragma unroll
        for (int o = -8; o < 8; ++o) {
            const int t = t0 + tt + o;
            const bool in = (o >= -hw) && (o < hw) && (t >= 0) && (t < L);
            const f32x4 v = up_bf4(pv[tt + o + 8]);
            sum += in ? v : (f32x4){0.f, 0.f, 0.f, 0.f}; cnt += in ? 1.f : 0.f;
        }
        const f32x4 r = sum * __builtin_amdgcn_rcpf(cnt) - up_bf4(pv[tt + 8]);
        u32x2 w; w.x = pk2(r[0], r[1]); w.y = pk2(r[2], r[3]);
        *(u32x2*)(P.Abr + (size_t)(row0 + tt) * D + 512 + 4 * lane) = w;
    }
}
__device__ __forceinline__ void conv_unit(const PcPtrs& P, const LAS float* wl, int unit, int lane) {
    constexpr int T = 8;
    const int row0 = unit * T;
    const int L = row0 < MP ? 256 : 1024;
    const int sb = row0 < MP ? (row0 & ~255) : MP + ((row0 - MP) & ~1023);
    const int t0 = row0 - sb;
    f32x4 acc[T];
    const f32x4 bias = *(const f32x4*)(P.bdw + 4 * lane);
#pragma unroll
    for (int tt = 0; tt < T; ++tt) acc[tt] = bias;
#pragma unroll 1
    for (int c = 0; c < 2; ++c) {
        u32x2 ar[20], gr[20];
#pragma unroll
        for (int i = 0; i < 20; ++i) {
            const int t = t0 - 15 + 20 * c + i;
            const bool ok = (t >= 0) && (t < L);
            const bf16_t* p = P.Cin + (size_t)(sb + (ok ? t : 0)) * 512 + 4 * lane;
            ar[i] = *(const u32x2*)p; gr[i] = *(const u32x2*)(p + 256);
            if (!ok) { ar[i] = (u32x2){0u, 0u}; }
        }
#pragma unroll
        for (int g4 = 0; g4 < 5; ++g4) {
            const int s0 = 20 * c + 4 * g4;
            f32x4 tp[11];
#pragma unroll
            for (int q = 0; q < 11; ++q) tp[q] = *(const LAS f32x4*)(wl + (s0 + q) * CW + 4 * lane);
#pragma unroll
            for (int i = 0; i < 4; ++i) {
                const f32x4 a = up_bf4(ar[4 * g4 + i]), g = up_bf4(gr[4 * g4 + i]);
                f32x4 hh;
#pragma unroll
                for (int e = 0; e < 4; ++e) hh[e] = a[e] * sigmoidf_(g[e]);
#pragma unroll
                for (int tt = 0; tt < T; ++tt) acc[tt] += hh * tp[i - tt + 7];
            }
            asm volatile("" ::: "memory");
        }
    }
    const f32x4 lg = *(const f32x4*)(P.cng + 4 * lane), lb = *(const f32x4*)(P.cnb + 4 * lane);
    float s1[T], s2[T];
#pragma unroll
    for (int tt = 0; tt < T; ++tt) s1[tt] = (acc[tt][0] + acc[tt][1]) + (acc[tt][2] + acc[tt][3]);
#pragma unroll
    for (int o = 1; o < 64; o <<= 1)
#pragma unroll
        for (int tt = 0; tt < T; ++tt) s1[tt] += __shfl_xor(s1[tt], o);
#pragma unroll
    for (int tt = 0; tt < T; ++tt) { const float mu = s1[tt] * (1.0f / CW); acc[tt] = acc[tt] - mu; s2[tt] = (acc[tt][0] * acc[tt][0] + acc[tt][1] * acc[tt][1]) + (acc[tt][2] * acc[tt][2] + acc[tt][3] * acc[tt][3]); }
#pragma unroll
    for (int o = 1; o < 64; o <<= 1)
#pragma unroll
        for (int tt = 0; tt < T; ++tt) s2[tt] += __shfl_xor(s2[tt], o);
#pragma unroll
    for (int tt = 0; tt < T; ++tt) {
        const float rstd = 1.0f / sqrtf(s2[tt] * (1.0f / CW) + EPS);
        f32x4 y = acc[tt] * rstd * lg + lb;
#pragma unroll
        for (int e = 0; e < 4; ++e) y[e] = y[e] * sigmoidf_(y[e]);
        u32x2 o; o.x = pk2(y[0], y[1]); o.y = pk2(y[2], y[3]);
        *(u32x2*)(P.Abr + (size_t)(row0 + tt) * D + 768 + 4 * lane) = o;
    }
}

#define XB_TMO      128
#define XB_XCNT(j)  (256  + 64 * (j))
#define XB_XSUB(j)  (1280 + 64 * (j))
#define XB_XGEN(j)  (2304 + 64 * (j))
#define XB_TOP      3328
#define XB_TOPGEN   3392
#define XCD_BAR_WORDS 3456
#define XB_SPIN_CAP (1u << 18)
__device__ __forceinline__ unsigned xb_ld(unsigned* p)              { return __hip_atomic_load(p, __ATOMIC_RELAXED, __HIP_MEMORY_SCOPE_AGENT); }
__device__ __forceinline__ unsigned xb_add(unsigned* p, unsigned v) { return __hip_atomic_fetch_add(p, v, __ATOMIC_RELAXED, __HIP_MEMORY_SCOPE_AGENT); }
__device__ __forceinline__ unsigned xb_xcc_id() { return (unsigned)__builtin_amdgcn_s_getreg((3 << 11) | 20) & 0xFu; }
#define XB_SPIN(cond, bar) do { unsigned _sp = 0; while (cond) { __builtin_amdgcn_s_sleep(1); \
    if ((++_sp & 255u) == 0u) { if (xb_ld(&(bar)[XB_TMO])) break; if (_sp > XB_SPIN_CAP) { atomicAdd(&(bar)[XB_TMO], 1u); break; } } } } while (0)
struct XcdBarrier { unsigned* bar; unsigned x; unsigned nloc, nx; };
__device__ __forceinline__ XcdBarrier xcd_barrier_post(unsigned* bar) {
    XcdBarrier b; b.bar = bar; b.x = xb_xcc_id(); b.nloc = 0u; b.nx = 0u;
    if (threadIdx.x == 0) (void)xb_add(&bar[XB_XCNT(b.x)], 1u);
    return b;
}
__device__ __forceinline__ void xcd_barrier_complete(unsigned* bar, unsigned x, unsigned& nloc, unsigned& nx) {
    const unsigned G = gridDim.x * gridDim.y * gridDim.z;
    unsigned sum, cnt, mine, sp = 0u;
    for (;;) {
        sum = 0u; cnt = 0u; mine = 0u;
#pragma unroll
        for (unsigned j = 0; j < 16; ++j) { const unsigned c = xb_ld(&bar[XB_XCNT(j)]); sum += c; cnt += (c > 0u) ? 1u : 0u; mine = (j == x) ? c : mine; }
        if (sum == G) break;
        __builtin_amdgcn_s_sleep(1);
        if ((++sp & 255u) == 0u) { if (xb_ld(&bar[XB_TMO])) break; if (sp > XB_SPIN_CAP) { atomicAdd(&bar[XB_TMO], 1u); break; } }
    }
    nloc = mine > 0u ? mine : 1u; nx = cnt > 0u ? cnt : 1u;
}
__device__ __forceinline__ void xcd_barrier(XcdBarrier& b) {
    asm volatile("s_waitcnt vmcnt(0)" ::: "memory");
    __syncthreads();
    if (threadIdx.x == 0) {
        unsigned* bar = b.bar;
        __builtin_amdgcn_s_waitcnt(0);
        unsigned nloc = b.nloc, nx = b.nx;
        if (nloc == 0u) { xcd_barrier_complete(bar, b.x, nloc, nx); b.nloc = nloc; b.nx = nx; }
        const unsigned old = xb_add(&bar[XB_XSUB(b.x)], 1u);
        const unsigned gen = old / nloc;
        if (old + 1u == (gen + 1u) * nloc) {
            __builtin_amdgcn_fence(__ATOMIC_RELEASE, "agent");
            asm volatile("s_waitcnt vmcnt(0)" ::: "memory");
            const unsigned og = xb_add(&bar[XB_TOP], 1u);
            const unsigned tg = og / nx;
            if (og + 1u == (tg + 1u) * nx) xb_add(&bar[XB_TOPGEN], 1u);
            else XB_SPIN(xb_ld(&bar[XB_TOPGEN]) == tg, bar);
            __builtin_amdgcn_fence(__ATOMIC_ACQUIRE, "agent");
            xb_add(&bar[XB_XGEN(b.x)], 1u);
            asm volatile("s_waitcnt vmcnt(0)" ::: "memory");
        } else {
            XB_SPIN(xb_ld(&bar[XB_XGEN(b.x)]) == gen, bar);
            __builtin_amdgcn_fence(__ATOMIC_ACQUIRE, "agent");
            asm volatile("s_waitcnt vmcnt(0)" ::: "memory");
        }
    }
    __syncthreads();
}

constexpr int TP_PITCH = 65, TP_BYTES = 64 * TP_PITCH * 4;
template <bool WITH_C, bool GU_PERM>
__device__ __forceinline__ void transpose_item(const float* W, int N, bf16_t* WT, int ldt, int kcol0, LAS float* scr, int item, int lane,
                                               const float* shraw  , const float* shb  , float* csum  ) {
    const int nblk = N / 64, kb = item / nblk, nb = item % nblk, k0 = 64 * kb, n0 = 64 * nb;
    {
        const int r4 = lane >> 4, c4 = lane & 15;
        f32x4 v[16];
#pragma unroll
        for (int i = 0; i < 16; ++i) v[i] = __builtin_nontemporal_load((const f32x4*)(W + (size_t)(k0 + 4 * i + r4) * N + n0 + 4 * c4));
#pragma unroll
        for (int i = 0; i < 16; ++i) { LAS float* p = scr + (4 * i + r4) * TP_PITCH + 4 * c4; p[0] = v[i][0]; p[1] = v[i][1]; p[2] = v[i][2]; p[3] = v[i][3]; }
    }
    const int c = lane & 7, nn = lane >> 3;
    f32x4 sh[3][2];
    if (WITH_C) {
#pragma unroll
        for (int r = 0; r < 3; ++r)
#pragma unroll
            for (int h = 0; h < 2; ++h) sh[r][h] = *(const f32x4*)(shraw + (size_t)r * NMOD + k0 + 8 * c + 4 * h) + *(const f32x4*)(shb + k0 + 8 * c + 4 * h);
    }
    LDS_WAIT(); asm volatile("" ::: "memory");
#pragma unroll
    for (int j = 0; j < 8; ++j) {
        const int n = 8 * j + nn; const LAS float* s = scr + (8 * c) * TP_PITCH + n;
        float w[8];
#pragma unroll
        for (int q = 0; q < 8; ++q) w[q] = s[q * TP_PITCH];
        u32x4 o; o.x = pk2(w[0], w[1]); o.y = pk2(w[2], w[3]); o.z = pk2(w[4], w[5]); o.w = pk2(w[6], w[7]);
        int nrow = n0 + n;
        if (GU_PERM) nrow = nrow < FFN ? ((nrow >> 7) * 256 + (nrow & 127)) : (((nrow - FFN) >> 7) * 256 + 128 + ((nrow - FFN) & 127));
        *(u32x4*)(WT + (size_t)nrow * ldt + kcol0 + k0 + 8 * c) = o;
        if (WITH_C) {
            float d0 = 0.f, d1 = 0.f, d2 = 0.f;
#pragma unroll
            for (int q = 0; q < 8; ++q) { d0 += sh[0][q >> 2][q & 3] * w[q]; d1 += sh[1][q >> 2][q & 3] * w[q]; d2 += sh[2][q >> 2][q & 3] * w[q]; }
#pragma unroll
            for (int x = 1; x < 8; x <<= 1) { d0 += __shfl_xor(d0, x); d1 += __shfl_xor(d1, x); d2 += __shfl_xor(d2, x); }
            if (c == 0) { atomicAdd(csum + n0 + n, d0); atomicAdd(csum + N + n0 + n, d1); atomicAdd(csum + 2 * N + n0 + n, d2); }
        }
    }
    LDS_WAIT(); asm volatile("" ::: "memory");
}

constexpr int NWAVES = 8;
constexpr int I_IN = 16 * (NIN / 64), I_GU = 16 * (NGU / 64), I_DN = (FFN / 64) * 16, I_OUT = 16 * 16, I_OA = 8 * 16, I_OC = 4 * 16;
constexpr int I_LAYER = I_IN + I_GU + I_DN + I_OUT + I_OA + I_OC;
#ifndef MK_TAIL
#define MK_TAIL I_LAYER
#endif
constexpr int I_TAIL = MK_TAIL, I_HEAD = I_LAYER - I_TAIL;
#define TRANSPOSE_LAYER_ITEM(l_, r0_, scr_, lane_) do { const int tl_ = (l_); int tr_ = (r0_); \
        const float* shraw1_ = MODRAW + (size_t)(tl_ * 3) * NMOD; const float* shraw2_ = MODRAW + (size_t)(tl_ * 3) * NMOD + 3 * D; \
        if (tr_ < I_IN) { transpose_item<true, false>(w_in + (size_t)tl_ * D * NIN, NIN, WIN + (size_t)tl_ * NIN * D, D, 0, scr_, tr_, lane_, shraw1_, b_mod + (size_t)tl_ * NMOD, C1 + (size_t)(tl_ * 3) * NIN); break; } tr_ -= I_IN; \
        if (tr_ < I_GU) { transpose_item<true, true>(w_gu + (size_t)tl_ * D * NGU, NGU, WGU + (size_t)tl_ * NGU * D, D, 0, scr_, tr_, lane_, shraw2_, b_mod + (size_t)tl_ * NMOD + 3 * D, C2 + (size_t)(tl_ * 3) * NGU); break; } tr_ -= I_GU; \
        if (tr_ < I_DN) { transpose_item<false, false>(w_down + (size_t)tl_ * FFN * D, D, WDN + (size_t)tl_ * D * FFN, FFN, 0, scr_, tr_, lane_, nullptr, nullptr, nullptr); break; } tr_ -= I_DN; \
        if (tr_ < I_OUT) { transpose_item<false, false>(w_out + (size_t)tl_ * D * D, D, WOUT + (size_t)tl_ * D * D, D, 0, scr_, tr_, lane_, nullptr, nullptr, nullptr); break; } tr_ -= I_OUT; \
        if (tr_ < I_OA) { transpose_item<false, false>(w_oa + (size_t)tl_ * NAW * D, D, WBR + (size_t)tl_ * D * D, D, 0, scr_, tr_, lane_, nullptr, nullptr, nullptr); break; } tr_ -= I_OA; \
        transpose_item<false, false>(w_oc + (size_t)tl_ * CW * D, D, WBR + (size_t)tl_ * D * D, D, 768, scr_, tr_, lane_, nullptr, nullptr, nullptr); } while (0)
constexpr int LDS_BYTES = 163840;
static_assert(8 * TP_BYTES <= LDS_BYTES, "LDS map");
constexpr int NPHASE = 2 + 6 * DEPTH + 1;

struct Args {
    const float* in[26]; float* out; unsigned char* ws; int ph_lo, ph_hi;
};

__global__ void __launch_bounds__(NWAVES * 64, 2) fwd_kernel(Args args) {
    extern __shared__ __attribute__((aligned(16))) unsigned char lds_raw[];
    LAS unsigned char* lds = (LAS unsigned char*)lds_raw;
    const int tid = threadIdx.x, lane = tid & 63, wave = __builtin_amdgcn_readfirstlane(tid >> 6);
    const int G = gridDim.x, bx = blockIdx.x;
    const int vcu = (G % 8 == 0) ? (bx % 8) * (G / 8) + bx / 8 : bx;
    const int gw = vcu * NWAVES + wave, NGW = G * NWAVES;
    unsigned char* ws = args.ws;
    float* ctlf = (float*)(ws + WS_CTL);
    const float* x_prompt = args.in[0]; const float* x_sample = args.in[1]; const float* cache_k = args.in[2]; const float* cache_v = args.in[3];
    const float* cvec = args.in[4]; const float* c_ctx = args.in[5]; const float* w_mod = args.in[6]; const float* b_mod = args.in[7];
    const float* norm1_g = args.in[8]; const float* norm2_g = args.in[9]; const float* w_in = args.in[10]; const float* b_gate = args.in[11];
    const float* rpb = args.in[12]; const float* w_oa = args.in[13]; const float* w_pool = args.in[14]; const float* pool_scale = args.in[15];
    const float* w_ob = args.in[16]; const float* w_dw = args.in[17]; const float* b_dw = args.in[18]; const float* conv_norm_g = args.in[19];
    const float* conv_norm_b = args.in[20]; const float* w_oc = args.in[21]; const float* w_out = args.in[22]; const float* w_gu = args.in[23];
    const float* w_down = args.in[24]; const float* final_g = args.in[25];
    float* MODRAW = ctlf + CF_MODRAW; float* C1 = ctlf + CF_C1; float* C2 = ctlf + CF_C2; float* RSS = ctlf + CF_RSS;
    float* MODT = (float*)(ws + WS_MODT);
    bf16_t* WIN = (bf16_t*)(ws + WS_WIN); bf16_t* WGU = (bf16_t*)(ws + WS_WGU); bf16_t* WDN = (bf16_t*)(ws + WS_WDN); bf16_t* WBR = (bf16_t*)(ws + WS_WBR); bf16_t* WOUT = (bf16_t*)(ws + WS_WOUT);
    float* X = (float*)(ws + WS_X); bf16_t* XG = (bf16_t*)(ws + WS_XG);
    bf16_t* Qb = (bf16_t*)(ws + WS_Q); bf16_t* Kb = (bf16_t*)(ws + WS_K); bf16_t* VT = (bf16_t*)(ws + WS_VT); bf16_t* KC = (bf16_t*)(ws + WS_KC); bf16_t* VTC = (bf16_t*)(ws + WS_VTC);
    bf16_t* PIN = (bf16_t*)(ws + WS_PIN); bf16_t* CIN = (bf16_t*)(ws + WS_CIN); bf16_t* GT = (bf16_t*)(ws + WS_G); bf16_t* ABR = (bf16_t*)(ws + WS_ABR);
    float* MF = (float*)(ws + WS_MF); bf16_t* MB = (bf16_t*)(ws + WS_MB); bf16_t* ACT = (bf16_t*)(ws + WS_ACT);

#if !MK_PER_PHASE
    XcdBarrier bar = xcd_barrier_post((unsigned*)(ws + WS_CTL) + CW_BAR);
#define GRID_BAR() xcd_barrier(bar)
#else
#define GRID_BAR() do {} while (0)
#endif
    const int lo = args.ph_lo, hi = args.ph_hi;
#define IN(k) (lo <= (k) && (k) < hi)
#define SEAM(k) do { if (IN(k) && IN((k) + 1)) GRID_BAR(); } while (0)

    for (int rep_ = 0; rep_ < MK_REPS(4); ++rep_) { if (rep_) GRID_BAR();
    float* MODRAW_W = rep_ ? MF : MODRAW; float* C1_W = rep_ ? MF + DEPTH * 3 * NMOD : C1; float* C2_W = rep_ ? MF + DEPTH * 3 * (NMOD + NIN) : C2;
    if (IN(0)) {
        LAS float* sil = (LAS float*)lds; LAS float* red = (LAS float*)(lds + 16384);
        for (int i = tid; i < 3 * D; i += NWAVES * 64) { const float s = i < D ? c_ctx[i] : cvec[i - D]; sil[i] = s * sigmoidf_(s); }
        __syncthreads();
        for (int it = vcu; it < DEPTH * 24 * 8; it += G) {
            const int l = it / 192, rem = it % 192, nc = rem >> 3, kq = rem & 7, k0 = kq * 128 + wave * 16, n0 = nc * 256 + 4 * lane;
            const float* wp = w_mod + ((size_t)l * D + k0) * NMOD + n0;
            f32x4 w[16];
#pragma unroll
            for (int kk = 0; kk < 16; ++kk) w[kk] = __builtin_nontemporal_load((const f32x4*)(wp + (size_t)kk * NMOD));
            f32x4 a0 = {0.f, 0.f, 0.f, 0.f}, a1 = a0, a2 = a0;
#pragma unroll
            for (int kk = 0; kk < 16; ++kk) { a0 += sil[k0 + kk] * w[kk]; a1 += sil[D + k0 + kk] * w[kk]; a2 += sil[2 * D + k0 + kk] * w[kk]; }
#pragma unroll
            for (int e = 0; e < 4; ++e) { red[(wave * 12 + e) * 64 + lane] = a0[e]; red[(wave * 12 + 4 + e) * 64 + lane] = a1[e]; red[(wave * 12 + 8 + e) * 64 + lane] = a2[e]; }
            __syncthreads();
            for (int o = tid; o < 12 * 64; o += NWAVES * 64) {
                float s = 0.f;
#pragma unroll
                for (int ww = 0; ww < 8; ++ww) s += red[ww * 768 + o];
                const int q = o >> 6, ln = o & 63, r = q >> 2, e = q & 3;
                atomicAdd(MODRAW_W + (size_t)(l * 3 + r) * NMOD + nc * 256 + 4 * ln + e, s);
            }
            __syncthreads();
        }
    }
    SEAM(0);

    if (IN(1)) {
        LAS float* scr = (LAS float*)(lds + wave * TP_BYTES);
        constexpr int I_T = I_LAYER + (DEPTH - 1) * I_HEAD;
        constexpr int I_OB = DEPTH * 16 * 4 * 8;
        constexpr int I_X = M;
        constexpr int I_KC = DEPTH * 2 * 256;
        constexpr int I_VC = DEPTH * 2 * 8 * 4;
        constexpr int I_MT = DEPTH * 3 * 6 * 4;
        constexpr int I_ALL = I_T + I_OB + I_X + I_KC + I_VC + I_MT;
        for (int it0 = gw; it0 < I_ALL; it0 += NGW) {
            int it = it0;
            if (it < I_T) {
                if (it < I_LAYER) TRANSPOSE_LAYER_ITEM(0, it, scr, lane);
                else if constexpr (I_HEAD > 0) { const int q = it - I_LAYER; TRANSPOSE_LAYER_ITEM(1 + q / I_HEAD, q % I_HEAD, scr, lane); }
                continue;
            }
            it -= I_T;
            if (it < I_OB) {
                const int l = it / 512, rem = it % 512, nch = rem >> 5, g = (rem >> 3) & 3, cc = rem & 7, n = nch * 64 + lane;
                float a[8];
#pragma unroll
                for (int c = 0; c < 8; ++c) a[c] = 0.f;
                const float* wp = w_pool + ((size_t)(l * 4 + g) * 64 + cc * 8) * 64;
                for (int d = 0; d < 64; ++d) {
                    const float wb = w_ob[((size_t)l * PW + g * 64 + d) * D + n] * pool_scale[l * PW + g * 64 + d];
#pragma unroll
                    for (int c = 0; c < 8; ++c) a[c] += wp[c * 64 + d] * wb;
                }
                u32x4 o; o.x = pk2(a[0], a[1]); o.y = pk2(a[2], a[3]); o.z = pk2(a[4], a[5]); o.w = pk2(a[6], a[7]);
                *(u32x4*)(WBR + ((size_t)l * D + n) * D + 512 + g * 64 + cc * 8) = o;
                continue;
            }
            it -= I_OB;
            if (it < I_X) {
                const int row = it, mr = row < MP ? 0 : 1 + ((row - MP) >> 10);
                const float* xr = row < MP ? x_prompt + (size_t)row * D : x_sample + (size_t)(row - MP) * D;
                float ss = 0.f;
#pragma unroll
                for (int j = 0; j < 4; ++j) {
                    const int col = 256 * j + 4 * lane;
                    const f32x4 v = *(const f32x4*)(xr + col);
                    *(f32x4*)(X + (size_t)row * D + col) = v;
                    ss += (v[0] * v[0] + v[1] * v[1]) + (v[2] * v[2] + v[3] * v[3]);
                    const f32x4 sc = *(const f32x4*)(MODRAW + (size_t)mr * NMOD + D + col) + *(const f32x4*)(b_mod + D + col);
                    const f32x4 gg = *(const f32x4*)(norm1_g + col) * (sc + 1.0f);
                    const f32x4 xs = v * gg;
                    u32x2 o; o.x = pk2(xs[0], xs[1]); o.y = pk2(xs[2], xs[3]);
                    *(u32x2*)(XG + (size_t)row * D + col) = o;
                }
                ss = wave_sum(ss);
                if (lane == 0) RSS[row] = ss;
                continue;
            }
            it -= I_X;
            if (it < I_KC) {
                const int l = it / 512, bs = (it >> 8) & 1, key = it & 255;
                const float* src = cache_k + (((size_t)(bs * DEPTH + l) * 256 + key) * 512) + 8 * lane;
                const f32x4 a = *(const f32x4*)src, b = *(const f32x4*)(src + 4);
                *(u32x4*)(KC + (((size_t)(l * 2 + bs) * 256 + key) * 512) + 8 * lane) = pk8(a, b);
                continue;
            }
            it -= I_KC;
            if (it < I_VC) {
                const int l = it / 64, bs = (it >> 5) & 1, h = (it >> 2) & 7, kb = it & 3, key = kb * 64 + lane;
                const float* src = cache_v + (((size_t)(bs * DEPTH + l) * 256 + key) * 512) + h * 64;
                bf16_t* dst = VTC + ((size_t)((l * 2 + bs) * 8 + h) * 64) * 256 + pos_of_key(key);
#pragma unroll
                for (int d4 = 0; d4 < 16; ++d4) {
                    const f32x4 v = *(const f32x4*)(src + 4 * d4);
                    const unsigned w0 = pk2(v[0], v[1]), w1 = pk2(v[2], v[3]);
                    dst[(size_t)(4 * d4 + 0) * 256] = (bf16_t)(w0 & 0xffff); dst[(size_t)(4 * d4 + 1) * 256] = (bf16_t)(w0 >> 16);
                    dst[(size_t)(4 * d4 + 2) * 256] = (bf16_t)(w1 & 0xffff); dst[(size_t)(4 * d4 + 3) * 256] = (bf16_t)(w1 >> 16);
                }
                continue;
            }
            it -= I_VC;
            {
                const int q = it & 3, which = (it >> 2) % 6, lr = it / 24, l = lr / 3, col = q * 256 + 4 * lane;
                const float* mraw = MODRAW + (size_t)lr * NMOD; const float* bm = b_mod + (size_t)l * NMOD;
                f32x4 v;
                if (which == 0) v = *(const f32x4*)(norm1_g + (size_t)l * D + col) * (*(const f32x4*)(mraw + D + col) + *(const f32x4*)(bm + D + col) + 1.0f);
                else if (which == 1) v = *(const f32x4*)(mraw + col) + *(const f32x4*)(bm + col);
                else if (which == 2) v = *(const f32x4*)(mraw + 2 * D + col) + *(const f32x4*)(bm + 2 * D + col);
                else if (which == 3) v = *(const f32x4*)(norm2_g + (size_t)l * D + col) * (*(const f32x4*)(mraw + 4 * D + col) + *(const f32x4*)(bm + 4 * D + col) + 1.0f);
                else if (which == 4) v = *(const f32x4*)(mraw + 3 * D + col) + *(const f32x4*)(bm + 3 * D + col);
                else v = *(const f32x4*)(mraw + 5 * D + col) + *(const f32x4*)(bm + 5 * D + col);
                *(f32x4*)(MODT + ((size_t)lr * 6 + which) * D + col) = v;
            }
        }
        LDS_WAIT(); __syncthreads();
    }
    }
    SEAM(1);

    for (int l = 0; l < DEPTH; ++l) {
        const int p0 = 2 + 6 * l;
        const float* modt_l = MODT + (size_t)l * 3 * 6 * D;
        for (int rep_ = 0; rep_ < MK_REPS(0); ++rep_) { if (rep_) GRID_BAR();
        if (IN(p0)) {
            pg8::Gemm g{XG, WIN + (size_t)l * NIN * D, D, D};
            pg8::TileOrder S; S.init(M, NIN, D, G, bx);
            EpiIn E{RSS + (size_t)(2 * l) * M, C1 + (size_t)(l * 3) * NIN, b_gate + (size_t)l * 3072, Qb, Kb, VT, PIN, CIN, GT,
                    args.out + OUT_K + (size_t)l * 256 * 512, args.out + OUT_V + (size_t)l * 256 * 512};
            pg8::gemm_phase<EpiIn, pg8::TileOrder>(lds, g, S, E);
        }
        }
        SEAM(p0);
        for (int rep_ = 0; rep_ < MK_REPS(1); ++rep_) { if (rep_) GRID_BAR();
        if (IN(p0 + 1)) {
            AttnPtrs AP{Qb, Kb, VT, KC + (size_t)l * 2 * 256 * 512, VTC + (size_t)l * 2 * 8 * 64 * 256, ABR};
            PcPtrs PP{PIN, CIN, w_dw + (size_t)l * CONVK * CW, b_dw + (size_t)l * CW, conv_norm_g + (size_t)l * CW, conv_norm_b + (size_t)l * CW, ABR};
            int lane_p = lane; asm volatile("" : "+v"(lane_p));
            if (vcu < 128) {
                LAS float* rpl = (LAS float*)(lds + 1024); LAS float* parts = (LAS float*)(lds + 16384);
                LAS unsigned char* kl = lds + 53248; LAS unsigned char* vl = kl + PA_K_BYTES;
                const float* rpb_l = rpb + (size_t)l * 8 * 15 * 31;
                for (int i = wave * 64 + lane_p; i < 8 * 15 * 31; i += NWAVES * 64) rpl[i] = rpb_l[i] * LOG2E;
                if (!(rep_ && MK_VAR == 1)) attn_sample_block(AP, kl, vl, rpl, parts, vcu, wave, lane_p);
                { const int pu = vcu * NWAVES + wave; if (pu < 768 && !(rep_ && (MK_VAR == 4 || MK_VAR == 5))) pool_unit(PP, pu, lane_p); }
            } else {
                LAS float* wl = (LAS float*)lds; LAS unsigned char* kl = lds + 49152; LAS unsigned char* vl = kl + PA_K_BYTES;
                const int bh = vcu - 128;
                for (int i = wave * 64 + lane_p; i < 47 * CW / 4; i += NWAVES * 64) { const int j = i / (CW / 4) - 7;
                    *(LAS f32x4*)(wl + 4 * i) = (j >= 0 && j < CONVK) ? *(const f32x4*)(PP.wdw + 4 * (i - 7 * (CW / 4))) : (f32x4){0.f, 0.f, 0.f, 0.f}; }
                { StageRegs R; attn_stage_load(R, AP.K + (size_t)((bh >> 3) * 256) * NAW + (bh & 7) * 64, AP.Vt + (size_t)(bh * 64) * 256, 256, 256, wave * 64 + lane_p); attn_stage_store(R, 256, kl, vl, wave * 64 + lane_p); }
                LDS_WAIT(); __syncthreads();
                if (!(rep_ && (MK_VAR == 2 || MK_VAR == 5))) attn_prompt_lds(AP, kl, vl, bh, wave, lane_p);
                { const int it = bh * NWAVES + wave;
                    if (it < 768) { if (!(rep_ && (MK_VAR == 3 || MK_VAR == 5))) conv_unit(PP, wl, it, lane_p); } }
            }
            __syncthreads();
        }
        }
        SEAM(p0 + 1);
        const int t192 = (bx & 7) * 32 + (bx >> 3), pm192 = t192 >> 3, pn192 = t192 & 7;
        const bool has192 = (G == 256);
        for (int rep_ = 0; rep_ < MK_REPS(2); ++rep_) { if (rep_) GRID_BAR();
        if (IN(p0 + 2)) {
            EpiBranch192 E{GT, MB};
            if (has192) g192::gemm<EpiBranch192>(lds, ABR, D, WBR + (size_t)l * D * D, D, pm192, pn192, 16, E);
        }
        }
        SEAM(p0 + 2);
        for (int rep_ = 0; rep_ < MK_REPS(5); ++rep_) { if (rep_) GRID_BAR();
        if (IN(p0 + 3)) {
            EpiRes192 E{rep_ ? MF : X, rep_ ? ACT : XG, modt_l + 2 * D, modt_l + 3 * D, rep_ ? (float*)ABR : RSS + (size_t)(2 * l + 1) * M};
            if (has192) g192::gemm<EpiRes192>(lds, MB, D, WOUT + (size_t)l * D * D, D, pm192, pn192, 16, E);
        }
        }
        SEAM(p0 + 3);
        for (int rep_ = 0; rep_ < MK_REPS(3); ++rep_) { if (rep_) GRID_BAR();
        if (IN(p0 + 4)) {
            pg8::Gemm g{XG, WGU + (size_t)l * NGU * D, D, D};
            pg8::TileOrderGU S; S.init(M, NGU, D, G, bx);
            EpiGU E{RSS + (size_t)(2 * l + 1) * M, C2 + (size_t)(l * 3) * NGU, ACT};
            pg8::gemm_phase<EpiGU, pg8::TileOrderGU>(lds, g, S, E);
            if (I_TAIL > 0 && l + 1 < DEPTH && G == 256 && bx >= 32) {
                int lane_b = lane; asm volatile("" : "+v"(lane_b));
                LAS float* scr = (LAS float*)(lds + wave * TP_BYTES);
#pragma unroll 1
                for (int r = I_HEAD + (bx - 32) * NWAVES + wave; r < I_LAYER; r += 224 * NWAVES) TRANSPOSE_LAYER_ITEM(l + 1, r, scr, lane_b);
                LDS_WAIT(); __syncthreads();
            }
        }
        }
        SEAM(p0 + 4);
        for (int rep_ = 0; rep_ < MK_REPS(6); ++rep_) { if (rep_) GRID_BAR();
        if (IN(p0 + 5)) {
            EpiRes192 E{rep_ ? MF : X, rep_ ? MB : XG, modt_l + 5 * D, MODT + (size_t)((l + 1) % DEPTH) * 3 * 6 * D, rep_ ? (float*)ABR : RSS + (size_t)(2 * l + 2) * M};
            if (has192) g192::gemm<EpiRes192>(lds, ACT, FFN, WDN + (size_t)l * D * FFN, FFN, pm192, pn192, FFN / 64, E);
        }
        }
        SEAM(p0 + 5);
    }
    if (IN(NPHASE - 1)) {
        for (int row = gw; row < M; row += NGW) {
            const float rinv = 1.0f / sqrtf(RSS[(size_t)8 * M + row] * (1.0f / D) + EPS);
#pragma unroll
            for (int j = 0; j < 4; ++j) {
                const int col = 256 * j + 4 * lane;
                const f32x4 v = *(const f32x4*)(X + (size_t)row * D + col) * rinv * *(const f32x4*)(final_g + col);
                __builtin_nontemporal_store(v, (f32x4*)(args.out + OUT_Y + (size_t)row * D + col));
            }
        }
    }
#undef IN
#undef SEAM
}

extern "C" void kernel_launch(void* const* d_in, const int* in_sizes, int n_in, void* d_out, int out_size, void* d_ws, size_t ws_size, hipStream_t stream) {
    static int grid = 0;
    if (grid == 0) {
        if (n_in != 26 || ws_size < WS_END) { fprintf(stderr, "kernel_launch: expected 26 inputs and >= %zu bytes of workspace; got %d, %zu\n", (size_t)WS_END, n_in, ws_size); grid = -1; return; }
        int dev = 0, cus = 0;
        if (hipGetDevice(&dev) != hipSuccess || hipDeviceGetAttribute(&cus, hipDeviceAttributeMultiprocessorCount, dev) != hipSuccess) { grid = -1; return; }
        if (hipFuncSetAttribute((const void*)fwd_kernel, hipFuncAttributeMaxDynamicSharedMemorySize, LDS_BYTES) != hipSuccess) { fprintf(stderr, "kernel_launch: hipFuncSetAttribute failed\n"); grid = -1; return; }
        (void)hipGetLastError();
        grid = cus;
    }
    if (grid < 0) return;
    (void)hipMemsetAsync((char*)d_ws + WS_CTL, 0, CTL_ZERO_BYTES, stream);
    Args a{};
    for (int i = 0; i < 26; ++i) a.in[i] = (const float*)d_in[i];
    a.out = (float*)d_out; a.ws = (unsigned char*)d_ws;
#if MK_PER_PHASE
    for (int p = 0; p < NPHASE; ++p) { a.ph_lo = p; a.ph_hi = p + 1; hipLaunchKernelGGL(fwd_kernel, dim3(grid), dim3(NWAVES * 64), LDS_BYTES, stream, a); }
#else
    a.ph_lo = 0; a.ph_hi = NPHASE;
    hipLaunchKernelGGL(fwd_kernel, dim3(grid), dim3(NWAVES * 64), LDS_BYTES, stream, a);
#endif
}
```

```cpp
#include <hip/hip_runtime.h>
#include <cstdio>
#include <cstdint>

#ifndef MK_PER_PHASE
#define MK_PER_PHASE 0
#endif

#ifndef MK_REPEAT
#define MK_REPEAT 0
#endif
#define MK_REPS(bit) ((MK_REPEAT >> (bit)) & 1 ? 2 : 1)
#ifndef MK_VAR
#define MK_VAR 0
#endif

constexpr int D = 1024, MP = 4096, MS = 2048, M = MP + MS, DEPTH = 4;
constexpr int NIN = 5376, FFN = 2816, NGU = 2 * FFN, NMOD = 6 * D;
constexpr int NAW = 512, PW = 256, CW = 256, CONVK = 31;
constexpr float EPS = 1e-6f;
constexpr float LOG2E = 1.4426950408889634f;
constexpr float QSCALE = 0.125f * LOG2E;

constexpr size_t MiB = 1u << 20;
constexpr size_t WS_CTL = 0, CTL_ZERO_BYTES = 5 * MiB / 4;
constexpr int CW_BAR = 4096;
constexpr int CF_MODRAW = 16384;
constexpr int CF_C1 = CF_MODRAW + DEPTH * 3 * NMOD;
constexpr int CF_C2 = CF_C1 + DEPTH * 3 * NIN;
constexpr int CF_RSS = CF_C2 + DEPTH * 3 * NGU;
constexpr int CF_END = CF_RSS + 9 * M;
static_assert((size_t)CF_END * 4 <= CTL_ZERO_BYTES, "control region");
constexpr size_t WS_MODT = 2 * MiB;
constexpr size_t WS_WIN = 4 * MiB;
constexpr size_t WS_WGU = 46 * MiB;
constexpr size_t WS_WDN = 90 * MiB;
constexpr size_t WS_WBR = 112 * MiB;
constexpr size_t WS_WOUT = 120 * MiB;
constexpr size_t WS_X = 128 * MiB;
constexpr size_t WS_XG = 152 * MiB;
constexpr size_t WS_Q = 164 * MiB, WS_K = 170 * MiB;
constexpr size_t WS_VT = 176 * MiB;
constexpr size_t WS_KC = 182 * MiB;
constexpr size_t WS_VTC = 184 * MiB;
constexpr size_t WS_PIN = 186 * MiB;
constexpr size_t WS_CIN = 189 * MiB;
constexpr size_t WS_G = 195 * MiB;
constexpr size_t WS_ABR = 231 * MiB;
constexpr size_t WS_MF = 243 * MiB;
constexpr size_t WS_MB = 267 * MiB;
constexpr size_t WS_ACT = 279 * MiB;
constexpr size_t WS_END = 312 * MiB;
constexpr size_t VT_SAMPLE_OFF = (size_t)16 * 8 * 64 * 256;

constexpr size_t OUT_Y = 0, OUT_K = (size_t)M * D, OUT_V = OUT_K + (size_t)16 * DEPTH * 256 * 512;

#define GAS __attribute__((address_space(1)))
#define LAS __attribute__((address_space(3)))
typedef unsigned short bf16_t;
typedef short bf16x8 __attribute__((ext_vector_type(8)));
typedef float f32x4 __attribute__((ext_vector_type(4)));
typedef float f32x2 __attribute__((ext_vector_type(2)));
typedef float f32x16 __attribute__((ext_vector_type(16)));
typedef unsigned u32x4 __attribute__((ext_vector_type(4)));
typedef unsigned u32x2 __attribute__((ext_vector_type(2)));
typedef __bf16 bf16x2_t __attribute__((ext_vector_type(2)));
#define LDS_WAIT() asm volatile("s_waitcnt lgkmcnt(0)" ::: "memory")

__device__ __forceinline__ unsigned pk2(float lo, float hi) { f32x2 v = {lo, hi}; bf16x2_t b = __builtin_convertvector(v, bf16x2_t); return __builtin_bit_cast(unsigned, b); }
__device__ __forceinline__ u32x4 pk8(f32x4 a, f32x4 b) { u32x4 w; w.x = pk2(a[0], a[1]); w.y = pk2(a[2], a[3]); w.z = pk2(b[0], b[1]); w.w = pk2(b[2], b[3]); return w; }
__device__ __forceinline__ float bf_lo(unsigned w) { return __uint_as_float(w << 16); }
__device__ __forceinline__ float bf_hi(unsigned w) { return __uint_as_float(w & 0xffff0000u); }
__device__ __forceinline__ float sigmoidf_(float x) { return __builtin_amdgcn_rcpf(1.0f + __builtin_amdgcn_exp2f(-LOG2E * x)); }
__device__ __forceinline__ float wave_sum(float v) {
#pragma unroll
    for (int o = 1; o < 64; o <<= 1) v += __shfl_xor(v, o);
    return v;
}
__device__ __forceinline__ int pos_of_key(int t) { return (t & ~12) | ((t & 4) << 1) | ((t & 8) >> 1); }
__device__ __forceinline__ int mod_row_of_pm(int pm) { return pm < 16 ? 0 : 1 + ((pm - 16) >> 2); }

namespace pg8 {
constexpr int BM = 256, BK = 64, HALF = 128, HTB = HALF * BK * 2  , STAGE_BYTES = 8 * HTB, NXCD = 8, WGM = 4;
__host__ __device__ __forceinline__ int lds_byte(int r, int c) { return r * 128 + ((((c >> 3) ^ (r >> 1)) & 7) << 4) + (c & 7) * 2; }
__host__ __device__ __forceinline__ void stage_rc(int b, int& R, int& C) { R = b >> 7; C = (((b >> 4) ^ (R >> 1)) & 7) * 8; }
__host__ __device__ __forceinline__ int perm32(int rho) { const int n = rho >> 4, i = rho & 15; return 8 * (i >> 2) + 4 * n + (i & 3); }

struct Unit { int pm, pn, k0, nt, kind, half; };
struct Gemm { const bf16_t* A; const bf16_t* Bt; int lda, ldb; };

struct TileOrder {
    int nM, nN, nwg, G, c, nt;
    __device__ void init(int M_, int N_, int K_, int G_, int c_) { nM = M_ / BM; nN = N_ / BM; nwg = nM * nN; G = G_; c = c_; nt = K_ / BK; }
    __device__ bool next(int i, Unit& u) const {
        const long L = (long)i * G + c; if (L >= nwg) return false;
        int wgid = (int)L; { const int q = nwg / NXCD, r = nwg % NXCD, xcd = wgid % NXCD, off = wgid / NXCD; wgid = (xcd < r ? xcd * (q + 1) : r * (q + 1) + (xcd - r) * q) + off; }
        const int nig = WGM * nN, gid = wgid / nig, fm = gid * WGM, gsz = (nM - fm) < WGM ? (nM - fm) : WGM;
        u.pm = fm + ((wgid % nig) % gsz); u.pn = (wgid % nig) / gsz; u.k0 = 0; u.nt = nt; u.kind = 0; u.half = 0; return true;
    }
};
struct TileOrderGU {
    TileOrder base;
    __device__ void init(int M_, int N_, int K_, int G_, int c_) { base.init(M_, N_, K_, G_, c_); }
    __device__ bool next(int i, Unit& u) const {
        if (i < 2) return base.next(i, u);
        if (i > 2 || base.c >= 32 || base.G != 256) { if (base.G == 256) return false; return base.next(i, u); }
        const int c = base.c, xcd = c & 7, off = 64 + ((c >> 3) & 1);
        const int wgid = xcd * 66 + off;
        const int nig = WGM * base.nN, gid = wgid / nig, fm = gid * WGM, gsz = (base.nM - fm) < WGM ? (base.nM - fm) : WGM;
        u.pm = fm + ((wgid % nig) % gsz); u.pn = (wgid % nig) / gsz; u.k0 = 0; u.nt = base.nt; u.kind = 0; u.half = 1 + (c >> 4); return true;
    }
};
struct PanelOrder {
    int c, nseg, ka, na, kb, nb, kc, nc;
    __device__ bool next(int i, Unit& u) const {
        if (c >= 96 || i >= nseg) return false;
        const int T = (c & 7) * 12 + (c >> 3);
        u.pm = T >> 2; u.pn = T & 3; u.k0 = i == 0 ? ka : (i == 1 ? kb : kc); u.nt = i == 0 ? na : (i == 1 ? nb : nc); u.kind = i; u.half = 0; return true;
    }
};

template <class Epi, class Sched>
__device__ __forceinline__ void gemm_phase(LAS unsigned char* lds, const Gemm g, const Sched& S, const Epi& E) {
    int tid = threadIdx.x; asm volatile("" : "+v"(tid));
    const int wid = __builtin_amdgcn_readfirstlane(tid >> 6), lane = tid & 63, wr = wid >> 2, wc = wid & 3, fr = lane & 15, fq = lane >> 4;
    unsigned voffA[2], voffB[2];
#pragma unroll
    for (int i = 0; i < 2; ++i) { int R, C; stage_rc(tid * 16 + i * 8192, R, C); const int Rb = (R & ~31) + perm32(R & 31);
        voffA[i] = (unsigned)(R * g.lda + C) * 2u; voffB[i] = (unsigned)(Rb * g.ldb + C) * 2u; }
    const size_t kstep = (size_t)(BK * 2);
    const size_t hstepA = (size_t)HALF * g.lda * 2, hstepB = (size_t)HALF * g.ldb * 2;
    const size_t tstepA = 2 * hstepA, tstepB = 2 * hstepB;
    const unsigned ldsw = (unsigned)wid * 1024u;
    const int aoffk[2] = {lds_byte(wr * 64 + fr, fq * 8), lds_byte(wr * 64 + fr, fq * 8 + 32)}, boffk[2] = {lds_byte(wc * 32 + fr, fq * 8), lds_byte(wc * 32 + fr, fq * 8 + 32)};
#define PG8_SA(b, h) (((b) * 2 + (h)) * HTB)
#define PG8_SB(b, h) ((4 + (b) * 2 + (h)) * HTB)
#define PG8_STAGE(bufoff, gbase, voff) do { _Pragma("unroll") for (int _i = 0; _i < 2; ++_i) \
        __builtin_amdgcn_global_load_lds((const unsigned*)((const char*)(gbase) + (voff)[_i]), (LAS unsigned*)(lds + (bufoff) + ldsw + _i * 8192), 16, 0, 0); } while (0)
#define PG8_LDA(dst, b, h) do { _Pragma("unroll") for (int m = 0; m < 4; ++m) _Pragma("unroll") for (int k = 0; k < 2; ++k) dst[m][k] = *(const LAS bf16x8*)(lds + PG8_SA(b, h) + aoffk[k] + m * 2048); } while (0)
#define PG8_LDB(dst, b, h) do { _Pragma("unroll") for (int n = 0; n < 2; ++n) _Pragma("unroll") for (int k = 0; k < 2; ++k) dst[n][k] = *(const LAS bf16x8*)(lds + PG8_SB(b, h) + boffk[k] + n * 2048); } while (0)
#define PG8_MMA(ai, bj, At, Bt) do { __builtin_amdgcn_s_setprio(1); _Pragma("unroll") for (int m = 0; m < 4; ++m) _Pragma("unroll") for (int n = 0; n < 2; ++n) _Pragma("unroll") for (int k = 0; k < 2; ++k) \
        acc[ai][bj][m][n] = __builtin_amdgcn_mfma_f32_16x16x32_bf16(Bt[n][k], At[m][k], acc[ai][bj][m][n], 0, 0, 0); __builtin_amdgcn_s_setprio(0); } while (0)
#define PG8_WAIT_V(n) asm volatile("s_waitcnt vmcnt(" #n ")" ::: "memory")
#define PG8_WAIT_L(n) asm volatile("s_waitcnt lgkmcnt(" #n ")" ::: "memory")
#define PG8_BAR __builtin_amdgcn_s_barrier()
#define PG8_SCHED __builtin_amdgcn_sched_barrier(0)
    Unit cur, nxt; int ui = 0;
    if (!S.next(0, cur)) return;
    f32x4 acc[2][2][4][2];
#pragma unroll
    for (int a = 0; a < 2; ++a)
#pragma unroll
        for (int b = 0; b < 2; ++b)
#pragma unroll
            for (int m = 0; m < 4; ++m)
#pragma unroll
                for (int n = 0; n < 2; ++n) acc[a][b][m][n] = (f32x4){0.f, 0.f, 0.f, 0.f};
    bf16x8 At[4][2], B0[2][2], B1[2][2];
    const char* cA = (const char*)g.A + (size_t)cur.pm * tstepA + (size_t)cur.k0 * 2; const char* cB = (const char*)g.Bt + (size_t)cur.pn * tstepB + (size_t)cur.k0 * 2;
    PG8_STAGE(PG8_SB(0, 0), cB, voffB); PG8_STAGE(PG8_SB(0, 1), cB + hstepB, voffB); PG8_STAGE(PG8_SA(0, 0), cA, voffA); PG8_STAGE(PG8_SA(0, 1), cA + hstepA, voffA);
    if (wr == 1) PG8_BAR;
    PG8_WAIT_V(2); PG8_BAR;
    PG8_STAGE(PG8_SB(1, 0), cB + kstep, voffB); PG8_STAGE(PG8_SA(1, 0), cA + kstep, voffA); PG8_STAGE(PG8_SB(1, 1), cB + hstepB + kstep, voffB);
    PG8_WAIT_V(6); PG8_BAR;
    for (;;) {
        const bool has_next = S.next(ui + 1, nxt);
        const char* nA = has_next ? (const char*)g.A + (size_t)nxt.pm * tstepA + (size_t)nxt.k0 * 2 : cA; const char* nB = has_next ? (const char*)g.Bt + (size_t)nxt.pn * tstepB + (size_t)nxt.k0 * 2 : cB;
        const int nt = cur.nt;
        const bool do0 = cur.half != 2, do1 = cur.half != 1;
        for (int t = 0; t < nt; t += 2) {
            const bool last = (t == nt - 2);
            const char* a1 = cA + (size_t)(t + 1) * kstep;
            const char* a2 = last ? nA : cA + (size_t)(t + 2) * kstep; const char* b2 = last ? nB : cB + (size_t)(t + 2) * kstep;
            const char* a3 = a2 + kstep; const char* b3 = b2 + kstep;
            PG8_LDB(B0, 0, 0); PG8_LDB(B1, 0, 1); PG8_SCHED; PG8_LDA(At, 0, 0); PG8_STAGE(PG8_SA(1, 1), a1 + hstepA, voffA);
            PG8_WAIT_V(8); PG8_WAIT_L(0); PG8_BAR; if (do0) { PG8_MMA(0, 0, At, B0); PG8_MMA(0, 1, At, B1); } PG8_BAR; PG8_SCHED;
            PG8_LDA(At, 0, 1); PG8_STAGE(PG8_SB(0, 0), b2, voffB); PG8_STAGE(PG8_SB(0, 1), b2 + hstepB, voffB); PG8_STAGE(PG8_SA(0, 0), a2, voffA);
            PG8_WAIT_V(8); PG8_WAIT_L(0); PG8_BAR; if (do1) { PG8_MMA(1, 0, At, B0); PG8_MMA(1, 1, At, B1); } PG8_BAR; PG8_SCHED;
            PG8_LDB(B0, 1, 0); PG8_LDB(B1, 1, 1); PG8_SCHED; PG8_LDA(At, 1, 0); PG8_STAGE(PG8_SA(0, 1), a2 + hstepA, voffA);
            PG8_WAIT_V(8); PG8_WAIT_L(0); PG8_BAR; if (do0) { PG8_MMA(0, 0, At, B0); PG8_MMA(0, 1, At, B1); } PG8_BAR; PG8_SCHED;
            PG8_LDA(At, 1, 1); PG8_STAGE(PG8_SB(1, 0), b3, voffB); PG8_STAGE(PG8_SB(1, 1), b3 + hstepB, voffB); PG8_STAGE(PG8_SA(1, 0), a3, voffA);
            PG8_WAIT_V(8); PG8_WAIT_L(0); PG8_BAR; if (do1) { PG8_MMA(1, 0, At, B0); PG8_MMA(1, 1, At, B1); } PG8_BAR; PG8_SCHED;
        }
        if (wr == 0) PG8_BAR;
        E(acc, cur, wr, wc, fr, fq);
        if (!has_next) break;
#pragma unroll
        for (int a = 0; a < 2; ++a)
#pragma unroll
            for (int b = 0; b < 2; ++b)
#pragma unroll
                for (int m = 0; m < 4; ++m)
#pragma unroll
                    for (int n = 0; n < 2; ++n) acc[a][b][m][n] = (f32x4){0.f, 0.f, 0.f, 0.f};
        cur = nxt; cA = nA; cB = nB; ++ui;
        if (wr == 1) PG8_BAR;
    }
    PG8_WAIT_V(0);
    PG8_BAR;
#undef PG8_SA
#undef PG8_SB
#undef PG8_STAGE
#undef PG8_LDA
#undef PG8_LDB
#undef PG8_MMA
#undef PG8_WAIT_V
#undef PG8_WAIT_L
#undef PG8_BAR
#undef PG8_SCHED
}
}

typedef f32x4 Acc[2][2][4][2];

struct EpiIn {
    const float* rss; const float* c1; const float* bgate;
    bf16_t *Q, *K, *Vt, *Pin, *Cin, *G; float *outk, *outv;
    __device__ __forceinline__ void operator()(const Acc& acc, const pg8::Unit& u, int wr, int wc, int fr, int fq) const {
        const int pn = u.pn, pm = u.pm, mr = mod_row_of_pm(pm);
        const int cb = pn * 256 + wc * 32 + 8 * fq;
        f32x4 cv[2][2];
#pragma unroll
        for (int bj = 0; bj < 2; ++bj)
#pragma unroll
            for (int n = 0; n < 2; ++n) { cv[bj][n] = *(const f32x4*)(c1 + (size_t)mr * NIN + cb + bj * 128 + 4 * n);
                if (pn >= 9) cv[bj][n] += *(const f32x4*)(bgate + (cb - 2304) + bj * 128 + 4 * n); }
        float rinvs[2][4];
#pragma unroll
        for (int ai = 0; ai < 2; ++ai)
#pragma unroll
            for (int m = 0; m < 4; ++m) rinvs[ai][m] = rss[pm * 256 + ai * 128 + wr * 64 + m * 16 + fr];
#pragma unroll
        for (int ai = 0; ai < 2; ++ai)
#pragma unroll
            for (int m = 0; m < 4; ++m) {
                const int row = pm * 256 + ai * 128 + wr * 64 + m * 16 + fr;
                const float rinv = 1.0f / sqrtf(rinvs[ai][m] * (1.0f / D) + EPS);
#pragma unroll
                for (int bj = 0; bj < 2; ++bj) {
                    const int col = cb + bj * 128;
                    f32x4 v0 = acc[ai][bj][m][0] * rinv + cv[bj][0], v1 = acc[ai][bj][m][1] * rinv + cv[bj][1];
                    if (pn < 2) {
                        *(u32x4*)(Q + (size_t)row * NAW + col) = pk8(v0 * QSCALE, v1 * QSCALE);
                    } else if (pn < 4) {
                        const int c = col - 512;
                        *(u32x4*)(K + (size_t)row * NAW + c) = pk8(v0, v1);
                        if (pm < 16) { float* o = outk + ((size_t)(pm * DEPTH * 256 + (row & 255))) * 512 + c; __builtin_nontemporal_store(v0, (f32x4*)o); __builtin_nontemporal_store(v1, (f32x4*)(o + 4)); }
                    } else if (pn < 6) {
                        const int c = col - 1024, h = c >> 6, d = c & 63;
                        if (pm < 16) { float* o = outv + ((size_t)(pm * DEPTH * 256 + (row & 255))) * 512 + c; __builtin_nontemporal_store(v0, (f32x4*)o); __builtin_nontemporal_store(v1, (f32x4*)(o + 4)); }
                        bf16_t* vb; int L;
                        if (pm < 16) { L = 256; vb = Vt + ((size_t)((pm * 8 + h) * 64 + d)) * 256 + pos_of_key(row & 255); }
                        else { const int rs = row - MP, bs = rs >> 10; L = 1024; vb = Vt + VT_SAMPLE_OFF + ((size_t)((bs * 8 + h) * 64 + d)) * 1024 + pos_of_key(rs & 1023); }
                        const u32x4 w = pk8(v0, v1);
                        vb[0] = (bf16_t)(w.x & 0xffff); vb[(size_t)L] = (bf16_t)(w.x >> 16); vb[(size_t)2 * L] = (bf16_t)(w.y & 0xffff); vb[(size_t)3 * L] = (bf16_t)(w.y >> 16);
                        vb[(size_t)4 * L] = (bf16_t)(w.z & 0xffff); vb[(size_t)5 * L] = (bf16_t)(w.z >> 16); vb[(size_t)6 * L] = (bf16_t)(w.w & 0xffff); vb[(size_t)7 * L] = (bf16_t)(w.w >> 16);
                    } else if (pn == 6) {
                        *(u32x4*)(Pin + (size_t)row * PW + (col - 1536)) = pk8(v0, v1);
                    } else if (pn < 9) {
                        *(u32x4*)(Cin + (size_t)row * 512 + (col - 1792)) = pk8(v0, v1);
                    } else {
#pragma unroll
                        for (int e = 0; e < 4; ++e) { v0[e] = sigmoidf_(v0[e]); v1[e] = sigmoidf_(v1[e]); }
                        *(u32x4*)(G + (size_t)row * 3072 + (col - 2304)) = pk8(v0, v1);
                    }
                }
                asm volatile("" ::: "memory");
            }
    }
};

struct EpiBranch {
    const bf16_t* G; float* mf; bf16_t* mb;
    __device__ __forceinline__ void operator()(const Acc& acc, const pg8::Unit& u, int wr, int wc, int fr, int fq) const {
        const int cb = u.pn * 256 + wc * 32 + 8 * fq, kind = u.kind;
#pragma unroll
        for (int ai = 0; ai < 2; ++ai)
#pragma unroll
            for (int m = 0; m < 4; ++m) {
                const int row = u.pm * 256 + ai * 128 + wr * 64 + m * 16 + fr;
#pragma unroll
                for (int bj = 0; bj < 2; ++bj) {
                    const int col = cb + bj * 128;
                    const u32x4 gw = *(const u32x4*)(G + (size_t)row * 3072 + kind * 1024 + col);
                    f32x4 v0 = acc[ai][bj][m][0], v1 = acc[ai][bj][m][1];
                    v0[0] *= bf_lo(gw.x); v0[1] *= bf_hi(gw.x); v0[2] *= bf_lo(gw.y); v0[3] *= bf_hi(gw.y);
                    v1[0] *= bf_lo(gw.z); v1[1] *= bf_hi(gw.z); v1[2] *= bf_lo(gw.w); v1[3] *= bf_hi(gw.w);
                    float* sp = mf + (size_t)row * D + col;
                    if (kind > 0) { v0 += *(const f32x4*)sp; v1 += *(const f32x4*)(sp + 4); }
                    if (kind < 2) { *(f32x4*)sp = v0; *(f32x4*)(sp + 4) = v1; }
                    else *(u32x4*)(mb + (size_t)row * D + col) = pk8(v0, v1);
                }
                asm volatile("" ::: "memory");
            }
    }
};

struct EpiRes {
    float* x; bf16_t* xg; const float* gate; const float* gsn; float* rssn;
    __device__ __forceinline__ void operator()(const Acc& acc, const pg8::Unit& u, int wr, int wc, int fr, int fq) const {
        const int mr = mod_row_of_pm(u.pm), cb = u.pn * 256 + wc * 32 + 8 * fq;
        float ss[2][4];
#pragma unroll
        for (int ai = 0; ai < 2; ++ai)
#pragma unroll
            for (int m = 0; m < 4; ++m) ss[ai][m] = 0.f;
#pragma unroll
        for (int bj = 0; bj < 2; ++bj) {
            const int col = cb + bj * 128;
            const f32x4 gt0 = *(const f32x4*)(gate + (size_t)mr * 6 * D + col), gt1 = *(const f32x4*)(gate + (size_t)mr * 6 * D + col + 4);
            const f32x4 gs0 = *(const f32x4*)(gsn + (size_t)mr * 6 * D + col), gs1 = *(const f32x4*)(gsn + (size_t)mr * 6 * D + col + 4);
#pragma unroll
            for (int ai = 0; ai < 2; ++ai)
#pragma unroll
                for (int m = 0; m < 4; ++m) {
                    const int row = u.pm * 256 + ai * 128 + wr * 64 + m * 16 + fr;
                    float* xp = x + (size_t)row * D + col;
                    f32x4 x0 = *(const f32x4*)xp, x1 = *(const f32x4*)(xp + 4);
                    x0 += gt0 * acc[ai][bj][m][0]; x1 += gt1 * acc[ai][bj][m][1];
                    *(f32x4*)xp = x0; *(f32x4*)(xp + 4) = x1;
                    ss[ai][m] += (x0[0] * x0[0] + x0[1] * x0[1]) + (x0[2] * x0[2] + x0[3] * x0[3]) + (x1[0] * x1[0] + x1[1] * x1[1]) + (x1[2] * x1[2] + x1[3] * x1[3]);
                    *(u32x4*)(xg + (size_t)row * D + col) = pk8(x0 * gs0, x1 * gs1);
                    asm volatile("" ::: "memory");
                }
        }
#pragma unroll
        for (int ai = 0; ai < 2; ++ai)
#pragma unroll
            for (int m = 0; m < 4; ++m) {
                float s = ss[ai][m];
                s += __shfl_xor(s, 16); s += __shfl_xor(s, 32);
                if (fq == 0) atomicAdd(rssn + u.pm * 256 + ai * 128 + wr * 64 + m * 16 + fr, s);
            }
    }
};

struct EpiGU {
    const float* rss; const float* c2; bf16_t* act;
    __device__ __forceinline__ void operator()(const Acc& acc, const pg8::Unit& u, int wr, int wc, int fr, int fq) const {
        const int mr = mod_row_of_pm(u.pm), ca0 = u.pn * 128 + wc * 32 + 8 * fq;
        f32x4 ca[2], cbv[2];
#pragma unroll
        for (int n = 0; n < 2; ++n) { ca[n] = *(const f32x4*)(c2 + (size_t)mr * NGU + ca0 + 4 * n); cbv[n] = *(const f32x4*)(c2 + (size_t)mr * NGU + FFN + ca0 + 4 * n); }
        float rinvs[2][4];
#pragma unroll
        for (int ai = 0; ai < 2; ++ai)
#pragma unroll
            for (int m = 0; m < 4; ++m) rinvs[ai][m] = rss[u.pm * 256 + ai * 128 + wr * 64 + m * 16 + fr];
#pragma unroll
        for (int ai = 0; ai < 2; ++ai)
#pragma unroll
            for (int m = 0; m < 4; ++m) {
                if (u.half == 2 - ai) continue;
                const int row = u.pm * 256 + ai * 128 + wr * 64 + m * 16 + fr;
                const float rinv = 1.0f / sqrtf(rinvs[ai][m] * (1.0f / D) + EPS);
                f32x4 o[2];
#pragma unroll
                for (int n = 0; n < 2; ++n) {
                    const f32x4 a = acc[ai][0][m][n] * rinv + ca[n], b = acc[ai][1][m][n] * rinv + cbv[n];
#pragma unroll
                    for (int e = 0; e < 4; ++e) o[n][e] = a[e] * sigmoidf_(a[e]) * b[e];
                }
                *(u32x4*)(act + (size_t)row * FFN + ca0) = pk8(o[0], o[1]);
                asm volatile("" ::: "memory");
            }
    }
};

namespace g192 {
constexpr int TM = 192, TN = 128, BK = 64, ABYTES = TM * BK * 2, BBYTES = TN * BK * 2, SBYTES = ABYTES + BBYTES;
typedef f32x4 Acc6[6][2];
template <class Epi>
__device__ __forceinline__ void gemm(LAS unsigned char* lds, const bf16_t* A, int lda, const bf16_t* Bt, int ldb, int pm, int pn, int nt, const Epi& E) {
    int tid = threadIdx.x; asm volatile("" : "+v"(tid));
    const int wid = __builtin_amdgcn_readfirstlane(tid >> 6), lane = tid & 63, wr = wid >> 2, wc = wid & 3, fr = lane & 15, fq = lane >> 4;
    unsigned voffA[3], voffB[2];
#pragma unroll
    for (int i = 0; i < 3; ++i) { int R, C; pg8::stage_rc((wid + 8 * i) * 1024 + lane * 16, R, C); voffA[i] = (unsigned)(R * lda + C) * 2u; }
#pragma unroll
    for (int i = 0; i < 2; ++i) { int R, C; pg8::stage_rc((wid + 8 * i) * 1024 + lane * 16, R, C); const int Rb = (R & ~31) + pg8::perm32(R & 31); voffB[i] = (unsigned)(Rb * ldb + C) * 2u; }
    const char* gA = (const char*)(A + (size_t)pm * TM * lda); const char* gB = (const char*)(Bt + (size_t)pn * TN * ldb);
    const unsigned ldsw = (unsigned)wid * 1024u;
    const int aoffk[2] = {pg8::lds_byte(wr * 96 + fr, fq * 8), pg8::lds_byte(wr * 96 + fr, fq * 8 + 32)}, boffk[2] = {ABYTES + pg8::lds_byte(wc * 32 + fr, fq * 8), ABYTES + pg8::lds_byte(wc * 32 + fr, fq * 8 + 32)};
#define G192_STAGE(slot, t) do { \
        _Pragma("unroll") for (int _i = 0; _i < 3; ++_i) __builtin_amdgcn_global_load_lds((const unsigned*)(gA + (size_t)(t) * (BK * 2) + voffA[_i]), (LAS unsigned*)(lds + (slot) * SBYTES + ldsw + _i * 8192), 16, 0, 0); \
        _Pragma("unroll") for (int _i = 0; _i < 2; ++_i) __builtin_amdgcn_global_load_lds((const unsigned*)(gB + (size_t)(t) * (BK * 2) + voffB[_i]), (LAS unsigned*)(lds + (slot) * SBYTES + ABYTES + ldsw + _i * 8192), 16, 0, 0); } while (0)
#define G192_WAIT_V(n) asm volatile("s_waitcnt vmcnt(" #n ")" ::: "memory")
#define G192_WAIT_L(n) asm volatile("s_waitcnt lgkmcnt(" #n ")" ::: "memory")
    f32x4 acc[6][2], tot[6][2];
#pragma unroll
    for (int m = 0; m < 6; ++m)
#pragma unroll
        for (int n = 0; n < 2; ++n) { acc[m][n] = (f32x4){0.f, 0.f, 0.f, 0.f}; tot[m][n] = (f32x4){0.f, 0.f, 0.f, 0.f}; }
    G192_STAGE(0, 0); G192_STAGE(1, 1); G192_STAGE(2, 2);
    G192_WAIT_V(10); __builtin_amdgcn_s_barrier();
#pragma unroll 1
    for (int t = 0; t < nt; ++t) {
        const int slot = t & 3;
        if (t + 3 < nt) G192_STAGE((t + 3) & 3, t + 3);
        bf16x8 At[6][2], Bf[2][2];
        const LAS unsigned char* sb = lds + slot * SBYTES;
#pragma unroll
        for (int n = 0; n < 2; ++n)
#pragma unroll
            for (int k = 0; k < 2; ++k) Bf[n][k] = *(const LAS bf16x8*)(sb + boffk[k] + n * 2048);
#pragma unroll
        for (int m = 0; m < 6; ++m)
#pragma unroll
            for (int k = 0; k < 2; ++k) At[m][k] = *(const LAS bf16x8*)(sb + aoffk[k] + m * 2048);
        G192_WAIT_L(0);
        __builtin_amdgcn_s_setprio(1);
#pragma unroll
        for (int m = 0; m < 6; ++m)
#pragma unroll
            for (int n = 0; n < 2; ++n)
#pragma unroll
                for (int k = 0; k < 2; ++k) acc[m][n] = __builtin_amdgcn_mfma_f32_16x16x32_bf16(Bf[n][k], At[m][k], acc[m][n], 0, 0, 0);
        __builtin_amdgcn_s_setprio(0);
        if (Epi::BRANCH) { if (t == 7 || t == 11 || t == nt - 1) E.seg(acc, tot, t == 7 ? 0 : (t == 11 ? 1 : 2), pm, pn, wr, wc, fr, fq); }
        if (t + 3 < nt) G192_WAIT_V(10); else if (t + 2 < nt) G192_WAIT_V(5); else G192_WAIT_V(0);
        __builtin_amdgcn_s_barrier();
    }
    E(Epi::BRANCH ? tot : acc, pm, pn, wr, wc, fr, fq);
#undef G192_STAGE
#undef G192_WAIT_V
#undef G192_WAIT_L
}
}

struct EpiBranch192 {
    static constexpr bool BRANCH = true;
    const bf16_t* G; bf16_t* mb;
    __device__ __forceinline__ void seg(g192::Acc6& acc, g192::Acc6& tot, int kind, int pm, int pn, int wr, int wc, int fr, int fq) const {
        const int col = pn * 128 + wc * 32 + 8 * fq;
#pragma unroll
        for (int m = 0; m < 6; ++m) {
            const int row = pm * 192 + wr * 96 + m * 16 + fr;
            const u32x4 gw = *(const u32x4*)(G + (size_t)row * 3072 + kind * 1024 + col);
            f32x4 g0 = {bf_lo(gw.x), bf_hi(gw.x), bf_lo(gw.y), bf_hi(gw.y)}, g1 = {bf_lo(gw.z), bf_hi(gw.z), bf_lo(gw.w), bf_hi(gw.w)};
            tot[m][0] += g0 * acc[m][0]; tot[m][1] += g1 * acc[m][1];
            acc[m][0] = (f32x4){0.f, 0.f, 0.f, 0.f}; acc[m][1] = (f32x4){0.f, 0.f, 0.f, 0.f};
        }
    }
    __device__ __forceinline__ void operator()(const g192::Acc6& tot, int pm, int pn, int wr, int wc, int fr, int fq) const {
        const int col = pn * 128 + wc * 32 + 8 * fq;
#pragma unroll
        for (int m = 0; m < 6; ++m) { const int row = pm * 192 + wr * 96 + m * 16 + fr; *(u32x4*)(mb + (size_t)row * D + col) = pk8(tot[m][0], tot[m][1]); }
    }
};
struct EpiRes192 {
    static constexpr bool BRANCH = false;
    float* x; bf16_t* xg; const float* gate; const float* gsn; float* rssn;
    __device__ __forceinline__ void seg(g192::Acc6&, g192::Acc6&, int, int, int, int, int, int, int) const {}
    __device__ __forceinline__ void operator()(const g192::Acc6& acc, int pm, int pn, int wr, int wc, int fr, int fq) const {
        const int col = pn * 128 + wc * 32 + 8 * fq;
        f32x4 xv[6][2], gt[6][2], gs[6][2];
#pragma unroll
        for (int m = 0; m < 6; ++m) {
            const int row = pm * 192 + wr * 96 + m * 16 + fr;
            const int mr = row < MP ? 0 : 1 + ((row - MP) >> 10);
            const float* gp = gate + (size_t)mr * 6 * D + col; const float* sp = gsn + (size_t)mr * 6 * D + col; const float* xp = x + (size_t)row * D + col;
            xv[m][0] = *(const f32x4*)xp; xv[m][1] = *(const f32x4*)(xp + 4);
            gt[m][0] = *(const f32x4*)gp; gt[m][1] = *(const f32x4*)(gp + 4); gs[m][0] = *(const f32x4*)sp; gs[m][1] = *(const f32x4*)(sp + 4);
        }
#pragma unroll
        for (int m = 0; m < 6; ++m) {
            const int row = pm * 192 + wr * 96 + m * 16 + fr;
            float* xp = x + (size_t)row * D + col;
            const f32x4 x0 = xv[m][0] + gt[m][0] * acc[m][0], x1 = xv[m][1] + gt[m][1] * acc[m][1];
            *(f32x4*)xp = x0; *(f32x4*)(xp + 4) = x1;
            float ss = (x0[0] * x0[0] + x0[1] * x0[1]) + (x0[2] * x0[2] + x0[3] * x0[3]) + (x1[0] * x1[0] + x1[1] * x1[1]) + (x1[2] * x1[2] + x1[3] * x1[3]);
            *(u32x4*)(xg + (size_t)row * D + col) = pk8(x0 * gs[m][0], x1 * gs[m][1]);
            ss += __shfl_xor(ss, 16); ss += __shfl_xor(ss, 32);
            if (fq == 0) atomicAdd(rssn + row, ss);
        }
    }
};

struct AttnState { f32x16 o0, o1; float m, l; };
struct KVFrag { bf16x8 k[4], v[2][2]; };
__device__ __forceinline__ void attn_load(KVFrag& f, const bf16_t* kptr  , const bf16_t* vptr  , int vstride32  ) {
#pragma unroll
    for (int s = 0; s < 4; ++s) f.k[s] = *(const bf16x8*)(kptr + 16 * s);
#pragma unroll
    for (int dt = 0; dt < 2; ++dt)
#pragma unroll
        for (int ks = 0; ks < 2; ++ks) f.v[dt][ks] = *(const bf16x8*)(vptr + (size_t)dt * vstride32 + 16 * ks);
}
__device__ __forceinline__ void attn_tile(AttnState& st, const bf16x8 (&qf)[4], const KVFrag& f, bool local, const LAS float* rl, int cq, int cs, int ck0  ) {
    f32x16 s = {0.f, 0.f, 0.f, 0.f, 0.f, 0.f, 0.f, 0.f, 0.f, 0.f, 0.f, 0.f, 0.f, 0.f, 0.f, 0.f};
#pragma unroll
    for (int k = 0; k < 4; ++k) s = __builtin_amdgcn_mfma_f32_32x32x16_bf16(f.k[k], qf[k], s, 0, 0, 0);
    if (local) {
        const LAS float* rb = rl + (ck0 - cq + 15);
        const int d0 = ck0 - cs;
#pragma unroll
        for (int i = 0; i < 16; ++i) {
            const int o = (i & 3) + 8 * (i >> 2);
            const bool ok = (unsigned)(d0 + o) < 16u;
            s[i] = ok ? s[i] + rb[o] : -1e30f;
        }
    }
    float mx = fmaxf(fmaxf(s[0], s[1]), fmaxf(s[2], s[3]));
#pragma unroll
    for (int i = 4; i < 16; i += 4) mx = fmaxf(mx, fmaxf(fmaxf(s[i], s[i + 1]), fmaxf(s[i + 2], s[i + 3])));
    mx = fmaxf(mx, __shfl_xor(mx, 32));
    const float mo = st.m, mn = fmaxf(mo, mx);
    st.m = mn;
    float ls = 0.f;
#pragma unroll
    for (int i = 0; i < 16; ++i) { const float p = __builtin_amdgcn_exp2f(s[i] - mn); s[i] = p; ls += p; }
    if (__builtin_amdgcn_ballot_w64(mn > mo) != 0ull) {
        const float alpha = __builtin_amdgcn_exp2f(mo - mn);
        st.l *= alpha;
#pragma unroll
        for (int i = 0; i < 16; ++i) { st.o0[i] *= alpha; st.o1[i] *= alpha; }
    }
    st.l += ls;
    u32x4 w0, w1;
    w0.x = pk2(s[0], s[1]); w0.y = pk2(s[2], s[3]); w0.z = pk2(s[4], s[5]); w0.w = pk2(s[6], s[7]);
    w1.x = pk2(s[8], s[9]); w1.y = pk2(s[10], s[11]); w1.z = pk2(s[12], s[13]); w1.w = pk2(s[14], s[15]);
    const bf16x8 p0 = __builtin_bit_cast(bf16x8, w0), p1 = __builtin_bit_cast(bf16x8, w1);
    st.o0 = __builtin_amdgcn_mfma_f32_32x32x16_bf16(f.v[0][0], p0, st.o0, 0, 0, 0);
    st.o0 = __builtin_amdgcn_mfma_f32_32x32x16_bf16(f.v[0][1], p1, st.o0, 0, 0, 0);
    st.o1 = __builtin_amdgcn_mfma_f32_32x32x16_bf16(f.v[1][0], p0, st.o1, 0, 0, 0);
    st.o1 = __builtin_amdgcn_mfma_f32_32x32x16_bf16(f.v[1][1], p1, st.o1, 0, 0, 0);
}
__device__ __forceinline__ void attn_store(const AttnState& st, bf16_t* orow  , int hf) {
    const float lt = st.l + __shfl_xor(st.l, 32);
    const float inv = 1.0f / lt;
#pragma unroll
    for (int g = 0; g < 4; ++g) {
        u32x2 a, b;
        a.x = pk2(st.o0[4 * g] * inv, st.o0[4 * g + 1] * inv); a.y = pk2(st.o0[4 * g + 2] * inv, st.o0[4 * g + 3] * inv);
        b.x = pk2(st.o1[4 * g] * inv, st.o1[4 * g + 1] * inv); b.y = pk2(st.o1[4 * g + 2] * inv, st.o1[4 * g + 3] * inv);
        *(u32x2*)(orow + 8 * g + 4 * hf) = a;
        *(u32x2*)(orow + 32 + 8 * g + 4 * hf) = b;
    }
}
struct AttnPtrs { const bf16_t *Q, *K, *Vt, *Kc, *Vtc; bf16_t* Abr; };
constexpr int PA_K_BYTES = 256 * 128, PA_V_BYTES = 64 * 512;
struct StageRegs { u32x4 kv[4], vv[4]; };
__device__ __forceinline__ void attn_stage_load(StageRegs& R, const bf16_t* ksrc, const bf16_t* vsrc, int vld, int nkeys, int tid) {
    const int nch = nkeys * 8, sh = nkeys == 256 ? 5 : 3;
#pragma unroll
    for (int i = 0; i < 4; ++i) { int q = tid + 512 * i; q = q < nch ? q : nch - 1;
        R.kv[i] = *(const u32x4*)(ksrc + (size_t)(q >> 3) * NAW + 8 * (q & 7));
        R.vv[i] = *(const u32x4*)(vsrc + (size_t)(q >> sh) * vld + 8 * (q & ((1 << sh) - 1))); }
}
__device__ __forceinline__ void attn_stage_store(const StageRegs& R, int nkeys, LAS unsigned char* kl, LAS unsigned char* vl, int tid) {
    const int nch = nkeys * 8, sh = nkeys == 256 ? 5 : 3;
#pragma unroll
    for (int i = 0; i < 4; ++i) { const int q = tid + 512 * i; if (q < nch) {
        const int key = q >> 3, c = q & 7, d = q >> sh, cv = q & ((1 << sh) - 1);
        *(LAS u32x4*)(kl + key * 128 + ((c ^ (key & 7)) << 4)) = R.kv[i];
        *(LAS u32x4*)(vl + d * 512 + ((cv ^ (d & 15)) << 4)) = R.vv[i]; } }
}
__device__ __forceinline__ void attn_lds_frag(KVFrag& f, const LAS unsigned char* kl, const LAS unsigned char* vl, int kt, int r32, int hf) {
    const int key = 32 * kt + r32;
#pragma unroll
    for (int s = 0; s < 4; ++s) f.k[s] = *(const LAS bf16x8*)(kl + key * 128 + (((2 * s + hf) ^ (key & 7)) << 4));
#pragma unroll
    for (int dt = 0; dt < 2; ++dt)
#pragma unroll
        for (int ks = 0; ks < 2; ++ks) { const int d = 32 * dt + r32; f.v[dt][ks] = *(const LAS bf16x8*)(vl + d * 512 + (((4 * kt + 2 * ks + hf) ^ (d & 15)) << 4)); }
}
__device__ __forceinline__ void attn_prompt_lds(const AttnPtrs& P, const LAS unsigned char* kl, const LAS unsigned char* vl, int bh, int qt, int lane) {
    const int r32 = lane & 31, hf = lane >> 5, b = bh >> 3, h = bh & 7;
    const int qrow = b * 256 + qt * 32 + r32;
    bf16x8 qf[4];
#pragma unroll
    for (int s = 0; s < 4; ++s) qf[s] = *(const bf16x8*)(P.Q + (size_t)qrow * NAW + h * 64 + 16 * s + 8 * hf);
    AttnState st; st.m = -1e30f; st.l = 0.f;
#pragma unroll
    for (int i = 0; i < 16; ++i) { st.o0[i] = 0.f; st.o1[i] = 0.f; }
    KVFrag fa, fb;
    attn_lds_frag(fa, kl, vl, 0, r32, hf);
#pragma unroll 1
    for (int t = 0; t < 8; t += 2) {
        attn_lds_frag(fb, kl, vl, t + 1, r32, hf);
        attn_tile(st, qf, fa, false, nullptr, 0, 0, 0);
        if (t + 2 < 8) attn_lds_frag(fa, kl, vl, t + 2, r32, hf);
        attn_tile(st, qf, fb, false, nullptr, 0, 0, 0);
    }
    attn_store(st, P.Abr + (size_t)qrow * D + h * 64, hf);
}
constexpr int ATT_PART_FLOATS = 34 * 64;
__device__ __forceinline__ void attn_sample_block(const AttnPtrs& P, LAS unsigned char* kl, LAS unsigned char* vl, const LAS float* rpl, LAS float* parts, int blk, int wave, int lane) {
    const int r32 = lane & 31, hf = lane >> 5, tid = wave * 64 + lane;
    const int bs = blk >> 6, h = (blk >> 3) & 7, i2 = (blk & 7) * 2;
    const int u = wave >> 1, half = wave & 1, r = i2 + (u >> 1), qh = u & 1;
    const int qrow = MP + bs * 1024 + r * 64 + qh * 32 + r32;
    const int cq = qh * 32 + r32; int cs = cq - 8; cs = cs < 0 ? 0 : (cs > 48 ? 48 : cs);
    int rs = r - 4; rs = rs < 0 ? 0 : (rs > 8 ? 8 : rs);
    int rs0 = i2 - 4; rs0 = rs0 < 0 ? 0 : (rs0 > 8 ? 8 : rs0);
    int rs1 = i2 - 3; rs1 = rs1 < 0 ? 0 : (rs1 > 8 ? 8 : rs1);
    const int nstage = rs1 != rs0 ? 4 : 3;
    const bf16_t* kloc = P.K + (size_t)(MP + bs * 1024) * NAW + h * 64;
    const bf16_t* vloc = P.Vt + VT_SAMPLE_OFF + (size_t)((bs * 8 + h) * 64) * 1024;
    bf16x8 qf[4];
#pragma unroll
    for (int s = 0; s < 4; ++s) qf[s] = *(const bf16x8*)(P.Q + (size_t)qrow * NAW + h * 64 + 16 * s + 8 * hf);
    AttnState st; st.m = -1e30f; st.l = 0.f;
#pragma unroll
    for (int i = 0; i < 16; ++i) { st.o0[i] = 0.f; st.o1[i] = 0.f; }
    LAS float* part = parts + u * ATT_PART_FLOATS;
    StageRegs R;
    attn_stage_load(R, P.Kc + (size_t)(bs * 256) * NAW + h * 64, P.Vtc + (size_t)((bs * 8 + h) * 64) * 256, 256, 256, tid);
#pragma unroll 1
    for (int sg = 0; sg < nstage; ++sg) {
        if (sg) __syncthreads();
        const int row0 = rs0 + 4 * (sg - 1);
        attn_stage_store(R, sg == 3 ? 64 : 256, kl, vl, tid);
        { const int sn = sg + 1 < nstage ? sg + 1 : 1, rown = rs0 + 4 * (sn - 1);
          attn_stage_load(R, kloc + (size_t)(rown * 64) * NAW, vloc + rown * 64, 1024, sn == 3 ? 64 : 256, tid); }
        LDS_WAIT(); __syncthreads();
        KVFrag f;
        if (sg == 0) {
#pragma unroll 1
            for (int kt = 4 * half; kt < 4 * half + 4; ++kt) { attn_lds_frag(f, kl, vl, kt, r32, hf); attn_tile(st, qf, f, false, nullptr, 0, 0, 0); }
        } else {
            const int nt = sg == 3 ? 2 : 8;
#pragma unroll 1
            for (int kt = half * (nt >> 1); kt < (half + 1) * (nt >> 1); ++kt) {
                const int jr = row0 + (kt >> 1), ch = kt & 1;
                if (jr < rs || jr >= rs + 8) continue;
                attn_lds_frag(f, kl, vl, kt, r32, hf);
                attn_tile(st, qf, f, true, rpl + (h * 15 + (jr - r + 7)) * 31, cq, cs, ch * 32 + 4 * hf);
            }
        }
    }
    if (half == 1) {
#pragma unroll
        for (int i = 0; i < 16; ++i) { part[i * 64 + lane] = st.o0[i]; part[(16 + i) * 64 + lane] = st.o1[i]; }
        part[32 * 64 + lane] = st.m; part[33 * 64 + lane] = st.l;
    }
    LDS_WAIT(); __syncthreads();
    if (half == 0) {
        const float m1 = part[32 * 64 + lane], l1 = part[33 * 64 + lane];
        const float mn = fmaxf(st.m, m1), a0 = __builtin_amdgcn_exp2f(st.m - mn), a1 = __builtin_amdgcn_exp2f(m1 - mn);
        st.l = st.l * a0 + l1 * a1;
#pragma unroll
        for (int i = 0; i < 16; ++i) { st.o0[i] = st.o0[i] * a0 + part[i * 64 + lane] * a1; st.o1[i] = st.o1[i] * a0 + part[(16 + i) * 64 + lane] * a1; }
        attn_store(st, P.Abr + (size_t)qrow * D + h * 64, hf);
    }
}

struct PcPtrs { const bf16_t *Pin, *Cin; const float *wdw, *bdw, *cng, *cnb; bf16_t* Abr; };
__device__ __forceinline__ f32x4 ld_bf4(const bf16_t* p) { const u32x2 w = *(const u32x2*)p; return (f32x4){bf_lo(w.x), bf_hi(w.x), bf_lo(w.y), bf_hi(w.y)}; }
__device__ __forceinline__ f32x4 up_bf4(u32x2 w) { return (f32x4){bf_lo(w.x), bf_hi(w.x), bf_lo(w.y), bf_hi(w.y)}; }
__device__ __forceinline__ void pool_unit(const PcPtrs& P, int unit, int lane) {
    const int row0 = unit * 8;
    const int L = row0 < MP ? 256 : 1024;
    const int sb = row0 < MP ? (row0 & ~255) : MP + ((row0 - MP) & ~1023);
    const int hw = 1 << (lane >> 4);
    const int t0 = row0 - sb;
    u32x2 pv[24];
#pragma unroll
    for (int i = 0; i < 24; ++i) { int t = t0 - 8 + i; t = t < 0 ? 0 : (t > L - 1 ? L - 1 : t); pv[i] = *(const u32x2*)(P.Pin + (size_t)(sb + t) * PW + 4 * lane); }
#pragma unroll
    for (int tt = 0; tt < 8; ++tt) {
        f32x4 sum = {0.f, 0.f, 0.f, 0.f}; float cnt = 0.f;
#pragma unroll
        for (int o = -8; o < 8; ++o) {
            const int t = t0 + tt + o;
            const bool in = (o >= -hw) && (o < hw) && (t >= 0) && (t < L);
            const f32x4 v = up_bf4(pv[tt + o + 8]);
            sum += in ? v : (f32x4){0.f, 0.f, 0.f, 0.f}; cnt += in ? 1.f : 0.f;
        }
        const f32x4 r = sum * __builtin_amdgcn_rcpf(cnt) - up_bf4(pv[tt + 8]);
        u32x2 w; w.x = pk2(r[0], r[1]); w.y = pk2(r[2], r[3]);
        *(u32x2*)(P.Abr + (size_t)(row0 + tt) * D + 512 + 4 * lane) = w;
    }
}
__device__ __forceinline__ void conv_unit(const PcPtrs& P, const LAS float* wl, int unit, int lane) {
    constexpr int T = 8;
    const int row0 = unit * T;
    const int L = row0 < MP ? 256 : 1024;
    const int sb = row0 < MP ? (row0 & ~255) : MP + ((row0 - MP) & ~1023);
    const int t0 = row0 - sb;
    f32x4 acc[T];
    const f32x4 bias = *(const f32x4*)(P.bdw + 4 * lane);
#pragma unroll
    for (int tt = 0; tt < T; ++tt) acc[tt] = bias;
#pragma unroll 1
    for (int c = 0; c < 2; ++c) {
        u32x2 ar[20], gr[20];
#pragma unroll
        for (int i = 0; i < 20; ++i) {
            const int t = t0 - 15 + 20 * c + i;
            const bool ok = (t >= 0) && (t < L);
            const bf16_t* p = P.Cin + (size_t)(sb + (ok ? t : 0)) * 512 + 4 * lane;
            ar[i] = *(const u32x2*)p; gr[i] = *(const u32x2*)(p + 256);
            if (!ok) { ar[i] = (u32x2){0u, 0u}; }
        }
#pragma unroll
        for (int g4 = 0; g4 < 5; ++g4) {
            const int s0 = 20 * c + 4 * g4;
            f32x4 tp[11];
#pragma unroll
            for (int q = 0; q < 11; ++q) tp[q] = *(const LAS f32x4*)(wl + (s0 + q) * CW + 4 * lane);
#pragma unroll
            for (int i = 0; i < 4; ++i) {
                const f32x4 a = up_bf4(ar[4 * g4 + i]), g = up_bf4(gr[4 * g4 + i]);
                f32x4 hh;
#pragma unroll
                for (int e = 0; e < 4; ++e) hh[e] = a[e] * sigmoidf_(g[e]);
#pragma unroll
                for (int tt = 0; tt < T; ++tt) acc[tt] += hh * tp[i - tt + 7];
            }
            asm volatile("" ::: "memory");
        }
    }
    const f32x4 lg = *(const f32x4*)(P.cng + 4 * lane), lb = *(const f32x4*)(P.cnb + 4 * lane);
    float s1[T], s2[T];
#pragma unroll
    for (int tt = 0; tt < T; ++tt) s1[tt] = (acc[tt][0] + acc[tt][1]) + (acc[tt][2] + acc[tt][3]);
#pragma unroll
    for (int o = 1; o < 64; o <<= 1)
#pragma unroll
        for (int tt = 0; tt < T; ++tt) s1[tt] += __shfl_xor(s1[tt], o);
#pragma unroll
    for (int tt = 0; tt < T; ++tt) { const float mu = s1[tt] * (1.0f / CW); acc[tt] = acc[tt] - mu; s2[tt] = (acc[tt][0] * acc[tt][0] + acc[tt][1] * acc[tt][1]) + (acc[tt][2] * acc[tt][2] + acc[tt][3] * acc[tt][3]); }
#pragma unroll
    for (int o = 1; o < 64; o <<= 1)
#pragma unroll
        for (int tt = 0; tt < T; ++tt) s2[tt] += __shfl_xor(s2[tt], o);
#pragma unroll
    for (int tt = 0; tt < T; ++tt) {
        const float rstd = 1.0f / sqrtf(s2[tt] * (1.0f / CW) + EPS);
        f32x4 y = acc[tt] * rstd * lg + lb;
#pragma unroll
        for (int e = 0; e < 4; ++e) y[e] = y[e] * sigmoidf_(y[e]);
        u32x2 o; o.x = pk2(y[0], y[1]); o.y = pk2(y[2], y[3]);
        *(u32x2*)(P.Abr + (size_t)(row0 + tt) * D + 768 + 4 * lane) = o;
    }
}

#define XB_TMO      128
#define XB_XCNT(j)  (256  + 64 * (j))
#define XB_XSUB(j)  (1280 + 64 * (j))
#define XB_XGEN(j)  (2304 + 64 * (j))
#define XB_TOP      3328
#define XB_TOPGEN   3392
#define XCD_BAR_WORDS 3456
#define XB_SPIN_CAP (1u << 18)
__device__ __forceinline__ unsigned xb_ld(unsigned* p)              { return __hip_atomic_load(p, __ATOMIC_RELAXED, __HIP_MEMORY_SCOPE_AGENT); }
__device__ __forceinline__ unsigned xb_add(unsigned* p, unsigned v) { return __hip_atomic_fetch_add(p, v, __ATOMIC_RELAXED, __HIP_MEMORY_SCOPE_AGENT); }
__device__ __forceinline__ unsigned xb_xcc_id() { return (unsigned)__builtin_amdgcn_s_getreg((3 << 11) | 20) & 0xFu; }
#define XB_SPIN(cond, bar) do { unsigned _sp = 0; while (cond) { __builtin_amdgcn_s_sleep(1); \
    if ((++_sp & 255u) == 0u) { if (xb_ld(&(bar)[XB_TMO])) break; if (_sp > XB_SPIN_CAP) { atomicAdd(&(bar)[XB_TMO], 1u); break; } } } } while (0)
struct XcdBarrier { unsigned* bar; unsigned x; unsigned nloc, nx; };
__device__ __forceinline__ XcdBarrier xcd_barrier_post(unsigned* bar) {
    XcdBarrier b; b.bar = bar; b.x = xb_xcc_id(); b.nloc = 0u; b.nx = 0u;
    if (threadIdx.x == 0) (void)xb_add(&bar[XB_XCNT(b.x)], 1u);
    return b;
}
__device__ __forceinline__ void xcd_barrier_complete(unsigned* bar, unsigned x, unsigned& nloc, unsigned& nx) {
    const unsigned G = gridDim.x * gridDim.y * gridDim.z;
    unsigned sum, cnt, mine, sp = 0u;
    for (;;) {
        sum = 0u; cnt = 0u; mine = 0u;
#pragma unroll
        for (unsigned j = 0; j < 16; ++j) { const unsigned c = xb_ld(&bar[XB_XCNT(j)]); sum += c; cnt += (c > 0u) ? 1u : 0u; mine = (j == x) ? c : mine; }
        if (sum == G) break;
        __builtin_amdgcn_s_sleep(1);
        if ((++sp & 255u) == 0u) { if (xb_ld(&bar[XB_TMO])) break; if (sp > XB_SPIN_CAP) { atomicAdd(&bar[XB_TMO], 1u); break; } }
    }
    nloc = mine > 0u ? mine : 1u; nx = cnt > 0u ? cnt : 1u;
}
__device__ __forceinline__ void xcd_barrier(XcdBarrier& b) {
    asm volatile("s_waitcnt vmcnt(0)" ::: "memory");
    __syncthreads();
    if (threadIdx.x == 0) {
        unsigned* bar = b.bar;
        __builtin_amdgcn_s_waitcnt(0);
        unsigned nloc = b.nloc, nx = b.nx;
        if (nloc == 0u) { xcd_barrier_complete(bar, b.x, nloc, nx); b.nloc = nloc; b.nx = nx; }
        const unsigned old = xb_add(&bar[XB_XSUB(b.x)], 1u);
        const unsigned gen = old / nloc;
        if (old + 1u == (gen + 1u) * nloc) {
            __builtin_amdgcn_fence(__ATOMIC_RELEASE, "agent");
            asm volatile("s_waitcnt vmcnt(0)" ::: "memory");
            const unsigned og = xb_add(&bar[XB_TOP], 1u);
            const unsigned tg = og / nx;
            if (og + 1u == (tg + 1u) * nx) xb_add(&bar[XB_TOPGEN], 1u);
            else XB_SPIN(xb_ld(&bar[XB_TOPGEN]) == tg, bar);
            __builtin_amdgcn_fence(__ATOMIC_ACQUIRE, "agent");
            xb_add(&bar[XB_XGEN(b.x)], 1u);
            asm volatile("s_waitcnt vmcnt(0)" ::: "memory");
        } else {
            XB_SPIN(xb_ld(&bar[XB_XGEN(b.x)]) == gen, bar);
            __builtin_amdgcn_fence(__ATOMIC_ACQUIRE, "agent");
            asm volatile("s_waitcnt vmcnt(0)" ::: "memory");
        }
    }
    __syncthreads();
}

constexpr int TP_PITCH = 65, TP_BYTES = 64 * TP_PITCH * 4;
template <bool WITH_C, bool GU_PERM>
__device__ __forceinline__ void transpose_item(const float* W, int N, bf16_t* WT, int ldt, int kcol0, LAS float* scr, int item, int lane,
                                               const float* shraw  , const float* shb  , float* csum  ) {
    const int nblk = N / 64, kb = item / nblk, nb = item % nblk, k0 = 64 * kb, n0 = 64 * nb;
    {
        const int r4 = lane >> 4, c4 = lane & 15;
        f32x4 v[16];
#pragma unroll
        for (int i = 0; i < 16; ++i) v[i] = __builtin_nontemporal_load((const f32x4*)(W + (size_t)(k0 + 4 * i + r4) * N + n0 + 4 * c4));
#pragma unroll
        for (int i = 0; i < 16; ++i) { LAS float* p = scr + (4 * i + r4) * TP_PITCH + 4 * c4; p[0] = v[i][0]; p[1] = v[i][1]; p[2] = v[i][2]; p[3] = v[i][3]; }
    }
    const int c = lane & 7, nn = lane >> 3;
    f32x4 sh[3][2];
    if (WITH_C) {
#pragma unroll
        for (int r = 0; r < 3; ++r)
#pragma unroll
            for (int h = 0; h < 2; ++h) sh[r][h] = *(const f32x4*)(shraw + (size_t)r * NMOD + k0 + 8 * c + 4 * h) + *(const f32x4*)(shb + k0 + 8 * c + 4 * h);
    }
    LDS_WAIT(); asm volatile("" ::: "memory");
#pragma unroll
    for (int j = 0; j < 8; ++j) {
        const int n = 8 * j + nn; const LAS float* s = scr + (8 * c) * TP_PITCH + n;
        float w[8];
#pragma unroll
        for (int q = 0; q < 8; ++q) w[q] = s[q * TP_PITCH];
        u32x4 o; o.x = pk2(w[0], w[1]); o.y = pk2(w[2], w[3]); o.z = pk2(w[4], w[5]); o.w = pk2(w[6], w[7]);
        int nrow = n0 + n;
        if (GU_PERM) nrow = nrow < FFN ? ((nrow >> 7) * 256 + (nrow & 127)) : (((nrow - FFN) >> 7) * 256 + 128 + ((nrow - FFN) & 127));
        *(u32x4*)(WT + (size_t)nrow * ldt + kcol0 + k0 + 8 * c) = o;
        if (WITH_C) {
            float d0 = 0.f, d1 = 0.f, d2 = 0.f;
#pragma unroll
            for (int q = 0; q < 8; ++q) { d0 += sh[0][q >> 2][q & 3] * w[q]; d1 += sh[1][q >> 2][q & 3] * w[q]; d2 += sh[2][q >> 2][q & 3] * w[q]; }
#pragma unroll
            for (int x = 1; x < 8; x <<= 1) { d0 += __shfl_xor(d0, x); d1 += __shfl_xor(d1, x); d2 += __shfl_xor(d2, x); }
            if (c == 0) { atomicAdd(csum + n0 + n, d0); atomicAdd(csum + N + n0 + n, d1); atomicAdd(csum + 2 * N + n0 + n, d2); }
        }
    }
    LDS_WAIT(); asm volatile("" ::: "memory");
}

constexpr int NWAVES = 8;
constexpr int I_IN = 16 * (NIN / 64), I_GU = 16 * (NGU / 64), I_DN = (FFN / 64) * 16, I_OUT = 16 * 16, I_OA = 8 * 16, I_OC = 4 * 16;
constexpr int I_LAYER = I_IN + I_GU + I_DN + I_OUT + I_OA + I_OC;
#ifndef MK_TAIL
#define MK_TAIL I_LAYER
#endif
constexpr int I_TAIL = MK_TAIL, I_HEAD = I_LAYER - I_TAIL;
constexpr int I_MIX = (I_TAIL >= 512) ? 512 : 0;
#define TRANSPOSE_LAYER_ITEM(l_, r0_, scr_, lane_) do { const int tl_ = (l_); int tr_ = (r0_); \
        const float* shraw1_ = MODRAW + (size_t)(tl_ * 3) * NMOD; const float* shraw2_ = MODRAW + (size_t)(tl_ * 3) * NMOD + 3 * D; \
        if (tr_ < I_IN) { transpose_item<true, false>(w_in + (size_t)tl_ * D * NIN, NIN, WIN + (size_t)tl_ * NIN * D, D, 0, scr_, tr_, lane_, shraw1_, b_mod + (size_t)tl_ * NMOD, C1 + (size_t)(tl_ * 3) * NIN); break; } tr_ -= I_IN; \
        if (tr_ < I_GU) { transpose_item<true, true>(w_gu + (size_t)tl_ * D * NGU, NGU, WGU + (size_t)tl_ * NGU * D, D, 0, scr_, tr_, lane_, shraw2_, b_mod + (size_t)tl_ * NMOD + 3 * D, C2 + (size_t)(tl_ * 3) * NGU); break; } tr_ -= I_GU; \
        if (tr_ < I_DN) { transpose_item<false, false>(w_down + (size_t)tl_ * FFN * D, D, WDN + (size_t)tl_ * D * FFN, FFN, 0, scr_, tr_, lane_, nullptr, nullptr, nullptr); break; } tr_ -= I_DN; \
        if (tr_ < I_OUT) { transpose_item<false, false>(w_out + (size_t)tl_ * D * D, D, WOUT + (size_t)tl_ * D * D, D, 0, scr_, tr_, lane_, nullptr, nullptr, nullptr); break; } tr_ -= I_OUT; \
        if (tr_ < I_OA) { transpose_item<false, false>(w_oa + (size_t)tl_ * NAW * D, D, WBR + (size_t)tl_ * D * D, D, 0, scr_, tr_, lane_, nullptr, nullptr, nullptr); break; } tr_ -= I_OA; \
        transpose_item<false, false>(w_oc + (size_t)tl_ * CW * D, D, WBR + (size_t)tl_ * D * D, D, 768, scr_, tr_, lane_, nullptr, nullptr, nullptr); } while (0)
constexpr int LDS_BYTES = 163840;
static_assert(8 * TP_BYTES <= LDS_BYTES, "LDS map");
constexpr int NPHASE = 2 + 6 * DEPTH + 1;

struct Args {
    const float* in[26]; float* out; unsigned char* ws; int ph_lo, ph_hi;
};

__global__ void __launch_bounds__(NWAVES * 64, 2) fwd_kernel(Args args) {
    extern __shared__ __attribute__((aligned(16))) unsigned char lds_raw[];
    LAS unsigned char* lds = (LAS unsigned char*)lds_raw;
    const int tid = threadIdx.x, lane = tid & 63, wave = __builtin_amdgcn_readfirstlane(tid >> 6);
    const int G = gridDim.x, bx = blockIdx.x;
    const int vcu = (G % 8 == 0) ? (bx % 8) * (G / 8) + bx / 8 : bx;
    const int gw = vcu * NWAVES + wave, NGW = G * NWAVES;
    unsigned char* ws = args.ws;
    float* ctlf = (float*)(ws + WS_CTL);
    const float* x_prompt = args.in[0]; const float* x_sample = args.in[1]; const float* cache_k = args.in[2]; const float* cache_v = args.in[3];
    const float* cvec = args.in[4]; const float* c_ctx = args.in[5]; const float* w_mod = args.in[6]; const float* b_mod = args.in[7];
    const float* norm1_g = args.in[8]; const float* norm2_g = args.in[9]; const float* w_in = args.in[10]; const float* b_gate = args.in[11];
    const float* rpb = args.in[12]; const float* w_oa = args.in[13]; const float* w_pool = args.in[14]; const float* pool_scale = args.in[15];
    const float* w_ob = args.in[16]; const float* w_dw = args.in[17]; const float* b_dw = args.in[18]; const float* conv_norm_g = args.in[19];
    const float* conv_norm_b = args.in[20]; const float* w_oc = args.in[21]; const float* w_out = args.in[22]; const float* w_gu = args.in[23];
    const float* w_down = args.in[24]; const float* final_g = args.in[25];
    float* MODRAW = ctlf + CF_MODRAW; float* C1 = ctlf + CF_C1; float* C2 = ctlf + CF_C2; float* RSS = ctlf + CF_RSS;
    float* MODT = (float*)(ws + WS_MODT);
    bf16_t* WIN = (bf16_t*)(ws + WS_WIN); bf16_t* WGU = (bf16_t*)(ws + WS_WGU); bf16_t* WDN = (bf16_t*)(ws + WS_WDN); bf16_t* WBR = (bf16_t*)(ws + WS_WBR); bf16_t* WOUT = (bf16_t*)(ws + WS_WOUT);
    float* X = (float*)(ws + WS_X); bf16_t* XG = (bf16_t*)(ws + WS_XG);
    bf16_t* Qb = (bf16_t*)(ws + WS_Q); bf16_t* Kb = (bf16_t*)(ws + WS_K); bf16_t* VT = (bf16_t*)(ws + WS_VT); bf16_t* KC = (bf16_t*)(ws + WS_KC); bf16_t* VTC = (bf16_t*)(ws + WS_VTC);
    bf16_t* PIN = (bf16_t*)(ws + WS_PIN); bf16_t* CIN = (bf16_t*)(ws + WS_CIN); bf16_t* GT = (bf16_t*)(ws + WS_G); bf16_t* ABR = (bf16_t*)(ws + WS_ABR);
    float* MF = (float*)(ws + WS_MF); bf16_t* MB = (bf16_t*)(ws + WS_MB); bf16_t* ACT = (bf16_t*)(ws + WS_ACT);

#if !MK_PER_PHASE
    XcdBarrier bar = xcd_barrier_post((unsigned*)(ws + WS_CTL) + CW_BAR);
#define GRID_BAR() xcd_barrier(bar)
#else
#define GRID_BAR() do {} while (0)
#endif
    const int lo = args.ph_lo, hi = args.ph_hi;
#define IN(k) (lo <= (k) && (k) < hi)
#define SEAM(k) do { if (IN(k) && IN((k) + 1)) GRID_BAR(); } while (0)

    for (int rep_ = 0; rep_ < MK_REPS(4); ++rep_) { if (rep_) GRID_BAR();
    float* MODRAW_W = rep_ ? MF : MODRAW; float* C1_W = rep_ ? MF + DEPTH * 3 * NMOD : C1; float* C2_W = rep_ ? MF + DEPTH * 3 * (NMOD + NIN) : C2;
    if (IN(0)) {
        LAS float* sil = (LAS float*)lds; LAS float* red = (LAS float*)(lds + 16384);
        for (int i = tid; i < 3 * D; i += NWAVES * 64) { const float s = i < D ? c_ctx[i] : cvec[i - D]; sil[i] = s * sigmoidf_(s); }
        __syncthreads();
        for (int it = vcu; it < DEPTH * 24 * 8; it += G) {
            const int l = it / 192, rem = it % 192, nc = rem >> 3, kq = rem & 7, k0 = kq * 128 + wave * 16, n0 = nc * 256 + 4 * lane;
            const float* wp = w_mod + ((size_t)l * D + k0) * NMOD + n0;
            f32x4 w[16];
#pragma unroll
            for (int kk = 0; kk < 16; ++kk) w[kk] = __builtin_nontemporal_load((const f32x4*)(wp + (size_t)kk * NMOD));
            f32x4 a0 = {0.f, 0.f, 0.f, 0.f}, a1 = a0, a2 = a0;
#pragma unroll
            for (int kk = 0; kk < 16; ++kk) { a0 += sil[k0 + kk] * w[kk]; a1 += sil[D + k0 + kk] * w[kk]; a2 += sil[2 * D + k0 + kk] * w[kk]; }
#pragma unroll
            for (int e = 0; e < 4; ++e) { red[(wave * 12 + e) * 64 + lane] = a0[e]; red[(wave * 12 + 4 + e) * 64 + lane] = a1[e]; red[(wave * 12 + 8 + e) * 64 + lane] = a2[e]; }
            __syncthreads();
            for (int o = tid; o < 12 * 64; o += NWAVES * 64) {
                float s = 0.f;
#pragma unroll
                for (int ww = 0; ww < 8; ++ww) s += red[ww * 768 + o];
                const int q = o >> 6, ln = o & 63, r = q >> 2, e = q & 3;
                atomicAdd(MODRAW_W + (size_t)(l * 3 + r) * NMOD + nc * 256 + 4 * ln + e, s);
            }
            __syncthreads();
        }
    }
    SEAM(0);

    if (IN(1)) {
        LAS float* scr = (LAS float*)(lds + wave * TP_BYTES);
        constexpr int I_T = I_LAYER + (DEPTH - 1) * I_HEAD;
        constexpr int I_OB = DEPTH * 16 * 4 * 8;
        constexpr int I_X = M;
        constexpr int I_KC = DEPTH * 2 * 256;
        constexpr int I_VC = DEPTH * 2 * 8 * 4;
        constexpr int I_MT = DEPTH * 3 * 6 * 4;
        constexpr int I_ALL = I_T + I_OB + I_X + I_KC + I_VC + I_MT;
        for (int it0 = gw; it0 < I_ALL; it0 += NGW) {
            int it = it0;
            if (it < I_T) {
                if (it < I_LAYER) TRANSPOSE_LAYER_ITEM(0, it, scr, lane);
                else if constexpr (I_HEAD > 0) { const int q = it - I_LAYER; TRANSPOSE_LAYER_ITEM(1 + q / I_HEAD, q % I_HEAD, scr, lane); }
                continue;
            }
            it -= I_T;
            if (it < I_OB) {
                const int l = it / 512, rem = it % 512, nch = rem >> 5, g = (rem >> 3) & 3, cc = rem & 7, n = nch * 64 + lane;
                float a[8];
#pragma unroll
                for (int c = 0; c < 8; ++c) a[c] = 0.f;
                const float* wp = w_pool + ((size_t)(l * 4 + g) * 64 + cc * 8) * 64;
                for (int d = 0; d < 64; ++d) {
                    const float wb = w_ob[((size_t)l * PW + g * 64 + d) * D + n] * pool_scale[l * PW + g * 64 + d];
#pragma unroll
                    for (int c = 0; c < 8; ++c) a[c] += wp[c * 64 + d] * wb;
                }
                u32x4 o; o.x = pk2(a[0], a[1]); o.y = pk2(a[2], a[3]); o.z = pk2(a[4], a[5]); o.w = pk2(a[6], a[7]);
                *(u32x4*)(WBR + ((size_t)l * D + n) * D + 512 + g * 64 + cc * 8) = o;
                continue;
            }
            it -= I_OB;
            if (it < I_X) {
                const int row = it, mr = row < MP ? 0 : 1 + ((row - MP) >> 10);
                const float* xr = row < MP ? x_prompt + (size_t)row * D : x_sample + (size_t)(row - MP) * D;
                float ss = 0.f;
#pragma unroll
                for (int j = 0; j < 4; ++j) {
                    const int col = 256 * j + 4 * lane;
                    const f32x4 v = *(const f32x4*)(xr + col);
                    *(f32x4*)(X + (size_t)row * D + col) = v;
                    ss += (v[0] * v[0] + v[1] * v[1]) + (v[2] * v[2] + v[3] * v[3]);
                    const f32x4 sc = *(const f32x4*)(MODRAW + (size_t)mr * NMOD + D + col) + *(const f32x4*)(b_mod + D + col);
                    const f32x4 gg = *(const f32x4*)(norm1_g + col) * (sc + 1.0f);
                    const f32x4 xs = v * gg;
                    u32x2 o; o.x = pk2(xs[0], xs[1]); o.y = pk2(xs[2], xs[3]);
                    *(u32x2*)(XG + (size_t)row * D + col) = o;
                }
                ss = wave_sum(ss);
                if (lane == 0) RSS[row] = ss;
                continue;
            }
            it -= I_X;
            if (it < I_KC) {
                const int l = it / 512, bs = (it >> 8) & 1, key = it & 255;
                const float* src = cache_k + (((size_t)(bs * DEPTH + l) * 256 + key) * 512) + 8 * lane;
                const f32x4 a = *(const f32x4*)src, b = *(const f32x4*)(src + 4);
                *(u32x4*)(KC + (((size_t)(l * 2 + bs) * 256 + key) * 512) + 8 * lane) = pk8(a, b);
                continue;
            }
            it -= I_KC;
            if (it < I_VC) {
                const int l = it / 64, bs = (it >> 5) & 1, h = (it >> 2) & 7, kb = it & 3, key = kb * 64 + lane;
                const float* src = cache_v + (((size_t)(bs * DEPTH + l) * 256 + key) * 512) + h * 64;
                bf16_t* dst = VTC + ((size_t)((l * 2 + bs) * 8 + h) * 64) * 256 + pos_of_key(key);
#pragma unroll
                for (int d4 = 0; d4 < 16; ++d4) {
                    const f32x4 v = *(const f32x4*)(src + 4 * d4);
                    const unsigned w0 = pk2(v[0], v[1]), w1 = pk2(v[2], v[3]);
                    dst[(size_t)(4 * d4 + 0) * 256] = (bf16_t)(w0 & 0xffff); dst[(size_t)(4 * d4 + 1) * 256] = (bf16_t)(w0 >> 16);
                    dst[(size_t)(4 * d4 + 2) * 256] = (bf16_t)(w1 & 0xffff); dst[(size_t)(4 * d4 + 3) * 256] = (bf16_t)(w1 >> 16);
                }
                continue;
            }
            it -= I_VC;
            {
                const int q = it & 3, which = (it >> 2) % 6, lr = it / 24, l = lr / 3, col = q * 256 + 4 * lane;
                const float* mraw = MODRAW + (size_t)lr * NMOD; const float* bm = b_mod + (size_t)l * NMOD;
                f32x4 v;
                if (which == 0) v = *(const f32x4*)(norm1_g + (size_t)l * D + col) * (*(const f32x4*)(mraw + D + col) + *(const f32x4*)(bm + D + col) + 1.0f);
                else if (which == 1) v = *(const f32x4*)(mraw + col) + *(const f32x4*)(bm + col);
                else if (which == 2) v = *(const f32x4*)(mraw + 2 * D + col) + *(const f32x4*)(bm + 2 * D + col);
                else if (which == 3) v = *(const f32x4*)(norm2_g + (size_t)l * D + col) * (*(const f32x4*)(mraw + 4 * D + col) + *(const f32x4*)(bm + 4 * D + col) + 1.0f);
                else if (which == 4) v = *(const f32x4*)(mraw + 3 * D + col) + *(const f32x4*)(bm + 3 * D + col);
                else v = *(const f32x4*)(mraw + 5 * D + col) + *(const f32x4*)(bm + 5 * D + col);
                *(f32x4*)(MODT + ((size_t)lr * 6 + which) * D + col) = v;
            }
        }
        LDS_WAIT(); __syncthreads();
    }
    }
    SEAM(1);

    for (int l = 0; l < DEPTH; ++l) {
        const int p0 = 2 + 6 * l;
        const float* modt_l = MODT + (size_t)l * 3 * 6 * D;
        for (int rep_ = 0; rep_ < MK_REPS(0); ++rep_) { if (rep_) GRID_BAR();
        if (IN(p0)) {
            pg8::Gemm g{XG, WIN + (size_t)l * NIN * D, D, D};
            pg8::TileOrder S; S.init(M, NIN, D, G, bx);
            EpiIn E{RSS + (size_t)(2 * l) * M, C1 + (size_t)(l * 3) * NIN, b_gate + (size_t)l * 3072, Qb, Kb, VT, PIN, CIN, GT,
                    args.out + OUT_K + (size_t)l * 256 * 512, args.out + OUT_V + (size_t)l * 256 * 512};
            pg8::gemm_phase<EpiIn, pg8::TileOrder>(lds, g, S, E);
        }
        }
        SEAM(p0);
        for (int rep_ = 0; rep_ < MK_REPS(1); ++rep_) { if (rep_) GRID_BAR();
        if (IN(p0 + 1)) {
            AttnPtrs AP{Qb, Kb, VT, KC + (size_t)l * 2 * 256 * 512, VTC + (size_t)l * 2 * 8 * 64 * 256, ABR};
            PcPtrs PP{PIN, CIN, w_dw + (size_t)l * CONVK * CW, b_dw + (size_t)l * CW, conv_norm_g + (size_t)l * CW, conv_norm_b + (size_t)l * CW, ABR};
            int lane_p = lane; asm volatile("" : "+v"(lane_p));
            if (vcu < 128) {
                LAS float* rpl = (LAS float*)(lds + 1024); LAS float* parts = (LAS float*)(lds + 16384);
                LAS unsigned char* kl = lds + 53248; LAS unsigned char* vl = kl + PA_K_BYTES;
                const float* rpb_l = rpb + (size_t)l * 8 * 15 * 31;
                for (int i = wave * 64 + lane_p; i < 8 * 15 * 31; i += NWAVES * 64) rpl[i] = rpb_l[i] * LOG2E;
                if (!(rep_ && MK_VAR == 1)) attn_sample_block(AP, kl, vl, rpl, parts, vcu, wave, lane_p);
                { const int pu = vcu * NWAVES + wave; if (pu < 768 && !(rep_ && (MK_VAR == 4 || MK_VAR == 5))) pool_unit(PP, pu, lane_p); }
            } else {
                LAS float* wl = (LAS float*)lds; LAS unsigned char* kl = lds + 49152; LAS unsigned char* vl = kl + PA_K_BYTES;
                const int bh = vcu - 128;
                for (int i = wave * 64 + lane_p; i < 47 * CW / 4; i += NWAVES * 64) { const int j = i / (CW / 4) - 7;
                    *(LAS f32x4*)(wl + 4 * i) = (j >= 0 && j < CONVK) ? *(const f32x4*)(PP.wdw + 4 * (i - 7 * (CW / 4))) : (f32x4){0.f, 0.f, 0.f, 0.f}; }
                { StageRegs R; attn_stage_load(R, AP.K + (size_t)((bh >> 3) * 256) * NAW + (bh & 7) * 64, AP.Vt + (size_t)(bh * 64) * 256, 256, 256, wave * 64 + lane_p); attn_stage_store(R, 256, kl, vl, wave * 64 + lane_p); }
                LDS_WAIT(); __syncthreads();
                if (!(rep_ && (MK_VAR == 2 || MK_VAR == 5))) attn_prompt_lds(AP, kl, vl, bh, wave, lane_p);
                { const int it = bh * NWAVES + wave;
                    if (it < 768) { if (!(rep_ && (MK_VAR == 3 || MK_VAR == 5))) conv_unit(PP, wl, it, lane_p); } }
                if (I_MIX > 0 && bh >= 96 && l + 1 < DEPTH && !rep_) {
                    __syncthreads();
                    LAS float* scr = (LAS float*)(lds + wave * TP_BYTES);
#pragma unroll 1
                    for (int r = I_LAYER - I_MIX + (bh - 96) * NWAVES + wave; r < I_LAYER; r += 32 * NWAVES) TRANSPOSE_LAYER_ITEM(l + 1, r, scr, lane_p);
                    LDS_WAIT();
                }
            }
            __syncthreads();
        }
        }
        SEAM(p0 + 1);
        const int t192 = (bx & 7) * 32 + (bx >> 3), pm192 = t192 >> 3, pn192 = t192 & 7;
        const bool has192 = (G == 256);
        for (int rep_ = 0; rep_ < MK_REPS(2); ++rep_) { if (rep_) GRID_BAR();
        if (IN(p0 + 2)) {
            EpiBranch192 E{GT, MB};
            if (has192) g192::gemm<EpiBranch192>(lds, ABR, D, WBR + (size_t)l * D * D, D, pm192, pn192, 16, E);
        }
        }
        SEAM(p0 + 2);
        for (int rep_ = 0; rep_ < MK_REPS(5); ++rep_) { if (rep_) GRID_BAR();
        if (IN(p0 + 3)) {
            EpiRes192 E{rep_ ? MF : X, rep_ ? ACT : XG, modt_l + 2 * D, modt_l + 3 * D, rep_ ? (float*)ABR : RSS + (size_t)(2 * l + 1) * M};
            if (has192) g192::gemm<EpiRes192>(lds, MB, D, WOUT + (size_t)l * D * D, D, pm192, pn192, 16, E);
        }
        }
        SEAM(p0 + 3);
        for (int rep_ = 0; rep_ < MK_REPS(3); ++rep_) { if (rep_) GRID_BAR();
        if (IN(p0 + 4)) {
            pg8::Gemm g{XG, WGU + (size_t)l * NGU * D, D, D};
            pg8::TileOrderGU S; S.init(M, NGU, D, G, bx);
            EpiGU E{RSS + (size_t)(2 * l + 1) * M, C2 + (size_t)(l * 3) * NGU, ACT};
            pg8::gemm_phase<EpiGU, pg8::TileOrderGU>(lds, g, S, E);
            if (I_TAIL > 0 && l + 1 < DEPTH && G == 256 && bx >= 32) {
                int lane_b = lane; asm volatile("" : "+v"(lane_b));
                LAS float* scr = (LAS float*)(lds + wave * TP_BYTES);
#pragma unroll 1
                for (int r = I_HEAD + (bx - 32) * NWAVES + wave; r < I_LAYER - I_MIX; r += 224 * NWAVES) TRANSPOSE_LAYER_ITEM(l + 1, r, scr, lane_b);
                LDS_WAIT(); __syncthreads();
            }
        }
        }
        SEAM(p0 + 4);
        for (int rep_ = 0; rep_ < MK_REPS(6); ++rep_) { if (rep_) GRID_BAR();
        if (IN(p0 + 5)) {
            EpiRes192 E{rep_ ? MF : X, rep_ ? MB : XG, modt_l + 5 * D, MODT + (size_t)((l + 1) % DEPTH) * 3 * 6 * D, rep_ ? (float*)ABR : RSS + (size_t)(2 * l + 2) * M};
            if (has192) g192::gemm<EpiRes192>(lds, ACT, FFN, WDN + (size_t)l * D * FFN, FFN, pm192, pn192, FFN / 64, E);
        }
        }
        SEAM(p0 + 5);
    }
    if (IN(NPHASE - 1)) {
        for (int row = gw; row < M; row += NGW) {
            const float rinv = 1.0f / sqrtf(RSS[(size_t)8 * M + row] * (1.0f / D) + EPS);
#pragma unroll
            for (int j = 0; j < 4; ++j) {
                const int col = 256 * j + 4 * lane;
                const f32x4 v = *(const f32x4*)(X + (size_t)row * D + col) * rinv * *(const f32x4*)(final_g + col);
                __builtin_nontemporal_store(v, (f32x4*)(args.out + OUT_Y + (size_t)row * D + col));
            }
        }
    }
#undef IN
#undef SEAM
}

extern "C" void kernel_launch(void* const* d_in, const int* in_sizes, int n_in, void* d_out, int out_size, void* d_ws, size_t ws_size, hipStream_t stream) {
    static int grid = 0;
    if (grid == 0) {
        if (n_in != 26 || ws_size < WS_END) { fprintf(stderr, "kernel_launch: expected 26 inputs and >= %zu bytes of workspace; got %d, %zu\n", (size_t)WS_END, n_in, ws_size); grid = -1; return; }
        int dev = 0, cus = 0;
        if (hipGetDevice(&dev) != hipSuccess || hipDeviceGetAttribute(&cus, hipDeviceAttributeMultiprocessorCount, dev) != hipSuccess) { grid = -1; return; }
        if (hipFuncSetAttribute((const void*)fwd_kernel, hipFuncAttributeMaxDynamicSharedMemorySize, LDS_BYTES) != hipSuccess) { fprintf(stderr, "kernel_launch: hipFuncSetAttribute failed\n"); grid = -1; return; }
        (void)hipGetLastError();
        grid = cus;
    }
    if (grid < 0) return;
    (void)hipMemsetAsync((char*)d_ws + WS_CTL, 0, CTL_ZERO_BYTES, stream);
    Args a{};
    for (int i = 0; i < 26; ++i) a.in[i] = (const float*)d_in[i];
    a.out = (float*)d_out; a.ws = (unsigned char*)d_ws;
#if MK_PER_PHASE
    for (int p = 0; p < NPHASE; ++p) { a.ph_lo = p; a.ph_hi = p + 1; hipLaunchKernelGGL(fwd_kernel, dim3(grid), dim3(NWAVES * 64), LDS_BYTES, stream, a); }
#else
    a.ph_lo = 0; a.ph_hi = NPHASE;
    hipLaunchKernelGGL(fwd_kernel, dim3(grid), dim3(NWAVES * 64), LDS_BYTES, stream, a);
#endif
}
```

```cpp
#include <hip/hip_runtime.h>
#include <cstdio>
#include <cstdint>

#ifndef MK_PER_PHASE
#define MK_PER_PHASE 0
#endif

#ifndef MK_REPEAT
#define MK_REPEAT 0
#endif
#define MK_REPS(bit) ((MK_REPEAT >> (bit)) & 1 ? 2 : 1)
#ifndef MK_VAR
#define MK_VAR 0
#endif

constexpr int D = 1024, MP = 4096, MS = 2048, M = MP + MS, DEPTH = 4;
constexpr int NIN = 5376, FFN = 2816, NGU = 2 * FFN, NMOD = 6 * D;
constexpr int NAW = 512, PW = 256, CW = 256, CONVK = 31;
constexpr float EPS = 1e-6f;
constexpr float LOG2E = 1.4426950408889634f;
constexpr float QSCALE = 0.125f * LOG2E;

constexpr size_t MiB = 1u << 20;
constexpr size_t WS_CTL = 0, CTL_ZERO_BYTES = 5 * MiB / 4;
constexpr int CW_BAR = 4096;
constexpr int CF_MODRAW = 16384;
constexpr int CF_C1 = CF_MODRAW + DEPTH * 3 * NMOD;
constexpr int CF_C2 = CF_C1 + DEPTH * 3 * NIN;
constexpr int CF_RSS = CF_C2 + DEPTH * 3 * NGU;
constexpr int CF_END = CF_RSS + 9 * M;
static_assert((size_t)CF_END * 4 <= CTL_ZERO_BYTES, "control region");
constexpr size_t WS_MODT = 2 * MiB;
constexpr size_t WS_WIN = 4 * MiB;
constexpr size_t WS_WGU = 46 * MiB;
constexpr size_t WS_WDN = 90 * MiB;
constexpr size_t WS_WBR = 112 * MiB;
constexpr size_t WS_WOUT = 120 * MiB;
constexpr size_t WS_X = 128 * MiB;
constexpr size_t WS_XG = 152 * MiB;
constexpr size_t WS_Q = 164 * MiB, WS_K = 170 * MiB;
constexpr size_t WS_VT = 176 * MiB;
constexpr size_t WS_KC = 182 * MiB;
constexpr size_t WS_VTC = 184 * MiB;
constexpr size_t WS_PIN = 186 * MiB;
constexpr size_t WS_CIN = 189 * MiB;
constexpr size_t WS_G = 195 * MiB;
constexpr size_t WS_ABR = 231 * MiB;
constexpr size_t WS_MF = 243 * MiB;
constexpr size_t WS_MB = 267 * MiB;
constexpr size_t WS_ACT = 279 * MiB;
constexpr size_t WS_END = 312 * MiB;
constexpr size_t VT_SAMPLE_OFF = (size_t)16 * 8 * 64 * 256;

constexpr size_t OUT_Y = 0, OUT_K = (size_t)M * D, OUT_V = OUT_K + (size_t)16 * DEPTH * 256 * 512;

#define GAS __attribute__((address_space(1)))
#define LAS __attribute__((address_space(3)))
typedef unsigned short bf16_t;
typedef short bf16x8 __attribute__((ext_vector_type(8)));
typedef float f32x4 __attribute__((ext_vector_type(4)));
typedef float f32x2 __attribute__((ext_vector_type(2)));
typedef float f32x16 __attribute__((ext_vector_type(16)));
typedef unsigned u32x4 __attribute__((ext_vector_type(4)));
typedef unsigned u32x2 __attribute__((ext_vector_type(2)));
typedef __bf16 bf16x2_t __attribute__((ext_vector_type(2)));
#define LDS_WAIT() asm volatile("s_waitcnt lgkmcnt(0)" ::: "memory")

__device__ __forceinline__ unsigned pk2(float lo, float hi) { f32x2 v = {lo, hi}; bf16x2_t b = __builtin_convertvector(v, bf16x2_t); return __builtin_bit_cast(unsigned, b); }
__device__ __forceinline__ u32x4 pk8(f32x4 a, f32x4 b) { u32x4 w; w.x = pk2(a[0], a[1]); w.y = pk2(a[2], a[3]); w.z = pk2(b[0], b[1]); w.w = pk2(b[2], b[3]); return w; }
__device__ __forceinline__ float bf_lo(unsigned w) { return __uint_as_float(w << 16); }
__device__ __forceinline__ float bf_hi(unsigned w) { return __uint_as_float(w & 0xffff0000u); }
__device__ __forceinline__ float sigmoidf_(float x) { return __builtin_amdgcn_rcpf(1.0f + __builtin_amdgcn_exp2f(-LOG2E * x)); }
__device__ __forceinline__ float wave_sum(float v) {
#pragma unroll
    for (int o = 1; o < 64; o <<= 1) v += __shfl_xor(v, o);
    return v;
}
__device__ __forceinline__ int pos_of_key(int t) { return (t & ~12) | ((t & 4) << 1) | ((t & 8) >> 1); }
__device__ __forceinline__ int mod_row_of_pm(int pm) { return pm < 16 ? 0 : 1 + ((pm - 16) >> 2); }

namespace pg8 {
constexpr int BM = 256, BK = 64, HALF = 128, HTB = HALF * BK * 2  , STAGE_BYTES = 8 * HTB, NXCD = 8, WGM = 4;
__host__ __device__ __forceinline__ int lds_byte(int r, int c) { return r * 128 + ((((c >> 3) ^ (r >> 1)) & 7) << 4) + (c & 7) * 2; }
__host__ __device__ __forceinline__ void stage_rc(int b, int& R, int& C) { R = b >> 7; C = (((b >> 4) ^ (R >> 1)) & 7) * 8; }
__host__ __device__ __forceinline__ int perm32(int rho) { const int n = rho >> 4, i = rho & 15; return 8 * (i >> 2) + 4 * n + (i & 3); }

struct Unit { int pm, pn, k0, nt, kind, half; };
struct Gemm { const bf16_t* A; const bf16_t* Bt; int lda, ldb; };

struct TileOrder {
    int nM, nN, nwg, G, c, nt;
    __device__ void init(int M_, int N_, int K_, int G_, int c_) { nM = M_ / BM; nN = N_ / BM; nwg = nM * nN; G = G_; c = c_; nt = K_ / BK; }
    __device__ bool next(int i, Unit& u) const {
        const long L = (long)i * G + c; if (L >= nwg) return false;
        int wgid = (int)L; { const int q = nwg / NXCD, r = nwg % NXCD, xcd = wgid % NXCD, off = wgid / NXCD; wgid = (xcd < r ? xcd * (q + 1) : r * (q + 1) + (xcd - r) * q) + off; }
        const int nig = WGM * nN, gid = wgid / nig, fm = gid * WGM, gsz = (nM - fm) < WGM ? (nM - fm) : WGM;
        u.pm = fm + ((wgid % nig) % gsz); u.pn = (wgid % nig) / gsz; u.k0 = 0; u.nt = nt; u.kind = 0; u.half = 0; return true;
    }
};
struct TileOrderGU {
    int nM, nN, nwg, nw, c, nt;
    __device__ void init(int M_, int N_, int K_, int nw_, int c_) { nM = M_ / BM; nN = N_ / BM; nwg = nM * nN; nw = nw_; c = c_; nt = K_ / BK; }
    __device__ __forceinline__ void done(const Unit&, int) const {}
    __device__ void tile_of(int L, Unit& u) const {
        const int wgid = (L % NXCD) * (nwg / NXCD) + L / NXCD;
        const int nig = WGM * nN, gid = wgid / nig, fm = gid * WGM, gsz = (nM - fm) < WGM ? (nM - fm) : WGM;
        u.pm = fm + ((wgid % nig) % gsz); u.pn = (wgid % nig) / gsz; u.k0 = 0; u.nt = nt; u.kind = 0;
    }
    __device__ bool next(int i, Unit& u) const {
        if (c >= nw || i > 2) return false;
        if (i < 2) { tile_of(i * nw + c, u); u.half = 0; return true; }
        const int j = c >> 3, per = (nwg - 2 * nw) / NXCD;
        if (j >= 2 * per) return false;
        tile_of(2 * nw + (j >> 1) * NXCD + (c & 7), u); u.half = 1 + (j & 1); return true;
    }
};

struct PanelOrder {
    int c, nseg, ka, na, kb, nb, kc, nc;
    __device__ bool next(int i, Unit& u) const {
        if (c >= 96 || i >= nseg) return false;
        const int T = (c & 7) * 12 + (c >> 3);
        u.pm = T >> 2; u.pn = T & 3; u.k0 = i == 0 ? ka : (i == 1 ? kb : kc); u.nt = i == 0 ? na : (i == 1 ? nb : nc); u.kind = i; u.half = 0; return true;
    }
};

template <class Epi, class Sched>
__device__ __forceinline__ void gemm_phase(LAS unsigned char* lds, const Gemm g, const Sched& S, const Epi& E) {
    int tid = threadIdx.x; asm volatile("" : "+v"(tid));
    const int wid = __builtin_amdgcn_readfirstlane(tid >> 6), lane = tid & 63, wr = wid >> 2, wc = wid & 3, fr = lane & 15, fq = lane >> 4;
    unsigned voffA[2], voffB[2];
#pragma unroll
    for (int i = 0; i < 2; ++i) { int R, C; stage_rc(tid * 16 + i * 8192, R, C); const int Rb = (R & ~31) + perm32(R & 31);
        voffA[i] = (unsigned)(R * g.lda + C) * 2u; voffB[i] = (unsigned)(Rb * g.ldb + C) * 2u; }
    const size_t kstep = (size_t)(BK * 2);
    const size_t hstepA = (size_t)HALF * g.lda * 2, hstepB = (size_t)HALF * g.ldb * 2;
    const size_t tstepA = 2 * hstepA, tstepB = 2 * hstepB;
    const unsigned ldsw = (unsigned)wid * 1024u;
    const int aoffk[2] = {lds_byte(wr * 64 + fr, fq * 8), lds_byte(wr * 64 + fr, fq * 8 + 32)}, boffk[2] = {lds_byte(wc * 32 + fr, fq * 8), lds_byte(wc * 32 + fr, fq * 8 + 32)};
#define PG8_SA(b, h) (((b) * 2 + (h)) * HTB)
#define PG8_SB(b, h) ((4 + (b) * 2 + (h)) * HTB)
#define PG8_STAGE(bufoff, gbase, voff) do { _Pragma("unroll") for (int _i = 0; _i < 2; ++_i) \
        __builtin_amdgcn_global_load_lds((const unsigned*)((const char*)(gbase) + (voff)[_i]), (LAS unsigned*)(lds + (bufoff) + ldsw + _i * 8192), 16, 0, 0); } while (0)
#define PG8_LDA(dst, b, h) do { _Pragma("unroll") for (int m = 0; m < 4; ++m) _Pragma("unroll") for (int k = 0; k < 2; ++k) dst[m][k] = *(const LAS bf16x8*)(lds + PG8_SA(b, h) + aoffk[k] + m * 2048); } while (0)
#define PG8_LDB(dst, b, h) do { _Pragma("unroll") for (int n = 0; n < 2; ++n) _Pragma("unroll") for (int k = 0; k < 2; ++k) dst[n][k] = *(const LAS bf16x8*)(lds + PG8_SB(b, h) + boffk[k] + n * 2048); } while (0)
#define PG8_MMA(ai, bj, At, Bt) do { __builtin_amdgcn_s_setprio(1); _Pragma("unroll") for (int m = 0; m < 4; ++m) _Pragma("unroll") for (int n = 0; n < 2; ++n) _Pragma("unroll") for (int k = 0; k < 2; ++k) \
        acc[ai][bj][m][n] = __builtin_amdgcn_mfma_f32_16x16x32_bf16(Bt[n][k], At[m][k], acc[ai][bj][m][n], 0, 0, 0); __builtin_amdgcn_s_setprio(0); } while (0)
#define PG8_WAIT_V(n) asm volatile("s_waitcnt vmcnt(" #n ")" ::: "memory")
#define PG8_WAIT_L(n) asm volatile("s_waitcnt lgkmcnt(" #n ")" ::: "memory")
#define PG8_BAR __builtin_amdgcn_s_barrier()
#define PG8_SCHED __builtin_amdgcn_sched_barrier(0)
    Unit cur, nxt; int ui = 0;
    if (!S.next(0, cur)) return;
    f32x4 acc[2][2][4][2];
#pragma unroll
    for (int a = 0; a < 2; ++a)
#pragma unroll
        for (int b = 0; b < 2; ++b)
#pragma unroll
            for (int m = 0; m < 4; ++m)
#pragma unroll
                for (int n = 0; n < 2; ++n) acc[a][b][m][n] = (f32x4){0.f, 0.f, 0.f, 0.f};
    bf16x8 At[4][2], B0[2][2], B1[2][2];
    const char* cA = (const char*)g.A + (size_t)cur.pm * tstepA + (size_t)cur.k0 * 2; const char* cB = (const char*)g.Bt + (size_t)cur.pn * tstepB + (size_t)cur.k0 * 2;
    PG8_STAGE(PG8_SB(0, 0), cB, voffB); PG8_STAGE(PG8_SB(0, 1), cB + hstepB, voffB); PG8_STAGE(PG8_SA(0, 0), cA, voffA); PG8_STAGE(PG8_SA(0, 1), cA + hstepA, voffA);
    if (wr == 1) PG8_BAR;
    PG8_WAIT_V(2); PG8_BAR;
    PG8_STAGE(PG8_SB(1, 0), cB + kstep, voffB); PG8_STAGE(PG8_SA(1, 0), cA + kstep, voffA); PG8_STAGE(PG8_SB(1, 1), cB + hstepB + kstep, voffB);
    PG8_WAIT_V(6); PG8_BAR;
    for (;;) {
        const bool has_next = S.next(ui + 1, nxt);
        const char* nA = has_next ? (const char*)g.A + (size_t)nxt.pm * tstepA + (size_t)nxt.k0 * 2 : cA; const char* nB = has_next ? (const char*)g.Bt + (size_t)nxt.pn * tstepB + (size_t)nxt.k0 * 2 : cB;
        const int nt = cur.nt;
        const bool do0 = cur.half != 2, do1 = cur.half != 1;
        for (int t = 0; t < nt; t += 2) {
            const bool last = (t == nt - 2);
            const char* a1 = cA + (size_t)(t + 1) * kstep;
            const char* a2 = last ? nA : cA + (size_t)(t + 2) * kstep; const char* b2 = last ? nB : cB + (size_t)(t + 2) * kstep;
            const char* a3 = a2 + kstep; const char* b3 = b2 + kstep;
            PG8_LDB(B0, 0, 0); PG8_LDB(B1, 0, 1); PG8_SCHED; PG8_LDA(At, 0, 0); PG8_STAGE(PG8_SA(1, 1), a1 + hstepA, voffA);
            PG8_WAIT_V(8); PG8_WAIT_L(0); PG8_BAR; if (do0) { PG8_MMA(0, 0, At, B0); PG8_MMA(0, 1, At, B1); } PG8_BAR; PG8_SCHED;
            PG8_LDA(At, 0, 1); PG8_STAGE(PG8_SB(0, 0), b2, voffB); PG8_STAGE(PG8_SB(0, 1), b2 + hstepB, voffB); PG8_STAGE(PG8_SA(0, 0), a2, voffA);
            PG8_WAIT_V(8); PG8_WAIT_L(0); PG8_BAR; if (do1) { PG8_MMA(1, 0, At, B0); PG8_MMA(1, 1, At, B1); } PG8_BAR; PG8_SCHED;
            PG8_LDB(B0, 1, 0); PG8_LDB(B1, 1, 1); PG8_SCHED; PG8_LDA(At, 1, 0); PG8_STAGE(PG8_SA(0, 1), a2 + hstepA, voffA);
            PG8_WAIT_V(8); PG8_WAIT_L(0); PG8_BAR; if (do0) { PG8_MMA(0, 0, At, B0); PG8_MMA(0, 1, At, B1); } PG8_BAR; PG8_SCHED;
            PG8_LDA(At, 1, 1); PG8_STAGE(PG8_SB(1, 0), b3, voffB); PG8_STAGE(PG8_SB(1, 1), b3 + hstepB, voffB); PG8_STAGE(PG8_SA(1, 0), a3, voffA);
            PG8_WAIT_V(8); PG8_WAIT_L(0); PG8_BAR; if (do1) { PG8_MMA(1, 0, At, B0); PG8_MMA(1, 1, At, B1); } PG8_BAR; PG8_SCHED;
        }
        if (wr == 0) PG8_BAR;
        E(acc, cur, wr, wc, fr, fq);
        if (!has_next) break;
#pragma unroll
        for (int a = 0; a < 2; ++a)
#pragma unroll
            for (int b = 0; b < 2; ++b)
#pragma unroll
                for (int m = 0; m < 4; ++m)
#pragma unroll
                    for (int n = 0; n < 2; ++n) acc[a][b][m][n] = (f32x4){0.f, 0.f, 0.f, 0.f};
        cur = nxt; cA = nA; cB = nB; ++ui;
        if (wr == 1) PG8_BAR;
    }
    PG8_WAIT_V(0);
    PG8_BAR;
#undef PG8_SA
#undef PG8_SB
#undef PG8_STAGE
#undef PG8_LDA
#undef PG8_LDB
#undef PG8_MMA
#undef PG8_WAIT_V
#undef PG8_WAIT_L
#undef PG8_BAR
#undef PG8_SCHED
}
}

typedef f32x4 Acc[2][2][4][2];

struct EpiIn {
    const float* rss; const float* c1; const float* bgate;
    bf16_t *Q, *K, *Vt, *Pin, *Cin, *G; float *outk, *outv;
    __device__ __forceinline__ void operator()(const Acc& acc, const pg8::Unit& u, int wr, int wc, int fr, int fq) const {
        const int pn = u.pn, pm = u.pm, mr = mod_row_of_pm(pm);
        const int cb = pn * 256 + wc * 32 + 8 * fq;
        f32x4 cv[2][2];
#pragma unroll
        for (int bj = 0; bj < 2; ++bj)
#pragma unroll
            for (int n = 0; n < 2; ++n) { cv[bj][n] = *(const f32x4*)(c1 + (size_t)mr * NIN + cb + bj * 128 + 4 * n);
                if (pn >= 9) cv[bj][n] += *(const f32x4*)(bgate + (cb - 2304) + bj * 128 + 4 * n); }
        float rinvs[2][4];
#pragma unroll
        for (int ai = 0; ai < 2; ++ai)
#pragma unroll
            for (int m = 0; m < 4; ++m) rinvs[ai][m] = rss[pm * 256 + ai * 128 + wr * 64 + m * 16 + fr];
#pragma unroll
        for (int ai = 0; ai < 2; ++ai)
#pragma unroll
            for (int m = 0; m < 4; ++m) {
                const int row = pm * 256 + ai * 128 + wr * 64 + m * 16 + fr;
                const float rinv = 1.0f / sqrtf(rinvs[ai][m] * (1.0f / D) + EPS);
#pragma unroll
                for (int bj = 0; bj < 2; ++bj) {
                    const int col = cb + bj * 128;
                    f32x4 v0 = acc[ai][bj][m][0] * rinv + cv[bj][0], v1 = acc[ai][bj][m][1] * rinv + cv[bj][1];
                    if (pn < 2) {
                        *(u32x4*)(Q + (size_t)row * NAW + col) = pk8(v0 * QSCALE, v1 * QSCALE);
                    } else if (pn < 4) {
                        const int c = col - 512;
                        *(u32x4*)(K + (size_t)row * NAW + c) = pk8(v0, v1);
                        if (pm < 16) { float* o = outk + ((size_t)(pm * DEPTH * 256 + (row & 255))) * 512 + c; __builtin_nontemporal_store(v0, (f32x4*)o); __builtin_nontemporal_store(v1, (f32x4*)(o + 4)); }
                    } else if (pn < 6) {
                        const int c = col - 1024, h = c >> 6, d = c & 63;
                        if (pm < 16) { float* o = outv + ((size_t)(pm * DEPTH * 256 + (row & 255))) * 512 + c; __builtin_nontemporal_store(v0, (f32x4*)o); __builtin_nontemporal_store(v1, (f32x4*)(o + 4)); }
                        bf16_t* vb; int L;
                        if (pm < 16) { L = 256; vb = Vt + ((size_t)((pm * 8 + h) * 64 + d)) * 256 + pos_of_key(row & 255); }
                        else { const int rs = row - MP, bs = rs >> 10; L = 1024; vb = Vt + VT_SAMPLE_OFF + ((size_t)((bs * 8 + h) * 64 + d)) * 1024 + pos_of_key(rs & 1023); }
                        const u32x4 w = pk8(v0, v1);
                        vb[0] = (bf16_t)(w.x & 0xffff); vb[(size_t)L] = (bf16_t)(w.x >> 16); vb[(size_t)2 * L] = (bf16_t)(w.y & 0xffff); vb[(size_t)3 * L] = (bf16_t)(w.y >> 16);
                        vb[(size_t)4 * L] = (bf16_t)(w.z & 0xffff); vb[(size_t)5 * L] = (bf16_t)(w.z >> 16); vb[(size_t)6 * L] = (bf16_t)(w.w & 0xffff); vb[(size_t)7 * L] = (bf16_t)(w.w >> 16);
                    } else if (pn == 6) {
                        *(u32x4*)(Pin + (size_t)row * PW + (col - 1536)) = pk8(v0, v1);
                    } else if (pn < 9) {
                        *(u32x4*)(Cin + (size_t)row * 512 + (col - 1792)) = pk8(v0, v1);
                    } else {
#pragma unroll
                        for (int e = 0; e < 4; ++e) { v0[e] = sigmoidf_(v0[e]); v1[e] = sigmoidf_(v1[e]); }
                        *(u32x4*)(G + (size_t)row * 3072 + (col - 2304)) = pk8(v0, v1);
                    }
                }
                asm volatile("" ::: "memory");
            }
    }
};

struct EpiBranch {
    const bf16_t* G; float* mf; bf16_t* mb;
    __device__ __forceinline__ void operator()(const Acc& acc, const pg8::Unit& u, int wr, int wc, int fr, int fq) const {
        const int cb = u.pn * 256 + wc * 32 + 8 * fq, kind = u.kind;
#pragma unroll
        for (int ai = 0; ai < 2; ++ai)
#pragma unroll
            for (int m = 0; m < 4; ++m) {
                const int row = u.pm * 256 + ai * 128 + wr * 64 + m * 16 + fr;
#pragma unroll
                for (int bj = 0; bj < 2; ++bj) {
                    const int col = cb + bj * 128;
                    const u32x4 gw = *(const u32x4*)(G + (size_t)row * 3072 + kind * 1024 + col);
                    f32x4 v0 = acc[ai][bj][m][0], v1 = acc[ai][bj][m][1];
                    v0[0] *= bf_lo(gw.x); v0[1] *= bf_hi(gw.x); v0[2] *= bf_lo(gw.y); v0[3] *= bf_hi(gw.y);
                    v1[0] *= bf_lo(gw.z); v1[1] *= bf_hi(gw.z); v1[2] *= bf_lo(gw.w); v1[3] *= bf_hi(gw.w);
                    float* sp = mf + (size_t)row * D + col;
                    if (kind > 0) { v0 += *(const f32x4*)sp; v1 += *(const f32x4*)(sp + 4); }
                    if (kind < 2) { *(f32x4*)sp = v0; *(f32x4*)(sp + 4) = v1; }
                    else *(u32x4*)(mb + (size_t)row * D + col) = pk8(v0, v1);
                }
                asm volatile("" ::: "memory");
            }
    }
};

struct EpiRes {
    float* x; bf16_t* xg; const float* gate; const float* gsn; float* rssn;
    __device__ __forceinline__ void operator()(const Acc& acc, const pg8::Unit& u, int wr, int wc, int fr, int fq) const {
        const int mr = mod_row_of_pm(u.pm), cb = u.pn * 256 + wc * 32 + 8 * fq;
        float ss[2][4];
#pragma unroll
        for (int ai = 0; ai < 2; ++ai)
#pragma unroll
            for (int m = 0; m < 4; ++m) ss[ai][m] = 0.f;
#pragma unroll
        for (int bj = 0; bj < 2; ++bj) {
            const int col = cb + bj * 128;
            const f32x4 gt0 = *(const f32x4*)(gate + (size_t)mr * 6 * D + col), gt1 = *(const f32x4*)(gate + (size_t)mr * 6 * D + col + 4);
            const f32x4 gs0 = *(const f32x4*)(gsn + (size_t)mr * 6 * D + col), gs1 = *(const f32x4*)(gsn + (size_t)mr * 6 * D + col + 4);
#pragma unroll
            for (int ai = 0; ai < 2; ++ai)
#pragma unroll
                for (int m = 0; m < 4; ++m) {
                    const int row = u.pm * 256 + ai * 128 + wr * 64 + m * 16 + fr;
                    float* xp = x + (size_t)row * D + col;
                    f32x4 x0 = *(const f32x4*)xp, x1 = *(const f32x4*)(xp + 4);
                    x0 += gt0 * acc[ai][bj][m][0]; x1 += gt1 * acc[ai][bj][m][1];
                    *(f32x4*)xp = x0; *(f32x4*)(xp + 4) = x1;
                    ss[ai][m] += (x0[0] * x0[0] + x0[1] * x0[1]) + (x0[2] * x0[2] + x0[3] * x0[3]) + (x1[0] * x1[0] + x1[1] * x1[1]) + (x1[2] * x1[2] + x1[3] * x1[3]);
                    *(u32x4*)(xg + (size_t)row * D + col) = pk8(x0 * gs0, x1 * gs1);
                    asm volatile("" ::: "memory");
                }
        }
#pragma unroll
        for (int ai = 0; ai < 2; ++ai)
#pragma unroll
            for (int m = 0; m < 4; ++m) {
                float s = ss[ai][m];
                s += __shfl_xor(s, 16); s += __shfl_xor(s, 32);
                if (fq == 0) atomicAdd(rssn + u.pm * 256 + ai * 128 + wr * 64 + m * 16 + fr, s);
            }
    }
};

struct EpiGU {
    const float* rss; const float* c2; bf16_t* act;
    __device__ __forceinline__ void operator()(const Acc& acc, const pg8::Unit& u, int wr, int wc, int fr, int fq) const {
        const int mr = mod_row_of_pm(u.pm), ca0 = u.pn * 128 + wc * 32 + 8 * fq;
        f32x4 ca[2], cbv[2];
#pragma unroll
        for (int n = 0; n < 2; ++n) { ca[n] = *(const f32x4*)(c2 + (size_t)mr * NGU + ca0 + 4 * n); cbv[n] = *(const f32x4*)(c2 + (size_t)mr * NGU + FFN + ca0 + 4 * n); }
        float rinvs[2][4];
#pragma unroll
        for (int ai = 0; ai < 2; ++ai)
#pragma unroll
            for (int m = 0; m < 4; ++m) rinvs[ai][m] = rss[u.pm * 256 + ai * 128 + wr * 64 + m * 16 + fr];
#pragma unroll
        for (int ai = 0; ai < 2; ++ai)
#pragma unroll
            for (int m = 0; m < 4; ++m) {
                if (u.half == 2 - ai) continue;
                const int row = u.pm * 256 + ai * 128 + wr * 64 + m * 16 + fr;
                const float rinv = 1.0f / sqrtf(rinvs[ai][m] * (1.0f / D) + EPS);
                f32x4 o[2];
#pragma unroll
                for (int n = 0; n < 2; ++n) {
                    const f32x4 a = acc[ai][0][m][n] * rinv + ca[n], b = acc[ai][1][m][n] * rinv + cbv[n];
#pragma unroll
                    for (int e = 0; e < 4; ++e) o[n][e] = a[e] * sigmoidf_(a[e]) * b[e];
                }
                *(u32x4*)(act + (size_t)row * FFN + ca0) = pk8(o[0], o[1]);
                asm volatile("" ::: "memory");
            }
    }
};

namespace g192 {
constexpr int TM = 192, TN = 128, BK = 64, ABYTES = TM * BK * 2, BBYTES = TN * BK * 2, SBYTES = ABYTES + BBYTES;
typedef f32x4 Acc6[6][2];
template <class Epi>
__device__ __forceinline__ void gemm(LAS unsigned char* lds, const bf16_t* A, int lda, const bf16_t* Bt, int ldb, int pm, int pn, int nt, const Epi& E) {
    int tid = threadIdx.x; asm volatile("" : "+v"(tid));
    const int wid = __builtin_amdgcn_readfirstlane(tid >> 6), lane = tid & 63, wr = wid >> 2, wc = wid & 3, fr = lane & 15, fq = lane >> 4;
    unsigned voffA[3], voffB[2];
#pragma unroll
    for (int i = 0; i < 3; ++i) { int R, C; pg8::stage_rc((wid + 8 * i) * 1024 + lane * 16, R, C); voffA[i] = (unsigned)(R * lda + C) * 2u; }
#pragma unroll
    for (int i = 0; i < 2; ++i) { int R, C; pg8::stage_rc((wid + 8 * i) * 1024 + lane * 16, R, C); const int Rb = (R & ~31) + pg8::perm32(R & 31); voffB[i] = (unsigned)(Rb * ldb + C) * 2u; }
    const char* gA = (const char*)(A + (size_t)pm * TM * lda); const char* gB = (const char*)(Bt + (size_t)pn * TN * ldb);
    const unsigned ldsw = (unsigned)wid * 1024u;
    const int aoffk[2] = {pg8::lds_byte(wr * 96 + fr, fq * 8), pg8::lds_byte(wr * 96 + fr, fq * 8 + 32)}, boffk[2] = {ABYTES + pg8::lds_byte(wc * 32 + fr, fq * 8), ABYTES + pg8::lds_byte(wc * 32 + fr, fq * 8 + 32)};
#define G192_STAGE(slot, t) do { \
        _Pragma("unroll") for (int _i = 0; _i < 3; ++_i) __builtin_amdgcn_global_load_lds((const unsigned*)(gA + (size_t)(t) * (BK * 2) + voffA[_i]), (LAS unsigned*)(lds + (slot) * SBYTES + ldsw + _i * 8192), 16, 0, 0); \
        _Pragma("unroll") for (int _i = 0; _i < 2; ++_i) __builtin_amdgcn_global_load_lds((const unsigned*)(gB + (size_t)(t) * (BK * 2) + voffB[_i]), (LAS unsigned*)(lds + (slot) * SBYTES + ABYTES + ldsw + _i * 8192), 16, 0, 0); } while (0)
#define G192_WAIT_V(n) asm volatile("s_waitcnt vmcnt(" #n ")" ::: "memory")
#define G192_WAIT_L(n) asm volatile("s_waitcnt lgkmcnt(" #n ")" ::: "memory")
    f32x4 acc[6][2], tot[6][2];
#pragma unroll
    for (int m = 0; m < 6; ++m)
#pragma unroll
        for (int n = 0; n < 2; ++n) { acc[m][n] = (f32x4){0.f, 0.f, 0.f, 0.f}; tot[m][n] = (f32x4){0.f, 0.f, 0.f, 0.f}; }
    G192_STAGE(0, 0); G192_STAGE(1, 1); G192_STAGE(2, 2);
    G192_WAIT_V(10); __builtin_amdgcn_s_barrier();
#pragma unroll 1
    for (int t = 0; t < nt; ++t) {
        const int slot = t & 3;
        if (t + 3 < nt) G192_STAGE((t + 3) & 3, t + 3);
        bf16x8 At[6][2], Bf[2][2];
        const LAS unsigned char* sb = lds + slot * SBYTES;
#pragma unroll
        for (int n = 0; n < 2; ++n)
#pragma unroll
            for (int k = 0; k < 2; ++k) Bf[n][k] = *(const LAS bf16x8*)(sb + boffk[k] + n * 2048);
#pragma unroll
        for (int m = 0; m < 6; ++m)
#pragma unroll
            for (int k = 0; k < 2; ++k) At[m][k] = *(const LAS bf16x8*)(sb + aoffk[k] + m * 2048);
        G192_WAIT_L(0);
        __builtin_amdgcn_s_setprio(1);
#pragma unroll
        for (int m = 0; m < 6; ++m)
#pragma unroll
            for (int n = 0; n < 2; ++n)
#pragma unroll
                for (int k = 0; k < 2; ++k) acc[m][n] = __builtin_amdgcn_mfma_f32_16x16x32_bf16(Bf[n][k], At[m][k], acc[m][n], 0, 0, 0);
        __builtin_amdgcn_s_setprio(0);
        if (Epi::BRANCH) { if (t == 7 || t == 11 || t == nt - 1) E.seg(acc, tot, t == 7 ? 0 : (t == 11 ? 1 : 2), pm, pn, wr, wc, fr, fq); }
        if (t + 3 < nt) G192_WAIT_V(10); else if (t + 2 < nt) G192_WAIT_V(5); else G192_WAIT_V(0);
        __builtin_amdgcn_s_barrier();
    }
    E(Epi::BRANCH ? tot : acc, pm, pn, wr, wc, fr, fq);
#undef G192_STAGE
#undef G192_WAIT_V
#undef G192_WAIT_L
}
}

struct EpiBranch192 {
    static constexpr bool BRANCH = true;
    const bf16_t* G; bf16_t* mb;
    __device__ __forceinline__ void seg(g192::Acc6& acc, g192::Acc6& tot, int kind, int pm, int pn, int wr, int wc, int fr, int fq) const {
        const int col = pn * 128 + wc * 32 + 8 * fq;
#pragma unroll
        for (int m = 0; m < 6; ++m) {
            const int row = pm * 192 + wr * 96 + m * 16 + fr;
            const u32x4 gw = *(const u32x4*)(G + (size_t)row * 3072 + kind * 1024 + col);
            f32x4 g0 = {bf_lo(gw.x), bf_hi(gw.x), bf_lo(gw.y), bf_hi(gw.y)}, g1 = {bf_lo(gw.z), bf_hi(gw.z), bf_lo(gw.w), bf_hi(gw.w)};
            tot[m][0] += g0 * acc[m][0]; tot[m][1] += g1 * acc[m][1];
            acc[m][0] = (f32x4){0.f, 0.f, 0.f, 0.f}; acc[m][1] = (f32x4){0.f, 0.f, 0.f, 0.f};
        }
    }
    __device__ __forceinline__ void operator()(const g192::Acc6& tot, int pm, int pn, int wr, int wc, int fr, int fq) const {
        const int col = pn * 128 + wc * 32 + 8 * fq;
#pragma unroll
        for (int m = 0; m < 6; ++m) { const int row = pm * 192 + wr * 96 + m * 16 + fr; *(u32x4*)(mb + (size_t)row * D + col) = pk8(tot[m][0], tot[m][1]); }
    }
};
struct EpiRes192 {
    static constexpr bool BRANCH = false;
    float* x; bf16_t* xg; const float* gate; const float* gsn; float* rssn;
    __device__ __forceinline__ void seg(g192::Acc6&, g192::Acc6&, int, int, int, int, int, int, int) const {}
    __device__ __forceinline__ void operator()(const g192::Acc6& acc, int pm, int pn, int wr, int wc, int fr, int fq) const {
        const int col = pn * 128 + wc * 32 + 8 * fq;
        f32x4 xv[6][2], gt[6][2], gs[6][2];
#pragma unroll
        for (int m = 0; m < 6; ++m) {
            const int row = pm * 192 + wr * 96 + m * 16 + fr;
            const int mr = row < MP ? 0 : 1 + ((row - MP) >> 10);
            const float* gp = gate + (size_t)mr * 6 * D + col; const float* sp = gsn + (size_t)mr * 6 * D + col; const float* xp = x + (size_t)row * D + col;
            xv[m][0] = *(const f32x4*)xp; xv[m][1] = *(const f32x4*)(xp + 4);
            gt[m][0] = *(const f32x4*)gp; gt[m][1] = *(const f32x4*)(gp + 4); gs[m][0] = *(const f32x4*)sp; gs[m][1] = *(const f32x4*)(sp + 4);
        }
#pragma unroll
        for (int m = 0; m < 6; ++m) {
            const int row = pm * 192 + wr * 96 + m * 16 + fr;
            float* xp = x + (size_t)row * D + col;
            const f32x4 x0 = xv[m][0] + gt[m][0] * acc[m][0], x1 = xv[m][1] + gt[m][1] * acc[m][1];
            *(f32x4*)xp = x0; *(f32x4*)(xp + 4) = x1;
            float ss = (x0[0] * x0[0] + x0[1] * x0[1]) + (x0[2] * x0[2] + x0[3] * x0[3]) + (x1[0] * x1[0] + x1[1] * x1[1]) + (x1[2] * x1[2] + x1[3] * x1[3]);
            *(u32x4*)(xg + (size_t)row * D + col) = pk8(x0 * gs[m][0], x1 * gs[m][1]);
            ss += __shfl_xor(ss, 16); ss += __shfl_xor(ss, 32);
            if (fq == 0) atomicAdd(rssn + row, ss);
        }
    }
};

struct AttnState { f32x16 o0, o1; float m, l; };
struct KVFrag { bf16x8 k[4], v[2][2]; };
__device__ __forceinline__ void attn_load(KVFrag& f, const bf16_t* kptr  , const bf16_t* vptr  , int vstride32  ) {
#pragma unroll
    for (int s = 0; s < 4; ++s) f.k[s] = *(const bf16x8*)(kptr + 16 * s);
#pragma unroll
    for (int dt = 0; dt < 2; ++dt)
#pragma unroll
        for (int ks = 0; ks < 2; ++ks) f.v[dt][ks] = *(const bf16x8*)(vptr + (size_t)dt * vstride32 + 16 * ks);
}
__device__ __forceinline__ void attn_tile(AttnState& st, const bf16x8 (&qf)[4], const KVFrag& f, bool local, const LAS float* rl, int cq, int cs, int ck0  ) {
    f32x16 s = {0.f, 0.f, 0.f, 0.f, 0.f, 0.f, 0.f, 0.f, 0.f, 0.f, 0.f, 0.f, 0.f, 0.f, 0.f, 0.f};
#pragma unroll
    for (int k = 0; k < 4; ++k) s = __builtin_amdgcn_mfma_f32_32x32x16_bf16(f.k[k], qf[k], s, 0, 0, 0);
    if (local) {
        const LAS float* rb = rl + (ck0 - cq + 15);
        const int d0 = ck0 - cs;
#pragma unroll
        for (int i = 0; i < 16; ++i) {
            const int o = (i & 3) + 8 * (i >> 2);
            const bool ok = (unsigned)(d0 + o) < 16u;
            s[i] = ok ? s[i] + rb[o] : -1e30f;
        }
    }
    float mx = fmaxf(fmaxf(s[0], s[1]), fmaxf(s[2], s[3]));
#pragma unroll
    for (int i = 4; i < 16; i += 4) mx = fmaxf(mx, fmaxf(fmaxf(s[i], s[i + 1]), fmaxf(s[i + 2], s[i + 3])));
    mx = fmaxf(mx, __shfl_xor(mx, 32));
    const float mo = st.m, mn = fmaxf(mo, mx);
    st.m = mn;
    float ls = 0.f;
#pragma unroll
    for (int i = 0; i < 16; ++i) { const float p = __builtin_amdgcn_exp2f(s[i] - mn); s[i] = p; ls += p; }
    if (__builtin_amdgcn_ballot_w64(mn > mo) != 0ull) {
        const float alpha = __builtin_amdgcn_exp2f(mo - mn);
        st.l *= alpha;
#pragma unroll
        for (int i = 0; i < 16; ++i) { st.o0[i] *= alpha; st.o1[i] *= alpha; }
    }
    st.l += ls;
    u32x4 w0, w1;
    w0.x = pk2(s[0], s[1]); w0.y = pk2(s[2], s[3]); w0.z = pk2(s[4], s[5]); w0.w = pk2(s[6], s[7]);
    w1.x = pk2(s[8], s[9]); w1.y = pk2(s[10], s[11]); w1.z = pk2(s[12], s[13]); w1.w = pk2(s[14], s[15]);
    const bf16x8 p0 = __builtin_bit_cast(bf16x8, w0), p1 = __builtin_bit_cast(bf16x8, w1);
    st.o0 = __builtin_amdgcn_mfma_f32_32x32x16_bf16(f.v[0][0], p0, st.o0, 0, 0, 0);
    st.o0 = __builtin_amdgcn_mfma_f32_32x32x16_bf16(f.v[0][1], p1, st.o0, 0, 0, 0);
    st.o1 = __builtin_amdgcn_mfma_f32_32x32x16_bf16(f.v[1][0], p0, st.o1, 0, 0, 0);
    st.o1 = __builtin_amdgcn_mfma_f32_32x32x16_bf16(f.v[1][1], p1, st.o1, 0, 0, 0);
}
__device__ __forceinline__ void attn_store(const AttnState& st, bf16_t* orow  , int hf) {
    const float lt = st.l + __shfl_xor(st.l, 32);
    const float inv = 1.0f / lt;
#pragma unroll
    for (int g = 0; g < 4; ++g) {
        u32x2 a, b;
        a.x = pk2(st.o0[4 * g] * inv, st.o0[4 * g + 1] * inv); a.y = pk2(st.o0[4 * g + 2] * inv, st.o0[4 * g + 3] * inv);
        b.x = pk2(st.o1[4 * g] * inv, st.o1[4 * g + 1] * inv); b.y = pk2(st.o1[4 * g + 2] * inv, st.o1[4 * g + 3] * inv);
        *(u32x2*)(orow + 8 * g + 4 * hf) = a;
        *(u32x2*)(orow + 32 + 8 * g + 4 * hf) = b;
    }
}
struct AttnPtrs { const bf16_t *Q, *K, *Vt, *Kc, *Vtc; bf16_t* Abr; };
constexpr int PA_K_BYTES = 256 * 128, PA_V_BYTES = 64 * 512;
struct StageRegs { u32x4 kv[4], vv[4]; };
__device__ __forceinline__ void attn_stage_load(StageRegs& R, const bf16_t* ksrc, const bf16_t* vsrc, int vld, int nkeys, int tid) {
    const int nch = nkeys * 8, sh = nkeys == 256 ? 5 : 3;
#pragma unroll
    for (int i = 0; i < 4; ++i) { int q = tid + 512 * i; q = q < nch ? q : nch - 1;
        R.kv[i] = *(const u32x4*)(ksrc + (size_t)(q >> 3) * NAW + 8 * (q & 7));
        R.vv[i] = *(const u32x4*)(vsrc + (size_t)(q >> sh) * vld + 8 * (q & ((1 << sh) - 1))); }
}
__device__ __forceinline__ void attn_stage_store(const StageRegs& R, int nkeys, LAS unsigned char* kl, LAS unsigned char* vl, int tid) {
    const int nch = nkeys * 8, sh = nkeys == 256 ? 5 : 3;
#pragma unroll
    for (int i = 0; i < 4; ++i) { const int q = tid + 512 * i; if (q < nch) {
        const int key = q >> 3, c = q & 7, d = q >> sh, cv = q & ((1 << sh) - 1);
        *(LAS u32x4*)(kl + key * 128 + ((c ^ (key & 7)) << 4)) = R.kv[i];
        *(LAS u32x4*)(vl + d * 512 + ((cv ^ (d & 15)) << 4)) = R.vv[i]; } }
}
__device__ __forceinline__ void attn_lds_frag(KVFrag& f, const LAS unsigned char* kl, const LAS unsigned char* vl, int kt, int r32, int hf) {
    const int key = 32 * kt + r32;
#pragma unroll
    for (int s = 0; s < 4; ++s) f.k[s] = *(const LAS bf16x8*)(kl + key * 128 + (((2 * s + hf) ^ (key & 7)) << 4));
#pragma unroll
    for (int dt = 0; dt < 2; ++dt)
#pragma unroll
        for (int ks = 0; ks < 2; ++ks) { const int d = 32 * dt + r32; f.v[dt][ks] = *(const LAS bf16x8*)(vl + d * 512 + (((4 * kt + 2 * ks + hf) ^ (d & 15)) << 4)); }
}
__device__ __forceinline__ void attn_prompt_lds(const AttnPtrs& P, const LAS unsigned char* kl, const LAS unsigned char* vl, int bh, int qt, int lane) {
    const int r32 = lane & 31, hf = lane >> 5, b = bh >> 3, h = bh & 7;
    const int qrow = b * 256 + qt * 32 + r32;
    bf16x8 qf[4];
#pragma unroll
    for (int s = 0; s < 4; ++s) qf[s] = *(const bf16x8*)(P.Q + (size_t)qrow * NAW + h * 64 + 16 * s + 8 * hf);
    AttnState st; st.m = -1e30f; st.l = 0.f;
#pragma unroll
    for (int i = 0; i < 16; ++i) { st.o0[i] = 0.f; st.o1[i] = 0.f; }
    KVFrag fa, fb;
    attn_lds_frag(fa, kl, vl, 0, r32, hf);
#pragma unroll 1
    for (int t = 0; t < 8; t += 2) {
        attn_lds_frag(fb, kl, vl, t + 1, r32, hf);
        attn_tile(st, qf, fa, false, nullptr, 0, 0, 0);
        if (t + 2 < 8) attn_lds_frag(fa, kl, vl, t + 2, r32, hf);
        attn_tile(st, qf, fb, false, nullptr, 0, 0, 0);
    }
    attn_store(st, P.Abr + (size_t)qrow * D + h * 64, hf);
}
constexpr int ATT_PART_FLOATS = 34 * 64;
__device__ __forceinline__ void attn_sample_block(const AttnPtrs& P, LAS unsigned char* kl, LAS unsigned char* vl, const LAS float* rpl, LAS float* parts, int blk, int wave, int lane) {
    const int r32 = lane & 31, hf = lane >> 5, tid = wave * 64 + lane;
    const int bs = blk >> 6, h = (blk >> 3) & 7, i2 = (blk & 7) * 2;
    const int u = wave >> 1, half = wave & 1, r = i2 + (u >> 1), qh = u & 1;
    const int qrow = MP + bs * 1024 + r * 64 + qh * 32 + r32;
    const int cq = qh * 32 + r32; int cs = cq - 8; cs = cs < 0 ? 0 : (cs > 48 ? 48 : cs);
    int rs = r - 4; rs = rs < 0 ? 0 : (rs > 8 ? 8 : rs);
    int rs0 = i2 - 4; rs0 = rs0 < 0 ? 0 : (rs0 > 8 ? 8 : rs0);
    int rs1 = i2 - 3; rs1 = rs1 < 0 ? 0 : (rs1 > 8 ? 8 : rs1);
    const int nstage = rs1 != rs0 ? 4 : 3;
    const bf16_t* kloc = P.K + (size_t)(MP + bs * 1024) * NAW + h * 64;
    const bf16_t* vloc = P.Vt + VT_SAMPLE_OFF + (size_t)((bs * 8 + h) * 64) * 1024;
    bf16x8 qf[4];
#pragma unroll
    for (int s = 0; s < 4; ++s) qf[s] = *(const bf16x8*)(P.Q + (size_t)qrow * NAW + h * 64 + 16 * s + 8 * hf);
    AttnState st; st.m = -1e30f; st.l = 0.f;
#pragma unroll
    for (int i = 0; i < 16; ++i) { st.o0[i] = 0.f; st.o1[i] = 0.f; }
    LAS float* part = parts + u * ATT_PART_FLOATS;
    StageRegs R;
    attn_stage_load(R, P.Kc + (size_t)(bs * 256) * NAW + h * 64, P.Vtc + (size_t)((bs * 8 + h) * 64) * 256, 256, 256, tid);
#pragma unroll 1
    for (int sg = 0; sg < nstage; ++sg) {
        if (sg) __syncthreads();
        const int row0 = rs0 + 4 * (sg - 1);
        attn_stage_store(R, sg == 3 ? 64 : 256, kl, vl, tid);
        { const int sn = sg + 1 < nstage ? sg + 1 : 1, rown = rs0 + 4 * (sn - 1);
          attn_stage_load(R, kloc + (size_t)(rown * 64) * NAW, vloc + rown * 64, 1024, sn == 3 ? 64 : 256, tid); }
        LDS_WAIT(); __syncthreads();
        KVFrag f;
        if (sg == 0) {
#pragma unroll 1
            for (int kt = 4 * half; kt < 4 * half + 4; ++kt) { attn_lds_frag(f, kl, vl, kt, r32, hf); attn_tile(st, qf, f, false, nullptr, 0, 0, 0); }
        } else {
            const int nt = sg == 3 ? 2 : 8;
#pragma unroll 1
            for (int kt = half * (nt >> 1); kt < (half + 1) * (nt >> 1); ++kt) {
                const int jr = row0 + (kt >> 1), ch = kt & 1;
                if (jr < rs || jr >= rs + 8) continue;
                attn_lds_frag(f, kl, vl, kt, r32, hf);
                attn_tile(st, qf, f, true, rpl + (h * 15 + (jr - r + 7)) * 31, cq, cs, ch * 32 + 4 * hf);
            }
        }
    }
    if (half == 1) {
#pragma unroll
        for (int i = 0; i < 16; ++i) { part[i * 64 + lane] = st.o0[i]; part[(16 + i) * 64 + lane] = st.o1[i]; }
        part[32 * 64 + lane] = st.m; part[33 * 64 + lane] = st.l;
    }
    LDS_WAIT(); __syncthreads();
    if (half == 0) {
        const float m1 = part[32 * 64 + lane], l1 = part[33 * 64 + lane];
        const float mn = fmaxf(st.m, m1), a0 = __builtin_amdgcn_exp2f(st.m - mn), a1 = __builtin_amdgcn_exp2f(m1 - mn);
        st.l = st.l * a0 + l1 * a1;
#pragma unroll
        for (int i = 0; i < 16; ++i) { st.o0[i] = st.o0[i] * a0 + part[i * 64 + lane] * a1; st.o1[i] = st.o1[i] * a0 + part[(16 + i) * 64 + lane] * a1; }
        attn_store(st, P.Abr + (size_t)qrow * D + h * 64, hf);
    }
}

struct PcPtrs { const bf16_t *Pin, *Cin; const float *wdw, *bdw, *cng, *cnb; bf16_t* Abr; };
__device__ __forceinline__ f32x4 ld_bf4(const bf16_t* p) { const u32x2 w = *(const u32x2*)p; return (f32x4){bf_lo(w.x), bf_hi(w.x), bf_lo(w.y), bf_hi(w.y)}; }
__device__ __forceinline__ f32x4 up_bf4(u32x2 w) { return (f32x4){bf_lo(w.x), bf_hi(w.x), bf_lo(w.y), bf_hi(w.y)}; }
__device__ __forceinline__ void pool_unit(const PcPtrs& P, int unit, int lane) {
    const int row0 = unit * 8;
    const int L = row0 < MP ? 256 : 1024;
    const int sb = row0 < MP ? (row0 & ~255) : MP + ((row0 - MP) & ~1023);
    const int hw = 1 << (lane >> 4);
    const int t0 = row0 - sb;
    u32x2 pv[24];
#pragma unroll
    for (int i = 0; i < 24; ++i) { int t = t0 - 8 + i; t = t < 0 ? 0 : (t > L - 1 ? L - 1 : t); pv[i] = *(const u32x2*)(P.Pin + (size_t)(sb + t) * PW + 4 * lane); }
#pragma unroll
    for (int tt = 0; tt < 8; ++tt) {
        f32x4 sum = {0.f, 0.f, 0.f, 0.f}; float cnt = 0.f;
#pragma unroll
        for (int o = -8; o < 8; ++o) {
            const int t = t0 + tt + o;
            const bool in = (o >= -hw) && (o < hw) && (t >= 0) && (t < L);
            const f32x4 v = up_bf4(pv[tt + o + 8]);
            sum += in ? v : (f32x4){0.f, 0.f, 0.f, 0.f}; cnt += in ? 1.f : 0.f;
        }
        const f32x4 r = sum * __builtin_amdgcn_rcpf(cnt) - up_bf4(pv[tt + 8]);
        u32x2 w; w.x = pk2(r[0], r[1]); w.y = pk2(r[2], r[3]);
        *(u32x2*)(P.Abr + (size_t)(row0 + tt) * D + 512 + 4 * lane) = w;
    }
}
__device__ __forceinline__ void conv_unit(const PcPtrs& P, const LAS float* wl, int unit, int lane) {
    constexpr int T = 8;
    const int row0 = unit * T;
    const int L = row0 < MP ? 256 : 1024;
    const int sb = row0 < MP ? (row0 & ~255) : MP + ((row0 - MP) & ~1023);
    const int t0 = row0 - sb;
    f32x4 acc[T];
    const f32x4 bias = *(const f32x4*)(P.bdw + 4 * lane);
#pragma unroll
    for (int tt = 0; tt < T; ++tt) acc[tt] = bias;
#pragma unroll 1
    for (int c = 0; c < 2; ++c) {
        u32x2 ar[20], gr[20];
#pragma unroll
        for (int i = 0; i < 20; ++i) {
            const int t = t0 - 15 + 20 * c + i;
            const bool ok = (t >= 0) && (t < L);
            const bf16_t* p = P.Cin + (size_t)(sb + (ok ? t : 0)) * 512 + 4 * lane;
            ar[i] = *(const u32x2*)p; gr[i] = *(const u32x2*)(p + 256);
            if (!ok) { ar[i] = (u32x2){0u, 0u}; }
        }
#pragma unroll
        for (int g4 = 0; g4 < 5; ++g4) {
            const int s0 = 20 * c + 4 * g4;
            f32x4 tp[11];
#pragma unroll
            for (int q = 0; q < 11; ++q) tp[q] = *(const LAS f32x4*)(wl + (s0 + q) * CW + 4 * lane);
#pragma unroll
            for (int i = 0; i < 4; ++i) {
                const f32x4 a = up_bf4(ar[4 * g4 + i]), g = up_bf4(gr[4 * g4 + i]);
                f32x4 hh;
#pragma unroll
                for (int e = 0; e < 4; ++e) hh[e] = a[e] * sigmoidf_(g[e]);
#pragma unroll
                for (int tt = 0; tt < T; ++tt) acc[tt] += hh * tp[i - tt + 7];
            }
            asm volatile("" ::: "memory");
        }
    }
    const f32x4 lg = *(const f32x4*)(P.cng + 4 * lane), lb = *(const f32x4*)(P.cnb + 4 * lane);
    float s1[T], s2[T];
#pragma unroll
    for (int tt = 0; tt < T; ++tt) s1[tt] = (acc[tt][0] + acc[tt][1]) + (acc[tt][2] + acc[tt][3]);
#pragma unroll
    for (int o = 1; o < 64; o <<= 1)
#pragma unroll
        for (int tt = 0; tt < T; ++tt) s1[tt] += __shfl_xor(s1[tt], o);
#pragma unroll
    for (int tt = 0; tt < T; ++tt) { const float mu = s1[tt] * (1.0f / CW); acc[tt] = acc[tt] - mu; s2[tt] = (acc[tt][0] * acc[tt][0] + acc[tt][1] * acc[tt][1]) + (acc[tt][2] * acc[tt][2] + acc[tt][3] * acc[tt][3]); }
#pragma unroll
    for (int o = 1; o < 64; o <<= 1)
#pragma unroll
        for (int tt = 0; tt < T; ++tt) s2[tt] += __shfl_xor(s2[tt], o);
#pragma unroll
    for (int tt = 0; tt < T; ++tt) {
        const float rstd = 1.0f / sqrtf(s2[tt] * (1.0f / CW) + EPS);
        f32x4 y = acc[tt] * rstd * lg + lb;
#pragma unroll
        for (int e = 0; e < 4; ++e) y[e] = y[e] * sigmoidf_(y[e]);
        u32x2 o; o.x = pk2(y[0], y[1]); o.y = pk2(y[2], y[3]);
        *(u32x2*)(P.Abr + (size_t)(row0 + tt) * D + 768 + 4 * lane) = o;
    }
}

#define XB_TMO      128
#define XB_XCNT(j)  (256  + 64 * (j))
#define XB_XSUB(j)  (1280 + 64 * (j))
#define XB_XGEN(j)  (2304 + 64 * (j))
#define XB_TOP      3328
#define XB_TOPGEN   3392
#define XCD_BAR_WORDS 3456
#define XB_SPIN_CAP (1u << 18)
__device__ __forceinline__ unsigned xb_ld(unsigned* p)              { return __hip_atomic_load(p, __ATOMIC_RELAXED, __HIP_MEMORY_SCOPE_AGENT); }
__device__ __forceinline__ unsigned xb_add(unsigned* p, unsigned v) { return __hip_atomic_fetch_add(p, v, __ATOMIC_RELAXED, __HIP_MEMORY_SCOPE_AGENT); }
__device__ __forceinline__ unsigned xb_xcc_id() { return (unsigned)__builtin_amdgcn_s_getreg((3 << 11) | 20) & 0xFu; }
#define XB_SPIN(cond, bar) do { unsigned _sp = 0; while (cond) { __builtin_amdgcn_s_sleep(1); \
    if ((++_sp & 255u) == 0u) { if (xb_ld(&(bar)[XB_TMO])) break; if (_sp > XB_SPIN_CAP) { atomicAdd(&(bar)[XB_TMO], 1u); break; } } } } while (0)
struct XcdBarrier { unsigned* bar; unsigned x; unsigned nloc, nx; };
__device__ __forceinline__ XcdBarrier xcd_barrier_post(unsigned* bar) {
    XcdBarrier b; b.bar = bar; b.x = xb_xcc_id(); b.nloc = 0u; b.nx = 0u;
    if (threadIdx.x == 0) (void)xb_add(&bar[XB_XCNT(b.x)], 1u);
    return b;
}
__device__ __forceinline__ void xcd_barrier_complete(unsigned* bar, unsigned x, unsigned& nloc, unsigned& nx) {
    const unsigned G = gridDim.x * gridDim.y * gridDim.z;
    unsigned sum, cnt, mine, sp = 0u;
    for (;;) {
        sum = 0u; cnt = 0u; mine = 0u;
#pragma unroll
        for (unsigned j = 0; j < 16; ++j) { const unsigned c = xb_ld(&bar[XB_XCNT(j)]); sum += c; cnt += (c > 0u) ? 1u : 0u; mine = (j == x) ? c : mine; }
        if (sum == G) break;
        __builtin_amdgcn_s_sleep(1);
        if ((++sp & 255u) == 0u) { if (xb_ld(&bar[XB_TMO])) break; if (sp > XB_SPIN_CAP) { atomicAdd(&bar[XB_TMO], 1u); break; } }
    }
    nloc = mine > 0u ? mine : 1u; nx = cnt > 0u ? cnt : 1u;
}
__device__ __forceinline__ void xcd_barrier(XcdBarrier& b) {
    asm volatile("s_waitcnt vmcnt(0)" ::: "memory");
    __syncthreads();
    if (threadIdx.x == 0) {
        unsigned* bar = b.bar;
        __builtin_amdgcn_s_waitcnt(0);
        unsigned nloc = b.nloc, nx = b.nx;
        if (nloc == 0u) { xcd_barrier_complete(bar, b.x, nloc, nx); b.nloc = nloc; b.nx = nx; }
        const unsigned old = xb_add(&bar[XB_XSUB(b.x)], 1u);
        const unsigned gen = old / nloc;
        if (old + 1u == (gen + 1u) * nloc) {
            __builtin_amdgcn_fence(__ATOMIC_RELEASE, "agent");
            asm volatile("s_waitcnt vmcnt(0)" ::: "memory");
            const unsigned og = xb_add(&bar[XB_TOP], 1u);
            const unsigned tg = og / nx;
            if (og + 1u == (tg + 1u) * nx) xb_add(&bar[XB_TOPGEN], 1u);
            else XB_SPIN(xb_ld(&bar[XB_TOPGEN]) == tg, bar);
            __builtin_amdgcn_fence(__ATOMIC_ACQUIRE, "agent");
            xb_add(&bar[XB_XGEN(b.x)], 1u);
            asm volatile("s_waitcnt vmcnt(0)" ::: "memory");
        } else {
            XB_SPIN(xb_ld(&bar[XB_XGEN(b.x)]) == gen, bar);
            __builtin_amdgcn_fence(__ATOMIC_ACQUIRE, "agent");
            asm volatile("s_waitcnt vmcnt(0)" ::: "memory");
        }
    }
    __syncthreads();
}

constexpr int TP_PITCH = 65, TP_BYTES = 64 * TP_PITCH * 4;
template <bool WITH_C, bool GU_PERM>
__device__ __forceinline__ void transpose_item(const float* W, int N, bf16_t* WT, int ldt, int kcol0, LAS float* scr, int item, int lane,
                                               const float* shraw  , const float* shb  , float* csum  ) {
    const int nblk = N / 64, kb = item / nblk, nb = item % nblk, k0 = 64 * kb, n0 = 64 * nb;
    {
        const int r4 = lane >> 4, c4 = lane & 15;
        f32x4 v[16];
#pragma unroll
        for (int i = 0; i < 16; ++i) v[i] = __builtin_nontemporal_load((const f32x4*)(W + (size_t)(k0 + 4 * i + r4) * N + n0 + 4 * c4));
#pragma unroll
        for (int i = 0; i < 16; ++i) { LAS float* p = scr + (4 * i + r4) * TP_PITCH + 4 * c4; p[0] = v[i][0]; p[1] = v[i][1]; p[2] = v[i][2]; p[3] = v[i][3]; }
    }
    const int c = lane & 7, nn = lane >> 3;
    f32x4 sh[3][2];
    if (WITH_C) {
#pragma unroll
        for (int r = 0; r < 3; ++r)
#pragma unroll
            for (int h = 0; h < 2; ++h) sh[r][h] = *(const f32x4*)(shraw + (size_t)r * NMOD + k0 + 8 * c + 4 * h) + *(const f32x4*)(shb + k0 + 8 * c + 4 * h);
    }
    LDS_WAIT(); asm volatile("" ::: "memory");
#pragma unroll
    for (int j = 0; j < 8; ++j) {
        const int n = 8 * j + nn; const LAS float* s = scr + (8 * c) * TP_PITCH + n;
        float w[8];
#pragma unroll
        for (int q = 0; q < 8; ++q) w[q] = s[q * TP_PITCH];
        u32x4 o; o.x = pk2(w[0], w[1]); o.y = pk2(w[2], w[3]); o.z = pk2(w[4], w[5]); o.w = pk2(w[6], w[7]);
        int nrow = n0 + n;
        if (GU_PERM) nrow = nrow < FFN ? ((nrow >> 7) * 256 + (nrow & 127)) : (((nrow - FFN) >> 7) * 256 + 128 + ((nrow - FFN) & 127));
        *(u32x4*)(WT + (size_t)nrow * ldt + kcol0 + k0 + 8 * c) = o;
        if (WITH_C) {
            float d0 = 0.f, d1 = 0.f, d2 = 0.f;
#pragma unroll
            for (int q = 0; q < 8; ++q) { d0 += sh[0][q >> 2][q & 3] * w[q]; d1 += sh[1][q >> 2][q & 3] * w[q]; d2 += sh[2][q >> 2][q & 3] * w[q]; }
#pragma unroll
            for (int x = 1; x < 8; x <<= 1) { d0 += __shfl_xor(d0, x); d1 += __shfl_xor(d1, x); d2 += __shfl_xor(d2, x); }
            if (c == 0) { atomicAdd(csum + n0 + n, d0); atomicAdd(csum + N + n0 + n, d1); atomicAdd(csum + 2 * N + n0 + n, d2); }
        }
    }
    LDS_WAIT(); asm volatile("" ::: "memory");
}

constexpr int NWAVES = 8;
constexpr int I_IN = 16 * (NIN / 64), I_GU = 16 * (NGU / 64), I_DN = (FFN / 64) * 16, I_OUT = 16 * 16, I_OA = 8 * 16, I_OC = 4 * 16;
constexpr int I_LAYER = I_IN + I_GU + I_DN + I_OUT + I_OA + I_OC;
#ifndef MK_TAIL
#define MK_TAIL I_LAYER
#endif
constexpr int I_TAIL = MK_TAIL, I_HEAD = I_LAYER - I_TAIL;
constexpr int I_MIX = (I_TAIL >= 512) ? 512 : 0;
#ifndef MK_BG1
#define MK_BG1 1536
#endif
constexpr int I_BG1 = MK_BG1;
static_assert(I_HEAD + I_BG1 <= I_LAYER - I_MIX, "background split");
#define TRANSPOSE_LAYER_ITEM(l_, r0_, scr_, lane_) do { const int tl_ = (l_); int tr_ = (r0_); \
        const float* shraw1_ = MODRAW + (size_t)(tl_ * 3) * NMOD; const float* shraw2_ = MODRAW + (size_t)(tl_ * 3) * NMOD + 3 * D; \
        if (tr_ < I_IN) { transpose_item<true, false>(w_in + (size_t)tl_ * D * NIN, NIN, WIN + (size_t)tl_ * NIN * D, D, 0, scr_, tr_, lane_, shraw1_, b_mod + (size_t)tl_ * NMOD, C1 + (size_t)(tl_ * 3) * NIN); break; } tr_ -= I_IN; \
        if (tr_ < I_GU) { transpose_item<true, true>(w_gu + (size_t)tl_ * D * NGU, NGU, WGU + (size_t)tl_ * NGU * D, D, 0, scr_, tr_, lane_, shraw2_, b_mod + (size_t)tl_ * NMOD + 3 * D, C2 + (size_t)(tl_ * 3) * NGU); break; } tr_ -= I_GU; \
        if (tr_ < I_DN) { transpose_item<false, false>(w_down + (size_t)tl_ * FFN * D, D, WDN + (size_t)tl_ * D * FFN, FFN, 0, scr_, tr_, lane_, nullptr, nullptr, nullptr); break; } tr_ -= I_DN; \
        if (tr_ < I_OUT) { transpose_item<false, false>(w_out + (size_t)tl_ * D * D, D, WOUT + (size_t)tl_ * D * D, D, 0, scr_, tr_, lane_, nullptr, nullptr, nullptr); break; } tr_ -= I_OUT; \
        if (tr_ < I_OA) { transpose_item<false, false>(w_oa + (size_t)tl_ * NAW * D, D, WBR + (size_t)tl_ * D * D, D, 0, scr_, tr_, lane_, nullptr, nullptr, nullptr); break; } tr_ -= I_OA; \
        transpose_item<false, false>(w_oc + (size_t)tl_ * CW * D, D, WBR + (size_t)tl_ * D * D, D, 768, scr_, tr_, lane_, nullptr, nullptr, nullptr); } while (0)
constexpr int LDS_BYTES = 163840;
static_assert(8 * TP_BYTES <= LDS_BYTES, "LDS map");
constexpr int NPHASE = 2 + 6 * DEPTH + 1;

struct Args {
    const float* in[26]; float* out; unsigned char* ws; int ph_lo, ph_hi;
};

__global__ void __launch_bounds__(NWAVES * 64, 2) fwd_kernel(Args args) {
    extern __shared__ __attribute__((aligned(16))) unsigned char lds_raw[];
    LAS unsigned char* lds = (LAS unsigned char*)lds_raw;
    const int tid = threadIdx.x, lane = tid & 63, wave = __builtin_amdgcn_readfirstlane(tid >> 6);
    const int G = gridDim.x, bx = blockIdx.x;
    const int vcu = (G % 8 == 0) ? (bx % 8) * (G / 8) + bx / 8 : bx;
    const int gw = vcu * NWAVES + wave, NGW = G * NWAVES;
    unsigned char* ws = args.ws;
    float* ctlf = (float*)(ws + WS_CTL);
    const float* x_prompt = args.in[0]; const float* x_sample = args.in[1]; const float* cache_k = args.in[2]; const float* cache_v = args.in[3];
    const float* cvec = args.in[4]; const float* c_ctx = args.in[5]; const float* w_mod = args.in[6]; const float* b_mod = args.in[7];
    const float* norm1_g = args.in[8]; const float* norm2_g = args.in[9]; const float* w_in = args.in[10]; const float* b_gate = args.in[11];
    const float* rpb = args.in[12]; const float* w_oa = args.in[13]; const float* w_pool = args.in[14]; const float* pool_scale = args.in[15];
    const float* w_ob = args.in[16]; const float* w_dw = args.in[17]; const float* b_dw = args.in[18]; const float* conv_norm_g = args.in[19];
    const float* conv_norm_b = args.in[20]; const float* w_oc = args.in[21]; const float* w_out = args.in[22]; const float* w_gu = args.in[23];
    const float* w_down = args.in[24]; const float* final_g = args.in[25];
    float* MODRAW = ctlf + CF_MODRAW; float* C1 = ctlf + CF_C1; float* C2 = ctlf + CF_C2; float* RSS = ctlf + CF_RSS;
    float* MODT = (float*)(ws + WS_MODT);
    bf16_t* WIN = (bf16_t*)(ws + WS_WIN); bf16_t* WGU = (bf16_t*)(ws + WS_WGU); bf16_t* WDN = (bf16_t*)(ws + WS_WDN); bf16_t* WBR = (bf16_t*)(ws + WS_WBR); bf16_t* WOUT = (bf16_t*)(ws + WS_WOUT);
    float* X = (float*)(ws + WS_X); bf16_t* XG = (bf16_t*)(ws + WS_XG);
    bf16_t* Qb = (bf16_t*)(ws + WS_Q); bf16_t* Kb = (bf16_t*)(ws + WS_K); bf16_t* VT = (bf16_t*)(ws + WS_VT); bf16_t* KC = (bf16_t*)(ws + WS_KC); bf16_t* VTC = (bf16_t*)(ws + WS_VTC);
    bf16_t* PIN = (bf16_t*)(ws + WS_PIN); bf16_t* CIN = (bf16_t*)(ws + WS_CIN); bf16_t* GT = (bf16_t*)(ws + WS_G); bf16_t* ABR = (bf16_t*)(ws + WS_ABR);
    float* MF = (float*)(ws + WS_MF); bf16_t* MB = (bf16_t*)(ws + WS_MB); bf16_t* ACT = (bf16_t*)(ws + WS_ACT);

#if !MK_PER_PHASE
    XcdBarrier bar = xcd_barrier_post((unsigned*)(ws + WS_CTL) + CW_BAR);
#define GRID_BAR() xcd_barrier(bar)
#else
#define GRID_BAR() do {} while (0)
#endif
    const int lo = args.ph_lo, hi = args.ph_hi;
#define IN(k) (lo <= (k) && (k) < hi)
#define SEAM(k) do { if (IN(k) && IN((k) + 1)) GRID_BAR(); } while (0)

    for (int rep_ = 0; rep_ < MK_REPS(4); ++rep_) { if (rep_) GRID_BAR();
    float* MODRAW_W = rep_ ? MF : MODRAW; float* C1_W = rep_ ? MF + DEPTH * 3 * NMOD : C1; float* C2_W = rep_ ? MF + DEPTH * 3 * (NMOD + NIN) : C2;
    if (IN(0)) {
        LAS float* sil = (LAS float*)lds; LAS float* red = (LAS float*)(lds + 16384);
        for (int i = tid; i < 3 * D; i += NWAVES * 64) { const float s = i < D ? c_ctx[i] : cvec[i - D]; sil[i] = s * sigmoidf_(s); }
        __syncthreads();
        for (int it = vcu; it < DEPTH * 24 * 8; it += G) {
            const int l = it / 192, rem = it % 192, nc = rem >> 3, kq = rem & 7, k0 = kq * 128 + wave * 16, n0 = nc * 256 + 4 * lane;
            const float* wp = w_mod + ((size_t)l * D + k0) * NMOD + n0;
            f32x4 w[16];
#pragma unroll
            for (int kk = 0; kk < 16; ++kk) w[kk] = __builtin_nontemporal_load((const f32x4*)(wp + (size_t)kk * NMOD));
            f32x4 a0 = {0.f, 0.f, 0.f, 0.f}, a1 = a0, a2 = a0;
#pragma unroll
            for (int kk = 0; kk < 16; ++kk) { a0 += sil[k0 + kk] * w[kk]; a1 += sil[D + k0 + kk] * w[kk]; a2 += sil[2 * D + k0 + kk] * w[kk]; }
#pragma unroll
            for (int e = 0; e < 4; ++e) { red[(wave * 12 + e) * 64 + lane] = a0[e]; red[(wave * 12 + 4 + e) * 64 + lane] = a1[e]; red[(wave * 12 + 8 + e) * 64 + lane] = a2[e]; }
            __syncthreads();
            for (int o = tid; o < 12 * 64; o += NWAVES * 64) {
                float s = 0.f;
#pragma unroll
                for (int ww = 0; ww < 8; ++ww) s += red[ww * 768 + o];
                const int q = o >> 6, ln = o & 63, r = q >> 2, e = q & 3;
                atomicAdd(MODRAW_W + (size_t)(l * 3 + r) * NMOD + nc * 256 + 4 * ln + e, s);
            }
            __syncthreads();
        }
    }
    SEAM(0);

    if (IN(1)) {
        LAS float* scr = (LAS float*)(lds + wave * TP_BYTES);
        constexpr int I_T = I_LAYER + (DEPTH - 1) * I_HEAD;
        constexpr int I_OB = DEPTH * 16 * 4 * 8;
        constexpr int I_X = M;
        constexpr int I_KC = DEPTH * 2 * 256;
        constexpr int I_VC = DEPTH * 2 * 8 * 4;
        constexpr int I_MT = DEPTH * 3 * 6 * 4;
        constexpr int I_ALL = I_T + I_OB + I_X + I_KC + I_VC + I_MT;
        for (int it0 = gw; it0 < I_ALL; it0 += NGW) {
            int it = it0;
            if (it < I_T) {
                if (it < I_LAYER) TRANSPOSE_LAYER_ITEM(0, it, scr, lane);
                else if constexpr (I_HEAD > 0) { const int q = it - I_LAYER; TRANSPOSE_LAYER_ITEM(1 + q / I_HEAD, q % I_HEAD, scr, lane); }
                continue;
            }
            it -= I_T;
            if (it < I_OB) {
                const int l = it / 512, rem = it % 512, nch = rem >> 5, g = (rem >> 3) & 3, cc = rem & 7, n = nch * 64 + lane;
                float a[8];
#pragma unroll
                for (int c = 0; c < 8; ++c) a[c] = 0.f;
                const float* wp = w_pool + ((size_t)(l * 4 + g) * 64 + cc * 8) * 64;
                for (int d = 0; d < 64; ++d) {
                    const float wb = w_ob[((size_t)l * PW + g * 64 + d) * D + n] * pool_scale[l * PW + g * 64 + d];
#pragma unroll
                    for (int c = 0; c < 8; ++c) a[c] += wp[c * 64 + d] * wb;
                }
                u32x4 o; o.x = pk2(a[0], a[1]); o.y = pk2(a[2], a[3]); o.z = pk2(a[4], a[5]); o.w = pk2(a[6], a[7]);
                *(u32x4*)(WBR + ((size_t)l * D + n) * D + 512 + g * 64 + cc * 8) = o;
                continue;
            }
            it -= I_OB;
            if (it < I_X) {
                const int row = it, mr = row < MP ? 0 : 1 + ((row - MP) >> 10);
                const float* xr = row < MP ? x_prompt + (size_t)row * D : x_sample + (size_t)(row - MP) * D;
                float ss = 0.f;
#pragma unroll
                for (int j = 0; j < 4; ++j) {
                    const int col = 256 * j + 4 * lane;
                    const f32x4 v = *(const f32x4*)(xr + col);
                    *(f32x4*)(X + (size_t)row * D + col) = v;
                    ss += (v[0] * v[0] + v[1] * v[1]) + (v[2] * v[2] + v[3] * v[3]);
                    const f32x4 sc = *(const f32x4*)(MODRAW + (size_t)mr * NMOD + D + col) + *(const f32x4*)(b_mod + D + col);
                    const f32x4 gg = *(const f32x4*)(norm1_g + col) * (sc + 1.0f);
                    const f32x4 xs = v * gg;
                    u32x2 o; o.x = pk2(xs[0], xs[1]); o.y = pk2(xs[2], xs[3]);
                    *(u32x2*)(XG + (size_t)row * D + col) = o;
                }
                ss = wave_sum(ss);
                if (lane == 0) RSS[row] = ss;
                continue;
            }
            it -= I_X;
            if (it < I_KC) {
                const int l = it / 512, bs = (it >> 8) & 1, key = it & 255;
                const float* src = cache_k + (((size_t)(bs * DEPTH + l) * 256 + key) * 512) + 8 * lane;
                const f32x4 a = *(const f32x4*)src, b = *(const f32x4*)(src + 4);
                *(u32x4*)(KC + (((size_t)(l * 2 + bs) * 256 + key) * 512) + 8 * lane) = pk8(a, b);
                continue;
            }
            it -= I_KC;
            if (it < I_VC) {
                const int l = it / 64, bs = (it >> 5) & 1, h = (it >> 2) & 7, kb = it & 3, key = kb * 64 + lane;
                const float* src = cache_v + (((size_t)(bs * DEPTH + l) * 256 + key) * 512) + h * 64;
                bf16_t* dst = VTC + ((size_t)((l * 2 + bs) * 8 + h) * 64) * 256 + pos_of_key(key);
#pragma unroll
                for (int d4 = 0; d4 < 16; ++d4) {
                    const f32x4 v = *(const f32x4*)(src + 4 * d4);
                    const unsigned w0 = pk2(v[0], v[1]), w1 = pk2(v[2], v[3]);
                    dst[(size_t)(4 * d4 + 0) * 256] = (bf16_t)(w0 & 0xffff); dst[(size_t)(4 * d4 + 1) * 256] = (bf16_t)(w0 >> 16);
                    dst[(size_t)(4 * d4 + 2) * 256] = (bf16_t)(w1 & 0xffff); dst[(size_t)(4 * d4 + 3) * 256] = (bf16_t)(w1 >> 16);
                }
                continue;
            }
            it -= I_VC;
            {
                const int q = it & 3, which = (it >> 2) % 6, lr = it / 24, l = lr / 3, col = q * 256 + 4 * lane;
                const float* mraw = MODRAW + (size_t)lr * NMOD; const float* bm = b_mod + (size_t)l * NMOD;
                f32x4 v;
                if (which == 0) v = *(const f32x4*)(norm1_g + (size_t)l * D + col) * (*(const f32x4*)(mraw + D + col) + *(const f32x4*)(bm + D + col) + 1.0f);
                else if (which == 1) v = *(const f32x4*)(mraw + col) + *(const f32x4*)(bm + col);
                else if (which == 2) v = *(const f32x4*)(mraw + 2 * D + col) + *(const f32x4*)(bm + 2 * D + col);
                else if (which == 3) v = *(const f32x4*)(norm2_g + (size_t)l * D + col) * (*(const f32x4*)(mraw + 4 * D + col) + *(const f32x4*)(bm + 4 * D + col) + 1.0f);
                else if (which == 4) v = *(const f32x4*)(mraw + 3 * D + col) + *(const f32x4*)(bm + 3 * D + col);
                else v = *(const f32x4*)(mraw + 5 * D + col) + *(const f32x4*)(bm + 5 * D + col);
                *(f32x4*)(MODT + ((size_t)lr * 6 + which) * D + col) = v;
            }
        }
        LDS_WAIT(); __syncthreads();
    }
    }
    SEAM(1);

    for (int l = 0; l < DEPTH; ++l) {
        const int p0 = 2 + 6 * l;
        const float* modt_l = MODT + (size_t)l * 3 * 6 * D;
        for (int rep_ = 0; rep_ < MK_REPS(0); ++rep_) { if (rep_) GRID_BAR();
        if (IN(p0)) {
            pg8::Gemm g{XG, WIN + (size_t)l * NIN * D, D, D};
            pg8::TileOrder S; S.init(M, NIN, D, G, bx);
            EpiIn E{RSS + (size_t)(2 * l) * M, C1 + (size_t)(l * 3) * NIN, b_gate + (size_t)l * 3072, Qb, Kb, VT, PIN, CIN, GT,
                    args.out + OUT_K + (size_t)l * 256 * 512, args.out + OUT_V + (size_t)l * 256 * 512};
            pg8::gemm_phase<EpiIn, pg8::TileOrder>(lds, g, S, E);
        }
        }
        SEAM(p0);
        for (int rep_ = 0; rep_ < MK_REPS(1); ++rep_) { if (rep_) GRID_BAR();
        if (IN(p0 + 1)) {
            AttnPtrs AP{Qb, Kb, VT, KC + (size_t)l * 2 * 256 * 512, VTC + (size_t)l * 2 * 8 * 64 * 256, ABR};
            PcPtrs PP{PIN, CIN, w_dw + (size_t)l * CONVK * CW, b_dw + (size_t)l * CW, conv_norm_g + (size_t)l * CW, conv_norm_b + (size_t)l * CW, ABR};
            int lane_p = lane; asm volatile("" : "+v"(lane_p));
            if (vcu < 128) {
                LAS float* rpl = (LAS float*)(lds + 1024); LAS float* parts = (LAS float*)(lds + 16384);
                LAS unsigned char* kl = lds + 53248; LAS unsigned char* vl = kl + PA_K_BYTES;
                const float* rpb_l = rpb + (size_t)l * 8 * 15 * 31;
                for (int i = wave * 64 + lane_p; i < 8 * 15 * 31; i += NWAVES * 64) rpl[i] = rpb_l[i] * LOG2E;
                if (!(rep_ && MK_VAR == 1)) attn_sample_block(AP, kl, vl, rpl, parts, vcu, wave, lane_p);
                { const int pu = vcu * NWAVES + wave; if (pu < 768 && !(rep_ && (MK_VAR == 4 || MK_VAR == 5))) pool_unit(PP, pu, lane_p); }
            } else {
                LAS float* wl = (LAS float*)lds; LAS unsigned char* kl = lds + 49152; LAS unsigned char* vl = kl + PA_K_BYTES;
                const int bh = vcu - 128;
                for (int i = wave * 64 + lane_p; i < 47 * CW / 4; i += NWAVES * 64) { const int j = i / (CW / 4) - 7;
                    *(LAS f32x4*)(wl + 4 * i) = (j >= 0 && j < CONVK) ? *(const f32x4*)(PP.wdw + 4 * (i - 7 * (CW / 4))) : (f32x4){0.f, 0.f, 0.f, 0.f}; }
                { StageRegs R; attn_stage_load(R, AP.K + (size_t)((bh >> 3) * 256) * NAW + (bh & 7) * 64, AP.Vt + (size_t)(bh * 64) * 256, 256, 256, wave * 64 + lane_p); attn_stage_store(R, 256, kl, vl, wave * 64 + lane_p); }
                LDS_WAIT(); __syncthreads();
                if (!(rep_ && (MK_VAR == 2 || MK_VAR == 5))) attn_prompt_lds(AP, kl, vl, bh, wave, lane_p);
                { const int it = bh * NWAVES + wave;
                    if (it < 768) { if (!(rep_ && (MK_VAR == 3 || MK_VAR == 5))) conv_unit(PP, wl, it, lane_p); } }
                if (I_MIX > 0 && bh >= 96 && l + 1 < DEPTH && !rep_) {
                    __syncthreads();
                    LAS float* scr = (LAS float*)(lds + wave * TP_BYTES);
#pragma unroll 1
                    for (int r = I_LAYER - I_MIX + (bh - 96) * NWAVES + wave; r < I_LAYER; r += 32 * NWAVES) TRANSPOSE_LAYER_ITEM(l + 1, r, scr, lane_p);
                    LDS_WAIT();
                }
            }
            __syncthreads();
        }
        }
        SEAM(p0 + 1);
        const int t192 = (bx & 7) * 32 + (bx >> 3), pm192 = t192 >> 3, pn192 = t192 & 7;
        const bool has192 = (G == 256);
        for (int rep_ = 0; rep_ < MK_REPS(2); ++rep_) { if (rep_) GRID_BAR();
        if (IN(p0 + 2)) {
            EpiBranch192 E{GT, MB};
            if (has192) g192::gemm<EpiBranch192>(lds, ABR, D, WBR + (size_t)l * D * D, D, pm192, pn192, 16, E);
        }
        }
        SEAM(p0 + 2);
        for (int rep_ = 0; rep_ < MK_REPS(5); ++rep_) { if (rep_) GRID_BAR();
        if (IN(p0 + 3)) {
            EpiRes192 E{rep_ ? MF : X, rep_ ? ACT : XG, modt_l + 2 * D, modt_l + 3 * D, rep_ ? (float*)ABR : RSS + (size_t)(2 * l + 1) * M};
            if (has192) g192::gemm<EpiRes192>(lds, MB, D, WOUT + (size_t)l * D * D, D, pm192, pn192, 16, E);
        }
        }
        SEAM(p0 + 3);
        for (int rep_ = 0; rep_ < MK_REPS(3); ++rep_) { if (rep_) GRID_BAR();
        if (IN(p0 + 4)) {
            pg8::Gemm g{XG, WGU + (size_t)l * NGU * D, D, D};
            const bool bg = (I_TAIL > 0 && l + 1 < DEPTH && G == 256);
            const int nw = bg ? 232 : 256;
            pg8::TileOrderGU S; S.init(M, NGU, D, nw, bx);
            EpiGU E{RSS + (size_t)(2 * l + 1) * M, C2 + (size_t)(l * 3) * NGU, ACT};
            pg8::gemm_phase<EpiGU, pg8::TileOrderGU>(lds, g, S, E);
            if (bg && bx >= 128) {
                int lane_b = lane; asm volatile("" : "+v"(lane_b));
                LAS float* scr = (LAS float*)(lds + wave * TP_BYTES);
                const bool conv_only = bx >= nw;
                const int r0 = conv_only ? I_HEAD + (bx - 232) * NWAVES + wave : I_HEAD + I_BG1 + (bx - 128) * NWAVES + wave;
                const int r1 = conv_only ? I_HEAD + I_BG1 : I_LAYER - I_MIX, rs = conv_only ? 24 * NWAVES : 104 * NWAVES;
#pragma unroll 1
                for (int r = r0; r < r1; r += rs) TRANSPOSE_LAYER_ITEM(l + 1, r, scr, lane_b);
                LDS_WAIT(); __syncthreads();
            }
        }
        }
        SEAM(p0 + 4);
        for (int rep_ = 0; rep_ < MK_REPS(6); ++rep_) { if (rep_) GRID_BAR();
        if (IN(p0 + 5)) {
            EpiRes192 E{rep_ ? MF : X, rep_ ? MB : XG, modt_l + 5 * D, MODT + (size_t)((l + 1) % DEPTH) * 3 * 6 * D, rep_ ? (float*)ABR : RSS + (size_t)(2 * l + 2) * M};
            if (has192) g192::gemm<EpiRes192>(lds, ACT, FFN, WDN + (size_t)l * D * FFN, FFN, pm192, pn192, FFN / 64, E);
        }
        }
        SEAM(p0 + 5);
    }
    if (IN(NPHASE - 1)) {
        for (int row = gw; row < M; row += NGW) {
            const float rinv = 1.0f / sqrtf(RSS[(size_t)8 * M + row] * (1.0f / D) + EPS);
#pragma unroll
            for (int j = 0; j < 4; ++j) {
                const int col = 256 * j + 4 * lane;
                const f32x4 v = *(const f32x4*)(X + (size_t)row * D + col) * rinv * *(const f32x4*)(final_g + col);
                __builtin_nontemporal_store(v, (f32x4*)(args.out + OUT_Y + (size_t)row * D + col));
            }
        }
    }
#undef IN
#undef SEAM
}

extern "C" void kernel_launch(void* const* d_in, const int* in_sizes, int n_in, void* d_out, int out_size, void* d_ws, size_t ws_size, hipStream_t stream) {
    static int grid = 0;
    if (grid == 0) {
        if (n_in != 26 || ws_size < WS_END) { fprintf(stderr, "kernel_launch: expected 26 inputs and >= %zu bytes of workspace; got %d, %zu\n", (size_t)WS_END, n_in, ws_size); grid = -1; return; }
        int dev = 0, cus = 0;
        if (hipGetDevice(&dev) != hipSuccess || hipDeviceGetAttribute(&cus, hipDeviceAttributeMultiprocessorCount, dev) != hipSuccess) { grid = -1; return; }
        if (hipFuncSetAttribute((const void*)fwd_kernel, hipFuncAttributeMaxDynamicSharedMemorySize, LDS_BYTES) != hipSuccess) { fprintf(stderr, "kernel_launch: hipFuncSetAttribute failed\n"); grid = -1; return; }
        (void)hipGetLastError();
        grid = cus;
    }
    if (grid < 0) return;
    (void)hipMemsetAsync((char*)d_ws + WS_CTL, 0, CTL_ZERO_BYTES, stream);
    Args a{};
    for (int i = 0; i < 26; ++i) a.in[i] = (const float*)d_in[i];
    a.out = (float*)d_out; a.ws = (unsigned char*)d_ws;
#if MK_PER_PHASE
    for (int p = 0; p < NPHASE; ++p) { a.ph_lo = p; a.ph_hi = p + 1; hipLaunchKernelGGL(fwd_kernel, dim3(grid), dim3(NWAVES * 64), LDS_BYTES, stream, a); }
#else
    a.ph_lo = 0; a.ph_hi = NPHASE;
    hipLaunchKernelGGL(fwd_kernel, dim3(grid), dim3(NWAVES * 64), LDS_BYTES, stream, a);
#endif
}
```

```cpp
#include <hip/hip_runtime.h>
#include <cstdio>
#include <cstdint>

#ifndef MK_PER_PHASE
#define MK_PER_PHASE 0
#endif

#ifndef MK_REPEAT
#define MK_REPEAT 0
#endif
#define MK_REPS(bit) ((MK_REPEAT >> (bit)) & 1 ? 2 : 1)
#ifndef MK_VAR
#define MK_VAR 0
#endif

constexpr int D = 1024, MP = 4096, MS = 2048, M = MP + MS, DEPTH = 4;
constexpr int NIN = 5376, FFN = 2816, NGU = 2 * FFN, NMOD = 6 * D;
constexpr int NAW = 512, PW = 256, CW = 256, CONVK = 31;
constexpr float EPS = 1e-6f;
constexpr float LOG2E = 1.4426950408889634f;
constexpr float QSCALE = 0.125f * LOG2E;

constexpr size_t MiB = 1u << 20;
constexpr size_t WS_CTL = 0, CTL_ZERO_BYTES = 5 * MiB / 4;
constexpr int CW_BAR = 4096;
constexpr int CF_MODRAW = 16384;
constexpr int CF_C1 = CF_MODRAW + DEPTH * 3 * NMOD;
constexpr int CF_C2 = CF_C1 + DEPTH * 3 * NIN;
constexpr int CF_RSS = CF_C2 + DEPTH * 3 * NGU;
constexpr int CF_END = CF_RSS + 9 * M;
static_assert((size_t)CF_END * 4 <= CTL_ZERO_BYTES, "control region");
constexpr size_t WS_MODT = 2 * MiB;
constexpr size_t WS_WIN = 4 * MiB;
constexpr size_t WS_WGU = 46 * MiB;
constexpr size_t WS_WDN = 90 * MiB;
constexpr size_t WS_WBR = 112 * MiB;
constexpr size_t WS_WOUT = 120 * MiB;
constexpr size_t WS_X = 128 * MiB;
constexpr size_t WS_XG = 152 * MiB;
constexpr size_t WS_Q = 164 * MiB, WS_K = 170 * MiB;
constexpr size_t WS_VT = 176 * MiB;
constexpr size_t WS_KC = 182 * MiB;
constexpr size_t WS_VTC = 184 * MiB;
constexpr size_t WS_PIN = 186 * MiB;
constexpr size_t WS_CIN = 189 * MiB;
constexpr size_t WS_G = 195 * MiB;
constexpr size_t WS_ABR = 231 * MiB;
constexpr size_t WS_MF = 243 * MiB;
constexpr size_t WS_MB = 267 * MiB;
constexpr size_t WS_ACT = 279 * MiB;
constexpr size_t WS_END = 312 * MiB;
constexpr size_t VT_SAMPLE_OFF = (size_t)16 * 8 * 64 * 256;

constexpr size_t OUT_Y = 0, OUT_K = (size_t)M * D, OUT_V = OUT_K + (size_t)16 * DEPTH * 256 * 512;

#define GAS __attribute__((address_space(1)))
#define LAS __attribute__((address_space(3)))
typedef unsigned short bf16_t;
typedef short bf16x8 __attribute__((ext_vector_type(8)));
typedef float f32x4 __attribute__((ext_vector_type(4)));
typedef float f32x2 __attribute__((ext_vector_type(2)));
typedef float f32x16 __attribute__((ext_vector_type(16)));
typedef unsigned u32x4 __attribute__((ext_vector_type(4)));
typedef unsigned u32x2 __attribute__((ext_vector_type(2)));
typedef __bf16 bf16x2_t __attribute__((ext_vector_type(2)));
#define LDS_WAIT() asm volatile("s_waitcnt lgkmcnt(0)" ::: "memory")

__device__ __forceinline__ unsigned pk2(float lo, float hi) { f32x2 v = {lo, hi}; bf16x2_t b = __builtin_convertvector(v, bf16x2_t); return __builtin_bit_cast(unsigned, b); }
__device__ __forceinline__ u32x4 pk8(f32x4 a, f32x4 b) { u32x4 w; w.x = pk2(a[0], a[1]); w.y = pk2(a[2], a[3]); w.z = pk2(b[0], b[1]); w.w = pk2(b[2], b[3]); return w; }
__device__ __forceinline__ float bf_lo(unsigned w) { return __uint_as_float(w << 16); }
__device__ __forceinline__ float bf_hi(unsigned w) { return __uint_as_float(w & 0xffff0000u); }
__device__ __forceinline__ float sigmoidf_(float x) { return __builtin_amdgcn_rcpf(1.0f + __builtin_amdgcn_exp2f(-LOG2E * x)); }
__device__ __forceinline__ float wave_sum(float v) {
#pragma unroll
    for (int o = 1; o < 64; o <<= 1) v += __shfl_xor(v, o);
    return v;
}
__device__ __forceinline__ int pos_of_key(int t) { return (t & ~12) | ((t & 4) << 1) | ((t & 8) >> 1); }
__device__ __forceinline__ int mod_row_of_pm(int pm) { return pm < 16 ? 0 : 1 + ((pm - 16) >> 2); }

namespace pg8 {
constexpr int BM = 256, BK = 64, HALF = 128, HTB = HALF * BK * 2  , STAGE_BYTES = 8 * HTB, NXCD = 8, WGM = 4;
__host__ __device__ __forceinline__ int lds_byte(int r, int c) { return r * 128 + ((((c >> 3) ^ (r >> 1)) & 7) << 4) + (c & 7) * 2; }
__host__ __device__ __forceinline__ void stage_rc(int b, int& R, int& C) { R = b >> 7; C = (((b >> 4) ^ (R >> 1)) & 7) * 8; }
__host__ __device__ __forceinline__ int perm32(int rho) { const int n = rho >> 4, i = rho & 15; return 8 * (i >> 2) + 4 * n + (i & 3); }

struct Unit { int pm, pn, k0, nt, kind, half; };
struct Gemm { const bf16_t* A; const bf16_t* Bt; int lda, ldb; };

struct TileOrder {
    int nM, nN, nwg, G, c, nt;
    __device__ void init(int M_, int N_, int K_, int G_, int c_) { nM = M_ / BM; nN = N_ / BM; nwg = nM * nN; G = G_; c = c_; nt = K_ / BK; }
    __device__ bool next(int i, Unit& u) const {
        const long L = (long)i * G + c; if (L >= nwg) return false;
        int wgid = (int)L; { const int q = nwg / NXCD, r = nwg % NXCD, xcd = wgid % NXCD, off = wgid / NXCD; wgid = (xcd < r ? xcd * (q + 1) : r * (q + 1) + (xcd - r) * q) + off; }
        const int nig = WGM * nN, gid = wgid / nig, fm = gid * WGM, gsz = (nM - fm) < WGM ? (nM - fm) : WGM;
        u.pm = fm + ((wgid % nig) % gsz); u.pn = (wgid % nig) / gsz; u.k0 = 0; u.nt = nt; u.kind = 0; u.half = 0; return true;
    }
};
struct TileOrderGU {
    int nM, nN, nwg, nw, c, nt;
    __device__ void init(int M_, int N_, int K_, int nw_, int c_) { nM = M_ / BM; nN = N_ / BM; nwg = nM * nN; nw = nw_; c = c_; nt = K_ / BK; }
    __device__ __forceinline__ void done(const Unit&, int) const {}
    __device__ void tile_of(int L, Unit& u) const {
        const int wgid = (L % NXCD) * (nwg / NXCD) + L / NXCD;
        const int nig = 3 * nN, gid = wgid / nig, fm = gid * 3;
        u.pm = fm + ((wgid % nig) % 3); u.pn = (wgid % nig) / 3; u.k0 = 0; u.nt = nt; u.kind = 0;
    }
    __device__ bool next(int i, Unit& u) const {
        if (c >= nw || i > 2) return false;
        if (i < 2) { tile_of(i * nw + c, u); u.half = 0; return true; }
        const int j = c >> 3, per = (nwg - 2 * nw) / NXCD;
        if (j >= 2 * per) return false;
        tile_of(2 * nw + (j >> 1) * NXCD + (c & 7), u); u.half = 1 + (j & 1); return true;
    }
};

struct PanelOrder {
    int c, nseg, ka, na, kb, nb, kc, nc;
    __device__ bool next(int i, Unit& u) const {
        if (c >= 96 || i >= nseg) return false;
        const int T = (c & 7) * 12 + (c >> 3);
        u.pm = T >> 2; u.pn = T & 3; u.k0 = i == 0 ? ka : (i == 1 ? kb : kc); u.nt = i == 0 ? na : (i == 1 ? nb : nc); u.kind = i; u.half = 0; return true;
    }
};

template <class Epi, class Sched>
__device__ __forceinline__ void gemm_phase(LAS unsigned char* lds, const Gemm g, const Sched& S, const Epi& E) {
    int tid = threadIdx.x; asm volatile("" : "+v"(tid));
    const int wid = __builtin_amdgcn_readfirstlane(tid >> 6), lane = tid & 63, wr = wid >> 2, wc = wid & 3, fr = lane & 15, fq = lane >> 4;
    unsigned voffA[2], voffB[2];
#pragma unroll
    for (int i = 0; i < 2; ++i) { int R, C; stage_rc(tid * 16 + i * 8192, R, C); const int Rb = (R & ~31) + perm32(R & 31);
        voffA[i] = (unsigned)(R * g.lda + C) * 2u; voffB[i] = (unsigned)(Rb * g.ldb + C) * 2u; }
    const size_t kstep = (size_t)(BK * 2);
    const size_t hstepA = (size_t)HALF * g.lda * 2, hstepB = (size_t)HALF * g.ldb * 2;
    const size_t tstepA = 2 * hstepA, tstepB = 2 * hstepB;
    const unsigned ldsw = (unsigned)wid * 1024u;
    const int aoffk[2] = {lds_byte(wr * 64 + fr, fq * 8), lds_byte(wr * 64 + fr, fq * 8 + 32)}, boffk[2] = {lds_byte(wc * 32 + fr, fq * 8), lds_byte(wc * 32 + fr, fq * 8 + 32)};
#define PG8_SA(b, h) (((b) * 2 + (h)) * HTB)
#define PG8_SB(b, h) ((4 + (b) * 2 + (h)) * HTB)
#define PG8_STAGE(bufoff, gbase, voff) do { _Pragma("unroll") for (int _i = 0; _i < 2; ++_i) \
        __builtin_amdgcn_global_load_lds((const unsigned*)((const char*)(gbase) + (voff)[_i]), (LAS unsigned*)(lds + (bufoff) + ldsw + _i * 8192), 16, 0, 0); } while (0)
#define PG8_LDA(dst, b, h) do { _Pragma("unroll") for (int m = 0; m < 4; ++m) _Pragma("unroll") for (int k = 0; k < 2; ++k) dst[m][k] = *(const LAS bf16x8*)(lds + PG8_SA(b, h) + aoffk[k] + m * 2048); } while (0)
#define PG8_LDB(dst, b, h) do { _Pragma("unroll") for (int n = 0; n < 2; ++n) _Pragma("unroll") for (int k = 0; k < 2; ++k) dst[n][k] = *(const LAS bf16x8*)(lds + PG8_SB(b, h) + boffk[k] + n * 2048); } while (0)
#define PG8_MMA(ai, bj, At, Bt) do { __builtin_amdgcn_s_setprio(1); _Pragma("unroll") for (int m = 0; m < 4; ++m) _Pragma("unroll") for (int n = 0; n < 2; ++n) _Pragma("unroll") for (int k = 0; k < 2; ++k) \
        acc[ai][bj][m][n] = __builtin_amdgcn_mfma_f32_16x16x32_bf16(Bt[n][k], At[m][k], acc[ai][bj][m][n], 0, 0, 0); __builtin_amdgcn_s_setprio(0); } while (0)
#define PG8_WAIT_V(n) asm volatile("s_waitcnt vmcnt(" #n ")" ::: "memory")
#define PG8_WAIT_L(n) asm volatile("s_waitcnt lgkmcnt(" #n ")" ::: "memory")
#define PG8_BAR __builtin_amdgcn_s_barrier()
#define PG8_SCHED __builtin_amdgcn_sched_barrier(0)
    Unit cur, nxt; int ui = 0;
    if (!S.next(0, cur)) return;
    f32x4 acc[2][2][4][2];
#pragma unroll
    for (int a = 0; a < 2; ++a)
#pragma unroll
        for (int b = 0; b < 2; ++b)
#pragma unroll
            for (int m = 0; m < 4; ++m)
#pragma unroll
                for (int n = 0; n < 2; ++n) acc[a][b][m][n] = (f32x4){0.f, 0.f, 0.f, 0.f};
    bf16x8 At[4][2], B0[2][2], B1[2][2];
    const char* cA = (const char*)g.A + (size_t)cur.pm * tstepA + (size_t)cur.k0 * 2; const char* cB = (const char*)g.Bt + (size_t)cur.pn * tstepB + (size_t)cur.k0 * 2;
    PG8_STAGE(PG8_SB(0, 0), cB, voffB); PG8_STAGE(PG8_SB(0, 1), cB + hstepB, voffB); PG8_STAGE(PG8_SA(0, 0), cA, voffA); PG8_STAGE(PG8_SA(0, 1), cA + hstepA, voffA);
    if (wr == 1) PG8_BAR;
    PG8_WAIT_V(2); PG8_BAR;
    PG8_STAGE(PG8_SB(1, 0), cB + kstep, voffB); PG8_STAGE(PG8_SA(1, 0), cA + kstep, voffA); PG8_STAGE(PG8_SB(1, 1), cB + hstepB + kstep, voffB);
    PG8_WAIT_V(6); PG8_BAR;
    for (;;) {
        const bool has_next = S.next(ui + 1, nxt);
        const char* nA = has_next ? (const char*)g.A + (size_t)nxt.pm * tstepA + (size_t)nxt.k0 * 2 : cA; const char* nB = has_next ? (const char*)g.Bt + (size_t)nxt.pn * tstepB + (size_t)nxt.k0 * 2 : cB;
        const int nt = cur.nt;
        const bool do0 = cur.half != 2, do1 = cur.half != 1;
        for (int t = 0; t < nt; t += 2) {
            const bool last = (t == nt - 2);
            const char* a1 = cA + (size_t)(t + 1) * kstep;
            const char* a2 = last ? nA : cA + (size_t)(t + 2) * kstep; const char* b2 = last ? nB : cB + (size_t)(t + 2) * kstep;
            const char* a3 = a2 + kstep; const char* b3 = b2 + kstep;
            PG8_LDB(B0, 0, 0); PG8_LDB(B1, 0, 1); PG8_SCHED; PG8_LDA(At, 0, 0); PG8_STAGE(PG8_SA(1, 1), a1 + hstepA, voffA);
            PG8_WAIT_V(8); PG8_WAIT_L(0); PG8_BAR; if (do0) { PG8_MMA(0, 0, At, B0); PG8_MMA(0, 1, At, B1); } PG8_BAR; PG8_SCHED;
            PG8_LDA(At, 0, 1); PG8_STAGE(PG8_SB(0, 0), b2, voffB); PG8_STAGE(PG8_SB(0, 1), b2 + hstepB, voffB); PG8_STAGE(PG8_SA(0, 0), a2, voffA);
            PG8_WAIT_V(8); PG8_WAIT_L(0); PG8_BAR; if (do1) { PG8_MMA(1, 0, At, B0); PG8_MMA(1, 1, At, B1); } PG8_BAR; PG8_SCHED;
            PG8_LDB(B0, 1, 0); PG8_LDB(B1, 1, 1); PG8_SCHED; PG8_LDA(At, 1, 0); PG8_STAGE(PG8_SA(0, 1), a2 + hstepA, voffA);
            PG8_WAIT_V(8); PG8_WAIT_L(0); PG8_BAR; if (do0) { PG8_MMA(0, 0, At, B0); PG8_MMA(0, 1, At, B1); } PG8_BAR; PG8_SCHED;
            PG8_LDA(At, 1, 1); PG8_STAGE(PG8_SB(1, 0), b3, voffB); PG8_STAGE(PG8_SB(1, 1), b3 + hstepB, voffB); PG8_STAGE(PG8_SA(1, 0), a3, voffA);
            PG8_WAIT_V(8); PG8_WAIT_L(0); PG8_BAR; if (do1) { PG8_MMA(1, 0, At, B0); PG8_MMA(1, 1, At, B1); } PG8_BAR; PG8_SCHED;
        }
        if (wr == 0) PG8_BAR;
        E(acc, cur, wr, wc, fr, fq);
        if (!has_next) break;
#pragma unroll
        for (int a = 0; a < 2; ++a)
#pragma unroll
            for (int b = 0; b < 2; ++b)
#pragma unroll
                for (int m = 0; m < 4; ++m)
#pragma unroll
                    for (int n = 0; n < 2; ++n) acc[a][b][m][n] = (f32x4){0.f, 0.f, 0.f, 0.f};
        cur = nxt; cA = nA; cB = nB; ++ui;
        if (wr == 1) PG8_BAR;
    }
    PG8_WAIT_V(0);
    PG8_BAR;
#undef PG8_SA
#undef PG8_SB
#undef PG8_STAGE
#undef PG8_LDA
#undef PG8_LDB
#undef PG8_MMA
#undef PG8_WAIT_V
#undef PG8_WAIT_L
#undef PG8_BAR
#undef PG8_SCHED
}
}

typedef f32x4 Acc[2][2][4][2];

struct EpiIn {
    const float* rss; const float* c1; const float* bgate;
    bf16_t *Q, *K, *Vt, *Pin, *Cin, *G; float *outk, *outv;
    __device__ __forceinline__ void operator()(const Acc& acc, const pg8::Unit& u, int wr, int wc, int fr, int fq) const {
        const int pn = u.pn, pm = u.pm, mr = mod_row_of_pm(pm);
        const int cb = pn * 256 + wc * 32 + 8 * fq;
        f32x4 cv[2][2];
#pragma unroll
        for (int bj = 0; bj < 2; ++bj)
#pragma unroll
            for (int n = 0; n < 2; ++n) { cv[bj][n] = *(const f32x4*)(c1 + (size_t)mr * NIN + cb + bj * 128 + 4 * n);
                if (pn >= 9) cv[bj][n] += *(const f32x4*)(bgate + (cb - 2304) + bj * 128 + 4 * n); }
        float rinvs[2][4];
#pragma unroll
        for (int ai = 0; ai < 2; ++ai)
#pragma unroll
            for (int m = 0; m < 4; ++m) rinvs[ai][m] = rss[pm * 256 + ai * 128 + wr * 64 + m * 16 + fr];
#pragma unroll
        for (int ai = 0; ai < 2; ++ai)
#pragma unroll
            for (int m = 0; m < 4; ++m) {
                const int row = pm * 256 + ai * 128 + wr * 64 + m * 16 + fr;
                const float rinv = 1.0f / sqrtf(rinvs[ai][m] * (1.0f / D) + EPS);
#pragma unroll
                for (int bj = 0; bj < 2; ++bj) {
                    const int col = cb + bj * 128;
                    f32x4 v0 = acc[ai][bj][m][0] * rinv + cv[bj][0], v1 = acc[ai][bj][m][1] * rinv + cv[bj][1];
                    if (pn < 2) {
                        *(u32x4*)(Q + (size_t)row * NAW + col) = pk8(v0 * QSCALE, v1 * QSCALE);
                    } else if (pn < 4) {
                        const int c = col - 512;
                        *(u32x4*)(K + (size_t)row * NAW + c) = pk8(v0, v1);
                        if (pm < 16) { float* o = outk + ((size_t)(pm * DEPTH * 256 + (row & 255))) * 512 + c; __builtin_nontemporal_store(v0, (f32x4*)o); __builtin_nontemporal_store(v1, (f32x4*)(o + 4)); }
                    } else if (pn < 6) {
                        const int c = col - 1024, h = c >> 6, d = c & 63;
                        if (pm < 16) { float* o = outv + ((size_t)(pm * DEPTH * 256 + (row & 255))) * 512 + c; __builtin_nontemporal_store(v0, (f32x4*)o); __builtin_nontemporal_store(v1, (f32x4*)(o + 4)); }
                        bf16_t* vb; int L;
                        if (pm < 16) { L = 256; vb = Vt + ((size_t)((pm * 8 + h) * 64 + d)) * 256 + pos_of_key(row & 255); }
                        else { const int rs = row - MP, bs = rs >> 10; L = 1024; vb = Vt + VT_SAMPLE_OFF + ((size_t)((bs * 8 + h) * 64 + d)) * 1024 + pos_of_key(rs & 1023); }
                        const u32x4 w = pk8(v0, v1);
                        vb[0] = (bf16_t)(w.x & 0xffff); vb[(size_t)L] = (bf16_t)(w.x >> 16); vb[(size_t)2 * L] = (bf16_t)(w.y & 0xffff); vb[(size_t)3 * L] = (bf16_t)(w.y >> 16);
                        vb[(size_t)4 * L] = (bf16_t)(w.z & 0xffff); vb[(size_t)5 * L] = (bf16_t)(w.z >> 16); vb[(size_t)6 * L] = (bf16_t)(w.w & 0xffff); vb[(size_t)7 * L] = (bf16_t)(w.w >> 16);
                    } else if (pn == 6) {
                        *(u32x4*)(Pin + (size_t)row * PW + (col - 1536)) = pk8(v0, v1);
                    } else if (pn < 9) {
                        *(u32x4*)(Cin + (size_t)row * 512 + (col - 1792)) = pk8(v0, v1);
                    } else {
#pragma unroll
                        for (int e = 0; e < 4; ++e) { v0[e] = sigmoidf_(v0[e]); v1[e] = sigmoidf_(v1[e]); }
                        *(u32x4*)(G + (size_t)row * 3072 + (col - 2304)) = pk8(v0, v1);
                    }
                }
                asm volatile("" ::: "memory");
            }
    }
};

struct EpiBranch {
    const bf16_t* G; float* mf; bf16_t* mb;
    __device__ __forceinline__ void operator()(const Acc& acc, const pg8::Unit& u, int wr, int wc, int fr, int fq) const {
        const int cb = u.pn * 256 + wc * 32 + 8 * fq, kind = u.kind;
#pragma unroll
        for (int ai = 0; ai < 2; ++ai)
#pragma unroll
            for (int m = 0; m < 4; ++m) {
                const int row = u.pm * 256 + ai * 128 + wr * 64 + m * 16 + fr;
#pragma unroll
                for (int bj = 0; bj < 2; ++bj) {
                    const int col = cb + bj * 128;
                    const u32x4 gw = *(const u32x4*)(G + (size_t)row * 3072 + kind * 1024 + col);
                    f32x4 v0 = acc[ai][bj][m][0], v1 = acc[ai][bj][m][1];
                    v0[0] *= bf_lo(gw.x); v0[1] *= bf_hi(gw.x); v0[2] *= bf_lo(gw.y); v0[3] *= bf_hi(gw.y);
                    v1[0] *= bf_lo(gw.z); v1[1] *= bf_hi(gw.z); v1[2] *= bf_lo(gw.w); v1[3] *= bf_hi(gw.w);
                    float* sp = mf + (size_t)row * D + col;
                    if (kind > 0) { v0 += *(const f32x4*)sp; v1 += *(const f32x4*)(sp + 4); }
                    if (kind < 2) { *(f32x4*)sp = v0; *(f32x4*)(sp + 4) = v1; }
                    else *(u32x4*)(mb + (size_t)row * D + col) = pk8(v0, v1);
                }
                asm volatile("" ::: "memory");
            }
    }
};

struct EpiRes {
    float* x; bf16_t* xg; const float* gate; const float* gsn; float* rssn;
    __device__ __forceinline__ void operator()(const Acc& acc, const pg8::Unit& u, int wr, int wc, int fr, int fq) const {
        const int mr = mod_row_of_pm(u.pm), cb = u.pn * 256 + wc * 32 + 8 * fq;
        float ss[2][4];
#pragma unroll
        for (int ai = 0; ai < 2; ++ai)
#pragma unroll
            for (int m = 0; m < 4; ++m) ss[ai][m] = 0.f;
#pragma unroll
        for (int bj = 0; bj < 2; ++bj) {
            const int col = cb + bj * 128;
            const f32x4 gt0 = *(const f32x4*)(gate + (size_t)mr * 6 * D + col), gt1 = *(const f32x4*)(gate + (size_t)mr * 6 * D + col + 4);
            const f32x4 gs0 = *(const f32x4*)(gsn + (size_t)mr * 6 * D + col), gs1 = *(const f32x4*)(gsn + (size_t)mr * 6 * D + col + 4);
#pragma unroll
            for (int ai = 0; ai < 2; ++ai)
#pragma unroll
                for (int m = 0; m < 4; ++m) {
                    const int row = u.pm * 256 + ai * 128 + wr * 64 + m * 16 + fr;
                    float* xp = x + (size_t)row * D + col;
                    f32x4 x0 = *(const f32x4*)xp, x1 = *(const f32x4*)(xp + 4);
                    x0 += gt0 * acc[ai][bj][m][0]; x1 += gt1 * acc[ai][bj][m][1];
                    *(f32x4*)xp = x0; *(f32x4*)(xp + 4) = x1;
                    ss[ai][m] += (x0[0] * x0[0] + x0[1] * x0[1]) + (x0[2] * x0[2] + x0[3] * x0[3]) + (x1[0] * x1[0] + x1[1] * x1[1]) + (x1[2] * x1[2] + x1[3] * x1[3]);
                    *(u32x4*)(xg + (size_t)row * D + col) = pk8(x0 * gs0, x1 * gs1);
                    asm volatile("" ::: "memory");
                }
        }
#pragma unroll
        for (int ai = 0; ai < 2; ++ai)
#pragma unroll
            for (int m = 0; m < 4; ++m) {
                float s = ss[ai][m];
                s += __shfl_xor(s, 16); s += __shfl_xor(s, 32);
                if (fq == 0) atomicAdd(rssn + u.pm * 256 + ai * 128 + wr * 64 + m * 16 + fr, s);
            }
    }
};

struct EpiGU {
    const float* rss; const float* c2; bf16_t* act;
    __device__ __forceinline__ void operator()(const Acc& acc, const pg8::Unit& u, int wr, int wc, int fr, int fq) const {
        const int mr = mod_row_of_pm(u.pm), ca0 = u.pn * 128 + wc * 32 + 8 * fq;
        f32x4 ca[2], cbv[2];
#pragma unroll
        for (int n = 0; n < 2; ++n) { ca[n] = *(const f32x4*)(c2 + (size_t)mr * NGU + ca0 + 4 * n); cbv[n] = *(const f32x4*)(c2 + (size_t)mr * NGU + FFN + ca0 + 4 * n); }
        float rinvs[2][4];
#pragma unroll
        for (int ai = 0; ai < 2; ++ai)
#pragma unroll
            for (int m = 0; m < 4; ++m) rinvs[ai][m] = rss[u.pm * 256 + ai * 128 + wr * 64 + m * 16 + fr];
#pragma unroll
        for (int ai = 0; ai < 2; ++ai)
#pragma unroll
            for (int m = 0; m < 4; ++m) {
                if (u.half == 2 - ai) continue;
                const int row = u.pm * 256 + ai * 128 + wr * 64 + m * 16 + fr;
                const float rinv = 1.0f / sqrtf(rinvs[ai][m] * (1.0f / D) + EPS);
                f32x4 o[2];
#pragma unroll
                for (int n = 0; n < 2; ++n) {
                    const f32x4 a = acc[ai][0][m][n] * rinv + ca[n], b = acc[ai][1][m][n] * rinv + cbv[n];
#pragma unroll
                    for (int e = 0; e < 4; ++e) o[n][e] = a[e] * sigmoidf_(a[e]) * b[e];
                }
                *(u32x4*)(act + (size_t)row * FFN + ca0) = pk8(o[0], o[1]);
                asm volatile("" ::: "memory");
            }
    }
};

namespace g192 {
constexpr int TM = 192, TN = 128, BK = 64, ABYTES = TM * BK * 2, BBYTES = TN * BK * 2, SBYTES = ABYTES + BBYTES;
typedef f32x4 Acc6[6][2];
template <class Epi>
__device__ __forceinline__ void gemm(LAS unsigned char* lds, const bf16_t* A, int lda, const bf16_t* Bt, int ldb, int pm, int pn, int nt, const Epi& E) {
    int tid = threadIdx.x; asm volatile("" : "+v"(tid));
    const int wid = __builtin_amdgcn_readfirstlane(tid >> 6), lane = tid & 63, wr = wid >> 2, wc = wid & 3, fr = lane & 15, fq = lane >> 4;
    unsigned voffA[3], voffB[2];
#pragma unroll
    for (int i = 0; i < 3; ++i) { int R, C; pg8::stage_rc((wid + 8 * i) * 1024 + lane * 16, R, C); voffA[i] = (unsigned)(R * lda + C) * 2u; }
#pragma unroll
    for (int i = 0; i < 2; ++i) { int R, C; pg8::stage_rc((wid + 8 * i) * 1024 + lane * 16, R, C); const int Rb = (R & ~31) + pg8::perm32(R & 31); voffB[i] = (unsigned)(Rb * ldb + C) * 2u; }
    const char* gA = (const char*)(A + (size_t)pm * TM * lda); const char* gB = (const char*)(Bt + (size_t)pn * TN * ldb);
    const unsigned ldsw = (unsigned)wid * 1024u;
    const int aoffk[2] = {pg8::lds_byte(wr * 96 + fr, fq * 8), pg8::lds_byte(wr * 96 + fr, fq * 8 + 32)}, boffk[2] = {ABYTES + pg8::lds_byte(wc * 32 + fr, fq * 8), ABYTES + pg8::lds_byte(wc * 32 + fr, fq * 8 + 32)};
#define G192_STAGE(slot, t) do { \
        _Pragma("unroll") for (int _i = 0; _i < 3; ++_i) __builtin_amdgcn_global_load_lds((const unsigned*)(gA + (size_t)(t) * (BK * 2) + voffA[_i]), (LAS unsigned*)(lds + (slot) * SBYTES + ldsw + _i * 8192), 16, 0, 0); \
        _Pragma("unroll") for (int _i = 0; _i < 2; ++_i) __builtin_amdgcn_global_load_lds((const unsigned*)(gB + (size_t)(t) * (BK * 2) + voffB[_i]), (LAS unsigned*)(lds + (slot) * SBYTES + ABYTES + ldsw + _i * 8192), 16, 0, 0); } while (0)
#define G192_WAIT_V(n) asm volatile("s_waitcnt vmcnt(" #n ")" ::: "memory")
#define G192_WAIT_L(n) asm volatile("s_waitcnt lgkmcnt(" #n ")" ::: "memory")
    f32x4 acc[6][2], tot[6][2];
#pragma unroll
    for (int m = 0; m < 6; ++m)
#pragma unroll
        for (int n = 0; n < 2; ++n) { acc[m][n] = (f32x4){0.f, 0.f, 0.f, 0.f}; tot[m][n] = (f32x4){0.f, 0.f, 0.f, 0.f}; }
    G192_STAGE(0, 0); G192_STAGE(1, 1); G192_STAGE(2, 2);
    G192_WAIT_V(10); __builtin_amdgcn_s_barrier();
#pragma unroll 1
    for (int t = 0; t < nt; ++t) {
        const int slot = t & 3;
        if (t + 3 < nt) G192_STAGE((t + 3) & 3, t + 3);
        bf16x8 At[6][2], Bf[2][2];
        const LAS unsigned char* sb = lds + slot * SBYTES;
#pragma unroll
        for (int n = 0; n < 2; ++n)
#pragma unroll
            for (int k = 0; k < 2; ++k) Bf[n][k] = *(const LAS bf16x8*)(sb + boffk[k] + n * 2048);
#pragma unroll
        for (int m = 0; m < 6; ++m)
#pragma unroll
            for (int k = 0; k < 2; ++k) At[m][k] = *(const LAS bf16x8*)(sb + aoffk[k] + m * 2048);
        G192_WAIT_L(0);
        __builtin_amdgcn_s_setprio(1);
#pragma unroll
        for (int m = 0; m < 6; ++m)
#pragma unroll
            for (int n = 0; n < 2; ++n)
#pragma unroll
                for (int k = 0; k < 2; ++k) acc[m][n] = __builtin_amdgcn_mfma_f32_16x16x32_bf16(Bf[n][k], At[m][k], acc[m][n], 0, 0, 0);
        __builtin_amdgcn_s_setprio(0);
        if (Epi::BRANCH) { if (t == 7 || t == 11 || t == nt - 1) E.seg(acc, tot, t == 7 ? 0 : (t == 11 ? 1 : 2), pm, pn, wr, wc, fr, fq); }
        if (t + 3 < nt) G192_WAIT_V(10); else if (t + 2 < nt) G192_WAIT_V(5); else G192_WAIT_V(0);
        __builtin_amdgcn_s_barrier();
    }
    E(Epi::BRANCH ? tot : acc, pm, pn, wr, wc, fr, fq);
#undef G192_STAGE
#undef G192_WAIT_V
#undef G192_WAIT_L
}
}

struct EpiBranch192 {
    static constexpr bool BRANCH = true;
    const bf16_t* G; bf16_t* mb;
    __device__ __forceinline__ void seg(g192::Acc6& acc, g192::Acc6& tot, int kind, int pm, int pn, int wr, int wc, int fr, int fq) const {
        const int col = pn * 128 + wc * 32 + 8 * fq;
#pragma unroll
        for (int m = 0; m < 6; ++m) {
            const int row = pm * 192 + wr * 96 + m * 16 + fr;
            const u32x4 gw = *(const u32x4*)(G + (size_t)row * 3072 + kind * 1024 + col);
            f32x4 g0 = {bf_lo(gw.x), bf_hi(gw.x), bf_lo(gw.y), bf_hi(gw.y)}, g1 = {bf_lo(gw.z), bf_hi(gw.z), bf_lo(gw.w), bf_hi(gw.w)};
            tot[m][0] += g0 * acc[m][0]; tot[m][1] += g1 * acc[m][1];
            acc[m][0] = (f32x4){0.f, 0.f, 0.f, 0.f}; acc[m][1] = (f32x4){0.f, 0.f, 0.f, 0.f};
        }
    }
    __device__ __forceinline__ void operator()(const g192::Acc6& tot, int pm, int pn, int wr, int wc, int fr, int fq) const {
        const int col = pn * 128 + wc * 32 + 8 * fq;
#pragma unroll
        for (int m = 0; m < 6; ++m) { const int row = pm * 192 + wr * 96 + m * 16 + fr; *(u32x4*)(mb + (size_t)row * D + col) = pk8(tot[m][0], tot[m][1]); }
    }
};
struct EpiRes192 {
    static constexpr bool BRANCH = false;
    float* x; bf16_t* xg; const float* gate; const float* gsn; float* rssn;
    __device__ __forceinline__ void seg(g192::Acc6&, g192::Acc6&, int, int, int, int, int, int, int) const {}
    __device__ __forceinline__ void operator()(const g192::Acc6& acc, int pm, int pn, int wr, int wc, int fr, int fq) const {
        const int col = pn * 128 + wc * 32 + 8 * fq;
        f32x4 xv[6][2], gt[6][2], gs[6][2];
#pragma unroll
        for (int m = 0; m < 6; ++m) {
            const int row = pm * 192 + wr * 96 + m * 16 + fr;
            const int mr = row < MP ? 0 : 1 + ((row - MP) >> 10);
            const float* gp = gate + (size_t)mr * 6 * D + col; const float* sp = gsn + (size_t)mr * 6 * D + col; const float* xp = x + (size_t)row * D + col;
            xv[m][0] = *(const f32x4*)xp; xv[m][1] = *(const f32x4*)(xp + 4);
            gt[m][0] = *(const f32x4*)gp; gt[m][1] = *(const f32x4*)(gp + 4); gs[m][0] = *(const f32x4*)sp; gs[m][1] = *(const f32x4*)(sp + 4);
        }
#pragma unroll
        for (int m = 0; m < 6; ++m) {
            const int row = pm * 192 + wr * 96 + m * 16 + fr;
            float* xp = x + (size_t)row * D + col;
            const f32x4 x0 = xv[m][0] + gt[m][0] * acc[m][0], x1 = xv[m][1] + gt[m][1] * acc[m][1];
            *(f32x4*)xp = x0; *(f32x4*)(xp + 4) = x1;
            float ss = (x0[0] * x0[0] + x0[1] * x0[1]) + (x0[2] * x0[2] + x0[3] * x0[3]) + (x1[0] * x1[0] + x1[1] * x1[1]) + (x1[2] * x1[2] + x1[3] * x1[3]);
            *(u32x4*)(xg + (size_t)row * D + col) = pk8(x0 * gs[m][0], x1 * gs[m][1]);
            ss += __shfl_xor(ss, 16); ss += __shfl_xor(ss, 32);
            if (fq == 0) atomicAdd(rssn + row, ss);
        }
    }
};

struct AttnState { f32x16 o0, o1; float m, l; };
struct KVFrag { bf16x8 k[4], v[2][2]; };
__device__ __forceinline__ void attn_load(KVFrag& f, const bf16_t* kptr  , const bf16_t* vptr  , int vstride32  ) {
#pragma unroll
    for (int s = 0; s < 4; ++s) f.k[s] = *(const bf16x8*)(kptr + 16 * s);
#pragma unroll
    for (int dt = 0; dt < 2; ++dt)
#pragma unroll
        for (int ks = 0; ks < 2; ++ks) f.v[dt][ks] = *(const bf16x8*)(vptr + (size_t)dt * vstride32 + 16 * ks);
}
__device__ __forceinline__ void attn_tile(AttnState& st, const bf16x8 (&qf)[4], const KVFrag& f, bool local, const LAS float* rl, int cq, int cs, int ck0  ) {
    f32x16 s = {0.f, 0.f, 0.f, 0.f, 0.f, 0.f, 0.f, 0.f, 0.f, 0.f, 0.f, 0.f, 0.f, 0.f, 0.f, 0.f};
#pragma unroll
    for (int k = 0; k < 4; ++k) s = __builtin_amdgcn_mfma_f32_32x32x16_bf16(f.k[k], qf[k], s, 0, 0, 0);
    if (local) {
        const LAS float* rb = rl + (ck0 - cq + 15);
        const int d0 = ck0 - cs;
#pragma unroll
        for (int i = 0; i < 16; ++i) {
            const int o = (i & 3) + 8 * (i >> 2);
            const bool ok = (unsigned)(d0 + o) < 16u;
            s[i] = ok ? s[i] + rb[o] : -1e30f;
        }
    }
    float mx = fmaxf(fmaxf(s[0], s[1]), fmaxf(s[2], s[3]));
#pragma unroll
    for (int i = 4; i < 16; i += 4) mx = fmaxf(mx, fmaxf(fmaxf(s[i], s[i + 1]), fmaxf(s[i + 2], s[i + 3])));
    mx = fmaxf(mx, __shfl_xor(mx, 32));
    const float mo = st.m, mn = fmaxf(mo, mx);
    st.m = mn;
    float ls = 0.f;
#pragma unroll
    for (int i = 0; i < 16; ++i) { const float p = __builtin_amdgcn_exp2f(s[i] - mn); s[i] = p; ls += p; }
    if (__builtin_amdgcn_ballot_w64(mn > mo) != 0ull) {
        const float alpha = __builtin_amdgcn_exp2f(mo - mn);
        st.l *= alpha;
#pragma unroll
        for (int i = 0; i < 16; ++i) { st.o0[i] *= alpha; st.o1[i] *= alpha; }
    }
    st.l += ls;
    u32x4 w0, w1;
    w0.x = pk2(s[0], s[1]); w0.y = pk2(s[2], s[3]); w0.z = pk2(s[4], s[5]); w0.w = pk2(s[6], s[7]);
    w1.x = pk2(s[8], s[9]); w1.y = pk2(s[10], s[11]); w1.z = pk2(s[12], s[13]); w1.w = pk2(s[14], s[15]);
    const bf16x8 p0 = __builtin_bit_cast(bf16x8, w0), p1 = __builtin_bit_cast(bf16x8, w1);
    st.o0 = __builtin_amdgcn_mfma_f32_32x32x16_bf16(f.v[0][0], p0, st.o0, 0, 0, 0);
    st.o0 = __builtin_amdgcn_mfma_f32_32x32x16_bf16(f.v[0][1], p1, st.o0, 0, 0, 0);
    st.o1 = __builtin_amdgcn_mfma_f32_32x32x16_bf16(f.v[1][0], p0, st.o1, 0, 0, 0);
    st.o1 = __builtin_amdgcn_mfma_f32_32x32x16_bf16(f.v[1][1], p1, st.o1, 0, 0, 0);
}
__device__ __forceinline__ void attn_store(const AttnState& st, bf16_t* orow  , int hf) {
    const float lt = st.l + __shfl_xor(st.l, 32);
    const float inv = 1.0f / lt;
#pragma unroll
    for (int g = 0; g < 4; ++g) {
        u32x2 a, b;
        a.x = pk2(st.o0[4 * g] * inv, st.o0[4 * g + 1] * inv); a.y = pk2(st.o0[4 * g + 2] * inv, st.o0[4 * g + 3] * inv);
        b.x = pk2(st.o1[4 * g] * inv, st.o1[4 * g + 1] * inv); b.y = pk2(st.o1[4 * g + 2] * inv, st.o1[4 * g + 3] * inv);
        *(u32x2*)(orow + 8 * g + 4 * hf) = a;
        *(u32x2*)(orow + 32 + 8 * g + 4 * hf) = b;
    }
}
struct AttnPtrs { const bf16_t *Q, *K, *Vt, *Kc, *Vtc; bf16_t* Abr; };
constexpr int PA_K_BYTES = 256 * 128, PA_V_BYTES = 64 * 512;
struct StageRegs { u32x4 kv[4], vv[4]; };
__device__ __forceinline__ void attn_stage_load(StageRegs& R, const bf16_t* ksrc, const bf16_t* vsrc, int vld, int nkeys, int tid) {
    const int nch = nkeys * 8, sh = nkeys == 256 ? 5 : 3;
#pragma unroll
    for (int i = 0; i < 4; ++i) { int q = tid + 512 * i; q = q < nch ? q : nch - 1;
        R.kv[i] = *(const u32x4*)(ksrc + (size_t)(q >> 3) * NAW + 8 * (q & 7));
        R.vv[i] = *(const u32x4*)(vsrc + (size_t)(q >> sh) * vld + 8 * (q & ((1 << sh) - 1))); }
}
__device__ __forceinline__ void attn_stage_store(const StageRegs& R, int nkeys, LAS unsigned char* kl, LAS unsigned char* vl, int tid) {
    const int nch = nkeys * 8, sh = nkeys == 256 ? 5 : 3;
#pragma unroll
    for (int i = 0; i < 4; ++i) { const int q = tid + 512 * i; if (q < nch) {
        const int key = q >> 3, c = q & 7, d = q >> sh, cv = q & ((1 << sh) - 1);
        *(LAS u32x4*)(kl + key * 128 + ((c ^ (key & 7)) << 4)) = R.kv[i];
        *(LAS u32x4*)(vl + d * 512 + ((cv ^ (d & 15)) << 4)) = R.vv[i]; } }
}
__device__ __forceinline__ void attn_lds_frag(KVFrag& f, const LAS unsigned char* kl, const LAS unsigned char* vl, int kt, int r32, int hf) {
    const int key = 32 * kt + r32;
#pragma unroll
    for (int s = 0; s < 4; ++s) f.k[s] = *(const LAS bf16x8*)(kl + key * 128 + (((2 * s + hf) ^ (key & 7)) << 4));
#pragma unroll
    for (int dt = 0; dt < 2; ++dt)
#pragma unroll
        for (int ks = 0; ks < 2; ++ks) { const int d = 32 * dt + r32; f.v[dt][ks] = *(const LAS bf16x8*)(vl + d * 512 + (((4 * kt + 2 * ks + hf) ^ (d & 15)) << 4)); }
}
__device__ __forceinline__ void attn_prompt_lds(const AttnPtrs& P, const LAS unsigned char* kl, const LAS unsigned char* vl, int bh, int qt, int lane) {
    const int r32 = lane & 31, hf = lane >> 5, b = bh >> 3, h = bh & 7;
    const int qrow = b * 256 + qt * 32 + r32;
    bf16x8 qf[4];
#pragma unroll
    for (int s = 0; s < 4; ++s) qf[s] = *(const bf16x8*)(P.Q + (size_t)qrow * NAW + h * 64 + 16 * s + 8 * hf);
    AttnState st; st.m = -1e30f; st.l = 0.f;
#pragma unroll
    for (int i = 0; i < 16; ++i) { st.o0[i] = 0.f; st.o1[i] = 0.f; }
    KVFrag fa, fb;
    attn_lds_frag(fa, kl, vl, 0, r32, hf);
#pragma unroll 1
    for (int t = 0; t < 8; t += 2) {
        attn_lds_frag(fb, kl, vl, t + 1, r32, hf);
        attn_tile(st, qf, fa, false, nullptr, 0, 0, 0);
        if (t + 2 < 8) attn_lds_frag(fa, kl, vl, t + 2, r32, hf);
        attn_tile(st, qf, fb, false, nullptr, 0, 0, 0);
    }
    attn_store(st, P.Abr + (size_t)qrow * D + h * 64, hf);
}
constexpr int ATT_PART_FLOATS = 34 * 64;
__device__ __forceinline__ void attn_sample_block(const AttnPtrs& P, LAS unsigned char* kl, LAS unsigned char* vl, const LAS float* rpl, LAS float* parts, int blk, int wave, int lane) {
    const int r32 = lane & 31, hf = lane >> 5, tid = wave * 64 + lane;
    const int bs = blk >> 6, h = (blk >> 3) & 7, i2 = (blk & 7) * 2;
    const int u = wave >> 1, half = wave & 1, r = i2 + (u >> 1), qh = u & 1;
    const int qrow = MP + bs * 1024 + r * 64 + qh * 32 + r32;
    const int cq = qh * 32 + r32; int cs = cq - 8; cs = cs < 0 ? 0 : (cs > 48 ? 48 : cs);
    int rs = r - 4; rs = rs < 0 ? 0 : (rs > 8 ? 8 : rs);
    int rs0 = i2 - 4; rs0 = rs0 < 0 ? 0 : (rs0 > 8 ? 8 : rs0);
    int rs1 = i2 - 3; rs1 = rs1 < 0 ? 0 : (rs1 > 8 ? 8 : rs1);
    const int nstage = rs1 != rs0 ? 4 : 3;
    const bf16_t* kloc = P.K + (size_t)(MP + bs * 1024) * NAW + h * 64;
    const bf16_t* vloc = P.Vt + VT_SAMPLE_OFF + (size_t)((bs * 8 + h) * 64) * 1024;
    bf16x8 qf[4];
#pragma unroll
    for (int s = 0; s < 4; ++s) qf[s] = *(const bf16x8*)(P.Q + (size_t)qrow * NAW + h * 64 + 16 * s + 8 * hf);
    AttnState st; st.m = -1e30f; st.l = 0.f;
#pragma unroll
    for (int i = 0; i < 16; ++i) { st.o0[i] = 0.f; st.o1[i] = 0.f; }
    LAS float* part = parts + u * ATT_PART_FLOATS;
    StageRegs R;
    attn_stage_load(R, P.Kc + (size_t)(bs * 256) * NAW + h * 64, P.Vtc + (size_t)((bs * 8 + h) * 64) * 256, 256, 256, tid);
#pragma unroll 1
    for (int sg = 0; sg < nstage; ++sg) {
        if (sg) __syncthreads();
        const int row0 = rs0 + 4 * (sg - 1);
        attn_stage_store(R, sg == 3 ? 64 : 256, kl, vl, tid);
        { const int sn = sg + 1 < nstage ? sg + 1 : 1, rown = rs0 + 4 * (sn - 1);
          attn_stage_load(R, kloc + (size_t)(rown * 64) * NAW, vloc + rown * 64, 1024, sn == 3 ? 64 : 256, tid); }
        LDS_WAIT(); __syncthreads();
        KVFrag f;
        if (sg == 0) {
#pragma unroll 1
            for (int kt = 4 * half; kt < 4 * half + 4; ++kt) { attn_lds_frag(f, kl, vl, kt, r32, hf); attn_tile(st, qf, f, false, nullptr, 0, 0, 0); }
        } else {
            const int nt = sg == 3 ? 2 : 8;
#pragma unroll 1
            for (int kt = half * (nt >> 1); kt < (half + 1) * (nt >> 1); ++kt) {
                const int jr = row0 + (kt >> 1), ch = kt & 1;
                if (jr < rs || jr >= rs + 8) continue;
                attn_lds_frag(f, kl, vl, kt, r32, hf);
                attn_tile(st, qf, f, true, rpl + (h * 15 + (jr - r + 7)) * 31, cq, cs, ch * 32 + 4 * hf);
            }
        }
    }
    if (half == 1) {
#pragma unroll
        for (int i = 0; i < 16; ++i) { part[i * 64 + lane] = st.o0[i]; part[(16 + i) * 64 + lane] = st.o1[i]; }
        part[32 * 64 + lane] = st.m; part[33 * 64 + lane] = st.l;
    }
    LDS_WAIT(); __syncthreads();
    if (half == 0) {
        const float m1 = part[32 * 64 + lane], l1 = part[33 * 64 + lane];
        const float mn = fmaxf(st.m, m1), a0 = __builtin_amdgcn_exp2f(st.m - mn), a1 = __builtin_amdgcn_exp2f(m1 - mn);
        st.l = st.l * a0 + l1 * a1;
#pragma unroll
        for (int i = 0; i < 16; ++i) { st.o0[i] = st.o0[i] * a0 + part[i * 64 + lane] * a1; st.o1[i] = st.o1[i] * a0 + part[(16 + i) * 64 + lane] * a1; }
        attn_store(st, P.Abr + (size_t)qrow * D + h * 64, hf);
    }
}

struct PcPtrs { const bf16_t *Pin, *Cin; const float *wdw, *bdw, *cng, *cnb; bf16_t* Abr; };
__device__ __forceinline__ f32x4 ld_bf4(const bf16_t* p) { const u32x2 w = *(const u32x2*)p; return (f32x4){bf_lo(w.x), bf_hi(w.x), bf_lo(w.y), bf_hi(w.y)}; }
__device__ __forceinline__ f32x4 up_bf4(u32x2 w) { return (f32x4){bf_lo(w.x), bf_hi(w.x), bf_lo(w.y), bf_hi(w.y)}; }
__device__ __forceinline__ void pool_unit(const PcPtrs& P, int unit, int lane) {
    const int row0 = unit * 8;
    const int L = row0 < MP ? 256 : 1024;
    const int sb = row0 < MP ? (row0 & ~255) : MP + ((row0 - MP) & ~1023);
    const int hw = 1 << (lane >> 4);
    const int t0 = row0 - sb;
    u32x2 pv[24];
#pragma unroll
    for (int i = 0; i < 24; ++i) { int t = t0 - 8 + i; t = t < 0 ? 0 : (t > L - 1 ? L - 1 : t); pv[i] = *(const u32x2*)(P.Pin + (size_t)(sb + t) * PW + 4 * lane); }
#pragma unroll
    for (int tt = 0; tt < 8; ++tt) {
        f32x4 sum = {0.f, 0.f, 0.f, 0.f}; float cnt = 0.f;
#pragma unroll
        for (int o = -8; o < 8; ++o) {
            const int t = t0 + tt + o;
            const bool in = (o >= -hw) && (o < hw) && (t >= 0) && (t < L);
            const f32x4 v = up_bf4(pv[tt + o + 8]);
            sum += in ? v : (f32x4){0.f, 0.f, 0.f, 0.f}; cnt += in ? 1.f : 0.f;
        }
        const f32x4 r = sum * __builtin_amdgcn_rcpf(cnt) - up_bf4(pv[tt + 8]);
        u32x2 w; w.x = pk2(r[0], r[1]); w.y = pk2(r[2], r[3]);
        *(u32x2*)(P.Abr + (size_t)(row0 + tt) * D + 512 + 4 * lane) = w;
    }
}
__device__ __forceinline__ void conv_unit(const PcPtrs& P, const LAS float* wl, int unit, int lane) {
    constexpr int T = 8;
    const int row0 = unit * T;
    const int L = row0 < MP ? 256 : 1024;
    const int sb = row0 < MP ? (row0 & ~255) : MP + ((row0 - MP) & ~1023);
    const int t0 = row0 - sb;
    f32x4 acc[T];
    const f32x4 bias = *(const f32x4*)(P.bdw + 4 * lane);
#pragma unroll
    for (int tt = 0; tt < T; ++tt) acc[tt] = bias;
#pragma unroll 1
    for (int c = 0; c < 2; ++c) {
        u32x2 ar[20], gr[20];
#pragma unroll
        for (int i = 0; i < 20; ++i) {
            const int t = t0 - 15 + 20 * c + i;
            const bool ok = (t >= 0) && (t < L);
            const bf16_t* p = P.Cin + (size_t)(sb + (ok ? t : 0)) * 512 + 4 * lane;
            ar[i] = *(const u32x2*)p; gr[i] = *(const u32x2*)(p + 256);
            if (!ok) { ar[i] = (u32x2){0u, 0u}; }
        }
#pragma unroll
        for (int g4 = 0; g4 < 5; ++g4) {
            const int s0 = 20 * c + 4 * g4;
            f32x4 tp[11];
#pragma unroll
            for (int q = 0; q < 11; ++q) tp[q] = *(const LAS f32x4*)(wl + (s0 + q) * CW + 4 * lane);
#pragma unroll
            for (int i = 0; i < 4; ++i) {
                const f32x4 a = up_bf4(ar[4 * g4 + i]), g = up_bf4(gr[4 * g4 + i]);
                f32x4 hh;
#pragma unroll
                for (int e = 0; e < 4; ++e) hh[e] = a[e] * sigmoidf_(g[e]);
#pragma unroll
                for (int tt = 0; tt < T; ++tt) acc[tt] += hh * tp[i - tt + 7];
            }
            asm volatile("" ::: "memory");
        }
    }
    const f32x4 lg = *(const f32x4*)(P.cng + 4 * lane), lb = *(const f32x4*)(P.cnb + 4 * lane);
    float s1[T], s2[T];
#pragma unroll
    for (int tt = 0; tt < T; ++tt) s1[tt] = (acc[tt][0] + acc[tt][1]) + (acc[tt][2] + acc[tt][3]);
#pragma unroll
    for (int o = 1; o < 64; o <<= 1)
#pragma unroll
        for (int tt = 0; tt < T; ++tt) s1[tt] += __shfl_xor(s1[tt], o);
#pragma unroll
    for (int tt = 0; tt < T; ++tt) { const float mu = s1[tt] * (1.0f / CW); acc[tt] = acc[tt] - mu; s2[tt] = (acc[tt][0] * acc[tt][0] + acc[tt][1] * acc[tt][1]) + (acc[tt][2] * acc[tt][2] + acc[tt][3] * acc[tt][3]); }
#pragma unroll
    for (int o = 1; o < 64; o <<= 1)
#pragma unroll
        for (int tt = 0; tt < T; ++tt) s2[tt] += __shfl_xor(s2[tt], o);
#pragma unroll
    for (int tt = 0; tt < T; ++tt) {
        const float rstd = 1.0f / sqrtf(s2[tt] * (1.0f / CW) + EPS);
        f32x4 y = acc[tt] * rstd * lg + lb;
#pragma unroll
        for (int e = 0; e < 4; ++e) y[e] = y[e] * sigmoidf_(y[e]);
        u32x2 o; o.x = pk2(y[0], y[1]); o.y = pk2(y[2], y[3]);
        *(u32x2*)(P.Abr + (size_t)(row0 + tt) * D + 768 + 4 * lane) = o;
    }
}

#define XB_TMO      128
#define XB_XCNT(j)  (256  + 64 * (j))
#define XB_XSUB(j)  (1280 + 64 * (j))
#define XB_XGEN(j)  (2304 + 64 * (j))
#define XB_TOP      3328
#define XB_TOPGEN   3392
#define XB_LCNT(j)  (3456 + 64 * (j))
#define XB_MISMATCH 4480
#define XCD_BAR_WORDS 4544
#define XB_SPIN_CAP (1u << 18)
__device__ __forceinline__ unsigned xb_ld(unsigned* p)              { return __hip_atomic_load(p, __ATOMIC_RELAXED, __HIP_MEMORY_SCOPE_AGENT); }
__device__ __forceinline__ unsigned xb_add(unsigned* p, unsigned v) { return __hip_atomic_fetch_add(p, v, __ATOMIC_RELAXED, __HIP_MEMORY_SCOPE_AGENT); }
__device__ __forceinline__ unsigned xb_xcc_id() { return (unsigned)__builtin_amdgcn_s_getreg((3 << 11) | 20) & 0xFu; }
#define XB_SPIN(cond, bar) do { unsigned _sp = 0; while (cond) { __builtin_amdgcn_s_sleep(1); \
    if ((++_sp & 255u) == 0u) { if (xb_ld(&(bar)[XB_TMO])) break; if (_sp > XB_SPIN_CAP) { atomicAdd(&(bar)[XB_TMO], 1u); break; } } } } while (0)
struct XcdBarrier { unsigned* bar; unsigned x; unsigned nloc, nx; };
#define XB_LOCAL_OK 0x80000000u
__device__ __forceinline__ XcdBarrier xcd_barrier_post(unsigned* bar) {
    XcdBarrier b; b.bar = bar; b.x = xb_xcc_id(); b.nloc = 0u; b.nx = 0u;
    asm volatile("" : "+s"(b.x));
    if (threadIdx.x == 0) {
        if (b.x != (blockIdx.x & 7u) || gridDim.x != 256u) { (void)xb_add(&bar[XB_MISMATCH], 1u); asm volatile("s_waitcnt vmcnt(0)" ::: "memory"); }
        (void)xb_add(&bar[XB_XCNT(b.x)], 1u);
    }
    return b;
}
__device__ __forceinline__ void xcd_barrier_complete(unsigned* bar, unsigned x, unsigned& nloc, unsigned& nx) {
    asm volatile("" : "+s"(bar));
    const unsigned G = gridDim.x * gridDim.y * gridDim.z;
    unsigned sum, cnt, mine, sp = 0u;
    for (;;) {
        sum = 0u; cnt = 0u; mine = 0u;
#pragma unroll
        for (unsigned j = 0; j < 16; ++j) { const unsigned c = xb_ld(&bar[XB_XCNT(j)]); sum += c; cnt += (c > 0u) ? 1u : 0u; mine = (j == x) ? c : mine; }
        if (sum == G) break;
        __builtin_amdgcn_s_sleep(1);
        if ((++sp & 255u) == 0u) { if (xb_ld(&bar[XB_TMO])) break; if (sp > XB_SPIN_CAP) { atomicAdd(&bar[XB_TMO], 1u); break; } }
    }
    nloc = mine > 0u ? mine : 1u; nx = cnt > 0u ? cnt : 1u;
}
__device__ __forceinline__ void xcd_barrier_t0(XcdBarrier& b) {
    {
        unsigned* bar = b.bar; asm volatile("" : "+s"(bar));
        unsigned bx_ = b.x; asm volatile("" : "+s"(bx_));
        __builtin_amdgcn_s_waitcnt(0);
        unsigned nloc = b.nloc, nx = b.nx;
        if (nloc == 0u) { xcd_barrier_complete(bar, bx_, nloc, nx); b.nloc = nloc; b.nx = nx | ((nloc == 32u && xb_ld(&bar[XB_MISMATCH]) == 0u) ? XB_LOCAL_OK : 0u); }
        nx &= ~XB_LOCAL_OK;
        const unsigned old = xb_add(&bar[XB_XSUB(bx_)], 1u);
        const unsigned gen = old / nloc;
        if (old + 1u == (gen + 1u) * nloc) {
            __builtin_amdgcn_fence(__ATOMIC_RELEASE, "agent");
            asm volatile("s_waitcnt vmcnt(0)" ::: "memory");
            const unsigned og = xb_add(&bar[XB_TOP], 1u);
            const unsigned tg = og / nx;
            if (og + 1u == (tg + 1u) * nx) xb_add(&bar[XB_TOPGEN], 1u);
            else XB_SPIN(xb_ld(&bar[XB_TOPGEN]) == tg, bar);
            __builtin_amdgcn_fence(__ATOMIC_ACQUIRE, "agent");
            xb_add(&bar[XB_XGEN(bx_)], 1u);
            asm volatile("s_waitcnt vmcnt(0)" ::: "memory");
        } else {
            XB_SPIN(xb_ld(&bar[XB_XGEN(bx_)]) == gen, bar);
            __builtin_amdgcn_fence(__ATOMIC_ACQUIRE, "agent");
            asm volatile("s_waitcnt vmcnt(0)" ::: "memory");
        }
    }
}
__device__ __forceinline__ void xcd_barrier(XcdBarrier& b) {
    asm volatile("s_waitcnt vmcnt(0)" ::: "memory");
    __syncthreads();
    if (threadIdx.x == 0) xcd_barrier_t0(b);
    b.nloc = __builtin_amdgcn_readfirstlane(b.nloc); b.nx = __builtin_amdgcn_readfirstlane(b.nx);
    __syncthreads();
}
__device__ __forceinline__ void xcd_local_barrier(XcdBarrier& b, unsigned k  ) {
    asm volatile("s_waitcnt vmcnt(0)" ::: "memory");
    __syncthreads();
    if (threadIdx.x == 0) {
        if (b.nx & XB_LOCAL_OK) {
            __builtin_amdgcn_s_waitcnt(0);
            unsigned* lb = b.bar; asm volatile("" : "+s"(lb));
            unsigned lx = b.x; asm volatile("" : "+s"(lx));
            unsigned* c = &lb[XB_LCNT(lx)];
            const unsigned target = k * 32u;
            (void)xb_add(c, 1u);
            XB_SPIN(xb_ld(c) < target, lb);
            __builtin_amdgcn_fence(__ATOMIC_ACQUIRE, "agent");
            asm volatile("s_waitcnt vmcnt(0)" ::: "memory");
        } else xcd_barrier_t0(b);
    }
    b.nloc = __builtin_amdgcn_readfirstlane(b.nloc); b.nx = __builtin_amdgcn_readfirstlane(b.nx);
    __syncthreads();
}

constexpr int TP_PITCH = 65, TP_BYTES = 64 * TP_PITCH * 4;
template <bool WITH_C, bool GU_PERM>
__device__ __forceinline__ void transpose_item(const float* W, int N, bf16_t* WT, int ldt, int kcol0, LAS float* scr, int item, int lane,
                                               const float* shraw  , const float* shb  , float* csum  ) {
    const int nblk = N / 64, kb = item / nblk, nb = item % nblk, k0 = 64 * kb, n0 = 64 * nb;
    {
        const int r4 = lane >> 4, c4 = lane & 15;
        f32x4 v[16];
#pragma unroll
        for (int i = 0; i < 16; ++i) v[i] = __builtin_nontemporal_load((const f32x4*)(W + (size_t)(k0 + 4 * i + r4) * N + n0 + 4 * c4));
#pragma unroll
        for (int i = 0; i < 16; ++i) { LAS float* p = scr + (4 * i + r4) * TP_PITCH + 4 * c4; p[0] = v[i][0]; p[1] = v[i][1]; p[2] = v[i][2]; p[3] = v[i][3]; }
    }
    const int c = lane & 7, nn = lane >> 3;
    f32x4 sh[3][2];
    if (WITH_C) {
#pragma unroll
        for (int r = 0; r < 3; ++r)
#pragma unroll
            for (int h = 0; h < 2; ++h) sh[r][h] = *(const f32x4*)(shraw + (size_t)r * NMOD + k0 + 8 * c + 4 * h) + *(const f32x4*)(shb + k0 + 8 * c + 4 * h);
    }
    LDS_WAIT(); asm volatile("" ::: "memory");
#pragma unroll
    for (int j = 0; j < 8; ++j) {
        const int n = 8 * j + nn; const LAS float* s = scr + (8 * c) * TP_PITCH + n;
        float w[8];
#pragma unroll
        for (int q = 0; q < 8; ++q) w[q] = s[q * TP_PITCH];
        u32x4 o; o.x = pk2(w[0], w[1]); o.y = pk2(w[2], w[3]); o.z = pk2(w[4], w[5]); o.w = pk2(w[6], w[7]);
        int nrow = n0 + n;
        if (GU_PERM) nrow = nrow < FFN ? ((nrow >> 7) * 256 + (nrow & 127)) : (((nrow - FFN) >> 7) * 256 + 128 + ((nrow - FFN) & 127));
        *(u32x4*)(WT + (size_t)nrow * ldt + kcol0 + k0 + 8 * c) = o;
        if (WITH_C) {
            float d0 = 0.f, d1 = 0.f, d2 = 0.f;
#pragma unroll
            for (int q = 0; q < 8; ++q) { d0 += sh[0][q >> 2][q & 3] * w[q]; d1 += sh[1][q >> 2][q & 3] * w[q]; d2 += sh[2][q >> 2][q & 3] * w[q]; }
#pragma unroll
            for (int x = 1; x < 8; x <<= 1) { d0 += __shfl_xor(d0, x); d1 += __shfl_xor(d1, x); d2 += __shfl_xor(d2, x); }
            if (c == 0) { atomicAdd(csum + n0 + n, d0); atomicAdd(csum + N + n0 + n, d1); atomicAdd(csum + 2 * N + n0 + n, d2); }
        }
    }
    LDS_WAIT(); asm volatile("" ::: "memory");
}

constexpr int NWAVES = 8;
constexpr int I_IN = 16 * (NIN / 64), I_GU = 16 * (NGU / 64), I_DN = (FFN / 64) * 16, I_OUT = 16 * 16, I_OA = 8 * 16, I_OC = 4 * 16;
constexpr int I_LAYER = I_IN + I_GU + I_DN + I_OUT + I_OA + I_OC;
#ifndef MK_TAIL
#define MK_TAIL I_LAYER
#endif
constexpr int I_TAIL = MK_TAIL, I_HEAD = I_LAYER - I_TAIL;
constexpr int I_MIX = (I_TAIL >= 512) ? 512 : 0;
#ifndef MK_BG1
#define MK_BG1 1536
#endif
constexpr int I_BG1 = MK_BG1;
static_assert(I_HEAD + I_BG1 <= I_LAYER - I_MIX, "background split");
#define TRANSPOSE_LAYER_ITEM(l_, r0_, scr_, lane_) do { const int tl_ = (l_); int tr_ = (r0_); \
        const float* shraw1_ = MODRAW + (size_t)(tl_ * 3) * NMOD; const float* shraw2_ = MODRAW + (size_t)(tl_ * 3) * NMOD + 3 * D; \
        if (tr_ < I_IN) { transpose_item<true, false>(w_in + (size_t)tl_ * D * NIN, NIN, WIN + (size_t)tl_ * NIN * D, D, 0, scr_, tr_, lane_, shraw1_, b_mod + (size_t)tl_ * NMOD, C1 + (size_t)(tl_ * 3) * NIN); break; } tr_ -= I_IN; \
        if (tr_ < I_GU) { transpose_item<true, true>(w_gu + (size_t)tl_ * D * NGU, NGU, WGU + (size_t)tl_ * NGU * D, D, 0, scr_, tr_, lane_, shraw2_, b_mod + (size_t)tl_ * NMOD + 3 * D, C2 + (size_t)(tl_ * 3) * NGU); break; } tr_ -= I_GU; \
        if (tr_ < I_DN) { transpose_item<false, false>(w_down + (size_t)tl_ * FFN * D, D, WDN + (size_t)tl_ * D * FFN, FFN, 0, scr_, tr_, lane_, nullptr, nullptr, nullptr); break; } tr_ -= I_DN; \
        if (tr_ < I_OUT) { transpose_item<false, false>(w_out + (size_t)tl_ * D * D, D, WOUT + (size_t)tl_ * D * D, D, 0, scr_, tr_, lane_, nullptr, nullptr, nullptr); break; } tr_ -= I_OUT; \
        if (tr_ < I_OA) { transpose_item<false, false>(w_oa + (size_t)tl_ * NAW * D, D, WBR + (size_t)tl_ * D * D, D, 0, scr_, tr_, lane_, nullptr, nullptr, nullptr); break; } tr_ -= I_OA; \
        transpose_item<false, false>(w_oc + (size_t)tl_ * CW * D, D, WBR + (size_t)tl_ * D * D, D, 768, scr_, tr_, lane_, nullptr, nullptr, nullptr); } while (0)
constexpr int LDS_BYTES = 163840;
static_assert(8 * TP_BYTES <= LDS_BYTES, "LDS map");
constexpr int NPHASE = 2 + 6 * DEPTH + 1;

struct Args {
    const float* in[26]; float* out; unsigned char* ws; int ph_lo, ph_hi;
};

__global__ void __launch_bounds__(NWAVES * 64, 2) fwd_kernel(Args args) {
    extern __shared__ __attribute__((aligned(16))) unsigned char lds_raw[];
    LAS unsigned char* lds = (LAS unsigned char*)lds_raw;
    const int tid = threadIdx.x, lane = tid & 63, wave = __builtin_amdgcn_readfirstlane(tid >> 6);
    const int G = gridDim.x, bx = blockIdx.x;
    const int vcu = (G % 8 == 0) ? (bx % 8) * (G / 8) + bx / 8 : bx;
    const int gw = vcu * NWAVES + wave, NGW = G * NWAVES;
    typedef const Args __attribute__((address_space(4))) * ArgsP;
    ArgsP KAP = (ArgsP)__builtin_amdgcn_kernarg_segment_ptr();
#define PHASE_PTRS() asm volatile("" : "+s"(KAP))
#define WSB (KAP->ws)
#define ctlf ((float*)(WSB + WS_CTL))
#define x_prompt (KAP->in[0])
#define x_sample (KAP->in[1])
#define cache_k (KAP->in[2])
#define cache_v (KAP->in[3])
#define cvec (KAP->in[4])
#define c_ctx (KAP->in[5])
#define w_mod (KAP->in[6])
#define b_mod (KAP->in[7])
#define norm1_g (KAP->in[8])
#define norm2_g (KAP->in[9])
#define w_in (KAP->in[10])
#define b_gate (KAP->in[11])
#define rpb (KAP->in[12])
#define w_oa (KAP->in[13])
#define w_pool (KAP->in[14])
#define pool_scale (KAP->in[15])
#define w_ob (KAP->in[16])
#define w_dw (KAP->in[17])
#define b_dw (KAP->in[18])
#define conv_norm_g (KAP->in[19])
#define conv_norm_b (KAP->in[20])
#define w_oc (KAP->in[21])
#define w_out (KAP->in[22])
#define w_gu (KAP->in[23])
#define w_down (KAP->in[24])
#define final_g (KAP->in[25])
#define MODRAW (ctlf + CF_MODRAW)
#define C1 (ctlf + CF_C1)
#define C2 (ctlf + CF_C2)
#define RSS (ctlf + CF_RSS)
#define MODT ((float*)(WSB + WS_MODT))
#define WIN ((bf16_t*)(WSB + WS_WIN))
#define WGU ((bf16_t*)(WSB + WS_WGU))
#define WDN ((bf16_t*)(WSB + WS_WDN))
#define WBR ((bf16_t*)(WSB + WS_WBR))
#define WOUT ((bf16_t*)(WSB + WS_WOUT))
#define X ((float*)(WSB + WS_X))
#define XG ((bf16_t*)(WSB + WS_XG))
#define Qb ((bf16_t*)(WSB + WS_Q))
#define Kb ((bf16_t*)(WSB + WS_K))
#define VT ((bf16_t*)(WSB + WS_VT))
#define KC ((bf16_t*)(WSB + WS_KC))
#define VTC ((bf16_t*)(WSB + WS_VTC))
#define PIN ((bf16_t*)(WSB + WS_PIN))
#define CIN ((bf16_t*)(WSB + WS_CIN))
#define GT ((bf16_t*)(WSB + WS_G))
#define ABR ((bf16_t*)(WSB + WS_ABR))
#define MF ((float*)(WSB + WS_MF))
#define MB ((bf16_t*)(WSB + WS_MB))
#define ACT ((bf16_t*)(WSB + WS_ACT))

#if !MK_PER_PHASE
    XcdBarrier bar = xcd_barrier_post((unsigned*)(args.ws + WS_CTL) + CW_BAR);
#define GRID_BAR() xcd_barrier(bar)
#define LOCAL_BAR(k) xcd_local_barrier(bar, (unsigned)(k))
#else
#define GRID_BAR() do {} while (0)
#define LOCAL_BAR(k) do {} while (0)
#endif
    const int lo = args.ph_lo, hi = args.ph_hi;
#define IN(k) (lo <= (k) && (k) < hi)
#define SEAM(k) do { if (IN(k) && IN((k) + 1)) GRID_BAR(); } while (0)
#define SEAML(k, n) do { if (IN(k) && IN((k) + 1)) LOCAL_BAR(n); } while (0)

    for (int rep_ = 0; rep_ < MK_REPS(4); ++rep_) { if (rep_) GRID_BAR();
    float* MODRAW_W = rep_ ? MF : MODRAW; float* C1_W = rep_ ? MF + DEPTH * 3 * NMOD : C1; float* C2_W = rep_ ? MF + DEPTH * 3 * (NMOD + NIN) : C2;
    if (IN(0)) { PHASE_PTRS();
        LAS float* sil = (LAS float*)lds; LAS float* red = (LAS float*)(lds + 16384);
        for (int i = tid; i < 3 * D; i += NWAVES * 64) { const float s = i < D ? c_ctx[i] : cvec[i - D]; sil[i] = s * sigmoidf_(s); }
        __syncthreads();
        for (int it = vcu; it < DEPTH * 24 * 8; it += G) {
            const int l = it / 192, rem = it % 192, nc = rem >> 3, kq = rem & 7, k0 = kq * 128 + wave * 16, n0 = nc * 256 + 4 * lane;
            const float* wp = w_mod + ((size_t)l * D + k0) * NMOD + n0;
            f32x4 w[16];
#pragma unroll
            for (int kk = 0; kk < 16; ++kk) w[kk] = __builtin_nontemporal_load((const f32x4*)(wp + (size_t)kk * NMOD));
            f32x4 a0 = {0.f, 0.f, 0.f, 0.f}, a1 = a0, a2 = a0;
#pragma unroll
            for (int kk = 0; kk < 16; ++kk) { a0 += sil[k0 + kk] * w[kk]; a1 += sil[D + k0 + kk] * w[kk]; a2 += sil[2 * D + k0 + kk] * w[kk]; }
#pragma unroll
            for (int e = 0; e < 4; ++e) { red[(wave * 12 + e) * 64 + lane] = a0[e]; red[(wave * 12 + 4 + e) * 64 + lane] = a1[e]; red[(wave * 12 + 8 + e) * 64 + lane] = a2[e]; }
            __syncthreads();
            for (int o = tid; o < 12 * 64; o += NWAVES * 64) {
                float s = 0.f;
#pragma unroll
                for (int ww = 0; ww < 8; ++ww) s += red[ww * 768 + o];
                const int q = o >> 6, ln = o & 63, r = q >> 2, e = q & 3;
                atomicAdd(MODRAW_W + (size_t)(l * 3 + r) * NMOD + nc * 256 + 4 * ln + e, s);
            }
            __syncthreads();
        }
    }
    SEAM(0);

    if (IN(1)) { PHASE_PTRS();
        LAS float* scr = (LAS float*)(lds + wave * TP_BYTES);
        constexpr int I_T = I_LAYER + (DEPTH - 1) * I_HEAD;
        constexpr int I_OB = DEPTH * 16 * 4 * 8;
        constexpr int I_X = M;
        constexpr int I_KC = DEPTH * 2 * 256;
        constexpr int I_VC = DEPTH * 2 * 8 * 4;
        constexpr int I_MT = DEPTH * 3 * 6 * 4;
        constexpr int I_ALL = I_T + I_OB + I_X + I_KC + I_VC + I_MT;
        for (int it0 = gw; it0 < I_ALL; it0 += NGW) {
            int it = it0;
            if (it < I_T) {
                if (it < I_LAYER) TRANSPOSE_LAYER_ITEM(0, it, scr, lane);
                else if constexpr (I_HEAD > 0) { const int q = it - I_LAYER; TRANSPOSE_LAYER_ITEM(1 + q / I_HEAD, q % I_HEAD, scr, lane); }
                continue;
            }
            it -= I_T;
            if (it < I_OB) {
                const int l = it / 512, rem = it % 512, nch = rem >> 5, g = (rem >> 3) & 3, cc = rem & 7, n = nch * 64 + lane;
                float a[8];
#pragma unroll
                for (int c = 0; c < 8; ++c) a[c] = 0.f;
                const float* wp = w_pool + ((size_t)(l * 4 + g) * 64 + cc * 8) * 64;
                for (int d = 0; d < 64; ++d) {
                    const float wb = w_ob[((size_t)l * PW + g * 64 + d) * D + n] * pool_scale[l * PW + g * 64 + d];
#pragma unroll
                    for (int c = 0; c < 8; ++c) a[c] += wp[c * 64 + d] * wb;
                }
                u32x4 o; o.x = pk2(a[0], a[1]); o.y = pk2(a[2], a[3]); o.z = pk2(a[4], a[5]); o.w = pk2(a[6], a[7]);
                *(u32x4*)(WBR + ((size_t)l * D + n) * D + 512 + g * 64 + cc * 8) = o;
                continue;
            }
            it -= I_OB;
            if (it < I_X) {
                const int row = it, mr = row < MP ? 0 : 1 + ((row - MP) >> 10);
                const float* xr = row < MP ? x_prompt + (size_t)row * D : x_sample + (size_t)(row - MP) * D;
                float ss = 0.f;
#pragma unroll
                for (int j = 0; j < 4; ++j) {
                    const int col = 256 * j + 4 * lane;
                    const f32x4 v = *(const f32x4*)(xr + col);
                    *(f32x4*)(X + (size_t)row * D + col) = v;
                    ss += (v[0] * v[0] + v[1] * v[1]) + (v[2] * v[2] + v[3] * v[3]);
                    const f32x4 sc = *(const f32x4*)(MODRAW + (size_t)mr * NMOD + D + col) + *(const f32x4*)(b_mod + D + col);
                    const f32x4 gg = *(const f32x4*)(norm1_g + col) * (sc + 1.0f);
                    const f32x4 xs = v * gg;
                    u32x2 o; o.x = pk2(xs[0], xs[1]); o.y = pk2(xs[2], xs[3]);
                    *(u32x2*)(XG + (size_t)row * D + col) = o;
                }
                ss = wave_sum(ss);
                if (lane == 0) RSS[row] = ss;
                continue;
            }
            it -= I_X;
            if (it < I_KC) {
                const int l = it / 512, bs = (it >> 8) & 1, key = it & 255;
                const float* src = cache_k + (((size_t)(bs * DEPTH + l) * 256 + key) * 512) + 8 * lane;
                const f32x4 a = *(const f32x4*)src, b = *(const f32x4*)(src + 4);
                *(u32x4*)(KC + (((size_t)(l * 2 + bs) * 256 + key) * 512) + 8 * lane) = pk8(a, b);
                continue;
            }
            it -= I_KC;
            if (it < I_VC) {
                const int l = it / 64, bs = (it >> 5) & 1, h = (it >> 2) & 7, kb = it & 3, key = kb * 64 + lane;
                const float* src = cache_v + (((size_t)(bs * DEPTH + l) * 256 + key) * 512) + h * 64;
                bf16_t* dst = VTC + ((size_t)((l * 2 + bs) * 8 + h) * 64) * 256 + pos_of_key(key);
#pragma unroll
                for (int d4 = 0; d4 < 16; ++d4) {
                    const f32x4 v = *(const f32x4*)(src + 4 * d4);
                    const unsigned w0 = pk2(v[0], v[1]), w1 = pk2(v[2], v[3]);
                    dst[(size_t)(4 * d4 + 0) * 256] = (bf16_t)(w0 & 0xffff); dst[(size_t)(4 * d4 + 1) * 256] = (bf16_t)(w0 >> 16);
                    dst[(size_t)(4 * d4 + 2) * 256] = (bf16_t)(w1 & 0xffff); dst[(size_t)(4 * d4 + 3) * 256] = (bf16_t)(w1 >> 16);
                }
                continue;
            }
            it -= I_VC;
            {
                const int q = it & 3, which = (it >> 2) % 6, lr = it / 24, l = lr / 3, col = q * 256 + 4 * lane;
                const float* mraw = MODRAW + (size_t)lr * NMOD; const float* bm = b_mod + (size_t)l * NMOD;
                f32x4 v;
                if (which == 0) v = *(const f32x4*)(norm1_g + (size_t)l * D + col) * (*(const f32x4*)(mraw + D + col) + *(const f32x4*)(bm + D + col) + 1.0f);
                else if (which == 1) v = *(const f32x4*)(mraw + col) + *(const f32x4*)(bm + col);
                else if (which == 2) v = *(const f32x4*)(mraw + 2 * D + col) + *(const f32x4*)(bm + 2 * D + col);
                else if (which == 3) v = *(const f32x4*)(norm2_g + (size_t)l * D + col) * (*(const f32x4*)(mraw + 4 * D + col) + *(const f32x4*)(bm + 4 * D + col) + 1.0f);
                else if (which == 4) v = *(const f32x4*)(mraw + 3 * D + col) + *(const f32x4*)(bm + 3 * D + col);
                else v = *(const f32x4*)(mraw + 5 * D + col) + *(const f32x4*)(bm + 5 * D + col);
                *(f32x4*)(MODT + ((size_t)lr * 6 + which) * D + col) = v;
            }
        }
        LDS_WAIT(); __syncthreads();
    }
    }
    SEAM(1);

    for (int l = 0; l < DEPTH; ++l) {
        const int p0 = 2 + 6 * l;
        const float* modt_l = MODT + (size_t)l * 3 * 6 * D;
        for (int rep_ = 0; rep_ < MK_REPS(0); ++rep_) { if (rep_) GRID_BAR();
        if (IN(p0)) { PHASE_PTRS();
            pg8::Gemm g{XG, WIN + (size_t)l * NIN * D, D, D};
            pg8::TileOrder S; S.init(M, NIN, D, G, bx);
            EpiIn E{RSS + (size_t)(2 * l) * M, C1 + (size_t)(l * 3) * NIN, b_gate + (size_t)l * 3072, Qb, Kb, VT, PIN, CIN, GT,
                    args.out + OUT_K + (size_t)l * 256 * 512, args.out + OUT_V + (size_t)l * 256 * 512};
            pg8::gemm_phase<EpiIn, pg8::TileOrder>(lds, g, S, E);
        }
        }
        SEAM(p0);
        for (int rep_ = 0; rep_ < MK_REPS(1); ++rep_) { if (rep_) GRID_BAR();
        if (IN(p0 + 1)) { PHASE_PTRS();
            AttnPtrs AP{Qb, Kb, VT, KC + (size_t)l * 2 * 256 * 512, VTC + (size_t)l * 2 * 8 * 64 * 256, ABR};
            PcPtrs PP{PIN, CIN, w_dw + (size_t)l * CONVK * CW, b_dw + (size_t)l * CW, conv_norm_g + (size_t)l * CW, conv_norm_b + (size_t)l * CW, ABR};
            int lane_p = lane; asm volatile("" : "+v"(lane_p));
            if (vcu < 128) {
                LAS float* rpl = (LAS float*)(lds + 1024); LAS float* parts = (LAS float*)(lds + 16384);
                LAS unsigned char* kl = lds + 53248; LAS unsigned char* vl = kl + PA_K_BYTES;
                const float* rpb_l = rpb + (size_t)l * 8 * 15 * 31;
                for (int i = wave * 64 + lane_p; i < 8 * 15 * 31; i += NWAVES * 64) rpl[i] = rpb_l[i] * LOG2E;
                if (!(rep_ && MK_VAR == 1)) attn_sample_block(AP, kl, vl, rpl, parts, vcu, wave, lane_p);
                { const int pu = vcu * NWAVES + wave; if (pu < 768 && !(rep_ && (MK_VAR == 4 || MK_VAR == 5))) pool_unit(PP, pu, lane_p); }
            } else {
                LAS float* wl = (LAS float*)lds; LAS unsigned char* kl = lds + 49152; LAS unsigned char* vl = kl + PA_K_BYTES;
                const int bh = vcu - 128;
                for (int i = wave * 64 + lane_p; i < 47 * CW / 4; i += NWAVES * 64) { const int j = i / (CW / 4) - 7;
                    *(LAS f32x4*)(wl + 4 * i) = (j >= 0 && j < CONVK) ? *(const f32x4*)(PP.wdw + 4 * (i - 7 * (CW / 4))) : (f32x4){0.f, 0.f, 0.f, 0.f}; }
                { StageRegs R; attn_stage_load(R, AP.K + (size_t)((bh >> 3) * 256) * NAW + (bh & 7) * 64, AP.Vt + (size_t)(bh * 64) * 256, 256, 256, wave * 64 + lane_p); attn_stage_store(R, 256, kl, vl, wave * 64 + lane_p); }
                LDS_WAIT(); __syncthreads();
                if (!(rep_ && (MK_VAR == 2 || MK_VAR == 5))) attn_prompt_lds(AP, kl, vl, bh, wave, lane_p);
                { const int it = bh * NWAVES + wave;
                    if (it < 768) { if (!(rep_ && (MK_VAR == 3 || MK_VAR == 5))) conv_unit(PP, wl, it, lane_p); } }
                if (I_MIX > 0 && bh >= 96 && l + 1 < DEPTH && !rep_) {
                    __syncthreads();
                    LAS float* scr = (LAS float*)(lds + wave * TP_BYTES);
#pragma unroll 1
                    for (int r = I_LAYER - I_MIX + (bh - 96) * NWAVES + wave; r < I_LAYER; r += 32 * NWAVES) TRANSPOSE_LAYER_ITEM(l + 1, r, scr, lane_p);
                    LDS_WAIT();
                }
            }
            __syncthreads();
        }
        }
        SEAM(p0 + 1);
        const int t192 = (bx & 7) * 32 + (bx >> 3), pm192 = t192 >> 3, pn192 = t192 & 7;
        const bool has192 = (G == 256);
        for (int rep_ = 0; rep_ < MK_REPS(2); ++rep_) { if (rep_) GRID_BAR();
        if (IN(p0 + 2)) { PHASE_PTRS();
            EpiBranch192 E{GT, MB};
            if (has192) g192::gemm<EpiBranch192>(lds, ABR, D, WBR + (size_t)l * D * D, D, pm192, pn192, 16, E);
        }
        }
        SEAML(p0 + 2, 3 * l + 1);
        for (int rep_ = 0; rep_ < MK_REPS(5); ++rep_) { if (rep_) GRID_BAR();
        if (IN(p0 + 3)) { PHASE_PTRS();
            EpiRes192 E{rep_ ? MF : X, rep_ ? ACT : XG, modt_l + 2 * D, modt_l + 3 * D, rep_ ? (float*)ABR : RSS + (size_t)(2 * l + 1) * M};
            if (has192) g192::gemm<EpiRes192>(lds, MB, D, WOUT + (size_t)l * D * D, D, pm192, pn192, 16, E);
        }
        }
        SEAML(p0 + 3, 3 * l + 2);
        for (int rep_ = 0; rep_ < MK_REPS(3); ++rep_) { if (rep_) GRID_BAR();
        if (IN(p0 + 4)) { PHASE_PTRS();
            pg8::Gemm g{XG, WGU + (size_t)l * NGU * D, D, D};
            const bool bg = (I_TAIL > 0 && l + 1 < DEPTH && G == 256);
            const int nw = bg ? 232 : 256;
            pg8::TileOrderGU S; S.init(M, NGU, D, nw, bx);
            EpiGU E{RSS + (size_t)(2 * l + 1) * M, C2 + (size_t)(l * 3) * NGU, ACT};
            pg8::gemm_phase<EpiGU, pg8::TileOrderGU>(lds, g, S, E);
            if (bg && bx >= 128) {
                int lane_b = lane; asm volatile("" : "+v"(lane_b));
                LAS float* scr = (LAS float*)(lds + wave * TP_BYTES);
                const bool conv_only = bx >= nw;
                const int r0 = conv_only ? I_HEAD + (bx - 232) * NWAVES + wave : I_HEAD + I_BG1 + (bx - 128) * NWAVES + wave;
                const int r1 = conv_only ? I_HEAD + I_BG1 : I_LAYER - I_MIX, rs = conv_only ? 24 * NWAVES : 104 * NWAVES;
#pragma unroll 1
                for (int r = r0; r < r1; r += rs) TRANSPOSE_LAYER_ITEM(l + 1, r, scr, lane_b);
                LDS_WAIT(); __syncthreads();
            }
        }
        }
        SEAML(p0 + 4, 3 * l + 3);
        for (int rep_ = 0; rep_ < MK_REPS(6); ++rep_) { if (rep_) GRID_BAR();
        if (IN(p0 + 5)) { PHASE_PTRS();
            EpiRes192 E{rep_ ? MF : X, rep_ ? MB : XG, modt_l + 5 * D, MODT + (size_t)((l + 1) % DEPTH) * 3 * 6 * D, rep_ ? (float*)ABR : RSS + (size_t)(2 * l + 2) * M};
            if (has192) g192::gemm<EpiRes192>(lds, ACT, FFN, WDN + (size_t)l * D * FFN, FFN, pm192, pn192, FFN / 64, E);
        }
        }
        SEAM(p0 + 5);
    }
    if (IN(NPHASE - 1)) { PHASE_PTRS();
        for (int row = gw; row < M; row += NGW) {
            const float rinv = 1.0f / sqrtf(RSS[(size_t)8 * M + row] * (1.0f / D) + EPS);
#pragma unroll
            for (int j = 0; j < 4; ++j) {
                const int col = 256 * j + 4 * lane;
                const f32x4 v = *(const f32x4*)(X + (size_t)row * D + col) * rinv * *(const f32x4*)(final_g + col);
                __builtin_nontemporal_store(v, (f32x4*)(args.out + OUT_Y + (size_t)row * D + col));
            }
        }
    }
#undef IN
#undef PHASE_PTRS
#undef WSB
#undef ctlf
#undef x_prompt
#undef x_sample
#undef cache_k
#undef cache_v
#undef cvec
#undef c_ctx
#undef w_mod
#undef b_mod
#undef norm1_g
#undef norm2_g
#undef w_in
#undef b_gate
#undef rpb
#undef w_oa
#undef w_pool
#undef pool_scale
#undef w_ob
#undef w_dw
#undef b_dw
#undef conv_norm_g
#undef conv_norm_b
#undef w_oc
#undef w_out
#undef w_gu
#undef w_down
#undef final_g
#undef MODRAW
#undef C1
#undef C2
#undef RSS
#undef MODT
#undef WIN
#undef WGU
#undef WDN
#undef WBR
#undef WOUT
#undef X
#undef XG
#undef Qb
#undef Kb
#undef VT
#undef KC
#undef VTC
#undef PIN
#undef CIN
#undef GT
#undef ABR
#undef MF
#undef MB
#undef ACT
#undef SEAM
#undef SEAML
}

extern "C" void kernel_launch(void* const* d_in, const int* in_sizes, int n_in, void* d_out, int out_size, void* d_ws, size_t ws_size, hipStream_t stream) {
    static int grid = 0;
    if (grid == 0) {
        if (n_in != 26 || ws_size < WS_END) { fprintf(stderr, "kernel_launch: expected 26 inputs and >= %zu bytes of workspace; got %d, %zu\n", (size_t)WS_END, n_in, ws_size); grid = -1; return; }
        int dev = 0, cus = 0;
        if (hipGetDevice(&dev) != hipSuccess || hipDeviceGetAttribute(&cus, hipDeviceAttributeMultiprocessorCount, dev) != hipSuccess) { grid = -1; return; }
        if (hipFuncSetAttribute((const void*)fwd_kernel, hipFuncAttributeMaxDynamicSharedMemorySize, LDS_BYTES) != hipSuccess) { fprintf(stderr, "kernel_launch: hipFuncSetAttribute failed\n"); grid = -1; return; }
        (void)hipGetLastError();
        grid = cus;
    }
    if (grid < 0) return;
    (void)hipMemsetAsync((char*)d_ws + WS_CTL, 0, CTL_ZERO_BYTES, stream);
    Args a{};
    for (int i = 0; i < 26; ++i) a.in[i] = (const float*)d_in[i];
    a.out = (float*)d_out; a.ws = (unsigned char*)d_ws;
#if MK_PER_PHASE
    for (int p = 0; p < NPHASE; ++p) { a.ph_lo = p; a.ph_hi = p + 1; hipLaunchKernelGGL(fwd_kernel, dim3(grid), dim3(NWAVES * 64), LDS_BYTES, stream, a); }
#else
    a.ph_lo = 0; a.ph_hi = NPHASE;
    hipLaunchKernelGGL(fwd_kernel, dim3(grid), dim3(NWAVES * 64), LDS_BYTES, stream, a);
#endif
}
```

```cpp
#include <hip/hip_runtime.h>
#include <cstdio>
#include <cstdint>

#ifndef MK_PER_PHASE
#define MK_PER_PHASE 0
#endif

#ifndef MK_REPEAT
#define MK_REPEAT 0
#endif
#define MK_REPS(bit) ((MK_REPEAT >> (bit)) & 1 ? 2 : 1)
#ifndef MK_VAR
#define MK_VAR 0
#endif

constexpr int D = 1024, MP = 4096, MS = 2048, M = MP + MS, DEPTH = 4;
constexpr int NIN = 5376, FFN = 2816, NGU = 2 * FFN, NMOD = 6 * D;
constexpr int NAW = 512, PW = 256, CW = 256, CONVK = 31;
constexpr float EPS = 1e-6f;
constexpr float LOG2E = 1.4426950408889634f;
constexpr float QSCALE = 0.125f * LOG2E;

constexpr size_t MiB = 1u << 20;
constexpr size_t WS_CTL = 0, CTL_ZERO_BYTES = 5 * MiB / 4;
constexpr int CW_BAR = 4096;
constexpr int CF_MODRAW = 16384;
constexpr int CF_C1 = CF_MODRAW + DEPTH * 3 * NMOD;
constexpr int CF_C2 = CF_C1 + DEPTH * 3 * NIN;
constexpr int CF_RSS = CF_C2 + DEPTH * 3 * NGU;
constexpr int CF_END = CF_RSS + 9 * M;
static_assert((size_t)CF_END * 4 <= CTL_ZERO_BYTES, "control region");
constexpr size_t WS_MODT = 2 * MiB;
constexpr size_t WS_WIN = 4 * MiB;
constexpr size_t WS_WGU = 46 * MiB;
constexpr size_t WS_WDN = 90 * MiB;
constexpr size_t WS_WBR = 112 * MiB;
constexpr size_t WS_WOUT = 120 * MiB;
constexpr size_t WS_X = 128 * MiB;
constexpr size_t WS_XG = 152 * MiB;
constexpr size_t WS_Q = 164 * MiB, WS_K = 170 * MiB;
constexpr size_t WS_VT = 176 * MiB;
constexpr size_t WS_KC = 182 * MiB;
constexpr size_t WS_VTC = 184 * MiB;
constexpr size_t WS_PIN = 186 * MiB;
constexpr size_t WS_CIN = 189 * MiB;
constexpr size_t WS_G = 195 * MiB;
constexpr size_t WS_ABR = 231 * MiB;
constexpr size_t WS_MF = 243 * MiB;
constexpr size_t WS_MB = 267 * MiB;
constexpr size_t WS_ACT = 279 * MiB;
constexpr size_t WS_END = 312 * MiB;
constexpr size_t VT_SAMPLE_OFF = (size_t)16 * 8 * 64 * 256;

constexpr size_t OUT_Y = 0, OUT_K = (size_t)M * D, OUT_V = OUT_K + (size_t)16 * DEPTH * 256 * 512;

#define GAS __attribute__((address_space(1)))
#define LAS __attribute__((address_space(3)))
typedef unsigned short bf16_t;
typedef short bf16x8 __attribute__((ext_vector_type(8)));
typedef float f32x4 __attribute__((ext_vector_type(4)));
typedef float f32x2 __attribute__((ext_vector_type(2)));
typedef float f32x16 __attribute__((ext_vector_type(16)));
typedef unsigned u32x4 __attribute__((ext_vector_type(4)));
typedef unsigned u32x2 __attribute__((ext_vector_type(2)));
typedef __bf16 bf16x2_t __attribute__((ext_vector_type(2)));
#define LDS_WAIT() asm volatile("s_waitcnt lgkmcnt(0)" ::: "memory")

__device__ __forceinline__ unsigned pk2(float lo, float hi) { f32x2 v = {lo, hi}; bf16x2_t b = __builtin_convertvector(v, bf16x2_t); return __builtin_bit_cast(unsigned, b); }
__device__ __forceinline__ u32x4 pk8(f32x4 a, f32x4 b) { u32x4 w; w.x = pk2(a[0], a[1]); w.y = pk2(a[2], a[3]); w.z = pk2(b[0], b[1]); w.w = pk2(b[2], b[3]); return w; }
__device__ __forceinline__ float bf_lo(unsigned w) { return __uint_as_float(w << 16); }
__device__ __forceinline__ float bf_hi(unsigned w) { return __uint_as_float(w & 0xffff0000u); }
__device__ __forceinline__ float sigmoidf_(float x) { return __builtin_amdgcn_rcpf(1.0f + __builtin_amdgcn_exp2f(-LOG2E * x)); }
__device__ __forceinline__ float wave_sum(float v) {
#pragma unroll
    for (int o = 1; o < 64; o <<= 1) v += __shfl_xor(v, o);
    return v;
}
__device__ __forceinline__ int pos_of_key(int t) { return (t & ~12) | ((t & 4) << 1) | ((t & 8) >> 1); }
__device__ __forceinline__ int mod_row_of_pm(int pm) { return pm < 16 ? 0 : 1 + ((pm - 16) >> 2); }

namespace pg8 {
constexpr int BM = 256, BK = 64, HALF = 128, HTB = HALF * BK * 2  , STAGE_BYTES = 8 * HTB, NXCD = 8, WGM = 3;
__host__ __device__ __forceinline__ int lds_byte(int r, int c) { return r * 128 + ((((c >> 3) ^ (r >> 1)) & 7) << 4) + (c & 7) * 2; }
__host__ __device__ __forceinline__ void stage_rc(int b, int& R, int& C) { R = b >> 7; C = (((b >> 4) ^ (R >> 1)) & 7) * 8; }
__host__ __device__ __forceinline__ int perm32(int rho) { const int n = rho >> 4, i = rho & 15; return 8 * (i >> 2) + 4 * n + (i & 3); }

struct Unit { int pm, pn, k0, nt, kind, half; };
struct Gemm { const bf16_t* A; const bf16_t* Bt; int lda, ldb; };

struct TileOrder {
    int nM, nN, nwg, G, c, nt;
    __device__ void init(int M_, int N_, int K_, int G_, int c_) { nM = M_ / BM; nN = N_ / BM; nwg = nM * nN; G = G_; c = c_; nt = K_ / BK; }
    __device__ bool next(int i, Unit& u) const {
        const long L = (long)i * G + c; if (L >= nwg) return false;
        int wgid = (int)L; { const int q = nwg / NXCD, r = nwg % NXCD, xcd = wgid % NXCD, off = wgid / NXCD; wgid = (xcd < r ? xcd * (q + 1) : r * (q + 1) + (xcd - r) * q) + off; }
        const int nig = WGM * nN, gid = wgid / nig, fm = gid * WGM, gsz = (nM - fm) < WGM ? (nM - fm) : WGM;
        u.pm = fm + ((wgid % nig) % gsz); u.pn = (wgid % nig) / gsz; u.k0 = 0; u.nt = nt; u.kind = 0; u.half = 0; return true;
    }
};
struct TileOrderGU {
    int nM, nN, nwg, nw, c, nt;
    __device__ void init(int M_, int N_, int K_, int nw_, int c_) { nM = M_ / BM; nN = N_ / BM; nwg = nM * nN; nw = nw_; c = c_; nt = K_ / BK; }
    __device__ __forceinline__ void done(const Unit&, int) const {}
    __device__ void tile_of(int L, Unit& u) const {
        const int wgid = (L % NXCD) * (nwg / NXCD) + L / NXCD;
        const int nig = 3 * nN, gid = wgid / nig, fm = gid * 3;
        u.pm = fm + ((wgid % nig) % 3); u.pn = (wgid % nig) / 3; u.k0 = 0; u.nt = nt; u.kind = 0;
    }
    __device__ bool next(int i, Unit& u) const {
        if (c >= nw || i > 2) return false;
        if (i < 2) { tile_of(i * nw + c, u); u.half = 0; return true; }
        const int j = c >> 3, per = (nwg - 2 * nw) / NXCD;
        if (j >= 2 * per) return false;
        tile_of(2 * nw + (j >> 1) * NXCD + (c & 7), u); u.half = 1 + (j & 1); return true;
    }
};

struct PanelOrder {
    int c, nseg, ka, na, kb, nb, kc, nc;
    __device__ bool next(int i, Unit& u) const {
        if (c >= 96 || i >= nseg) return false;
        const int T = (c & 7) * 12 + (c >> 3);
        u.pm = T >> 2; u.pn = T & 3; u.k0 = i == 0 ? ka : (i == 1 ? kb : kc); u.nt = i == 0 ? na : (i == 1 ? nb : nc); u.kind = i; u.half = 0; return true;
    }
};

template <class Epi, class Sched>
__device__ __forceinline__ void gemm_phase(LAS unsigned char* lds, const Gemm g, const Sched& S, const Epi& E) {
    int tid = threadIdx.x; asm volatile("" : "+v"(tid));
    const int wid = __builtin_amdgcn_readfirstlane(tid >> 6), lane = tid & 63, wr = wid >> 2, wc = wid & 3, fr = lane & 15, fq = lane >> 4;
    unsigned voffA[2], voffB[2];
#pragma unroll
    for (int i = 0; i < 2; ++i) { int R, C; stage_rc(tid * 16 + i * 8192, R, C); const int Rb = (R & ~31) + perm32(R & 31);
        voffA[i] = (unsigned)(R * g.lda + C) * 2u; voffB[i] = (unsigned)(Rb * g.ldb + C) * 2u; }
    const size_t kstep = (size_t)(BK * 2);
    const size_t hstepA = (size_t)HALF * g.lda * 2, hstepB = (size_t)HALF * g.ldb * 2;
    const size_t tstepA = 2 * hstepA, tstepB = 2 * hstepB;
    const unsigned ldsw = (unsigned)wid * 1024u;
    const int aoffk[2] = {lds_byte(wr * 64 + fr, fq * 8), lds_byte(wr * 64 + fr, fq * 8 + 32)}, boffk[2] = {lds_byte(wc * 32 + fr, fq * 8), lds_byte(wc * 32 + fr, fq * 8 + 32)};
#define PG8_SA(b, h) (((b) * 2 + (h)) * HTB)
#define PG8_SB(b, h) ((4 + (b) * 2 + (h)) * HTB)
#define PG8_STAGE(bufoff, gbase, voff) do { _Pragma("unroll") for (int _i = 0; _i < 2; ++_i) \
        __builtin_amdgcn_global_load_lds((const unsigned*)((const char*)(gbase) + (voff)[_i]), (LAS unsigned*)(lds + (bufoff) + ldsw + _i * 8192), 16, 0, 0); } while (0)
#define PG8_LDA(dst, b, h) do { _Pragma("unroll") for (int m = 0; m < 4; ++m) _Pragma("unroll") for (int k = 0; k < 2; ++k) dst[m][k] = *(const LAS bf16x8*)(lds + PG8_SA(b, h) + aoffk[k] + m * 2048); } while (0)
#define PG8_LDB(dst, b, h) do { _Pragma("unroll") for (int n = 0; n < 2; ++n) _Pragma("unroll") for (int k = 0; k < 2; ++k) dst[n][k] = *(const LAS bf16x8*)(lds + PG8_SB(b, h) + boffk[k] + n * 2048); } while (0)
#define PG8_MMA(ai, bj, At, Bt) do { __builtin_amdgcn_s_setprio(1); _Pragma("unroll") for (int m = 0; m < 4; ++m) _Pragma("unroll") for (int n = 0; n < 2; ++n) _Pragma("unroll") for (int k = 0; k < 2; ++k) \
        acc[ai][bj][m][n] = __builtin_amdgcn_mfma_f32_16x16x32_bf16(Bt[n][k], At[m][k], acc[ai][bj][m][n], 0, 0, 0); __builtin_amdgcn_s_setprio(0); } while (0)
#define PG8_WAIT_V(n) asm volatile("s_waitcnt vmcnt(" #n ")" ::: "memory")
#define PG8_WAIT_L(n) asm volatile("s_waitcnt lgkmcnt(" #n ")" ::: "memory")
#define PG8_BAR __builtin_amdgcn_s_barrier()
#define PG8_SCHED __builtin_amdgcn_sched_barrier(0)
    Unit cur, nxt; int ui = 0;
    if (!S.next(0, cur)) return;
    f32x4 acc[2][2][4][2];
#pragma unroll
    for (int a = 0; a < 2; ++a)
#pragma unroll
        for (int b = 0; b < 2; ++b)
#pragma unroll
            for (int m = 0; m < 4; ++m)
#pragma unroll
                for (int n = 0; n < 2; ++n) acc[a][b][m][n] = (f32x4){0.f, 0.f, 0.f, 0.f};
    bf16x8 At[4][2], B0[2][2], B1[2][2];
    const char* cA = (const char*)g.A + (size_t)cur.pm * tstepA + (size_t)cur.k0 * 2; const char* cB = (const char*)g.Bt + (size_t)cur.pn * tstepB + (size_t)cur.k0 * 2;
    PG8_STAGE(PG8_SB(0, 0), cB, voffB); PG8_STAGE(PG8_SB(0, 1), cB + hstepB, voffB); PG8_STAGE(PG8_SA(0, 0), cA, voffA); PG8_STAGE(PG8_SA(0, 1), cA + hstepA, voffA);
    if (wr == 1) PG8_BAR;
    PG8_WAIT_V(2); PG8_BAR;
    PG8_STAGE(PG8_SB(1, 0), cB + kstep, voffB); PG8_STAGE(PG8_SA(1, 0), cA + kstep, voffA); PG8_STAGE(PG8_SB(1, 1), cB + hstepB + kstep, voffB);
    PG8_WAIT_V(6); PG8_BAR;
    for (;;) {
        const bool has_next = S.next(ui + 1, nxt);
        const char* nA = has_next ? (const char*)g.A + (size_t)nxt.pm * tstepA + (size_t)nxt.k0 * 2 : cA; const char* nB = has_next ? (const char*)g.Bt + (size_t)nxt.pn * tstepB + (size_t)nxt.k0 * 2 : cB;
        const int nt = cur.nt;
        const bool do0 = cur.half != 2, do1 = cur.half != 1;
        for (int t = 0; t < nt; t += 2) {
            const bool last = (t == nt - 2);
            const char* a1 = cA + (size_t)(t + 1) * kstep;
            const char* a2 = last ? nA : cA + (size_t)(t + 2) * kstep; const char* b2 = last ? nB : cB + (size_t)(t + 2) * kstep;
            const char* a3 = a2 + kstep; const char* b3 = b2 + kstep;
            PG8_LDB(B0, 0, 0); PG8_LDB(B1, 0, 1); PG8_SCHED; PG8_LDA(At, 0, 0); PG8_STAGE(PG8_SA(1, 1), a1 + hstepA, voffA);
            PG8_WAIT_V(8); PG8_WAIT_L(0); PG8_BAR; if (do0) { PG8_MMA(0, 0, At, B0); PG8_MMA(0, 1, At, B1); } PG8_BAR; PG8_SCHED;
            PG8_LDA(At, 0, 1); PG8_STAGE(PG8_SB(0, 0), b2, voffB); PG8_STAGE(PG8_SB(0, 1), b2 + hstepB, voffB); PG8_STAGE(PG8_SA(0, 0), a2, voffA);
            PG8_WAIT_V(8); PG8_WAIT_L(0); PG8_BAR; if (do1) { PG8_MMA(1, 0, At, B0); PG8_MMA(1, 1, At, B1); } PG8_BAR; PG8_SCHED;
            PG8_LDB(B0, 1, 0); PG8_LDB(B1, 1, 1); PG8_SCHED; PG8_LDA(At, 1, 0); PG8_STAGE(PG8_SA(0, 1), a2 + hstepA, voffA);
            PG8_WAIT_V(8); PG8_WAIT_L(0); PG8_BAR; if (do0) { PG8_MMA(0, 0, At, B0); PG8_MMA(0, 1, At, B1); } PG8_BAR; PG8_SCHED;
            PG8_LDA(At, 1, 1); PG8_STAGE(PG8_SB(1, 0), b3, voffB); PG8_STAGE(PG8_SB(1, 1), b3 + hstepB, voffB); PG8_STAGE(PG8_SA(1, 0), a3, voffA);
            PG8_WAIT_V(8); PG8_WAIT_L(0); PG8_BAR; if (do1) { PG8_MMA(1, 0, At, B0); PG8_MMA(1, 1, At, B1); } PG8_BAR; PG8_SCHED;
        }
        if (wr == 0) PG8_BAR;
        E(acc, cur, wr, wc, fr, fq);
        if (!has_next) break;
#pragma unroll
        for (int a = 0; a < 2; ++a)
#pragma unroll
            for (int b = 0; b < 2; ++b)
#pragma unroll
                for (int m = 0; m < 4; ++m)
#pragma unroll
                    for (int n = 0; n < 2; ++n) acc[a][b][m][n] = (f32x4){0.f, 0.f, 0.f, 0.f};
        cur = nxt; cA = nA; cB = nB; ++ui;
        if (wr == 1) PG8_BAR;
    }
    PG8_WAIT_V(0);
    PG8_BAR;
#undef PG8_SA
#undef PG8_SB
#undef PG8_STAGE
#undef PG8_LDA
#undef PG8_LDB
#undef PG8_MMA
#undef PG8_WAIT_V
#undef PG8_WAIT_L
#undef PG8_BAR
#undef PG8_SCHED
}
}

typedef f32x4 Acc[2][2][4][2];

struct EpiIn {
    const float* rss; const float* c1; const float* bgate;
    bf16_t *Q, *K, *Vt, *Pin, *Cin, *G; float *outk, *outv;
    __device__ __forceinline__ void operator()(const Acc& acc, const pg8::Unit& u, int wr, int wc, int fr, int fq) const {
        const int pn = u.pn, pm = u.pm, mr = mod_row_of_pm(pm);
        const int cb = pn * 256 + wc * 32 + 8 * fq;
        f32x4 cv[2][2];
#pragma unroll
        for (int bj = 0; bj < 2; ++bj)
#pragma unroll
            for (int n = 0; n < 2; ++n) { cv[bj][n] = *(const f32x4*)(c1 + (size_t)mr * NIN + cb + bj * 128 + 4 * n);
                if (pn >= 9) cv[bj][n] += *(const f32x4*)(bgate + (cb - 2304) + bj * 128 + 4 * n); }
        float rinvs[2][4];
#pragma unroll
        for (int ai = 0; ai < 2; ++ai)
#pragma unroll
            for (int m = 0; m < 4; ++m) rinvs[ai][m] = rss[pm * 256 + ai * 128 + wr * 64 + m * 16 + fr];
#pragma unroll
        for (int ai = 0; ai < 2; ++ai)
#pragma unroll
            for (int m = 0; m < 4; ++m) {
                const int row = pm * 256 + ai * 128 + wr * 64 + m * 16 + fr;
                const float rinv = 1.0f / sqrtf(rinvs[ai][m] * (1.0f / D) + EPS);
#pragma unroll
                for (int bj = 0; bj < 2; ++bj) {
                    const int col = cb + bj * 128;
                    f32x4 v0 = acc[ai][bj][m][0] * rinv + cv[bj][0], v1 = acc[ai][bj][m][1] * rinv + cv[bj][1];
                    if (pn < 2) {
                        *(u32x4*)(Q + (size_t)row * NAW + col) = pk8(v0 * QSCALE, v1 * QSCALE);
                    } else if (pn < 4) {
                        const int c = col - 512;
                        *(u32x4*)(K + (size_t)row * NAW + c) = pk8(v0, v1);
                        if (pm < 16) { float* o = outk + ((size_t)(pm * DEPTH * 256 + (row & 255))) * 512 + c; __builtin_nontemporal_store(v0, (f32x4*)o); __builtin_nontemporal_store(v1, (f32x4*)(o + 4)); }
                    } else if (pn < 6) {
                        const int c = col - 1024, h = c >> 6, d = c & 63;
                        if (pm < 16) { float* o = outv + ((size_t)(pm * DEPTH * 256 + (row & 255))) * 512 + c; __builtin_nontemporal_store(v0, (f32x4*)o); __builtin_nontemporal_store(v1, (f32x4*)(o + 4)); }
                        bf16_t* vb; int L;
                        if (pm < 16) { L = 256; vb = Vt + ((size_t)((pm * 8 + h) * 64 + d)) * 256 + pos_of_key(row & 255); }
                        else { const int rs = row - MP, bs = rs >> 10; L = 1024; vb = Vt + VT_SAMPLE_OFF + ((size_t)((bs * 8 + h) * 64 + d)) * 1024 + pos_of_key(rs & 1023); }
                        const u32x4 w = pk8(v0, v1);
                        vb[0] = (bf16_t)(w.x & 0xffff); vb[(size_t)L] = (bf16_t)(w.x >> 16); vb[(size_t)2 * L] = (bf16_t)(w.y & 0xffff); vb[(size_t)3 * L] = (bf16_t)(w.y >> 16);
                        vb[(size_t)4 * L] = (bf16_t)(w.z & 0xffff); vb[(size_t)5 * L] = (bf16_t)(w.z >> 16); vb[(size_t)6 * L] = (bf16_t)(w.w & 0xffff); vb[(size_t)7 * L] = (bf16_t)(w.w >> 16);
                    } else if (pn == 6) {
                        *(u32x4*)(Pin + (size_t)row * PW + (col - 1536)) = pk8(v0, v1);
                    } else if (pn < 9) {
                        *(u32x4*)(Cin + (size_t)row * 512 + (col - 1792)) = pk8(v0, v1);
                    } else {
#pragma unroll
                        for (int e = 0; e < 4; ++e) { v0[e] = sigmoidf_(v0[e]); v1[e] = sigmoidf_(v1[e]); }
                        *(u32x4*)(G + (size_t)row * 3072 + (col - 2304)) = pk8(v0, v1);
                    }
                }
                asm volatile("" ::: "memory");
            }
    }
};

struct EpiBranch {
    const bf16_t* G; float* mf; bf16_t* mb;
    __device__ __forceinline__ void operator()(const Acc& acc, const pg8::Unit& u, int wr, int wc, int fr, int fq) const {
        const int cb = u.pn * 256 + wc * 32 + 8 * fq, kind = u.kind;
#pragma unroll
        for (int ai = 0; ai < 2; ++ai)
#pragma unroll
            for (int m = 0; m < 4; ++m) {
                const int row = u.pm * 256 + ai * 128 + wr * 64 + m * 16 + fr;
#pragma unroll
                for (int bj = 0; bj < 2; ++bj) {
                    const int col = cb + bj * 128;
                    const u32x4 gw = *(const u32x4*)(G + (size_t)row * 3072 + kind * 1024 + col);
                    f32x4 v0 = acc[ai][bj][m][0], v1 = acc[ai][bj][m][1];
                    v0[0] *= bf_lo(gw.x); v0[1] *= bf_hi(gw.x); v0[2] *= bf_lo(gw.y); v0[3] *= bf_hi(gw.y);
                    v1[0] *= bf_lo(gw.z); v1[1] *= bf_hi(gw.z); v1[2] *= bf_lo(gw.w); v1[3] *= bf_hi(gw.w);
                    float* sp = mf + (size_t)row * D + col;
                    if (kind > 0) { v0 += *(const f32x4*)sp; v1 += *(const f32x4*)(sp + 4); }
                    if (kind < 2) { *(f32x4*)sp = v0; *(f32x4*)(sp + 4) = v1; }
                    else *(u32x4*)(mb + (size_t)row * D + col) = pk8(v0, v1);
                }
                asm volatile("" ::: "memory");
            }
    }
};

struct EpiRes {
    float* x; bf16_t* xg; const float* gate; const float* gsn; float* rssn;
    __device__ __forceinline__ void operator()(const Acc& acc, const pg8::Unit& u, int wr, int wc, int fr, int fq) const {
        const int mr = mod_row_of_pm(u.pm), cb = u.pn * 256 + wc * 32 + 8 * fq;
        float ss[2][4];
#pragma unroll
        for (int ai = 0; ai < 2; ++ai)
#pragma unroll
            for (int m = 0; m < 4; ++m) ss[ai][m] = 0.f;
#pragma unroll
        for (int bj = 0; bj < 2; ++bj) {
            const int col = cb + bj * 128;
            const f32x4 gt0 = *(const f32x4*)(gate + (size_t)mr * 6 * D + col), gt1 = *(const f32x4*)(gate + (size_t)mr * 6 * D + col + 4);
            const f32x4 gs0 = *(const f32x4*)(gsn + (size_t)mr * 6 * D + col), gs1 = *(const f32x4*)(gsn + (size_t)mr * 6 * D + col + 4);
#pragma unroll
            for (int ai = 0; ai < 2; ++ai)
#pragma unroll
                for (int m = 0; m < 4; ++m) {
                    const int row = u.pm * 256 + ai * 128 + wr * 64 + m * 16 + fr;
                    float* xp = x + (size_t)row * D + col;
                    f32x4 x0 = *(const f32x4*)xp, x1 = *(const f32x4*)(xp + 4);
                    x0 += gt0 * acc[ai][bj][m][0]; x1 += gt1 * acc[ai][bj][m][1];
                    *(f32x4*)xp = x0; *(f32x4*)(xp + 4) = x1;
                    ss[ai][m] += (x0[0] * x0[0] + x0[1] * x0[1]) + (x0[2] * x0[2] + x0[3] * x0[3]) + (x1[0] * x1[0] + x1[1] * x1[1]) + (x1[2] * x1[2] + x1[3] * x1[3]);
                    *(u32x4*)(xg + (size_t)row * D + col) = pk8(x0 * gs0, x1 * gs1);
                    asm volatile("" ::: "memory");
                }
        }
#pragma unroll
        for (int ai = 0; ai < 2; ++ai)
#pragma unroll
            for (int m = 0; m < 4; ++m) {
                float s = ss[ai][m];
                s += __shfl_xor(s, 16); s += __shfl_xor(s, 32);
                if (fq == 0) atomicAdd(rssn + u.pm * 256 + ai * 128 + wr * 64 + m * 16 + fr, s);
            }
    }
};

struct EpiGU {
    const float* rss; const float* c2; bf16_t* act;
    __device__ __forceinline__ void operator()(const Acc& acc, const pg8::Unit& u, int wr, int wc, int fr, int fq) const {
        const int mr = mod_row_of_pm(u.pm), ca0 = u.pn * 128 + wc * 32 + 8 * fq;
        f32x4 ca[2], cbv[2];
#pragma unroll
        for (int n = 0; n < 2; ++n) { ca[n] = *(const f32x4*)(c2 + (size_t)mr * NGU + ca0 + 4 * n); cbv[n] = *(const f32x4*)(c2 + (size_t)mr * NGU + FFN + ca0 + 4 * n); }
        float rinvs[2][4];
#pragma unroll
        for (int ai = 0; ai < 2; ++ai)
#pragma unroll
            for (int m = 0; m < 4; ++m) rinvs[ai][m] = rss[u.pm * 256 + ai * 128 + wr * 64 + m * 16 + fr];
#pragma unroll
        for (int ai = 0; ai < 2; ++ai)
#pragma unroll
            for (int m = 0; m < 4; ++m) {
                if (u.half == 2 - ai) continue;
                const int row = u.pm * 256 + ai * 128 + wr * 64 + m * 16 + fr;
                const float rinv = 1.0f / sqrtf(rinvs[ai][m] * (1.0f / D) + EPS);
                f32x4 o[2];
#pragma unroll
                for (int n = 0; n < 2; ++n) {
                    const f32x4 a = acc[ai][0][m][n] * rinv + ca[n], b = acc[ai][1][m][n] * rinv + cbv[n];
#pragma unroll
                    for (int e = 0; e < 4; ++e) o[n][e] = a[e] * sigmoidf_(a[e]) * b[e];
                }
                *(u32x4*)(act + (size_t)row * FFN + ca0) = pk8(o[0], o[1]);
                asm volatile("" ::: "memory");
            }
    }
};

namespace g192 {
constexpr int TM = 192, TN = 128, BK = 64, ABYTES = TM * BK * 2, BBYTES = TN * BK * 2, SBYTES = ABYTES + BBYTES;
typedef f32x4 Acc6[6][2];
template <class Epi>
__device__ __forceinline__ void gemm(LAS unsigned char* lds, const bf16_t* A, int lda, const bf16_t* Bt, int ldb, int pm, int pn, int nt, const Epi& E) {
    int tid = threadIdx.x; asm volatile("" : "+v"(tid));
    const int wid = __builtin_amdgcn_readfirstlane(tid >> 6), lane = tid & 63, wr = wid >> 2, wc = wid & 3, fr = lane & 15, fq = lane >> 4;
    unsigned voffA[3], voffB[2];
#pragma unroll
    for (int i = 0; i < 3; ++i) { int R, C; pg8::stage_rc((wid + 8 * i) * 1024 + lane * 16, R, C); voffA[i] = (unsigned)(R * lda + C) * 2u; }
#pragma unroll
    for (int i = 0; i < 2; ++i) { int R, C; pg8::stage_rc((wid + 8 * i) * 1024 + lane * 16, R, C); const int Rb = (R & ~31) + pg8::perm32(R & 31); voffB[i] = (unsigned)(Rb * ldb + C) * 2u; }
    const char* gA = (const char*)(A + (size_t)pm * TM * lda); const char* gB = (const char*)(Bt + (size_t)pn * TN * ldb);
    const unsigned ldsw = (unsigned)wid * 1024u;
    const int aoffk[2] = {pg8::lds_byte(wr * 96 + fr, fq * 8), pg8::lds_byte(wr * 96 + fr, fq * 8 + 32)}, boffk[2] = {ABYTES + pg8::lds_byte(wc * 32 + fr, fq * 8), ABYTES + pg8::lds_byte(wc * 32 + fr, fq * 8 + 32)};
#define G192_STAGE(slot, t) do { \
        _Pragma("unroll") for (int _i = 0; _i < 3; ++_i) __builtin_amdgcn_global_load_lds((const unsigned*)(gA + (size_t)(t) * (BK * 2) + voffA[_i]), (LAS unsigned*)(lds + (slot) * SBYTES + ldsw + _i * 8192), 16, 0, 0); \
        _Pragma("unroll") for (int _i = 0; _i < 2; ++_i) __builtin_amdgcn_global_load_lds((const unsigned*)(gB + (size_t)(t) * (BK * 2) + voffB[_i]), (LAS unsigned*)(lds + (slot) * SBYTES + ABYTES + ldsw + _i * 8192), 16, 0, 0); } while (0)
#define G192_WAIT_V(n) asm volatile("s_waitcnt vmcnt(" #n ")" ::: "memory")
#define G192_WAIT_L(n) asm volatile("s_waitcnt lgkmcnt(" #n ")" ::: "memory")
    f32x4 acc[6][2], tot[6][2];
#pragma unroll
    for (int m = 0; m < 6; ++m)
#pragma unroll
        for (int n = 0; n < 2; ++n) { acc[m][n] = (f32x4){0.f, 0.f, 0.f, 0.f}; tot[m][n] = (f32x4){0.f, 0.f, 0.f, 0.f}; }
    G192_STAGE(0, 0); G192_STAGE(1, 1); G192_STAGE(2, 2);
    G192_WAIT_V(10); __builtin_amdgcn_s_barrier();
#pragma unroll 1
    for (int t = 0; t < nt; ++t) {
        const int slot = t & 3;
        if (t + 3 < nt) G192_STAGE((t + 3) & 3, t + 3);
        bf16x8 At[6][2], Bf[2][2];
        const LAS unsigned char* sb = lds + slot * SBYTES;
#pragma unroll
        for (int n = 0; n < 2; ++n)
#pragma unroll
            for (int k = 0; k < 2; ++k) Bf[n][k] = *(const LAS bf16x8*)(sb + boffk[k] + n * 2048);
#pragma unroll
        for (int m = 0; m < 6; ++m)
#pragma unroll
            for (int k = 0; k < 2; ++k) At[m][k] = *(const LAS bf16x8*)(sb + aoffk[k] + m * 2048);
        G192_WAIT_L(0);
        __builtin_amdgcn_s_setprio(1);
#pragma unroll
        for (int m = 0; m < 6; ++m)
#pragma unroll
            for (int n = 0; n < 2; ++n)
#pragma unroll
                for (int k = 0; k < 2; ++k) acc[m][n] = __builtin_amdgcn_mfma_f32_16x16x32_bf16(Bf[n][k], At[m][k], acc[m][n], 0, 0, 0);
        __builtin_amdgcn_s_setprio(0);
        if (Epi::BRANCH) { if (t == 7 || t == 11 || t == nt - 1) E.seg(acc, tot, t == 7 ? 0 : (t == 11 ? 1 : 2), pm, pn, wr, wc, fr, fq); }
        if (t + 3 < nt) G192_WAIT_V(10); else if (t + 2 < nt) G192_WAIT_V(5); else G192_WAIT_V(0);
        __builtin_amdgcn_s_barrier();
    }
    E(Epi::BRANCH ? tot : acc, pm, pn, wr, wc, fr, fq);
#undef G192_STAGE
#undef G192_WAIT_V
#undef G192_WAIT_L
}
}

struct EpiBranch192 {
    static constexpr bool BRANCH = true;
    const bf16_t* G; bf16_t* mb;
    __device__ __forceinline__ void seg(g192::Acc6& acc, g192::Acc6& tot, int kind, int pm, int pn, int wr, int wc, int fr, int fq) const {
        const int col = pn * 128 + wc * 32 + 8 * fq;
#pragma unroll
        for (int m = 0; m < 6; ++m) {
            const int row = pm * 192 + wr * 96 + m * 16 + fr;
            const u32x4 gw = *(const u32x4*)(G + (size_t)row * 3072 + kind * 1024 + col);
            f32x4 g0 = {bf_lo(gw.x), bf_hi(gw.x), bf_lo(gw.y), bf_hi(gw.y)}, g1 = {bf_lo(gw.z), bf_hi(gw.z), bf_lo(gw.w), bf_hi(gw.w)};
            tot[m][0] += g0 * acc[m][0]; tot[m][1] += g1 * acc[m][1];
            acc[m][0] = (f32x4){0.f, 0.f, 0.f, 0.f}; acc[m][1] = (f32x4){0.f, 0.f, 0.f, 0.f};
        }
    }
    __device__ __forceinline__ void operator()(const g192::Acc6& tot, int pm, int pn, int wr, int wc, int fr, int fq) const {
        const int col = pn * 128 + wc * 32 + 8 * fq;
#pragma unroll
        for (int m = 0; m < 6; ++m) { const int row = pm * 192 + wr * 96 + m * 16 + fr; *(u32x4*)(mb + (size_t)row * D + col) = pk8(tot[m][0], tot[m][1]); }
    }
};
struct EpiRes192 {
    static constexpr bool BRANCH = false;
    float* x; bf16_t* xg; const float* gate; const float* gsn; float* rssn;
    __device__ __forceinline__ void seg(g192::Acc6&, g192::Acc6&, int, int, int, int, int, int, int) const {}
    __device__ __forceinline__ void operator()(const g192::Acc6& acc, int pm, int pn, int wr, int wc, int fr, int fq) const {
        const int col = pn * 128 + wc * 32 + 8 * fq;
        f32x4 xv[6][2], gt[6][2], gs[6][2];
#pragma unroll
        for (int m = 0; m < 6; ++m) {
            const int row = pm * 192 + wr * 96 + m * 16 + fr;
            const int mr = row < MP ? 0 : 1 + ((row - MP) >> 10);
            const float* gp = gate + (size_t)mr * 6 * D + col; const float* sp = gsn + (size_t)mr * 6 * D + col; const float* xp = x + (size_t)row * D + col;
            xv[m][0] = *(const f32x4*)xp; xv[m][1] = *(const f32x4*)(xp + 4);
            gt[m][0] = *(const f32x4*)gp; gt[m][1] = *(const f32x4*)(gp + 4); gs[m][0] = *(const f32x4*)sp; gs[m][1] = *(const f32x4*)(sp + 4);
        }
#pragma unroll
        for (int m = 0; m < 6; ++m) {
            const int row = pm * 192 + wr * 96 + m * 16 + fr;
            float* xp = x + (size_t)row * D + col;
            const f32x4 x0 = xv[m][0] + gt[m][0] * acc[m][0], x1 = xv[m][1] + gt[m][1] * acc[m][1];
            *(f32x4*)xp = x0; *(f32x4*)(xp + 4) = x1;
            float ss = (x0[0] * x0[0] + x0[1] * x0[1]) + (x0[2] * x0[2] + x0[3] * x0[3]) + (x1[0] * x1[0] + x1[1] * x1[1]) + (x1[2] * x1[2] + x1[3] * x1[3]);
            *(u32x4*)(xg + (size_t)row * D + col) = pk8(x0 * gs[m][0], x1 * gs[m][1]);
            ss += __shfl_xor(ss, 16); ss += __shfl_xor(ss, 32);
            if (fq == 0) atomicAdd(rssn + row, ss);
        }
    }
};

struct AttnState { f32x16 o0, o1; float m, l; };
struct KVFrag { bf16x8 k[4], v[2][2]; };
__device__ __forceinline__ void attn_load(KVFrag& f, const bf16_t* kptr  , const bf16_t* vptr  , int vstride32  ) {
#pragma unroll
    for (int s = 0; s < 4; ++s) f.k[s] = *(const bf16x8*)(kptr + 16 * s);
#pragma unroll
    for (int dt = 0; dt < 2; ++dt)
#pragma unroll
        for (int ks = 0; ks < 2; ++ks) f.v[dt][ks] = *(const bf16x8*)(vptr + (size_t)dt * vstride32 + 16 * ks);
}
__device__ __forceinline__ void attn_tile(AttnState& st, const bf16x8 (&qf)[4], const KVFrag& f, bool local, const LAS float* rl, int cq, int cs, int ck0  ) {
    f32x16 s = {0.f, 0.f, 0.f, 0.f, 0.f, 0.f, 0.f, 0.f, 0.f, 0.f, 0.f, 0.f, 0.f, 0.f, 0.f, 0.f};
#pragma unroll
    for (int k = 0; k < 4; ++k) s = __builtin_amdgcn_mfma_f32_32x32x16_bf16(f.k[k], qf[k], s, 0, 0, 0);
    if (local) {
        const LAS float* rb = rl + (ck0 - cq + 15);
        const int d0 = ck0 - cs;
#pragma unroll
        for (int i = 0; i < 16; ++i) {
            const int o = (i & 3) + 8 * (i >> 2);
            const bool ok = (unsigned)(d0 + o) < 16u;
            s[i] = ok ? s[i] + rb[o] : -1e30f;
        }
    }
    float mx = fmaxf(fmaxf(s[0], s[1]), fmaxf(s[2], s[3]));
#pragma unroll
    for (int i = 4; i < 16; i += 4) mx = fmaxf(mx, fmaxf(fmaxf(s[i], s[i + 1]), fmaxf(s[i + 2], s[i + 3])));
    mx = fmaxf(mx, __shfl_xor(mx, 32));
    const float mo = st.m, mn = fmaxf(mo, mx);
    st.m = mn;
    float ls = 0.f;
#pragma unroll
    for (int i = 0; i < 16; ++i) { const float p = __builtin_amdgcn_exp2f(s[i] - mn); s[i] = p; ls += p; }
    if (__builtin_amdgcn_ballot_w64(mn > mo) != 0ull) {
        const float alpha = __builtin_amdgcn_exp2f(mo - mn);
        st.l *= alpha;
#pragma unroll
        for (int i = 0; i < 16; ++i) { st.o0[i] *= alpha; st.o1[i] *= alpha; }
    }
    st.l += ls;
    u32x4 w0, w1;
    w0.x = pk2(s[0], s[1]); w0.y = pk2(s[2], s[3]); w0.z = pk2(s[4], s[5]); w0.w = pk2(s[6], s[7]);
    w1.x = pk2(s[8], s[9]); w1.y = pk2(s[10], s[11]); w1.z = pk2(s[12], s[13]); w1.w = pk2(s[14], s[15]);
    const bf16x8 p0 = __builtin_bit_cast(bf16x8, w0), p1 = __builtin_bit_cast(bf16x8, w1);
    st.o0 = __builtin_amdgcn_mfma_f32_32x32x16_bf16(f.v[0][0], p0, st.o0, 0, 0, 0);
    st.o0 = __builtin_amdgcn_mfma_f32_32x32x16_bf16(f.v[0][1], p1, st.o0, 0, 0, 0);
    st.o1 = __builtin_amdgcn_mfma_f32_32x32x16_bf16(f.v[1][0], p0, st.o1, 0, 0, 0);
    st.o1 = __builtin_amdgcn_mfma_f32_32x32x16_bf16(f.v[1][1], p1, st.o1, 0, 0, 0);
}
__device__ __forceinline__ void attn_store(const AttnState& st, bf16_t* orow  , int hf) {
    const float lt = st.l + __shfl_xor(st.l, 32);
    const float inv = 1.0f / lt;
#pragma unroll
    for (int g = 0; g < 4; ++g) {
        u32x2 a, b;
        a.x = pk2(st.o0[4 * g] * inv, st.o0[4 * g + 1] * inv); a.y = pk2(st.o0[4 * g + 2] * inv, st.o0[4 * g + 3] * inv);
        b.x = pk2(st.o1[4 * g] * inv, st.o1[4 * g + 1] * inv); b.y = pk2(st.o1[4 * g + 2] * inv, st.o1[4 * g + 3] * inv);
        *(u32x2*)(orow + 8 * g + 4 * hf) = a;
        *(u32x2*)(orow + 32 + 8 * g + 4 * hf) = b;
    }
}
struct AttnPtrs { const bf16_t *Q, *K, *Vt, *Kc, *Vtc; bf16_t* Abr; };
constexpr int PA_K_BYTES = 256 * 128, PA_V_BYTES = 64 * 512;
struct StageRegs { u32x4 kv[4], vv[4]; };
__device__ __forceinline__ void attn_stage_load(StageRegs& R, const bf16_t* ksrc, const bf16_t* vsrc, int vld, int nkeys, int tid) {
    const int nch = nkeys * 8, sh = nkeys == 256 ? 5 : 3;
#pragma unroll
    for (int i = 0; i < 4; ++i) { int q = tid + 512 * i; q = q < nch ? q : nch - 1;
        R.kv[i] = *(const u32x4*)(ksrc + (size_t)(q >> 3) * NAW + 8 * (q & 7));
        R.vv[i] = *(const u32x4*)(vsrc + (size_t)(q >> sh) * vld + 8 * (q & ((1 << sh) - 1))); }
}
__device__ __forceinline__ void attn_stage_store(const StageRegs& R, int nkeys, LAS unsigned char* kl, LAS unsigned char* vl, int tid) {
    const int nch = nkeys * 8, sh = nkeys == 256 ? 5 : 3;
#pragma unroll
    for (int i = 0; i < 4; ++i) { const int q = tid + 512 * i; if (q < nch) {
        const int key = q >> 3, c = q & 7, d = q >> sh, cv = q & ((1 << sh) - 1);
        *(LAS u32x4*)(kl + key * 128 + ((c ^ (key & 7)) << 4)) = R.kv[i];
        *(LAS u32x4*)(vl + d * 512 + ((cv ^ (d & 15)) << 4)) = R.vv[i]; } }
}
__device__ __forceinline__ void attn_lds_frag(KVFrag& f, const LAS unsigned char* kl, const LAS unsigned char* vl, int kt, int r32, int hf) {
    const int key = 32 * kt + r32;
#pragma unroll
    for (int s = 0; s < 4; ++s) f.k[s] = *(const LAS bf16x8*)(kl + key * 128 + (((2 * s + hf) ^ (key & 7)) << 4));
#pragma unroll
    for (int dt = 0; dt < 2; ++dt)
#pragma unroll
        for (int ks = 0; ks < 2; ++ks) { const int d = 32 * dt + r32; f.v[dt][ks] = *(const LAS bf16x8*)(vl + d * 512 + (((4 * kt + 2 * ks + hf) ^ (d & 15)) << 4)); }
}
__device__ __forceinline__ void attn_prompt_lds(const AttnPtrs& P, const LAS unsigned char* kl, const LAS unsigned char* vl, int bh, int qt, int lane) {
    const int r32 = lane & 31, hf = lane >> 5, b = bh >> 3, h = bh & 7;
    const int qrow = b * 256 + qt * 32 + r32;
    bf16x8 qf[4];
#pragma unroll
    for (int s = 0; s < 4; ++s) qf[s] = *(const bf16x8*)(P.Q + (size_t)qrow * NAW + h * 64 + 16 * s + 8 * hf);
    AttnState st; st.m = -1e30f; st.l = 0.f;
#pragma unroll
    for (int i = 0; i < 16; ++i) { st.o0[i] = 0.f; st.o1[i] = 0.f; }
    KVFrag fa, fb;
    attn_lds_frag(fa, kl, vl, 0, r32, hf);
#pragma unroll 1
    for (int t = 0; t < 8; t += 2) {
        attn_lds_frag(fb, kl, vl, t + 1, r32, hf);
        attn_tile(st, qf, fa, false, nullptr, 0, 0, 0);
        if (t + 2 < 8) attn_lds_frag(fa, kl, vl, t + 2, r32, hf);
        attn_tile(st, qf, fb, false, nullptr, 0, 0, 0);
    }
    attn_store(st, P.Abr + (size_t)qrow * D + h * 64, hf);
}
constexpr int ATT_PART_FLOATS = 34 * 64;
__device__ __forceinline__ void attn_sample_block(const AttnPtrs& P, LAS unsigned char* kl, LAS unsigned char* vl, const LAS float* rpl, LAS float* parts, int blk, int wave, int lane) {
    const int r32 = lane & 31, hf = lane >> 5, tid = wave * 64 + lane;
    const int bs = blk >> 6, h = (blk >> 3) & 7, i2 = (blk & 7) * 2;
    const int u = wave >> 1, half = wave & 1, r = i2 + (u >> 1), qh = u & 1;
    const int qrow = MP + bs * 1024 + r * 64 + qh * 32 + r32;
    const int cq = qh * 32 + r32; int cs = cq - 8; cs = cs < 0 ? 0 : (cs > 48 ? 48 : cs);
    int rs = r - 4; rs = rs < 0 ? 0 : (rs > 8 ? 8 : rs);
    int rs0 = i2 - 4; rs0 = rs0 < 0 ? 0 : (rs0 > 8 ? 8 : rs0);
    int rs1 = i2 - 3; rs1 = rs1 < 0 ? 0 : (rs1 > 8 ? 8 : rs1);
    const int nstage = rs1 != rs0 ? 4 : 3;
    const bf16_t* kloc = P.K + (size_t)(MP + bs * 1024) * NAW + h * 64;
    const bf16_t* vloc = P.Vt + VT_SAMPLE_OFF + (size_t)((bs * 8 + h) * 64) * 1024;
    bf16x8 qf[4];
#pragma unroll
    for (int s = 0; s < 4; ++s) qf[s] = *(const bf16x8*)(P.Q + (size_t)qrow * NAW + h * 64 + 16 * s + 8 * hf);
    AttnState st; st.m = -1e30f; st.l = 0.f;
#pragma unroll
    for (int i = 0; i < 16; ++i) { st.o0[i] = 0.f; st.o1[i] = 0.f; }
    LAS float* part = parts + u * ATT_PART_FLOATS;
    StageRegs R;
    attn_stage_load(R, P.Kc + (size_t)(bs * 256) * NAW + h * 64, P.Vtc + (size_t)((bs * 8 + h) * 64) * 256, 256, 256, tid);
#pragma unroll 1
    for (int sg = 0; sg < nstage; ++sg) {
        if (sg) __syncthreads();
        const int row0 = rs0 + 4 * (sg - 1);
        attn_stage_store(R, sg == 3 ? 64 : 256, kl, vl, tid);
        { const int sn = sg + 1 < nstage ? sg + 1 : 1, rown = rs0 + 4 * (sn - 1);
          attn_stage_load(R, kloc + (size_t)(rown * 64) * NAW, vloc + rown * 64, 1024, sn == 3 ? 64 : 256, tid); }
        LDS_WAIT(); __syncthreads();
        KVFrag f;
        if (sg == 0) {
#pragma unroll 1
            for (int kt = 4 * half; kt < 4 * half + 4; ++kt) { attn_lds_frag(f, kl, vl, kt, r32, hf); attn_tile(st, qf, f, false, nullptr, 0, 0, 0); }
        } else {
            const int nt = sg == 3 ? 2 : 8;
#pragma unroll 1
            for (int kt = half * (nt >> 1); kt < (half + 1) * (nt >> 1); ++kt) {
                const int jr = row0 + (kt >> 1), ch = kt & 1;
                if (jr < rs || jr >= rs + 8) continue;
                attn_lds_frag(f, kl, vl, kt, r32, hf);
                attn_tile(st, qf, f, true, rpl + (h * 15 + (jr - r + 7)) * 31, cq, cs, ch * 32 + 4 * hf);
            }
        }
    }
    if (half == 1) {
#pragma unroll
        for (int i = 0; i < 16; ++i) { part[i * 64 + lane] = st.o0[i]; part[(16 + i) * 64 + lane] = st.o1[i]; }
        part[32 * 64 + lane] = st.m; part[33 * 64 + lane] = st.l;
    }
    LDS_WAIT(); __syncthreads();
    if (half == 0) {
        const float m1 = part[32 * 64 + lane], l1 = part[33 * 64 + lane];
        const float mn = fmaxf(st.m, m1), a0 = __builtin_amdgcn_exp2f(st.m - mn), a1 = __builtin_amdgcn_exp2f(m1 - mn);
        st.l = st.l * a0 + l1 * a1;
#pragma unroll
        for (int i = 0; i < 16; ++i) { st.o0[i] = st.o0[i] * a0 + part[i * 64 + lane] * a1; st.o1[i] = st.o1[i] * a0 + part[(16 + i) * 64 + lane] * a1; }
        attn_store(st, P.Abr + (size_t)qrow * D + h * 64, hf);
    }
}

struct PcPtrs { const bf16_t *Pin, *Cin; const float *wdw, *bdw, *cng, *cnb; bf16_t* Abr; };
__device__ __forceinline__ f32x4 ld_bf4(const bf16_t* p) { const u32x2 w = *(const u32x2*)p; return (f32x4){bf_lo(w.x), bf_hi(w.x), bf_lo(w.y), bf_hi(w.y)}; }
__device__ __forceinline__ f32x4 up_bf4(u32x2 w) { return (f32x4){bf_lo(w.x), bf_hi(w.x), bf_lo(w.y), bf_hi(w.y)}; }
__device__ __forceinline__ void pool_unit(const PcPtrs& P, int unit, int lane) {
    const int row0 = unit * 8;
    const int L = row0 < MP ? 256 : 1024;
    const int sb = row0 < MP ? (row0 & ~255) : MP + ((row0 - MP) & ~1023);
    const int hw = 1 << (lane >> 4);
    const int t0 = row0 - sb;
    u32x2 pv[24];
#pragma unroll
    for (int i = 0; i < 24; ++i) { int t = t0 - 8 + i; t = t < 0 ? 0 : (t > L - 1 ? L - 1 : t); pv[i] = *(const u32x2*)(P.Pin + (size_t)(sb + t) * PW + 4 * lane); }
#pragma unroll
    for (int tt = 0; tt < 8; ++tt) {
        f32x4 sum = {0.f, 0.f, 0.f, 0.f}; float cnt = 0.f;
#pragma unroll
        for (int o = -8; o < 8; ++o) {
            const int t = t0 + tt + o;
            const bool in = (o >= -hw) && (o < hw) && (t >= 0) && (t < L);
            const f32x4 v = up_bf4(pv[tt + o + 8]);
            sum += in ? v : (f32x4){0.f, 0.f, 0.f, 0.f}; cnt += in ? 1.f : 0.f;
        }
        const f32x4 r = sum * __builtin_amdgcn_rcpf(cnt) - up_bf4(pv[tt + 8]);
        u32x2 w; w.x = pk2(r[0], r[1]); w.y = pk2(r[2], r[3]);
        *(u32x2*)(P.Abr + (size_t)(row0 + tt) * D + 512 + 4 * lane) = w;
    }
}
__device__ __forceinline__ void conv_unit(const PcPtrs& P, const LAS float* wl, int unit, int lane) {
    constexpr int T = 8;
    const int row0 = unit * T;
    const int L = row0 < MP ? 256 : 1024;
    const int sb = row0 < MP ? (row0 & ~255) : MP + ((row0 - MP) & ~1023);
    const int t0 = row0 - sb;
    f32x4 acc[T];
    const f32x4 bias = *(const f32x4*)(P.bdw + 4 * lane);
#pragma unroll
    for (int tt = 0; tt < T; ++tt) acc[tt] = bias;
#pragma unroll 1
    for (int c = 0; c < 2; ++c) {
        u32x2 ar[20], gr[20];
#pragma unroll
        for (int i = 0; i < 20; ++i) {
            const int t = t0 - 15 + 20 * c + i;
            const bool ok = (t >= 0) && (t < L);
            const bf16_t* p = P.Cin + (size_t)(sb + (ok ? t : 0)) * 512 + 4 * lane;
            ar[i] = *(const u32x2*)p; gr[i] = *(const u32x2*)(p + 256);
            if (!ok) { ar[i] = (u32x2){0u, 0u}; }
        }
#pragma unroll
        for (int g4 = 0; g4 < 5; ++g4) {
            const int s0 = 20 * c + 4 * g4;
            f32x4 tp[11];
#pragma unroll
            for (int q = 0; q < 11; ++q) tp[q] = *(const LAS f32x4*)(wl + (s0 + q) * CW + 4 * lane);
#pragma unroll
            for (int i = 0; i < 4; ++i) {
                const f32x4 a = up_bf4(ar[4 * g4 + i]), g = up_bf4(gr[4 * g4 + i]);
                f32x4 hh;
#pragma unroll
                for (int e = 0; e < 4; ++e) hh[e] = a[e] * sigmoidf_(g[e]);
#pragma unroll
                for (int tt = 0; tt < T; ++tt) acc[tt] += hh * tp[i - tt + 7];
            }
            asm volatile("" ::: "memory");
        }
    }
    const f32x4 lg = *(const f32x4*)(P.cng + 4 * lane), lb = *(const f32x4*)(P.cnb + 4 * lane);
    float s1[T], s2[T];
#pragma unroll
    for (int tt = 0; tt < T; ++tt) s1[tt] = (acc[tt][0] + acc[tt][1]) + (acc[tt][2] + acc[tt][3]);
#pragma unroll
    for (int o = 1; o < 64; o <<= 1)
#pragma unroll
        for (int tt = 0; tt < T; ++tt) s1[tt] += __shfl_xor(s1[tt], o);
#pragma unroll
    for (int tt = 0; tt < T; ++tt) { const float mu = s1[tt] * (1.0f / CW); acc[tt] = acc[tt] - mu; s2[tt] = (acc[tt][0] * acc[tt][0] + acc[tt][1] * acc[tt][1]) + (acc[tt][2] * acc[tt][2] + acc[tt][3] * acc[tt][3]); }
#pragma unroll
    for (int o = 1; o < 64; o <<= 1)
#pragma unroll
        for (int tt = 0; tt < T; ++tt) s2[tt] += __shfl_xor(s2[tt], o);
#pragma unroll
    for (int tt = 0; tt < T; ++tt) {
        const float rstd = 1.0f / sqrtf(s2[tt] * (1.0f / CW) + EPS);
        f32x4 y = acc[tt] * rstd * lg + lb;
#pragma unroll
        for (int e = 0; e < 4; ++e) y[e] = y[e] * sigmoidf_(y[e]);
        u32x2 o; o.x = pk2(y[0], y[1]); o.y = pk2(y[2], y[3]);
        *(u32x2*)(P.Abr + (size_t)(row0 + tt) * D + 768 + 4 * lane) = o;
    }
}

#define XB_TMO      128
#define XB_XCNT(j)  (256  + 64 * (j))
#define XB_XSUB(j)  (1280 + 64 * (j))
#define XB_XGEN(j)  (2304 + 64 * (j))
#define XB_TOP      3328
#define XB_TOPGEN   3392
#define XB_LCNT(j)  (3456 + 64 * (j))
#define XB_MISMATCH 4480
#define XB_CONV     4544
#define XCD_BAR_WORDS 4608
#define XB_SPIN_CAP (1u << 18)
__device__ __forceinline__ unsigned xb_ld(unsigned* p)              { return __hip_atomic_load(p, __ATOMIC_RELAXED, __HIP_MEMORY_SCOPE_AGENT); }
__device__ __forceinline__ unsigned xb_add(unsigned* p, unsigned v) { return __hip_atomic_fetch_add(p, v, __ATOMIC_RELAXED, __HIP_MEMORY_SCOPE_AGENT); }
__device__ __forceinline__ unsigned xb_xcc_id() { return (unsigned)__builtin_amdgcn_s_getreg((3 << 11) | 20) & 0xFu; }
#define XB_SPIN(cond, bar) do { unsigned _sp = 0; while (cond) { __builtin_amdgcn_s_sleep(1); \
    if ((++_sp & 255u) == 0u) { if (xb_ld(&(bar)[XB_TMO])) break; if (_sp > XB_SPIN_CAP) { atomicAdd(&(bar)[XB_TMO], 1u); break; } } } } while (0)
struct XcdBarrier { unsigned* bar; unsigned x; unsigned nloc, nx; };
#define XB_LOCAL_OK 0x80000000u
__device__ __forceinline__ XcdBarrier xcd_barrier_post(unsigned* bar) {
    XcdBarrier b; b.bar = bar; b.x = xb_xcc_id(); b.nloc = 0u; b.nx = 0u;
    asm volatile("" : "+s"(b.x));
    if (threadIdx.x == 0) {
        if (b.x != (blockIdx.x & 7u) || gridDim.x != 256u) { (void)xb_add(&bar[XB_MISMATCH], 1u); asm volatile("s_waitcnt vmcnt(0)" ::: "memory"); }
        (void)xb_add(&bar[XB_XCNT(b.x)], 1u);
    }
    return b;
}
__device__ __forceinline__ void xcd_barrier_complete(unsigned* bar, unsigned x, unsigned& nloc, unsigned& nx) {
    asm volatile("" : "+s"(bar));
    const unsigned G = gridDim.x * gridDim.y * gridDim.z;
    unsigned sum, cnt, mine, sp = 0u;
    for (;;) {
        sum = 0u; cnt = 0u; mine = 0u;
#pragma unroll
        for (unsigned j = 0; j < 16; ++j) { const unsigned c = xb_ld(&bar[XB_XCNT(j)]); sum += c; cnt += (c > 0u) ? 1u : 0u; mine = (j == x) ? c : mine; }
        if (sum == G) break;
        __builtin_amdgcn_s_sleep(1);
        if ((++sp & 255u) == 0u) { if (xb_ld(&bar[XB_TMO])) break; if (sp > XB_SPIN_CAP) { atomicAdd(&bar[XB_TMO], 1u); break; } }
    }
    nloc = mine > 0u ? mine : 1u; nx = cnt > 0u ? cnt : 1u;
}
__device__ __forceinline__ void xcd_barrier_t0(XcdBarrier& b) {
    {
        unsigned* bar = b.bar; asm volatile("" : "+s"(bar));
        unsigned bx_ = b.x; asm volatile("" : "+s"(bx_));
        __builtin_amdgcn_s_waitcnt(0);
        unsigned nloc = b.nloc, nx = b.nx;
        if (nloc == 0u) { xcd_barrier_complete(bar, bx_, nloc, nx); b.nloc = nloc; b.nx = nx | ((nloc == 32u && xb_ld(&bar[XB_MISMATCH]) == 0u) ? XB_LOCAL_OK : 0u); }
        nx &= ~XB_LOCAL_OK;
        const unsigned old = xb_add(&bar[XB_XSUB(bx_)], 1u);
        const unsigned gen = old / nloc;
        if (old + 1u == (gen + 1u) * nloc) {
            __builtin_amdgcn_fence(__ATOMIC_RELEASE, "agent");
            asm volatile("s_waitcnt vmcnt(0)" ::: "memory");
            const unsigned og = xb_add(&bar[XB_TOP], 1u);
            const unsigned tg = og / nx;
            if (og + 1u == (tg + 1u) * nx) xb_add(&bar[XB_TOPGEN], 1u);
            else XB_SPIN(xb_ld(&bar[XB_TOPGEN]) == tg, bar);
            __builtin_amdgcn_fence(__ATOMIC_ACQUIRE, "agent");
            xb_add(&bar[XB_XGEN(bx_)], 1u);
            asm volatile("s_waitcnt vmcnt(0)" ::: "memory");
        } else {
            XB_SPIN(xb_ld(&bar[XB_XGEN(bx_)]) == gen, bar);
            __builtin_amdgcn_fence(__ATOMIC_ACQUIRE, "agent");
            asm volatile("s_waitcnt vmcnt(0)" ::: "memory");
        }
    }
}
__device__ __forceinline__ void xcd_barrier(XcdBarrier& b) {
    asm volatile("s_waitcnt vmcnt(0)" ::: "memory");
    __syncthreads();
    if (threadIdx.x == 0) xcd_barrier_t0(b);
    b.nloc = __builtin_amdgcn_readfirstlane(b.nloc); b.nx = __builtin_amdgcn_readfirstlane(b.nx);
    __syncthreads();
}
__device__ __forceinline__ void xcd_local_barrier(XcdBarrier& b, unsigned k  , unsigned conv_need = 0u  ) {
    asm volatile("s_waitcnt vmcnt(0)" ::: "memory");
    __syncthreads();
    if (threadIdx.x == 0) {
        if (b.nx & XB_LOCAL_OK) {
            __builtin_amdgcn_s_waitcnt(0);
            unsigned* lb = b.bar; asm volatile("" : "+s"(lb));
            unsigned lx = b.x; asm volatile("" : "+s"(lx));
            unsigned* c = &lb[XB_LCNT(lx)];
            const unsigned target = k * 32u;
            (void)xb_add(c, 1u);
            XB_SPIN(xb_ld(c) < target, lb);
            if (conv_need) XB_SPIN(xb_ld(&lb[XB_CONV]) < conv_need, lb);
            __builtin_amdgcn_fence(__ATOMIC_ACQUIRE, "agent");
            asm volatile("s_waitcnt vmcnt(0)" ::: "memory");
        } else xcd_barrier_t0(b);
    }
    b.nloc = __builtin_amdgcn_readfirstlane(b.nloc); b.nx = __builtin_amdgcn_readfirstlane(b.nx);
    __syncthreads();
}

constexpr int TP_PITCH = 65, TP_BYTES = 64 * TP_PITCH * 4;
__device__ __forceinline__ void st16_wt(void* p, u32x4 v) { asm volatile("global_store_dwordx4 %0, %1, off sc1\n\ts_nop 1" :: "v"(p), "v"(v) : "memory"); }
template <bool WITH_C, bool GU_PERM, bool WT = false>
__device__ __forceinline__ void transpose_item(const float* W, int N, bf16_t* WTp, int ldt, int kcol0, LAS float* scr, int item, int lane,
                                               const float* shraw  , const float* shb  , float* csum  ) {
    const int nblk = N / 64, kb = item / nblk, nb = item % nblk, k0 = 64 * kb, n0 = 64 * nb;
    {
        const int r4 = lane >> 4, c4 = lane & 15;
        f32x4 v[16];
#pragma unroll
        for (int i = 0; i < 16; ++i) v[i] = __builtin_nontemporal_load((const f32x4*)(W + (size_t)(k0 + 4 * i + r4) * N + n0 + 4 * c4));
#pragma unroll
        for (int i = 0; i < 16; ++i) { LAS float* p = scr + (4 * i + r4) * TP_PITCH + 4 * c4; p[0] = v[i][0]; p[1] = v[i][1]; p[2] = v[i][2]; p[3] = v[i][3]; }
    }
    const int c = lane & 7, nn = lane >> 3;
    f32x4 sh[3][2];
    if (WITH_C) {
#pragma unroll
        for (int r = 0; r < 3; ++r)
#pragma unroll
            for (int h = 0; h < 2; ++h) sh[r][h] = *(const f32x4*)(shraw + (size_t)r * NMOD + k0 + 8 * c + 4 * h) + *(const f32x4*)(shb + k0 + 8 * c + 4 * h);
    }
    LDS_WAIT(); asm volatile("" ::: "memory");
#pragma unroll
    for (int j = 0; j < 8; ++j) {
        const int n = 8 * j + nn; const LAS float* s = scr + (8 * c) * TP_PITCH + n;
        float w[8];
#pragma unroll
        for (int q = 0; q < 8; ++q) w[q] = s[q * TP_PITCH];
        u32x4 o; o.x = pk2(w[0], w[1]); o.y = pk2(w[2], w[3]); o.z = pk2(w[4], w[5]); o.w = pk2(w[6], w[7]);
        int nrow = n0 + n;
        if (GU_PERM) nrow = nrow < FFN ? ((nrow >> 7) * 256 + (nrow & 127)) : (((nrow - FFN) >> 7) * 256 + 128 + ((nrow - FFN) & 127));
        if (WT) st16_wt(WTp + (size_t)nrow * ldt + kcol0 + k0 + 8 * c, o); else *(u32x4*)(WTp + (size_t)nrow * ldt + kcol0 + k0 + 8 * c) = o;
        if (WITH_C) {
            float d0 = 0.f, d1 = 0.f, d2 = 0.f;
#pragma unroll
            for (int q = 0; q < 8; ++q) { d0 += sh[0][q >> 2][q & 3] * w[q]; d1 += sh[1][q >> 2][q & 3] * w[q]; d2 += sh[2][q >> 2][q & 3] * w[q]; }
#pragma unroll
            for (int x = 1; x < 8; x <<= 1) { d0 += __shfl_xor(d0, x); d1 += __shfl_xor(d1, x); d2 += __shfl_xor(d2, x); }
            if (c == 0) { atomicAdd(csum + n0 + n, d0); atomicAdd(csum + N + n0 + n, d1); atomicAdd(csum + 2 * N + n0 + n, d2); }
        }
    }
    LDS_WAIT(); asm volatile("" ::: "memory");
}

constexpr int NWAVES = 8;
constexpr int I_IN = 16 * (NIN / 64), I_GU = 16 * (NGU / 64), I_DN = (FFN / 64) * 16, I_OUT = 16 * 16, I_OA = 8 * 16, I_OC = 4 * 16;
constexpr int I_LAYER = I_IN + I_GU + I_DN + I_OUT + I_OA + I_OC;
#ifndef MK_TAIL
#define MK_TAIL I_LAYER
#endif
constexpr int I_TAIL = MK_TAIL, I_HEAD = I_LAYER - I_TAIL;
constexpr int I_MIX = (I_TAIL >= 512) ? 512 : 0;
#ifndef MK_BG1
#define MK_BG1 1536
#endif
constexpr int I_BG1 = MK_BG1;
static_assert(I_HEAD + I_BG1 <= I_LAYER - I_MIX, "background split");
static_assert(I_HEAD == 0 && I_IN <= I_BG1, "every w_in item of the next layer belongs to the 24 converter workgroups (their tickets gate the XCD-local seam before the next in-projection)");
#define TRANSPOSE_LAYER_ITEM(l_, r0_, scr_, lane_) do { const int tl_ = (l_); int tr_ = (r0_); \
        const float* shraw1_ = MODRAW + (size_t)(tl_ * 3) * NMOD; const float* shraw2_ = MODRAW + (size_t)(tl_ * 3) * NMOD + 3 * D; \
        if (tr_ < I_IN) { transpose_item<true, false, true>(w_in + (size_t)tl_ * D * NIN, NIN, WIN + (size_t)tl_ * NIN * D, D, 0, scr_, tr_, lane_, shraw1_, b_mod + (size_t)tl_ * NMOD, C1 + (size_t)(tl_ * 3) * NIN); break; } tr_ -= I_IN; \
        if (tr_ < I_GU) { transpose_item<true, true>(w_gu + (size_t)tl_ * D * NGU, NGU, WGU + (size_t)tl_ * NGU * D, D, 0, scr_, tr_, lane_, shraw2_, b_mod + (size_t)tl_ * NMOD + 3 * D, C2 + (size_t)(tl_ * 3) * NGU); break; } tr_ -= I_GU; \
        if (tr_ < I_DN) { transpose_item<false, false>(w_down + (size_t)tl_ * FFN * D, D, WDN + (size_t)tl_ * D * FFN, FFN, 0, scr_, tr_, lane_, nullptr, nullptr, nullptr); break; } tr_ -= I_DN; \
        if (tr_ < I_OUT) { transpose_item<false, false>(w_out + (size_t)tl_ * D * D, D, WOUT + (size_t)tl_ * D * D, D, 0, scr_, tr_, lane_, nullptr, nullptr, nullptr); break; } tr_ -= I_OUT; \
        if (tr_ < I_OA) { transpose_item<false, false>(w_oa + (size_t)tl_ * NAW * D, D, WBR + (size_t)tl_ * D * D, D, 0, scr_, tr_, lane_, nullptr, nullptr, nullptr); break; } tr_ -= I_OA; \
        transpose_item<false, false>(w_oc + (size_t)tl_ * CW * D, D, WBR + (size_t)tl_ * D * D, D, 768, scr_, tr_, lane_, nullptr, nullptr, nullptr); } while (0)
constexpr int LDS_BYTES = 163840;
static_assert(8 * TP_BYTES <= LDS_BYTES, "LDS map");
constexpr int NPHASE = 2 + 6 * DEPTH + 1;

struct Args {
    const float* in[26]; float* out; unsigned char* ws; int ph_lo, ph_hi;
};

__global__ void __launch_bounds__(NWAVES * 64, 2) fwd_kernel(Args args) {
    extern __shared__ __attribute__((aligned(16))) unsigned char lds_raw[];
    LAS unsigned char* lds = (LAS unsigned char*)lds_raw;
    const int tid = threadIdx.x, lane = tid & 63, wave = __builtin_amdgcn_readfirstlane(tid >> 6);
    const int G = gridDim.x, bx = blockIdx.x;
    const int vcu = (G % 8 == 0) ? (bx % 8) * (G / 8) + bx / 8 : bx;
    const int gw = vcu * NWAVES + wave, NGW = G * NWAVES;
    typedef const Args __attribute__((address_space(4))) * ArgsP;
    ArgsP KAP = (ArgsP)__builtin_amdgcn_kernarg_segment_ptr();
#define PHASE_PTRS() asm volatile("" : "+s"(KAP))
#define WSB (KAP->ws)
#define ctlf ((float*)(WSB + WS_CTL))
#define x_prompt (KAP->in[0])
#define x_sample (KAP->in[1])
#define cache_k (KAP->in[2])
#define cache_v (KAP->in[3])
#define cvec (KAP->in[4])
#define c_ctx (KAP->in[5])
#define w_mod (KAP->in[6])
#define b_mod (KAP->in[7])
#define norm1_g (KAP->in[8])
#define norm2_g (KAP->in[9])
#define w_in (KAP->in[10])
#define b_gate (KAP->in[11])
#define rpb (KAP->in[12])
#define w_oa (KAP->in[13])
#define w_pool (KAP->in[14])
#define pool_scale (KAP->in[15])
#define w_ob (KAP->in[16])
#define w_dw (KAP->in[17])
#define b_dw (KAP->in[18])
#define conv_norm_g (KAP->in[19])
#define conv_norm_b (KAP->in[20])
#define w_oc (KAP->in[21])
#define w_out (KAP->in[22])
#define w_gu (KAP->in[23])
#define w_down (KAP->in[24])
#define final_g (KAP->in[25])
#define MODRAW (ctlf + CF_MODRAW)
#define C1 (ctlf + CF_C1)
#define C2 (ctlf + CF_C2)
#define RSS (ctlf + CF_RSS)
#define MODT ((float*)(WSB + WS_MODT))
#define WIN ((bf16_t*)(WSB + WS_WIN))
#define WGU ((bf16_t*)(WSB + WS_WGU))
#define WDN ((bf16_t*)(WSB + WS_WDN))
#define WBR ((bf16_t*)(WSB + WS_WBR))
#define WOUT ((bf16_t*)(WSB + WS_WOUT))
#define X ((float*)(WSB + WS_X))
#define XG ((bf16_t*)(WSB + WS_XG))
#define Qb ((bf16_t*)(WSB + WS_Q))
#define Kb ((bf16_t*)(WSB + WS_K))
#define VT ((bf16_t*)(WSB + WS_VT))
#define KC ((bf16_t*)(WSB + WS_KC))
#define VTC ((bf16_t*)(WSB + WS_VTC))
#define PIN ((bf16_t*)(WSB + WS_PIN))
#define CIN ((bf16_t*)(WSB + WS_CIN))
#define GT ((bf16_t*)(WSB + WS_G))
#define ABR ((bf16_t*)(WSB + WS_ABR))
#define MF ((float*)(WSB + WS_MF))
#define MB ((bf16_t*)(WSB + WS_MB))
#define ACT ((bf16_t*)(WSB + WS_ACT))

#if !MK_PER_PHASE
    XcdBarrier bar = xcd_barrier_post((unsigned*)(args.ws + WS_CTL) + CW_BAR);
#define GRID_BAR() xcd_barrier(bar)
#define LOCAL_BAR(k, cn) xcd_local_barrier(bar, (unsigned)(k), (unsigned)(cn))
#else
#define GRID_BAR() do {} while (0)
#define LOCAL_BAR(k, cn) do {} while (0)
#endif
    const int lo = args.ph_lo, hi = args.ph_hi;
#define IN(k) (lo <= (k) && (k) < hi)
#define SEAM(k) do { if (IN(k) && IN((k) + 1)) GRID_BAR(); } while (0)
#define SEAML(k, n, cn) do { if (IN(k) && IN((k) + 1)) LOCAL_BAR(n, cn); } while (0)

    for (int rep_ = 0; rep_ < MK_REPS(4); ++rep_) { if (rep_) GRID_BAR();
    float* MODRAW_W = rep_ ? MF : MODRAW; float* C1_W = rep_ ? MF + DEPTH * 3 * NMOD : C1; float* C2_W = rep_ ? MF + DEPTH * 3 * (NMOD + NIN) : C2;
    if (IN(0)) { PHASE_PTRS();
        LAS float* sil = (LAS float*)lds; LAS float* red = (LAS float*)(lds + 16384);
        for (int i = tid; i < 3 * D; i += NWAVES * 64) { const float s = i < D ? c_ctx[i] : cvec[i - D]; sil[i] = s * sigmoidf_(s); }
        __syncthreads();
        for (int it = vcu; it < DEPTH * 24 * 8; it += G) {
            const int l = it / 192, rem = it % 192, nc = rem >> 3, kq = rem & 7, k0 = kq * 128 + wave * 16, n0 = nc * 256 + 4 * lane;
            const float* wp = w_mod + ((size_t)l * D + k0) * NMOD + n0;
            f32x4 w[16];
#pragma unroll
            for (int kk = 0; kk < 16; ++kk) w[kk] = __builtin_nontemporal_load((const f32x4*)(wp + (size_t)kk * NMOD));
            f32x4 a0 = {0.f, 0.f, 0.f, 0.f}, a1 = a0, a2 = a0;
#pragma unroll
            for (int kk = 0; kk < 16; ++kk) { a0 += sil[k0 + kk] * w[kk]; a1 += sil[D + k0 + kk] * w[kk]; a2 += sil[2 * D + k0 + kk] * w[kk]; }
#pragma unroll
            for (int e = 0; e < 4; ++e) { red[(wave * 12 + e) * 64 + lane] = a0[e]; red[(wave * 12 + 4 + e) * 64 + lane] = a1[e]; red[(wave * 12 + 8 + e) * 64 + lane] = a2[e]; }
            __syncthreads();
            for (int o = tid; o < 12 * 64; o += NWAVES * 64) {
                float s = 0.f;
#pragma unroll
                for (int ww = 0; ww < 8; ++ww) s += red[ww * 768 + o];
                const int q = o >> 6, ln = o & 63, r = q >> 2, e = q & 3;
                atomicAdd(MODRAW_W + (size_t)(l * 3 + r) * NMOD + nc * 256 + 4 * ln + e, s);
            }
            __syncthreads();
        }
    }
    SEAM(0);

    if (IN(1)) { PHASE_PTRS();
        LAS float* scr = (LAS float*)(lds + wave * TP_BYTES);
        constexpr int I_T = I_LAYER + (DEPTH - 1) * I_HEAD;
        constexpr int I_OB = DEPTH * 16 * 4 * 8;
        constexpr int I_X = M;
        constexpr int I_KC = DEPTH * 2 * 256;
        constexpr int I_VC = DEPTH * 2 * 8 * 4;
        constexpr int I_MT = DEPTH * 3 * 6 * 4;
        constexpr int I_ALL = I_T + I_OB + I_X + I_KC + I_VC + I_MT;
        for (int it0 = gw; it0 < I_ALL; it0 += NGW) {
            int it = it0;
            if (it < I_T) {
                if (it < I_LAYER) TRANSPOSE_LAYER_ITEM(0, it, scr, lane);
                else if constexpr (I_HEAD > 0) { const int q = it - I_LAYER; TRANSPOSE_LAYER_ITEM(1 + q / I_HEAD, q % I_HEAD, scr, lane); }
                continue;
            }
            it -= I_T;
            if (it < I_OB) {
                const int l = it / 512, rem = it % 512, nch = rem >> 5, g = (rem >> 3) & 3, cc = rem & 7, n = nch * 64 + lane;
                float a[8];
#pragma unroll
                for (int c = 0; c < 8; ++c) a[c] = 0.f;
                const float* wp = w_pool + ((size_t)(l * 4 + g) * 64 + cc * 8) * 64;
                for (int d = 0; d < 64; ++d) {
                    const float wb = w_ob[((size_t)l * PW + g * 64 + d) * D + n] * pool_scale[l * PW + g * 64 + d];
#pragma unroll
                    for (int c = 0; c < 8; ++c) a[c] += wp[c * 64 + d] * wb;
                }
                u32x4 o; o.x = pk2(a[0], a[1]); o.y = pk2(a[2], a[3]); o.z = pk2(a[4], a[5]); o.w = pk2(a[6], a[7]);
                *(u32x4*)(WBR + ((size_t)l * D + n) * D + 512 + g * 64 + cc * 8) = o;
                continue;
            }
            it -= I_OB;
            if (it < I_X) {
                const int row = it, mr = row < MP ? 0 : 1 + ((row - MP) >> 10);
                const float* xr = row < MP ? x_prompt + (size_t)row * D : x_sample + (size_t)(row - MP) * D;
                float ss = 0.f;
#pragma unroll
                for (int j = 0; j < 4; ++j) {
                    const int col = 256 * j + 4 * lane;
                    const f32x4 v = *(const f32x4*)(xr + col);
                    *(f32x4*)(X + (size_t)row * D + col) = v;
                    ss += (v[0] * v[0] + v[1] * v[1]) + (v[2] * v[2] + v[3] * v[3]);
                    const f32x4 sc = *(const f32x4*)(MODRAW + (size_t)mr * NMOD + D + col) + *(const f32x4*)(b_mod + D + col);
                    const f32x4 gg = *(const f32x4*)(norm1_g + col) * (sc + 1.0f);
                    const f32x4 xs = v * gg;
                    u32x2 o; o.x = pk2(xs[0], xs[1]); o.y = pk2(xs[2], xs[3]);
                    *(u32x2*)(XG + (size_t)row * D + col) = o;
                }
                ss = wave_sum(ss);
                if (lane == 0) RSS[row] = ss;
                continue;
            }
            it -= I_X;
            if (it < I_KC) {
                const int l = it / 512, bs = (it >> 8) & 1, key = it & 255;
                const float* src = cache_k + (((size_t)(bs * DEPTH + l) * 256 + key) * 512) + 8 * lane;
                const f32x4 a = *(const f32x4*)src, b = *(const f32x4*)(src + 4);
                *(u32x4*)(KC + (((size_t)(l * 2 + bs) * 256 + key) * 512) + 8 * lane) = pk8(a, b);
                continue;
            }
            it -= I_KC;
            if (it < I_VC) {
                const int l = it / 64, bs = (it >> 5) & 1, h = (it >> 2) & 7, kb = it & 3, key = kb * 64 + lane;
                const float* src = cache_v + (((size_t)(bs * DEPTH + l) * 256 + key) * 512) + h * 64;
                bf16_t* dst = VTC + ((size_t)((l * 2 + bs) * 8 + h) * 64) * 256 + pos_of_key(key);
#pragma unroll
                for (int d4 = 0; d4 < 16; ++d4) {
                    const f32x4 v = *(const f32x4*)(src + 4 * d4);
                    const unsigned w0 = pk2(v[0], v[1]), w1 = pk2(v[2], v[3]);
                    dst[(size_t)(4 * d4 + 0) * 256] = (bf16_t)(w0 & 0xffff); dst[(size_t)(4 * d4 + 1) * 256] = (bf16_t)(w0 >> 16);
                    dst[(size_t)(4 * d4 + 2) * 256] = (bf16_t)(w1 & 0xffff); dst[(size_t)(4 * d4 + 3) * 256] = (bf16_t)(w1 >> 16);
                }
                continue;
            }
            it -= I_VC;
            {
                const int q = it & 3, which = (it >> 2) % 6, lr = it / 24, l = lr / 3, col = q * 256 + 4 * lane;
                const float* mraw = MODRAW + (size_t)lr * NMOD; const float* bm = b_mod + (size_t)l * NMOD;
                f32x4 v;
                if (which == 0) v = *(const f32x4*)(norm1_g + (size_t)l * D + col) * (*(const f32x4*)(mraw + D + col) + *(const f32x4*)(bm + D + col) + 1.0f);
                else if (which == 1) v = *(const f32x4*)(mraw + col) + *(const f32x4*)(bm + col);
                else if (which == 2) v = *(const f32x4*)(mraw + 2 * D + col) + *(const f32x4*)(bm + 2 * D + col);
                else if (which == 3) v = *(const f32x4*)(norm2_g + (size_t)l * D + col) * (*(const f32x4*)(mraw + 4 * D + col) + *(const f32x4*)(bm + 4 * D + col) + 1.0f);
                else if (which == 4) v = *(const f32x4*)(mraw + 3 * D + col) + *(const f32x4*)(bm + 3 * D + col);
                else v = *(const f32x4*)(mraw + 5 * D + col) + *(const f32x4*)(bm + 5 * D + col);
                *(f32x4*)(MODT + ((size_t)lr * 6 + which) * D + col) = v;
            }
        }
        LDS_WAIT(); __syncthreads();
    }
    }
    SEAM(1);

    for (int l = 0; l < DEPTH; ++l) {
        const int p0 = 2 + 6 * l;
        const float* modt_l = MODT + (size_t)l * 3 * 6 * D;
        for (int rep_ = 0; rep_ < MK_REPS(0); ++rep_) { if (rep_) GRID_BAR();
        if (IN(p0)) { PHASE_PTRS();
            pg8::Gemm g{XG, WIN + (size_t)l * NIN * D, D, D};
            pg8::TileOrder S; S.init(M, NIN, D, G, bx);
            EpiIn E{RSS + (size_t)(2 * l) * M, C1 + (size_t)(l * 3) * NIN, b_gate + (size_t)l * 3072, Qb, Kb, VT, PIN, CIN, GT,
                    args.out + OUT_K + (size_t)l * 256 * 512, args.out + OUT_V + (size_t)l * 256 * 512};
            pg8::gemm_phase<EpiIn, pg8::TileOrder>(lds, g, S, E);
        }
        }
        SEAM(p0);
        for (int rep_ = 0; rep_ < MK_REPS(1); ++rep_) { if (rep_) GRID_BAR();
        if (IN(p0 + 1)) { PHASE_PTRS();
            AttnPtrs AP{Qb, Kb, VT, KC + (size_t)l * 2 * 256 * 512, VTC + (size_t)l * 2 * 8 * 64 * 256, ABR};
            PcPtrs PP{PIN, CIN, w_dw + (size_t)l * CONVK * CW, b_dw + (size_t)l * CW, conv_norm_g + (size_t)l * CW, conv_norm_b + (size_t)l * CW, ABR};
            int lane_p = lane; asm volatile("" : "+v"(lane_p));
            if (vcu < 128) {
                LAS float* rpl = (LAS float*)(lds + 1024); LAS float* parts = (LAS float*)(lds + 16384);
                LAS unsigned char* kl = lds + 53248; LAS unsigned char* vl = kl + PA_K_BYTES;
                const float* rpb_l = rpb + (size_t)l * 8 * 15 * 31;
                for (int i = wave * 64 + lane_p; i < 8 * 15 * 31; i += NWAVES * 64) rpl[i] = rpb_l[i] * LOG2E;
                if (!(rep_ && MK_VAR == 1)) attn_sample_block(AP, kl, vl, rpl, parts, vcu, wave, lane_p);
                { const int pu = vcu * NWAVES + wave; if (pu < 768 && !(rep_ && (MK_VAR == 4 || MK_VAR == 5))) pool_unit(PP, pu, lane_p); }
            } else {
                LAS float* wl = (LAS float*)lds; LAS unsigned char* kl = lds + 49152; LAS unsigned char* vl = kl + PA_K_BYTES;
                const int bh = vcu - 128;
                for (int i = wave * 64 + lane_p; i < 47 * CW / 4; i += NWAVES * 64) { const int j = i / (CW / 4) - 7;
                    *(LAS f32x4*)(wl + 4 * i) = (j >= 0 && j < CONVK) ? *(const f32x4*)(PP.wdw + 4 * (i - 7 * (CW / 4))) : (f32x4){0.f, 0.f, 0.f, 0.f}; }
                { StageRegs R; attn_stage_load(R, AP.K + (size_t)((bh >> 3) * 256) * NAW + (bh & 7) * 64, AP.Vt + (size_t)(bh * 64) * 256, 256, 256, wave * 64 + lane_p); attn_stage_store(R, 256, kl, vl, wave * 64 + lane_p); }
                LDS_WAIT(); __syncthreads();
                if (!(rep_ && (MK_VAR == 2 || MK_VAR == 5))) attn_prompt_lds(AP, kl, vl, bh, wave, lane_p);
                { const int it = bh * NWAVES + wave;
                    if (it < 768) { if (!(rep_ && (MK_VAR == 3 || MK_VAR == 5))) conv_unit(PP, wl, it, lane_p); } }
                if (I_MIX > 0 && bh >= 96 && l + 1 < DEPTH && !rep_) {
                    __syncthreads();
                    LAS float* scr = (LAS float*)(lds + wave * TP_BYTES);
#pragma unroll 1
                    for (int r = I_LAYER - I_MIX + (bh - 96) * NWAVES + wave; r < I_LAYER; r += 32 * NWAVES) TRANSPOSE_LAYER_ITEM(l + 1, r, scr, lane_p);
                    LDS_WAIT();
                }
            }
            __syncthreads();
        }
        }
        SEAM(p0 + 1);
        const int t192 = (bx & 7) * 32 + (bx >> 3), pm192 = t192 >> 3, pn192 = t192 & 7;
        const bool has192 = (G == 256);
        for (int rep_ = 0; rep_ < MK_REPS(2); ++rep_) { if (rep_) GRID_BAR();
        if (IN(p0 + 2)) { PHASE_PTRS();
            EpiBranch192 E{GT, MB};
            if (has192) g192::gemm<EpiBranch192>(lds, ABR, D, WBR + (size_t)l * D * D, D, pm192, pn192, 16, E);
        }
        }
        SEAML(p0 + 2, 4 * l + 1, 0);
        for (int rep_ = 0; rep_ < MK_REPS(5); ++rep_) { if (rep_) GRID_BAR();
        if (IN(p0 + 3)) { PHASE_PTRS();
            EpiRes192 E{rep_ ? MF : X, rep_ ? ACT : XG, modt_l + 2 * D, modt_l + 3 * D, rep_ ? (float*)ABR : RSS + (size_t)(2 * l + 1) * M};
            if (has192) g192::gemm<EpiRes192>(lds, MB, D, WOUT + (size_t)l * D * D, D, pm192, pn192, 16, E);
        }
        }
        SEAML(p0 + 3, 4 * l + 2, 0);
        for (int rep_ = 0; rep_ < MK_REPS(3); ++rep_) { if (rep_) GRID_BAR();
        if (IN(p0 + 4)) { PHASE_PTRS();
            pg8::Gemm g{XG, WGU + (size_t)l * NGU * D, D, D};
            const bool bg = (I_TAIL > 0 && l + 1 < DEPTH && G == 256);
            const int nw = bg ? 232 : 256;
            pg8::TileOrderGU S; S.init(M, NGU, D, nw, bx);
            EpiGU E{RSS + (size_t)(2 * l + 1) * M, C2 + (size_t)(l * 3) * NGU, ACT};
            pg8::gemm_phase<EpiGU, pg8::TileOrderGU>(lds, g, S, E);
            if (bg && bx >= 128) {
                int lane_b = lane; asm volatile("" : "+v"(lane_b));
                LAS float* scr = (LAS float*)(lds + wave * TP_BYTES);
                const bool conv_only = bx >= nw;
                const int r0 = conv_only ? I_HEAD + (bx - 232) * NWAVES + wave : I_HEAD + I_BG1 + (bx - 128) * NWAVES + wave;
                const int r1 = conv_only ? I_HEAD + I_BG1 : I_LAYER - I_MIX, rs = conv_only ? 24 * NWAVES : 104 * NWAVES;
#pragma unroll 1
                for (int r = r0; r < r1; r += rs) TRANSPOSE_LAYER_ITEM(l + 1, r, scr, lane_b);
                LDS_WAIT(); asm volatile("s_waitcnt vmcnt(0)" ::: "memory"); __syncthreads();
                if (conv_only && tid == 0) (void)xb_add((unsigned*)(WSB + WS_CTL) + CW_BAR + XB_CONV, 1u);
            }
        }
        }
        SEAML(p0 + 4, 4 * l + 3, 0);
        for (int rep_ = 0; rep_ < MK_REPS(6); ++rep_) { if (rep_) GRID_BAR();
        if (IN(p0 + 5)) { PHASE_PTRS();
            EpiRes192 E{rep_ ? MF : X, rep_ ? MB : XG, modt_l + 5 * D, MODT + (size_t)((l + 1) % DEPTH) * 3 * 6 * D, rep_ ? (float*)ABR : RSS + (size_t)(2 * l + 2) * M};
            if (has192) g192::gemm<EpiRes192>(lds, ACT, FFN, WDN + (size_t)l * D * FFN, FFN, pm192, pn192, FFN / 64, E);
        }
        }
        SEAML(p0 + 5, 4 * l + 4, (l + 1 < DEPTH) ? 24 * (l + 1) : 0);
    }
    if (IN(NPHASE - 1)) { PHASE_PTRS();
        for (int row0 = (bx >> 3) * NWAVES + wave; row0 < M / 8; row0 += (G >> 3) * NWAVES) {
            const int row = (bx & 7) * (M / 8) + row0;
            const float rinv = 1.0f / sqrtf(RSS[(size_t)8 * M + row] * (1.0f / D) + EPS);
#pragma unroll
            for (int j = 0; j < 4; ++j) {
                const int col = 256 * j + 4 * lane;
                const f32x4 v = *(const f32x4*)(X + (size_t)row * D + col) * rinv * *(const f32x4*)(final_g + col);
                __builtin_nontemporal_store(v, (f32x4*)(args.out + OUT_Y + (size_t)row * D + col));
            }
        }
    }
#undef IN
#undef PHASE_PTRS
#undef WSB
#undef ctlf
#undef x_prompt
#undef x_sample
#undef cache_k
#undef cache_v
#undef cvec
#undef c_ctx
#undef w_mod
#undef b_mod
#undef norm1_g
#undef norm2_g
#undef w_in
#undef b_gate
#undef rpb
#undef w_oa
#undef w_pool
#undef pool_scale
#undef w_ob
#undef w_dw
#undef b_dw
#undef conv_norm_g
#undef conv_norm_b
#undef w_oc
#undef w_out
#undef w_gu
#undef w_down
#undef final_g
#undef MODRAW
#undef C1
#undef C2
#undef RSS
#undef MODT
#undef WIN
#undef WGU
#undef WDN
#undef WBR
#undef WOUT
#undef X
#undef XG
#undef Qb
#undef Kb
#undef VT
#undef KC
#undef VTC
#undef PIN
#undef CIN
#undef GT
#undef ABR
#undef MF
#undef MB
#undef ACT
#undef SEAM
#undef SEAML
}

extern "C" void kernel_launch(void* const* d_in, const int* in_sizes, int n_in, void* d_out, int out_size, void* d_ws, size_t ws_size, hipStream_t stream) {
    static int grid = 0;
    if (grid == 0) {
        if (n_in != 26 || ws_size < WS_END) { fprintf(stderr, "kernel_launch: expected 26 inputs and >= %zu bytes of workspace; got %d, %zu\n", (size_t)WS_END, n_in, ws_size); grid = -1; return; }
        int dev = 0, cus = 0;
        if (hipGetDevice(&dev) != hipSuccess || hipDeviceGetAttribute(&cus, hipDeviceAttributeMultiprocessorCount, dev) != hipSuccess) { grid = -1; return; }
        if (hipFuncSetAttribute((const void*)fwd_kernel, hipFuncAttributeMaxDynamicSharedMemorySize, LDS_BYTES) != hipSuccess) { fprintf(stderr, "kernel_launch: hipFuncSetAttribute failed\n"); grid = -1; return; }
        (void)hipGetLastError();
        grid = cus;
    }
    if (grid < 0) return;
    (void)hipMemsetAsync((char*)d_ws + WS_CTL, 0, CTL_ZERO_BYTES, stream);
    Args a{};
    for (int i = 0; i < 26; ++i) a.in[i] = (const float*)d_in[i];
    a.out = (float*)d_out; a.ws = (unsigned char*)d_ws;
#if MK_PER_PHASE
    for (int p = 0; p < NPHASE; ++p) { a.ph_lo = p; a.ph_hi = p + 1; hipLaunchKernelGGL(fwd_kernel, dim3(grid), dim3(NWAVES * 64), LDS_BYTES, stream, a); }
#else
    a.ph_lo = 0; a.ph_hi = NPHASE;
    hipLaunchKernelGGL(fwd_kernel, dim3(grid), dim3(NWAVES * 64), LDS_BYTES, stream, a);
#endif
}
```

```cpp
#include <hip/hip_runtime.h>
#include <cstdio>
#include <cstdint>

#ifndef MK_PER_PHASE
#define MK_PER_PHASE 0
#endif

#ifndef MK_REPEAT
#define MK_REPEAT 0
#endif
#define MK_REPS(bit) ((MK_REPEAT >> (bit)) & 1 ? 2 : 1)
#ifndef MK_VAR
#define MK_VAR 0
#endif

constexpr int D = 1024, MP = 4096, MS = 2048, M = MP + MS, DEPTH = 4;
constexpr int NIN = 5376, FFN = 2816, NGU = 2 * FFN, NMOD = 6 * D;
constexpr int NAW = 512, PW = 256, CW = 256, CONVK = 31;
constexpr float EPS = 1e-6f;
constexpr float LOG2E = 1.4426950408889634f;
constexpr float QSCALE = 0.125f * LOG2E;

constexpr size_t MiB = 1u << 20;
constexpr size_t WS_CTL = 0, CTL_ZERO_BYTES = 5 * MiB / 4;
constexpr int CW_BAR = 4096;
constexpr int CF_MODRAW = 16384;
constexpr int CF_C1 = CF_MODRAW + DEPTH * 3 * NMOD;
constexpr int CF_C2 = CF_C1 + DEPTH * 3 * NIN;
constexpr int CF_RSS = CF_C2 + DEPTH * 3 * NGU;
constexpr int CF_END = CF_RSS + 9 * M;
static_assert((size_t)CF_END * 4 <= CTL_ZERO_BYTES, "control region");
constexpr size_t WS_MODT = 2 * MiB;
constexpr size_t WS_WIN = 4 * MiB;
constexpr size_t WS_WGU = 46 * MiB;
constexpr size_t WS_WDN = 90 * MiB;
constexpr size_t WS_WBR = 112 * MiB;
constexpr size_t WS_WOUT = 120 * MiB;
constexpr size_t WS_X = 128 * MiB;
constexpr size_t WS_XG = 152 * MiB;
constexpr size_t WS_Q = 164 * MiB, WS_K = 170 * MiB;
constexpr size_t WS_VT = 176 * MiB;
constexpr size_t WS_KC = 182 * MiB;
constexpr size_t WS_VTC = 184 * MiB;
constexpr size_t WS_PIN = 186 * MiB;
constexpr size_t WS_CIN = 189 * MiB;
constexpr size_t WS_G = 195 * MiB;
constexpr size_t WS_ABR = 231 * MiB;
constexpr size_t WS_MF = 243 * MiB;
constexpr size_t WS_MB = 267 * MiB;
constexpr size_t WS_ACT = 279 * MiB;
constexpr size_t WS_END = 312 * MiB;
constexpr size_t VT_SAMPLE_OFF = (size_t)16 * 8 * 64 * 256;

constexpr size_t OUT_Y = 0, OUT_K = (size_t)M * D, OUT_V = OUT_K + (size_t)16 * DEPTH * 256 * 512;

#define GAS __attribute__((address_space(1)))
#define LAS __attribute__((address_space(3)))
typedef unsigned short bf16_t;
typedef short bf16x8 __attribute__((ext_vector_type(8)));
typedef float f32x4 __attribute__((ext_vector_type(4)));
typedef float f32x2 __attribute__((ext_vector_type(2)));
typedef float f32x16 __attribute__((ext_vector_type(16)));
typedef unsigned u32x4 __attribute__((ext_vector_type(4)));
typedef unsigned u32x2 __attribute__((ext_vector_type(2)));
typedef __bf16 bf16x2_t __attribute__((ext_vector_type(2)));
#define LDS_WAIT() asm volatile("s_waitcnt lgkmcnt(0)" ::: "memory")

__device__ __forceinline__ unsigned pk2(float lo, float hi) { f32x2 v = {lo, hi}; bf16x2_t b = __builtin_convertvector(v, bf16x2_t); return __builtin_bit_cast(unsigned, b); }
__device__ __forceinline__ u32x4 pk8(f32x4 a, f32x4 b) { u32x4 w; w.x = pk2(a[0], a[1]); w.y = pk2(a[2], a[3]); w.z = pk2(b[0], b[1]); w.w = pk2(b[2], b[3]); return w; }
__device__ __forceinline__ float bf_lo(unsigned w) { return __uint_as_float(w << 16); }
__device__ __forceinline__ float bf_hi(unsigned w) { return __uint_as_float(w & 0xffff0000u); }
__device__ __forceinline__ float sigmoidf_(float x) { return __builtin_amdgcn_rcpf(1.0f + __builtin_amdgcn_exp2f(-LOG2E * x)); }
__device__ __forceinline__ float wave_sum(float v) {
#pragma unroll
    for (int o = 1; o < 64; o <<= 1) v += __shfl_xor(v, o);
    return v;
}
__device__ __forceinline__ int pos_of_key(int t) { return (t & ~12) | ((t & 4) << 1) | ((t & 8) >> 1); }
__device__ __forceinline__ int mod_row_of_pm(int pm) { return pm < 16 ? 0 : 1 + ((pm - 16) >> 2); }

namespace pg8 {
constexpr int BM = 256, BK = 64, HALF = 128, HTB = HALF * BK * 2  , STAGE_BYTES = 8 * HTB, NXCD = 8, WGM = 3;
__host__ __device__ __forceinline__ int lds_byte(int r, int c) { return r * 128 + ((((c >> 3) ^ (r >> 1)) & 7) << 4) + (c & 7) * 2; }
__host__ __device__ __forceinline__ void stage_rc(int b, int& R, int& C) { R = b >> 7; C = (((b >> 4) ^ (R >> 1)) & 7) * 8; }
__host__ __device__ __forceinline__ int perm32(int rho) { const int n = rho >> 4, i = rho & 15; return 8 * (i >> 2) + 4 * n + (i & 3); }

struct Unit { int pm, pn, k0, nt, kind, half; };
struct Gemm { const bf16_t* A; const bf16_t* Bt; int lda, ldb; };

struct TileOrder {
    int nM, nN, nwg, G, c, nt;
    __device__ void init(int M_, int N_, int K_, int G_, int c_) { nM = M_ / BM; nN = N_ / BM; nwg = nM * nN; G = G_; c = c_; nt = K_ / BK; }
    __device__ bool next(int i, Unit& u) const {
        const long L = (long)i * G + c; if (L >= nwg) return false;
        int wgid = (int)L; { const int q = nwg / NXCD, r = nwg % NXCD, xcd = wgid % NXCD, off = wgid / NXCD; wgid = (xcd < r ? xcd * (q + 1) : r * (q + 1) + (xcd - r) * q) + off; }
        const int nig = WGM * nN, gid = wgid / nig, fm = gid * WGM, gsz = (nM - fm) < WGM ? (nM - fm) : WGM;
        u.pm = fm + ((wgid % nig) % gsz); u.pn = (wgid % nig) / gsz; u.k0 = 0; u.nt = nt; u.kind = 0; u.half = 0; return true;
    }
};
struct TileOrderGU {
    int nM, nN, nwg, nw, c, nt;
    __device__ void init(int M_, int N_, int K_, int nw_, int c_) { nM = M_ / BM; nN = N_ / BM; nwg = nM * nN; nw = nw_; c = c_; nt = K_ / BK; }
    __device__ __forceinline__ void done(const Unit&, int) const {}
    __device__ void tile_of(int L, Unit& u) const {
        const int wgid = (L % NXCD) * (nwg / NXCD) + L / NXCD;
        const int nig = 3 * nN, gid = wgid / nig, fm = gid * 3;
        u.pm = fm + ((wgid % nig) % 3); u.pn = (wgid % nig) / 3; u.k0 = 0; u.nt = nt; u.kind = 0;
    }
    __device__ bool next(int i, Unit& u) const {
        if (c >= nw || i > 2) return false;
        if (i < 2) { tile_of(i * nw + c, u); u.half = 0; return true; }
        const int j = c >> 3, per = (nwg - 2 * nw) / NXCD;
        if (j >= 2 * per) return false;
        tile_of(2 * nw + (j >> 1) * NXCD + (c & 7), u); u.half = 1 + (j & 1); return true;
    }
};

struct PanelOrder {
    int c, nseg, ka, na, kb, nb, kc, nc;
    __device__ bool next(int i, Unit& u) const {
        if (c >= 96 || i >= nseg) return false;
        const int T = (c & 7) * 12 + (c >> 3);
        u.pm = T >> 2; u.pn = T & 3; u.k0 = i == 0 ? ka : (i == 1 ? kb : kc); u.nt = i == 0 ? na : (i == 1 ? nb : nc); u.kind = i; u.half = 0; return true;
    }
};

template <class Epi, class Sched>
__device__ __forceinline__ void gemm_phase(LAS unsigned char* lds, const Gemm g, const Sched& S, const Epi& E) {
    int tid = threadIdx.x; asm volatile("" : "+v"(tid));
    const int wid = __builtin_amdgcn_readfirstlane(tid >> 6), lane = tid & 63, wr = wid >> 2, wc = wid & 3, fr = lane & 15, fq = lane >> 4;
    unsigned voffA[2], voffB[2];
#pragma unroll
    for (int i = 0; i < 2; ++i) { int R, C; stage_rc(tid * 16 + i * 8192, R, C); const int Rb = (R & ~31) + perm32(R & 31);
        voffA[i] = (unsigned)(R * g.lda + C) * 2u; voffB[i] = (unsigned)(Rb * g.ldb + C) * 2u; }
    const size_t kstep = (size_t)(BK * 2);
    const size_t hstepA = (size_t)HALF * g.lda * 2, hstepB = (size_t)HALF * g.ldb * 2;
    const size_t tstepA = 2 * hstepA, tstepB = 2 * hstepB;
    const unsigned ldsw = (unsigned)wid * 1024u;
    const int aoffk[2] = {lds_byte(wr * 64 + fr, fq * 8), lds_byte(wr * 64 + fr, fq * 8 + 32)}, boffk[2] = {lds_byte(wc * 32 + fr, fq * 8), lds_byte(wc * 32 + fr, fq * 8 + 32)};
#define PG8_SA(b, h) (((b) * 2 + (h)) * HTB)
#define PG8_SB(b, h) ((4 + (b) * 2 + (h)) * HTB)
#define PG8_STAGE(bufoff, gbase, voff) do { _Pragma("unroll") for (int _i = 0; _i < 2; ++_i) \
        __builtin_amdgcn_global_load_lds((const unsigned*)((const char*)(gbase) + (voff)[_i]), (LAS unsigned*)(lds + (bufoff) + ldsw + _i * 8192), 16, 0, 0); } while (0)
#define PG8_LDA(dst, b, h) do { _Pragma("unroll") for (int m = 0; m < 4; ++m) _Pragma("unroll") for (int k = 0; k < 2; ++k) dst[m][k] = *(const LAS bf16x8*)(lds + PG8_SA(b, h) + aoffk[k] + m * 2048); } while (0)
#define PG8_LDB(dst, b, h) do { _Pragma("unroll") for (int n = 0; n < 2; ++n) _Pragma("unroll") for (int k = 0; k < 2; ++k) dst[n][k] = *(const LAS bf16x8*)(lds + PG8_SB(b, h) + boffk[k] + n * 2048); } while (0)
#define PG8_MMA(ai, bj, At, Bt) do { __builtin_amdgcn_s_setprio(1); _Pragma("unroll") for (int m = 0; m < 4; ++m) _Pragma("unroll") for (int n = 0; n < 2; ++n) _Pragma("unroll") for (int k = 0; k < 2; ++k) \
        acc[ai][bj][m][n] = __builtin_amdgcn_mfma_f32_16x16x32_bf16(Bt[n][k], At[m][k], acc[ai][bj][m][n], 0, 0, 0); __builtin_amdgcn_s_setprio(0); } while (0)
#define PG8_WAIT_V(n) asm volatile("s_waitcnt vmcnt(" #n ")" ::: "memory")
#define PG8_WAIT_L(n) asm volatile("s_waitcnt lgkmcnt(" #n ")" ::: "memory")
#define PG8_BAR __builtin_amdgcn_s_barrier()
#define PG8_SCHED __builtin_amdgcn_sched_barrier(0)
    Unit cur, nxt; int ui = 0;
    if (!S.next(0, cur)) return;
    f32x4 acc[2][2][4][2];
#pragma unroll
    for (int a = 0; a < 2; ++a)
#pragma unroll
        for (int b = 0; b < 2; ++b)
#pragma unroll
            for (int m = 0; m < 4; ++m)
#pragma unroll
                for (int n = 0; n < 2; ++n) acc[a][b][m][n] = (f32x4){0.f, 0.f, 0.f, 0.f};
    bf16x8 At[4][2], B0[2][2], B1[2][2];
    const char* cA = (const char*)g.A + (size_t)cur.pm * tstepA + (size_t)cur.k0 * 2; const char* cB = (const char*)g.Bt + (size_t)cur.pn * tstepB + (size_t)cur.k0 * 2;
    PG8_STAGE(PG8_SB(0, 0), cB, voffB); PG8_STAGE(PG8_SB(0, 1), cB + hstepB, voffB); PG8_STAGE(PG8_SA(0, 0), cA, voffA); PG8_STAGE(PG8_SA(0, 1), cA + hstepA, voffA);
    if (wr == 1) PG8_BAR;
    PG8_WAIT_V(2); PG8_BAR;
    PG8_STAGE(PG8_SB(1, 0), cB + kstep, voffB); PG8_STAGE(PG8_SA(1, 0), cA + kstep, voffA); PG8_STAGE(PG8_SB(1, 1), cB + hstepB + kstep, voffB);
    PG8_WAIT_V(6); PG8_BAR;
    for (;;) {
        const bool has_next = S.next(ui + 1, nxt);
        const char* nA = has_next ? (const char*)g.A + (size_t)nxt.pm * tstepA + (size_t)nxt.k0 * 2 : cA; const char* nB = has_next ? (const char*)g.Bt + (size_t)nxt.pn * tstepB + (size_t)nxt.k0 * 2 : cB;
        const int nt = cur.nt;
        const bool do0 = cur.half != 2, do1 = cur.half != 1;
        for (int t = 0; t < nt; t += 2) {
            const bool last = (t == nt - 2);
            const char* a1 = cA + (size_t)(t + 1) * kstep;
            const char* a2 = last ? nA : cA + (size_t)(t + 2) * kstep; const char* b2 = last ? nB : cB + (size_t)(t + 2) * kstep;
            const char* a3 = a2 + kstep; const char* b3 = b2 + kstep;
            PG8_LDB(B0, 0, 0); PG8_LDB(B1, 0, 1); PG8_SCHED; PG8_LDA(At, 0, 0); PG8_STAGE(PG8_SA(1, 1), a1 + hstepA, voffA);
            PG8_WAIT_V(8); PG8_WAIT_L(0); PG8_BAR; if (do0) { PG8_MMA(0, 0, At, B0); PG8_MMA(0, 1, At, B1); } PG8_BAR; PG8_SCHED;
            PG8_LDA(At, 0, 1); PG8_STAGE(PG8_SB(0, 0), b2, voffB); PG8_STAGE(PG8_SB(0, 1), b2 + hstepB, voffB); PG8_STAGE(PG8_SA(0, 0), a2, voffA);
            PG8_WAIT_V(8); PG8_WAIT_L(0); PG8_BAR; if (do1) { PG8_MMA(1, 0, At, B0); PG8_MMA(1, 1, At, B1); } PG8_BAR; PG8_SCHED;
            PG8_LDB(B0, 1, 0); PG8_LDB(B1, 1, 1); PG8_SCHED; PG8_LDA(At, 1, 0); PG8_STAGE(PG8_SA(0, 1), a2 + hstepA, voffA);
            PG8_WAIT_V(8); PG8_WAIT_L(0); PG8_BAR; if (do0) { PG8_MMA(0, 0, At, B0); PG8_MMA(0, 1, At, B1); } PG8_BAR; PG8_SCHED;
            PG8_LDA(At, 1, 1); PG8_STAGE(PG8_SB(1, 0), b3, voffB); PG8_STAGE(PG8_SB(1, 1), b3 + hstepB, voffB); PG8_STAGE(PG8_SA(1, 0), a3, voffA);
            PG8_WAIT_V(8); PG8_WAIT_L(0); PG8_BAR; if (do1) { PG8_MMA(1, 0, At, B0); PG8_MMA(1, 1, At, B1); } PG8_BAR; PG8_SCHED;
        }
        if (wr == 0) PG8_BAR;
        E(acc, cur, wr, wc, fr, fq);
        if (!has_next) break;
#pragma unroll
        for (int a = 0; a < 2; ++a)
#pragma unroll
            for (int b = 0; b < 2; ++b)
#pragma unroll
                for (int m = 0; m < 4; ++m)
#pragma unroll
                    for (int n = 0; n < 2; ++n) acc[a][b][m][n] = (f32x4){0.f, 0.f, 0.f, 0.f};
        cur = nxt; cA = nA; cB = nB; ++ui;
        if (wr == 1) PG8_BAR;
    }
    PG8_WAIT_V(0);
    PG8_BAR;
#undef PG8_SA
#undef PG8_SB
#undef PG8_STAGE
#undef PG8_LDA
#undef PG8_LDB
#undef PG8_MMA
#undef PG8_WAIT_V
#undef PG8_WAIT_L
#undef PG8_BAR
#undef PG8_SCHED
}
}

typedef f32x4 Acc[2][2][4][2];

struct EpiIn {
    const float* rss; const float* c1; const float* bgate;
    bf16_t *Q, *K, *Vt, *Pin, *Cin, *G; float *outk, *outv;
    __device__ __forceinline__ void operator()(const Acc& acc, const pg8::Unit& u, int wr, int wc, int fr, int fq) const {
        const int pn = u.pn, pm = u.pm, mr = mod_row_of_pm(pm);
        const int cb = pn * 256 + wc * 32 + 8 * fq;
        f32x4 cv[2][2];
#pragma unroll
        for (int bj = 0; bj < 2; ++bj)
#pragma unroll
            for (int n = 0; n < 2; ++n) { cv[bj][n] = *(const f32x4*)(c1 + (size_t)mr * NIN + cb + bj * 128 + 4 * n);
                if (pn >= 9) cv[bj][n] += *(const f32x4*)(bgate + (cb - 2304) + bj * 128 + 4 * n); }
        float rinvs[2][4];
#pragma unroll
        for (int ai = 0; ai < 2; ++ai)
#pragma unroll
            for (int m = 0; m < 4; ++m) rinvs[ai][m] = rss[pm * 256 + ai * 128 + wr * 64 + m * 16 + fr];
#pragma unroll
        for (int ai = 0; ai < 2; ++ai)
#pragma unroll
            for (int m = 0; m < 4; ++m) {
                const int row = pm * 256 + ai * 128 + wr * 64 + m * 16 + fr;
                const float rinv = 1.0f / sqrtf(rinvs[ai][m] * (1.0f / D) + EPS);
#pragma unroll
                for (int bj = 0; bj < 2; ++bj) {
                    const int col = cb + bj * 128;
                    f32x4 v0 = acc[ai][bj][m][0] * rinv + cv[bj][0], v1 = acc[ai][bj][m][1] * rinv + cv[bj][1];
                    if (pn < 2) {
                        *(u32x4*)(Q + (size_t)row * NAW + col) = pk8(v0 * QSCALE, v1 * QSCALE);
                    } else if (pn < 4) {
                        const int c = col - 512;
                        *(u32x4*)(K + (size_t)row * NAW + c) = pk8(v0, v1);
                        if (pm < 16) { float* o = outk + ((size_t)(pm * DEPTH * 256 + (row & 255))) * 512 + c; __builtin_nontemporal_store(v0, (f32x4*)o); __builtin_nontemporal_store(v1, (f32x4*)(o + 4)); }
                    } else if (pn < 6) {
                        const int c = col - 1024, h = c >> 6, d = c & 63;
                        if (pm < 16) { float* o = outv + ((size_t)(pm * DEPTH * 256 + (row & 255))) * 512 + c; __builtin_nontemporal_store(v0, (f32x4*)o); __builtin_nontemporal_store(v1, (f32x4*)(o + 4)); }
                        bf16_t* vb; int L;
                        if (pm < 16) { L = 256; vb = Vt + ((size_t)((pm * 8 + h) * 64 + d)) * 256 + pos_of_key(row & 255); }
                        else { const int rs = row - MP, bs = rs >> 10; L = 1024; vb = Vt + VT_SAMPLE_OFF + ((size_t)((bs * 8 + h) * 64 + d)) * 1024 + pos_of_key(rs & 1023); }
                        const u32x4 w = pk8(v0, v1);
                        vb[0] = (bf16_t)(w.x & 0xffff); vb[(size_t)L] = (bf16_t)(w.x >> 16); vb[(size_t)2 * L] = (bf16_t)(w.y & 0xffff); vb[(size_t)3 * L] = (bf16_t)(w.y >> 16);
                        vb[(size_t)4 * L] = (bf16_t)(w.z & 0xffff); vb[(size_t)5 * L] = (bf16_t)(w.z >> 16); vb[(size_t)6 * L] = (bf16_t)(w.w & 0xffff); vb[(size_t)7 * L] = (bf16_t)(w.w >> 16);
                    } else if (pn == 6) {
                        *(u32x4*)(Pin + (size_t)row * PW + (col - 1536)) = pk8(v0, v1);
                    } else if (pn < 9) {
                        *(u32x4*)(Cin + (size_t)row * 512 + (col - 1792)) = pk8(v0, v1);
                    } else {
#pragma unroll
                        for (int e = 0; e < 4; ++e) { v0[e] = sigmoidf_(v0[e]); v1[e] = sigmoidf_(v1[e]); }
                        *(u32x4*)(G + (size_t)row * 3072 + (col - 2304)) = pk8(v0, v1);
                    }
                }
                asm volatile("" ::: "memory");
            }
    }
};

struct EpiBranch {
    const bf16_t* G; float* mf; bf16_t* mb;
    __device__ __forceinline__ void operator()(const Acc& acc, const pg8::Unit& u, int wr, int wc, int fr, int fq) const {
        const int cb = u.pn * 256 + wc * 32 + 8 * fq, kind = u.kind;
#pragma unroll
        for (int ai = 0; ai < 2; ++ai)
#pragma unroll
            for (int m = 0; m < 4; ++m) {
                const int row = u.pm * 256 + ai * 128 + wr * 64 + m * 16 + fr;
#pragma unroll
                for (int bj = 0; bj < 2; ++bj) {
                    const int col = cb + bj * 128;
                    const u32x4 gw = *(const u32x4*)(G + (size_t)row * 3072 + kind * 1024 + col);
                    f32x4 v0 = acc[ai][bj][m][0], v1 = acc[ai][bj][m][1];
                    v0[0] *= bf_lo(gw.x); v0[1] *= bf_hi(gw.x); v0[2] *= bf_lo(gw.y); v0[3] *= bf_hi(gw.y);
                    v1[0] *= bf_lo(gw.z); v1[1] *= bf_hi(gw.z); v1[2] *= bf_lo(gw.w); v1[3] *= bf_hi(gw.w);
                    float* sp = mf + (size_t)row * D + col;
                    if (kind > 0) { v0 += *(const f32x4*)sp; v1 += *(const f32x4*)(sp + 4); }
                    if (kind < 2) { *(f32x4*)sp = v0; *(f32x4*)(sp + 4) = v1; }
                    else *(u32x4*)(mb + (size_t)row * D + col) = pk8(v0, v1);
                }
                asm volatile("" ::: "memory");
            }
    }
};

struct EpiRes {
    float* x; bf16_t* xg; const float* gate; const float* gsn; float* rssn;
    __device__ __forceinline__ void operator()(const Acc& acc, const pg8::Unit& u, int wr, int wc, int fr, int fq) const {
        const int mr = mod_row_of_pm(u.pm), cb = u.pn * 256 + wc * 32 + 8 * fq;
        float ss[2][4];
#pragma unroll
        for (int ai = 0; ai < 2; ++ai)
#pragma unroll
            for (int m = 0; m < 4; ++m) ss[ai][m] = 0.f;
#pragma unroll
        for (int bj = 0; bj < 2; ++bj) {
            const int col = cb + bj * 128;
            const f32x4 gt0 = *(const f32x4*)(gate + (size_t)mr * 6 * D + col), gt1 = *(const f32x4*)(gate + (size_t)mr * 6 * D + col + 4);
            const f32x4 gs0 = *(const f32x4*)(gsn + (size_t)mr * 6 * D + col), gs1 = *(const f32x4*)(gsn + (size_t)mr * 6 * D + col + 4);
#pragma unroll
            for (int ai = 0; ai < 2; ++ai)
#pragma unroll
                for (int m = 0; m < 4; ++m) {
                    const int row = u.pm * 256 + ai * 128 + wr * 64 + m * 16 + fr;
                    float* xp = x + (size_t)row * D + col;
                    f32x4 x0 = *(const f32x4*)xp, x1 = *(const f32x4*)(xp + 4);
                    x0 += gt0 * acc[ai][bj][m][0]; x1 += gt1 * acc[ai][bj][m][1];
                    *(f32x4*)xp = x0; *(f32x4*)(xp + 4) = x1;
                    ss[ai][m] += (x0[0] * x0[0] + x0[1] * x0[1]) + (x0[2] * x0[2] + x0[3] * x0[3]) + (x1[0] * x1[0] + x1[1] * x1[1]) + (x1[2] * x1[2] + x1[3] * x1[3]);
                    *(u32x4*)(xg + (size_t)row * D + col) = pk8(x0 * gs0, x1 * gs1);
                    asm volatile("" ::: "memory");
                }
        }
#pragma unroll
        for (int ai = 0; ai < 2; ++ai)
#pragma unroll
            for (int m = 0; m < 4; ++m) {
                float s = ss[ai][m];
                s += __shfl_xor(s, 16); s += __shfl_xor(s, 32);
                if (fq == 0) atomicAdd(rssn + u.pm * 256 + ai * 128 + wr * 64 + m * 16 + fr, s);
            }
    }
};

struct EpiGU {
    const float* rss; const float* c2; bf16_t* act;
    __device__ __forceinline__ void operator()(const Acc& acc, const pg8::Unit& u, int wr, int wc, int fr, int fq) const {
        const int mr = mod_row_of_pm(u.pm), ca0 = u.pn * 128 + wc * 32 + 8 * fq;
        f32x4 ca[2], cbv[2];
#pragma unroll
        for (int n = 0; n < 2; ++n) { ca[n] = *(const f32x4*)(c2 + (size_t)mr * NGU + ca0 + 4 * n); cbv[n] = *(const f32x4*)(c2 + (size_t)mr * NGU + FFN + ca0 + 4 * n); }
        float rinvs[2][4];
#pragma unroll
        for (int ai = 0; ai < 2; ++ai)
#pragma unroll
            for (int m = 0; m < 4; ++m) rinvs[ai][m] = rss[u.pm * 256 + ai * 128 + wr * 64 + m * 16 + fr];
#pragma unroll
        for (int ai = 0; ai < 2; ++ai)
#pragma unroll
            for (int m = 0; m < 4; ++m) {
                if (u.half == 2 - ai) continue;
                const int row = u.pm * 256 + ai * 128 + wr * 64 + m * 16 + fr;
                const float rinv = 1.0f / sqrtf(rinvs[ai][m] * (1.0f / D) + EPS);
                f32x4 o[2];
#pragma unroll
                for (int n = 0; n < 2; ++n) {
                    const f32x4 a = acc[ai][0][m][n] * rinv + ca[n], b = acc[ai][1][m][n] * rinv + cbv[n];
#pragma unroll
                    for (int e = 0; e < 4; ++e) o[n][e] = a[e] * sigmoidf_(a[e]) * b[e];
                }
                *(u32x4*)(act + (size_t)row * FFN + ca0) = pk8(o[0], o[1]);
                asm volatile("" ::: "memory");
            }
    }
};

namespace g192 {
constexpr int TM = 192, TN = 128, BK = 64, ABYTES = TM * BK * 2, BBYTES = TN * BK * 2, SBYTES = ABYTES + BBYTES;
typedef f32x4 Acc6[6][2];
template <class Epi>
__device__ __forceinline__ void gemm(LAS unsigned char* lds, const bf16_t* A, int lda, const bf16_t* Bt, int ldb, int pm, int pn, int nt, const Epi& E) {
    int tid = threadIdx.x; asm volatile("" : "+v"(tid));
    const int wid = __builtin_amdgcn_readfirstlane(tid >> 6), lane = tid & 63, wr = wid >> 2, wc = wid & 3, fr = lane & 15, fq = lane >> 4;
    unsigned voffA[3], voffB[2];
#pragma unroll
    for (int i = 0; i < 3; ++i) { int R, C; pg8::stage_rc((wid + 8 * i) * 1024 + lane * 16, R, C); voffA[i] = (unsigned)(R * lda + C) * 2u; }
#pragma unroll
    for (int i = 0; i < 2; ++i) { int R, C; pg8::stage_rc((wid + 8 * i) * 1024 + lane * 16, R, C); const int Rb = (R & ~31) + pg8::perm32(R & 31); voffB[i] = (unsigned)(Rb * ldb + C) * 2u; }
    const char* gA = (const char*)(A + (size_t)pm * TM * lda); const char* gB = (const char*)(Bt + (size_t)pn * TN * ldb);
    const unsigned ldsw = (unsigned)wid * 1024u;
    const int aoffk[2] = {pg8::lds_byte(wr * 96 + fr, fq * 8), pg8::lds_byte(wr * 96 + fr, fq * 8 + 32)}, boffk[2] = {ABYTES + pg8::lds_byte(wc * 32 + fr, fq * 8), ABYTES + pg8::lds_byte(wc * 32 + fr, fq * 8 + 32)};
#define G192_STAGE(slot, t) do { \
        _Pragma("unroll") for (int _i = 0; _i < 3; ++_i) __builtin_amdgcn_global_load_lds((const unsigned*)(gA + (size_t)(t) * (BK * 2) + voffA[_i]), (LAS unsigned*)(lds + (slot) * SBYTES + ldsw + _i * 8192), 16, 0, 0); \
        _Pragma("unroll") for (int _i = 0; _i < 2; ++_i) __builtin_amdgcn_global_load_lds((const unsigned*)(gB + (size_t)(t) * (BK * 2) + voffB[_i]), (LAS unsigned*)(lds + (slot) * SBYTES + ABYTES + ldsw + _i * 8192), 16, 0, 0); } while (0)
#define G192_WAIT_V(n) asm volatile("s_waitcnt vmcnt(" #n ")" ::: "memory")
#define G192_WAIT_L(n) asm volatile("s_waitcnt lgkmcnt(" #n ")" ::: "memory")
    f32x4 acc[6][2], tot[6][2];
#pragma unroll
    for (int m = 0; m < 6; ++m)
#pragma unroll
        for (int n = 0; n < 2; ++n) { acc[m][n] = (f32x4){0.f, 0.f, 0.f, 0.f}; tot[m][n] = (f32x4){0.f, 0.f, 0.f, 0.f}; }
    G192_STAGE(0, 0); G192_STAGE(1, 1); G192_STAGE(2, 2);
    G192_WAIT_V(10); __builtin_amdgcn_s_barrier();
#pragma unroll 1
    for (int t = 0; t < nt; ++t) {
        const int slot = t & 3;
        if (t + 3 < nt) G192_STAGE((t + 3) & 3, t + 3);
        bf16x8 At[6][2], Bf[2][2];
        const LAS unsigned char* sb = lds + slot * SBYTES;
#pragma unroll
        for (int n = 0; n < 2; ++n)
#pragma unroll
            for (int k = 0; k < 2; ++k) Bf[n][k] = *(const LAS bf16x8*)(sb + boffk[k] + n * 2048);
#pragma unroll
        for (int m = 0; m < 6; ++m)
#pragma unroll
            for (int k = 0; k < 2; ++k) At[m][k] = *(const LAS bf16x8*)(sb + aoffk[k] + m * 2048);
        G192_WAIT_L(0);
        __builtin_amdgcn_s_setprio(1);
#pragma unroll
        for (int m = 0; m < 6; ++m)
#pragma unroll
            for (int n = 0; n < 2; ++n)
#pragma unroll
                for (int k = 0; k < 2; ++k) acc[m][n] = __builtin_amdgcn_mfma_f32_16x16x32_bf16(Bf[n][k], At[m][k], acc[m][n], 0, 0, 0);
        __builtin_amdgcn_s_setprio(0);
        if (Epi::BRANCH) { if (t == 7 || t == 11 || t == nt - 1) E.seg(acc, tot, t == 7 ? 0 : (t == 11 ? 1 : 2), pm, pn, wr, wc, fr, fq); }
        if (t + 3 < nt) G192_WAIT_V(10); else if (t + 2 < nt) G192_WAIT_V(5); else G192_WAIT_V(0);
        __builtin_amdgcn_s_barrier();
    }
    E(Epi::BRANCH ? tot : acc, pm, pn, wr, wc, fr, fq);
#undef G192_STAGE
#undef G192_WAIT_V
#undef G192_WAIT_L
}
}

struct EpiBranch192 {
    static constexpr bool BRANCH = true;
    const bf16_t* G; bf16_t* mb;
    __device__ __forceinline__ void seg(g192::Acc6& acc, g192::Acc6& tot, int kind, int pm, int pn, int wr, int wc, int fr, int fq) const {
        const int col = pn * 128 + wc * 32 + 8 * fq;
#pragma unroll
        for (int m = 0; m < 6; ++m) {
            const int row = pm * 192 + wr * 96 + m * 16 + fr;
            const u32x4 gw = *(const u32x4*)(G + (size_t)row * 3072 + kind * 1024 + col);
            f32x4 g0 = {bf_lo(gw.x), bf_hi(gw.x), bf_lo(gw.y), bf_hi(gw.y)}, g1 = {bf_lo(gw.z), bf_hi(gw.z), bf_lo(gw.w), bf_hi(gw.w)};
            tot[m][0] += g0 * acc[m][0]; tot[m][1] += g1 * acc[m][1];
            acc[m][0] = (f32x4){0.f, 0.f, 0.f, 0.f}; acc[m][1] = (f32x4){0.f, 0.f, 0.f, 0.f};
        }
    }
    __device__ __forceinline__ void operator()(const g192::Acc6& tot, int pm, int pn, int wr, int wc, int fr, int fq) const {
        const int col = pn * 128 + wc * 32 + 8 * fq;
#pragma unroll
        for (int m = 0; m < 6; ++m) { const int row = pm * 192 + wr * 96 + m * 16 + fr; *(u32x4*)(mb + (size_t)row * D + col) = pk8(tot[m][0], tot[m][1]); }
    }
};
struct EpiRes192 {
    static constexpr bool BRANCH = false;
    float* x; bf16_t* xg; const float* gate; const float* gsn; float* rssn;
    __device__ __forceinline__ void seg(g192::Acc6&, g192::Acc6&, int, int, int, int, int, int, int) const {}
    __device__ __forceinline__ void operator()(const g192::Acc6& acc, int pm, int pn, int wr, int wc, int fr, int fq) const {
        const int col = pn * 128 + wc * 32 + 8 * fq;
        f32x4 xv[6][2], gt[6][2], gs[6][2];
#pragma unroll
        for (int m = 0; m < 6; ++m) {
            const int row = pm * 192 + wr * 96 + m * 16 + fr;
            const int mr = row < MP ? 0 : 1 + ((row - MP) >> 10);
            const float* gp = gate + (size_t)mr * 6 * D + col; const float* sp = gsn + (size_t)mr * 6 * D + col; const float* xp = x + (size_t)row * D + col;
            xv[m][0] = *(const f32x4*)xp; xv[m][1] = *(const f32x4*)(xp + 4);
            gt[m][0] = *(const f32x4*)gp; gt[m][1] = *(const f32x4*)(gp + 4); gs[m][0] = *(const f32x4*)sp; gs[m][1] = *(const f32x4*)(sp + 4);
        }
#pragma unroll
        for (int m = 0; m < 6; ++m) {
            const int row = pm * 192 + wr * 96 + m * 16 + fr;
            float* xp = x + (size_t)row * D + col;
            const f32x4 x0 = xv[m][0] + gt[m][0] * acc[m][0], x1 = xv[m][1] + gt[m][1] * acc[m][1];
            *(f32x4*)xp = x0; *(f32x4*)(xp + 4) = x1;
            float ss = (x0[0] * x0[0] + x0[1] * x0[1]) + (x0[2] * x0[2] + x0[3] * x0[3]) + (x1[0] * x1[0] + x1[1] * x1[1]) + (x1[2] * x1[2] + x1[3] * x1[3]);
            *(u32x4*)(xg + (size_t)row * D + col) = pk8(x0 * gs[m][0], x1 * gs[m][1]);
            ss += __shfl_xor(ss, 16); ss += __shfl_xor(ss, 32);
            if (fq == 0) atomicAdd(rssn + row, ss);
        }
    }
};

struct AttnState { f32x16 o0, o1; float m, l; };
struct KVFrag { bf16x8 k[4], v[2][2]; };
__device__ __forceinline__ void attn_load(KVFrag& f, const bf16_t* kptr  , const bf16_t* vptr  , int vstride32  ) {
#pragma unroll
    for (int s = 0; s < 4; ++s) f.k[s] = *(const bf16x8*)(kptr + 16 * s);
#pragma unroll
    for (int dt = 0; dt < 2; ++dt)
#pragma unroll
        for (int ks = 0; ks < 2; ++ks) f.v[dt][ks] = *(const bf16x8*)(vptr + (size_t)dt * vstride32 + 16 * ks);
}
__device__ __forceinline__ void attn_tile(AttnState& st, const bf16x8 (&qf)[4], const KVFrag& f, bool local, const LAS float* rl, int cq, int cs, int ck0  ) {
    f32x16 s = {0.f, 0.f, 0.f, 0.f, 0.f, 0.f, 0.f, 0.f, 0.f, 0.f, 0.f, 0.f, 0.f, 0.f, 0.f, 0.f};
#pragma unroll
    for (int k = 0; k < 4; ++k) s = __builtin_amdgcn_mfma_f32_32x32x16_bf16(f.k[k], qf[k], s, 0, 0, 0);
    if (local) {
        const LAS float* rb = rl + (ck0 - cq + 15);
        const int d0 = ck0 - cs;
#pragma unroll
        for (int i = 0; i < 16; ++i) {
            const int o = (i & 3) + 8 * (i >> 2);
            const bool ok = (unsigned)(d0 + o) < 16u;
            s[i] = ok ? s[i] + rb[o] : -1e30f;
        }
    }
    float mx = fmaxf(fmaxf(s[0], s[1]), fmaxf(s[2], s[3]));
#pragma unroll
    for (int i = 4; i < 16; i += 4) mx = fmaxf(mx, fmaxf(fmaxf(s[i], s[i + 1]), fmaxf(s[i + 2], s[i + 3])));
    mx = fmaxf(mx, __shfl_xor(mx, 32));
    const float mo = st.m, mn = fmaxf(mo, mx);
    st.m = mn;
    float ls = 0.f;
#pragma unroll
    for (int i = 0; i < 16; ++i) { const float p = __builtin_amdgcn_exp2f(s[i] - mn); s[i] = p; ls += p; }
    if (__builtin_amdgcn_ballot_w64(mn > mo) != 0ull) {
        const float alpha = __builtin_amdgcn_exp2f(mo - mn);
        st.l *= alpha;
#pragma unroll
        for (int i = 0; i < 16; ++i) { st.o0[i] *= alpha; st.o1[i] *= alpha; }
    }
    st.l += ls;
    u32x4 w0, w1;
    w0.x = pk2(s[0], s[1]); w0.y = pk2(s[2], s[3]); w0.z = pk2(s[4], s[5]); w0.w = pk2(s[6], s[7]);
    w1.x = pk2(s[8], s[9]); w1.y = pk2(s[10], s[11]); w1.z = pk2(s[12], s[13]); w1.w = pk2(s[14], s[15]);
    const bf16x8 p0 = __builtin_bit_cast(bf16x8, w0), p1 = __builtin_bit_cast(bf16x8, w1);
    st.o0 = __builtin_amdgcn_mfma_f32_32x32x16_bf16(f.v[0][0], p0, st.o0, 0, 0, 0);
    st.o0 = __builtin_amdgcn_mfma_f32_32x32x16_bf16(f.v[0][1], p1, st.o0, 0, 0, 0);
    st.o1 = __builtin_amdgcn_mfma_f32_32x32x16_bf16(f.v[1][0], p0, st.o1, 0, 0, 0);
    st.o1 = __builtin_amdgcn_mfma_f32_32x32x16_bf16(f.v[1][1], p1, st.o1, 0, 0, 0);
}
__device__ __forceinline__ void attn_store(const AttnState& st, bf16_t* orow  , int hf) {
    const float lt = st.l + __shfl_xor(st.l, 32);
    const float inv = 1.0f / lt;
#pragma unroll
    for (int g = 0; g < 4; ++g) {
        u32x2 a, b;
        a.x = pk2(st.o0[4 * g] * inv, st.o0[4 * g + 1] * inv); a.y = pk2(st.o0[4 * g + 2] * inv, st.o0[4 * g + 3] * inv);
        b.x = pk2(st.o1[4 * g] * inv, st.o1[4 * g + 1] * inv); b.y = pk2(st.o1[4 * g + 2] * inv, st.o1[4 * g + 3] * inv);
        *(u32x2*)(orow + 8 * g + 4 * hf) = a;
        *(u32x2*)(orow + 32 + 8 * g + 4 * hf) = b;
    }
}
struct AttnPtrs { const bf16_t *Q, *K, *Vt, *Kc, *Vtc; bf16_t* Abr; };
constexpr int PA_K_BYTES = 256 * 128, PA_V_BYTES = 64 * 512;
struct StageRegs { u32x4 kv[4], vv[4]; };
__device__ __forceinline__ void attn_stage_load(StageRegs& R, const bf16_t* ksrc, const bf16_t* vsrc, int vld, int nkeys, int tid) {
    const int nch = nkeys * 8, sh = nkeys == 256 ? 5 : 3;
#pragma unroll
    for (int i = 0; i < 4; ++i) { int q = tid + 512 * i; q = q < nch ? q : nch - 1;
        R.kv[i] = *(const u32x4*)(ksrc + (size_t)(q >> 3) * NAW + 8 * (q & 7));
        R.vv[i] = *(const u32x4*)(vsrc + (size_t)(q >> sh) * vld + 8 * (q & ((1 << sh) - 1))); }
}
__device__ __forceinline__ void attn_stage_store(const StageRegs& R, int nkeys, LAS unsigned char* kl, LAS unsigned char* vl, int tid) {
    const int nch = nkeys * 8, sh = nkeys == 256 ? 5 : 3;
#pragma unroll
    for (int i = 0; i < 4; ++i) { const int q = tid + 512 * i; if (q < nch) {
        const int key = q >> 3, c = q & 7, d = q >> sh, cv = q & ((1 << sh) - 1);
        *(LAS u32x4*)(kl + key * 128 + ((c ^ (key & 7)) << 4)) = R.kv[i];
        *(LAS u32x4*)(vl + d * 512 + ((cv ^ (d & 15)) << 4)) = R.vv[i]; } }
}
__device__ __forceinline__ void attn_lds_frag(KVFrag& f, const LAS unsigned char* kl, const LAS unsigned char* vl, int kt, int r32, int hf) {
    const int key = 32 * kt + r32;
#pragma unroll
    for (int s = 0; s < 4; ++s) f.k[s] = *(const LAS bf16x8*)(kl + key * 128 + (((2 * s + hf) ^ (key & 7)) << 4));
#pragma unroll
    for (int dt = 0; dt < 2; ++dt)
#pragma unroll
        for (int ks = 0; ks < 2; ++ks) { const int d = 32 * dt + r32; f.v[dt][ks] = *(const LAS bf16x8*)(vl + d * 512 + (((4 * kt + 2 * ks + hf) ^ (d & 15)) << 4)); }
}
__device__ __forceinline__ void attn_prompt_lds(const AttnPtrs& P, const LAS unsigned char* kl, const LAS unsigned char* vl, int bh, int qt, int lane) {
    const int r32 = lane & 31, hf = lane >> 5, b = bh >> 3, h = bh & 7;
    const int qrow = b * 256 + qt * 32 + r32;
    bf16x8 qf[4];
#pragma unroll
    for (int s = 0; s < 4; ++s) qf[s] = *(const bf16x8*)(P.Q + (size_t)qrow * NAW + h * 64 + 16 * s + 8 * hf);
    AttnState st; st.m = -1e30f; st.l = 0.f;
#pragma unroll
    for (int i = 0; i < 16; ++i) { st.o0[i] = 0.f; st.o1[i] = 0.f; }
    KVFrag fa, fb;
    attn_lds_frag(fa, kl, vl, 0, r32, hf);
#pragma unroll 1
    for (int t = 0; t < 8; t += 2) {
        attn_lds_frag(fb, kl, vl, t + 1, r32, hf);
        attn_tile(st, qf, fa, false, nullptr, 0, 0, 0);
        if (t + 2 < 8) attn_lds_frag(fa, kl, vl, t + 2, r32, hf);
        attn_tile(st, qf, fb, false, nullptr, 0, 0, 0);
    }
    attn_store(st, P.Abr + (size_t)qrow * D + h * 64, hf);
}
constexpr int ATT_PART_FLOATS = 34 * 64;
__device__ __forceinline__ void attn_sample_block(const AttnPtrs& P, LAS unsigned char* kl, LAS unsigned char* vl, const LAS float* rpl, LAS float* parts, int blk, int wave, int lane) {
    const int r32 = lane & 31, hf = lane >> 5, tid = wave * 64 + lane;
    const int bs = blk >> 6, h = (blk >> 3) & 7, i2 = (blk & 7) * 2;
    const int u = wave >> 1, half = wave & 1, r = i2 + (u >> 1), qh = u & 1;
    const int qrow = MP + bs * 1024 + r * 64 + qh * 32 + r32;
    const int cq = qh * 32 + r32; int cs = cq - 8; cs = cs < 0 ? 0 : (cs > 48 ? 48 : cs);
    int rs = r - 4; rs = rs < 0 ? 0 : (rs > 8 ? 8 : rs);
    int rs0 = i2 - 4; rs0 = rs0 < 0 ? 0 : (rs0 > 8 ? 8 : rs0);
    int rs1 = i2 - 3; rs1 = rs1 < 0 ? 0 : (rs1 > 8 ? 8 : rs1);
    const int nstage = rs1 != rs0 ? 4 : 3;
    const bf16_t* kloc = P.K + (size_t)(MP + bs * 1024) * NAW + h * 64;
    const bf16_t* vloc = P.Vt + VT_SAMPLE_OFF + (size_t)((bs * 8 + h) * 64) * 1024;
    bf16x8 qf[4];
#pragma unroll
    for (int s = 0; s < 4; ++s) qf[s] = *(const bf16x8*)(P.Q + (size_t)qrow * NAW + h * 64 + 16 * s + 8 * hf);
    AttnState st; st.m = -1e30f; st.l = 0.f;
#pragma unroll
    for (int i = 0; i < 16; ++i) { st.o0[i] = 0.f; st.o1[i] = 0.f; }
    LAS float* part = parts + u * ATT_PART_FLOATS;
    StageRegs R;
    attn_stage_load(R, P.Kc + (size_t)(bs * 256) * NAW + h * 64, P.Vtc + (size_t)((bs * 8 + h) * 64) * 256, 256, 256, tid);
#pragma unroll 1
    for (int sg = 0; sg < nstage; ++sg) {
        if (sg) __syncthreads();
        const int row0 = rs0 + 4 * (sg - 1);
        attn_stage_store(R, sg == 3 ? 64 : 256, kl, vl, tid);
        { const int sn = sg + 1 < nstage ? sg + 1 : 1, rown = rs0 + 4 * (sn - 1);
          attn_stage_load(R, kloc + (size_t)(rown * 64) * NAW, vloc + rown * 64, 1024, sn == 3 ? 64 : 256, tid); }
        LDS_WAIT(); __syncthreads();
        KVFrag f;
        if (sg == 0) {
#pragma unroll 1
            for (int kt = 4 * half; kt < 4 * half + 4; ++kt) { attn_lds_frag(f, kl, vl, kt, r32, hf); attn_tile(st, qf, f, false, nullptr, 0, 0, 0); }
        } else {
            const int nt = sg == 3 ? 2 : 8;
#pragma unroll 1
            for (int kt = half * (nt >> 1); kt < (half + 1) * (nt >> 1); ++kt) {
                const int jr = row0 + (kt >> 1), ch = kt & 1;
                if (jr < rs || jr >= rs + 8) continue;
                attn_lds_frag(f, kl, vl, kt, r32, hf);
                attn_tile(st, qf, f, true, rpl + (h * 15 + (jr - r + 7)) * 31, cq, cs, ch * 32 + 4 * hf);
            }
        }
    }
    if (half == 1) {
#pragma unroll
        for (int i = 0; i < 16; ++i) { part[i * 64 + lane] = st.o0[i]; part[(16 + i) * 64 + lane] = st.o1[i]; }
        part[32 * 64 + lane] = st.m; part[33 * 64 + lane] = st.l;
    }
    LDS_WAIT(); __syncthreads();
    if (half == 0) {
        const float m1 = part[32 * 64 + lane], l1 = part[33 * 64 + lane];
        const float mn = fmaxf(st.m, m1), a0 = __builtin_amdgcn_exp2f(st.m - mn), a1 = __builtin_amdgcn_exp2f(m1 - mn);
        st.l = st.l * a0 + l1 * a1;
#pragma unroll
        for (int i = 0; i < 16; ++i) { st.o0[i] = st.o0[i] * a0 + part[i * 64 + lane] * a1; st.o1[i] = st.o1[i] * a0 + part[(16 + i) * 64 + lane] * a1; }
        attn_store(st, P.Abr + (size_t)qrow * D + h * 64, hf);
    }
}

struct PcPtrs { const bf16_t *Pin, *Cin; const float *wdw, *bdw, *cng, *cnb; bf16_t* Abr; };
__device__ __forceinline__ f32x4 ld_bf4(const bf16_t* p) { const u32x2 w = *(const u32x2*)p; return (f32x4){bf_lo(w.x), bf_hi(w.x), bf_lo(w.y), bf_hi(w.y)}; }
__device__ __forceinline__ f32x4 up_bf4(u32x2 w) { return (f32x4){bf_lo(w.x), bf_hi(w.x), bf_lo(w.y), bf_hi(w.y)}; }
__device__ __forceinline__ void pool_unit(const PcPtrs& P, int unit, int lane) {
    const int row0 = unit * 8;
    const int L = row0 < MP ? 256 : 1024;
    const int sb = row0 < MP ? (row0 & ~255) : MP + ((row0 - MP) & ~1023);
    const int hw = 1 << (lane >> 4);
    const int t0 = row0 - sb;
    u32x2 pv[24];
#pragma unroll
    for (int i = 0; i < 24; ++i) { int t = t0 - 8 + i; t = t < 0 ? 0 : (t > L - 1 ? L - 1 : t); pv[i] = *(const u32x2*)(P.Pin + (size_t)(sb + t) * PW + 4 * lane); }
#pragma unroll
    for (int tt = 0; tt < 8; ++tt) {
        f32x4 sum = {0.f, 0.f, 0.f, 0.f}; float cnt = 0.f;
#pragma unroll
        for (int o = -8; o < 8; ++o) {
            const int t = t0 + tt + o;
            const bool in = (o >= -hw) && (o < hw) && (t >= 0) && (t < L);
            const f32x4 v = up_bf4(pv[tt + o + 8]);
            sum += in ? v : (f32x4){0.f, 0.f, 0.f, 0.f}; cnt += in ? 1.f : 0.f;
        }
        const f32x4 r = sum * __builtin_amdgcn_rcpf(cnt) - up_bf4(pv[tt + 8]);
        u32x2 w; w.x = pk2(r[0], r[1]); w.y = pk2(r[2], r[3]);
        *(u32x2*)(P.Abr + (size_t)(row0 + tt) * D + 512 + 4 * lane) = w;
    }
}
__device__ __forceinline__ void conv_unit(const PcPtrs& P, const LAS float* wl, int unit, int lane) {
    constexpr int T = 8;
    const int row0 = unit * T;
    const int L = row0 < MP ? 256 : 1024;
    const int sb = row0 < MP ? (row0 & ~255) : MP + ((row0 - MP) & ~1023);
    const int t0 = row0 - sb;
    f32x4 acc[T];
    const f32x4 bias = *(const f32x4*)(P.bdw + 4 * lane);
#pragma unroll
    for (int tt = 0; tt < T; ++tt) acc[tt] = bias;
#pragma unroll 1
    for (int c = 0; c < 2; ++c) {
        u32x2 ar[20], gr[20];
#pragma unroll
        for (int i = 0; i < 20; ++i) {
            const int t = t0 - 15 + 20 * c + i;
            const bool ok = (t >= 0) && (t < L);
            const bf16_t* p = P.Cin + (size_t)(sb + (ok ? t : 0)) * 512 + 4 * lane;
            ar[i] = *(const u32x2*)p; gr[i] = *(const u32x2*)(p + 256);
            if (!ok) { ar[i] = (u32x2){0u, 0u}; }
        }
#pragma unroll
        for (int g4 = 0; g4 < 5; ++g4) {
            const int s0 = 20 * c + 4 * g4;
            f32x4 tp[11];
#pragma unroll
            for (int q = 0; q < 11; ++q) tp[q] = *(const LAS f32x4*)(wl + (s0 + q) * CW + 4 * lane);
#pragma unroll
            for (int i = 0; i < 4; ++i) {
                const f32x4 a = up_bf4(ar[4 * g4 + i]), g = up_bf4(gr[4 * g4 + i]);
                f32x4 hh;
#pragma unroll
                for (int e = 0; e < 4; ++e) hh[e] = a[e] * sigmoidf_(g[e]);
#pragma unroll
                for (int tt = 0; tt < T; ++tt) acc[tt] += hh * tp[i - tt + 7];
            }
            asm volatile("" ::: "memory");
        }
    }
    const f32x4 lg = *(const f32x4*)(P.cng + 4 * lane), lb = *(const f32x4*)(P.cnb + 4 * lane);
    float s1[T], s2[T];
#pragma unroll
    for (int tt = 0; tt < T; ++tt) s1[tt] = (acc[tt][0] + acc[tt][1]) + (acc[tt][2] + acc[tt][3]);
#pragma unroll
    for (int o = 1; o < 64; o <<= 1)
#pragma unroll
        for (int tt = 0; tt < T; ++tt) s1[tt] += __shfl_xor(s1[tt], o);
#pragma unroll
    for (int tt = 0; tt < T; ++tt) { const float mu = s1[tt] * (1.0f / CW); acc[tt] = acc[tt] - mu; s2[tt] = (acc[tt][0] * acc[tt][0] + acc[tt][1] * acc[tt][1]) + (acc[tt][2] * acc[tt][2] + acc[tt][3] * acc[tt][3]); }
#pragma unroll
    for (int o = 1; o < 64; o <<= 1)
#pragma unroll
        for (int tt = 0; tt < T; ++tt) s2[tt] += __shfl_xor(s2[tt], o);
#pragma unroll
    for (int tt = 0; tt < T; ++tt) {
        const float rstd = 1.0f / sqrtf(s2[tt] * (1.0f / CW) + EPS);
        f32x4 y = acc[tt] * rstd * lg + lb;
#pragma unroll
        for (int e = 0; e < 4; ++e) y[e] = y[e] * sigmoidf_(y[e]);
        u32x2 o; o.x = pk2(y[0], y[1]); o.y = pk2(y[2], y[3]);
        *(u32x2*)(P.Abr + (size_t)(row0 + tt) * D + 768 + 4 * lane) = o;
    }
}

#define XB_TMO      128
#define XB_XCNT(j)  (256  + 64 * (j))
#define XB_XSUB(j)  (1280 + 64 * (j))
#define XB_XGEN(j)  (2304 + 64 * (j))
#define XB_TOP      3328
#define XB_TOPGEN   3392
#define XB_LCNT(j)  (3456 + 64 * (j))
#define XB_MISMATCH 4480
#define XB_CONV     4544
#define XCD_BAR_WORDS 4608
#define XB_SPIN_CAP (1u << 18)
__device__ __forceinline__ unsigned xb_ld(unsigned* p)              { return __hip_atomic_load(p, __ATOMIC_RELAXED, __HIP_MEMORY_SCOPE_AGENT); }
__device__ __forceinline__ unsigned xb_add(unsigned* p, unsigned v) { return __hip_atomic_fetch_add(p, v, __ATOMIC_RELAXED, __HIP_MEMORY_SCOPE_AGENT); }
__device__ __forceinline__ unsigned xb_xcc_id() { return (unsigned)__builtin_amdgcn_s_getreg((3 << 11) | 20) & 0xFu; }
#define XB_SPIN(cond, bar) do { unsigned _sp = 0; while (cond) { __builtin_amdgcn_s_sleep(1); \
    if ((++_sp & 255u) == 0u) { if (xb_ld(&(bar)[XB_TMO])) break; if (_sp > XB_SPIN_CAP) { atomicAdd(&(bar)[XB_TMO], 1u); break; } } } } while (0)
struct XcdBarrier { unsigned* bar; unsigned x; unsigned nloc, nx; };
#define XB_LOCAL_OK 0x80000000u
__device__ __forceinline__ XcdBarrier xcd_barrier_post(unsigned* bar) {
    XcdBarrier b; b.bar = bar; b.x = xb_xcc_id(); b.nloc = 0u; b.nx = 0u;
    asm volatile("" : "+s"(b.x));
    if (threadIdx.x == 0) {
        if (b.x != (blockIdx.x & 7u) || gridDim.x != 256u) { (void)xb_add(&bar[XB_MISMATCH], 1u); asm volatile("s_waitcnt vmcnt(0)" ::: "memory"); }
        (void)xb_add(&bar[XB_XCNT(b.x)], 1u);
    }
    return b;
}
__device__ __forceinline__ void xcd_barrier_complete(unsigned* bar, unsigned x, unsigned& nloc, unsigned& nx) {
    asm volatile("" : "+s"(bar));
    const unsigned G = gridDim.x * gridDim.y * gridDim.z;
    unsigned sum, cnt, mine, sp = 0u;
    for (;;) {
        sum = 0u; cnt = 0u; mine = 0u;
#pragma unroll
        for (unsigned j = 0; j < 16; ++j) { const unsigned c = xb_ld(&bar[XB_XCNT(j)]); sum += c; cnt += (c > 0u) ? 1u : 0u; mine = (j == x) ? c : mine; }
        if (sum == G) break;
        __builtin_amdgcn_s_sleep(1);
        if ((++sp & 255u) == 0u) { if (xb_ld(&bar[XB_TMO])) break; if (sp > XB_SPIN_CAP) { atomicAdd(&bar[XB_TMO], 1u); break; } }
    }
    nloc = mine > 0u ? mine : 1u; nx = cnt > 0u ? cnt : 1u;
}
__device__ __forceinline__ void xcd_barrier_t0(XcdBarrier& b) {
    {
        unsigned* bar = b.bar; asm volatile("" : "+s"(bar));
        unsigned bx_ = b.x; asm volatile("" : "+s"(bx_));
        __builtin_amdgcn_s_waitcnt(0);
        unsigned nloc = b.nloc, nx = b.nx;
        if (nloc == 0u) { xcd_barrier_complete(bar, bx_, nloc, nx); b.nloc = nloc; b.nx = nx | ((nloc == 32u && xb_ld(&bar[XB_MISMATCH]) == 0u) ? XB_LOCAL_OK : 0u); }
        nx &= ~XB_LOCAL_OK;
        const unsigned old = xb_add(&bar[XB_XSUB(bx_)], 1u);
        const unsigned gen = old / nloc;
        if (old + 1u == (gen + 1u) * nloc) {
            __builtin_amdgcn_fence(__ATOMIC_RELEASE, "agent");
            asm volatile("s_waitcnt vmcnt(0)" ::: "memory");
            const unsigned og = xb_add(&bar[XB_TOP], 1u);
            const unsigned tg = og / nx;
            if (og + 1u == (tg + 1u) * nx) xb_add(&bar[XB_TOPGEN], 1u);
            else XB_SPIN(xb_ld(&bar[XB_TOPGEN]) == tg, bar);
            __builtin_amdgcn_fence(__ATOMIC_ACQUIRE, "agent");
            xb_add(&bar[XB_XGEN(bx_)], 1u);
            asm volatile("s_waitcnt vmcnt(0)" ::: "memory");
        } else {
            XB_SPIN(xb_ld(&bar[XB_XGEN(bx_)]) == gen, bar);
            __builtin_amdgcn_fence(__ATOMIC_ACQUIRE, "agent");
            asm volatile("s_waitcnt vmcnt(0)" ::: "memory");
        }
    }
}
__device__ __forceinline__ void xcd_barrier(XcdBarrier& b) {
    asm volatile("s_waitcnt vmcnt(0)" ::: "memory");
    __syncthreads();
    if (threadIdx.x == 0) xcd_barrier_t0(b);
    b.nloc = __builtin_amdgcn_readfirstlane(b.nloc); b.nx = __builtin_amdgcn_readfirstlane(b.nx);
    __syncthreads();
}
__device__ __forceinline__ void xcd_local_barrier(XcdBarrier& b, unsigned k  , unsigned conv_need = 0u  ) {
    asm volatile("s_waitcnt vmcnt(0)" ::: "memory");
    __syncthreads();
    if (threadIdx.x == 0) {
        if (b.nx & XB_LOCAL_OK) {
            __builtin_amdgcn_s_waitcnt(0);
            unsigned* lb = b.bar; asm volatile("" : "+s"(lb));
            unsigned lx = b.x; asm volatile("" : "+s"(lx));
            unsigned* c = &lb[XB_LCNT(lx)];
            const unsigned target = k * 32u;
            (void)xb_add(c, 1u);
            XB_SPIN(xb_ld(c) < target, lb);
            if (conv_need) XB_SPIN(xb_ld(&lb[XB_CONV]) < conv_need, lb);
            __builtin_amdgcn_fence(__ATOMIC_ACQUIRE, "agent");
            asm volatile("s_waitcnt vmcnt(0)" ::: "memory");
        } else xcd_barrier_t0(b);
    }
    b.nloc = __builtin_amdgcn_readfirstlane(b.nloc); b.nx = __builtin_amdgcn_readfirstlane(b.nx);
    __syncthreads();
}

constexpr int TP_PITCH = 65, TP_BYTES = 64 * TP_PITCH * 4;
__device__ __forceinline__ void st16_wt(void* p, u32x4 v) { asm volatile("global_store_dwordx4 %0, %1, off sc1\n\ts_nop 1" :: "v"(p), "v"(v) : "memory"); }
template <bool WITH_C, bool GU_PERM, bool WT = false>
__device__ __forceinline__ void transpose_item(const float* W, int N, bf16_t* WTp, int ldt, int kcol0, LAS float* scr, int item, int lane,
                                               const float* shraw  , const float* shb  , float* csum  ) {
    const int nblk = N / 64, kb = item / nblk, nb = item % nblk, k0 = 64 * kb, n0 = 64 * nb;
    {
        const int r4 = lane >> 4, c4 = lane & 15;
        f32x4 v[16];
#pragma unroll
        for (int i = 0; i < 16; ++i) v[i] = __builtin_nontemporal_load((const f32x4*)(W + (size_t)(k0 + 4 * i + r4) * N + n0 + 4 * c4));
#pragma unroll
        for (int i = 0; i < 16; ++i) { LAS float* p = scr + (4 * i + r4) * TP_PITCH + 4 * c4; p[0] = v[i][0]; p[1] = v[i][1]; p[2] = v[i][2]; p[3] = v[i][3]; }
    }
    const int c = lane & 7, nn = lane >> 3;
    f32x4 sh[3][2];
    if (WITH_C) {
#pragma unroll
        for (int r = 0; r < 3; ++r)
#pragma unroll
            for (int h = 0; h < 2; ++h) sh[r][h] = *(const f32x4*)(shraw + (size_t)r * NMOD + k0 + 8 * c + 4 * h) + *(const f32x4*)(shb + k0 + 8 * c + 4 * h);
    }
    LDS_WAIT(); asm volatile("" ::: "memory");
#pragma unroll
    for (int j = 0; j < 8; ++j) {
        const int n = 8 * j + nn; const LAS float* s = scr + (8 * c) * TP_PITCH + n;
        float w[8];
#pragma unroll
        for (int q = 0; q < 8; ++q) w[q] = s[q * TP_PITCH];
        u32x4 o; o.x = pk2(w[0], w[1]); o.y = pk2(w[2], w[3]); o.z = pk2(w[4], w[5]); o.w = pk2(w[6], w[7]);
        int nrow = n0 + n;
        if (GU_PERM) nrow = nrow < FFN ? ((nrow >> 7) * 256 + (nrow & 127)) : (((nrow - FFN) >> 7) * 256 + 128 + ((nrow - FFN) & 127));
        if (WT) st16_wt(WTp + (size_t)nrow * ldt + kcol0 + k0 + 8 * c, o); else *(u32x4*)(WTp + (size_t)nrow * ldt + kcol0 + k0 + 8 * c) = o;
        if (WITH_C) {
            float d0 = 0.f, d1 = 0.f, d2 = 0.f;
#pragma unroll
            for (int q = 0; q < 8; ++q) { d0 += sh[0][q >> 2][q & 3] * w[q]; d1 += sh[1][q >> 2][q & 3] * w[q]; d2 += sh[2][q >> 2][q & 3] * w[q]; }
#pragma unroll
            for (int x = 1; x < 8; x <<= 1) { d0 += __shfl_xor(d0, x); d1 += __shfl_xor(d1, x); d2 += __shfl_xor(d2, x); }
            if (c == 0) { atomicAdd(csum + n0 + n, d0); atomicAdd(csum + N + n0 + n, d1); atomicAdd(csum + 2 * N + n0 + n, d2); }
        }
    }
    LDS_WAIT(); asm volatile("" ::: "memory");
}

constexpr int NWAVES = 8;
constexpr int I_IN = 16 * (NIN / 64), I_GU = 16 * (NGU / 64), I_DN = (FFN / 64) * 16, I_OUT = 16 * 16, I_OA = 8 * 16, I_OC = 4 * 16;
constexpr int I_LAYER = I_IN + I_GU + I_DN + I_OUT + I_OA + I_OC;
#ifndef MK_TAIL
#define MK_TAIL I_LAYER
#endif
constexpr int I_TAIL = MK_TAIL, I_HEAD = I_LAYER - I_TAIL;
constexpr int I_MIX = (I_TAIL >= 512) ? 384 : 0;
#ifndef MK_BG1
#define MK_BG1 1536
#endif
constexpr int I_BG1 = MK_BG1;
static_assert(I_HEAD + I_BG1 <= I_LAYER - I_MIX, "background split");
static_assert(I_HEAD == 0 && I_IN <= I_BG1, "every w_in item of the next layer belongs to the 24 converter workgroups (their tickets gate the XCD-local seam before the next in-projection)");
#define TRANSPOSE_LAYER_ITEM(l_, r0_, scr_, lane_) do { const int tl_ = (l_); int tr_ = (r0_); \
        const float* shraw1_ = MODRAW + (size_t)(tl_ * 3) * NMOD; const float* shraw2_ = MODRAW + (size_t)(tl_ * 3) * NMOD + 3 * D; \
        if (tr_ < I_IN) { transpose_item<true, false, true>(w_in + (size_t)tl_ * D * NIN, NIN, WIN + (size_t)tl_ * NIN * D, D, 0, scr_, tr_, lane_, shraw1_, b_mod + (size_t)tl_ * NMOD, C1 + (size_t)(tl_ * 3) * NIN); break; } tr_ -= I_IN; \
        if (tr_ < I_GU) { transpose_item<true, true>(w_gu + (size_t)tl_ * D * NGU, NGU, WGU + (size_t)tl_ * NGU * D, D, 0, scr_, tr_, lane_, shraw2_, b_mod + (size_t)tl_ * NMOD + 3 * D, C2 + (size_t)(tl_ * 3) * NGU); break; } tr_ -= I_GU; \
        if (tr_ < I_DN) { transpose_item<false, false>(w_down + (size_t)tl_ * FFN * D, D, WDN + (size_t)tl_ * D * FFN, FFN, 0, scr_, tr_, lane_, nullptr, nullptr, nullptr); break; } tr_ -= I_DN; \
        if (tr_ < I_OUT) { transpose_item<false, false>(w_out + (size_t)tl_ * D * D, D, WOUT + (size_t)tl_ * D * D, D, 0, scr_, tr_, lane_, nullptr, nullptr, nullptr); break; } tr_ -= I_OUT; \
        if (tr_ < I_OA) { transpose_item<false, false>(w_oa + (size_t)tl_ * NAW * D, D, WBR + (size_t)tl_ * D * D, D, 0, scr_, tr_, lane_, nullptr, nullptr, nullptr); break; } tr_ -= I_OA; \
        transpose_item<false, false>(w_oc + (size_t)tl_ * CW * D, D, WBR + (size_t)tl_ * D * D, D, 768, scr_, tr_, lane_, nullptr, nullptr, nullptr); } while (0)
constexpr int LDS_BYTES = 163840;
static_assert(8 * TP_BYTES <= LDS_BYTES, "LDS map");
constexpr int NPHASE = 2 + 6 * DEPTH + 1;

struct Args {
    const float* in[26]; float* out; unsigned char* ws; int ph_lo, ph_hi;
};

__global__ void __launch_bounds__(NWAVES * 64, 2) fwd_kernel(Args args) {
    extern __shared__ __attribute__((aligned(16))) unsigned char lds_raw[];
    LAS unsigned char* lds = (LAS unsigned char*)lds_raw;
    const int tid = threadIdx.x, lane = tid & 63, wave = __builtin_amdgcn_readfirstlane(tid >> 6);
    const int G = gridDim.x, bx = blockIdx.x;
    const int vcu = (G % 8 == 0) ? (bx % 8) * (G / 8) + bx / 8 : bx;
    const int gw = vcu * NWAVES + wave, NGW = G * NWAVES;
    typedef const Args __attribute__((address_space(4))) * ArgsP;
    ArgsP KAP = (ArgsP)__builtin_amdgcn_kernarg_segment_ptr();
#define PHASE_PTRS() asm volatile("" : "+s"(KAP))
#define WSB (KAP->ws)
#define ctlf ((float*)(WSB + WS_CTL))
#define x_prompt (KAP->in[0])
#define x_sample (KAP->in[1])
#define cache_k (KAP->in[2])
#define cache_v (KAP->in[3])
#define cvec (KAP->in[4])
#define c_ctx (KAP->in[5])
#define w_mod (KAP->in[6])
#define b_mod (KAP->in[7])
#define norm1_g (KAP->in[8])
#define norm2_g (KAP->in[9])
#define w_in (KAP->in[10])
#define b_gate (KAP->in[11])
#define rpb (KAP->in[12])
#define w_oa (KAP->in[13])
#define w_pool (KAP->in[14])
#define pool_scale (KAP->in[15])
#define w_ob (KAP->in[16])
#define w_dw (KAP->in[17])
#define b_dw (KAP->in[18])
#define conv_norm_g (KAP->in[19])
#define conv_norm_b (KAP->in[20])
#define w_oc (KAP->in[21])
#define w_out (KAP->in[22])
#define w_gu (KAP->in[23])
#define w_down (KAP->in[24])
#define final_g (KAP->in[25])
#define MODRAW (ctlf + CF_MODRAW)
#define C1 (ctlf + CF_C1)
#define C2 (ctlf + CF_C2)
#define RSS (ctlf + CF_RSS)
#define MODT ((float*)(WSB + WS_MODT))
#define WIN ((bf16_t*)(WSB + WS_WIN))
#define WGU ((bf16_t*)(WSB + WS_WGU))
#define WDN ((bf16_t*)(WSB + WS_WDN))
#define WBR ((bf16_t*)(WSB + WS_WBR))
#define WOUT ((bf16_t*)(WSB + WS_WOUT))
#define X ((float*)(WSB + WS_X))
#define XG ((bf16_t*)(WSB + WS_XG))
#define Qb ((bf16_t*)(WSB + WS_Q))
#define Kb ((bf16_t*)(WSB + WS_K))
#define VT ((bf16_t*)(WSB + WS_VT))
#define KC ((bf16_t*)(WSB + WS_KC))
#define VTC ((bf16_t*)(WSB + WS_VTC))
#define PIN ((bf16_t*)(WSB + WS_PIN))
#define CIN ((bf16_t*)(WSB + WS_CIN))
#define GT ((bf16_t*)(WSB + WS_G))
#define ABR ((bf16_t*)(WSB + WS_ABR))
#define MF ((float*)(WSB + WS_MF))
#define MB ((bf16_t*)(WSB + WS_MB))
#define ACT ((bf16_t*)(WSB + WS_ACT))

#if !MK_PER_PHASE
    XcdBarrier bar = xcd_barrier_post((unsigned*)(args.ws + WS_CTL) + CW_BAR);
#define GRID_BAR() xcd_barrier(bar)
#define LOCAL_BAR(k, cn) xcd_local_barrier(bar, (unsigned)(k), (unsigned)(cn))
#else
#define GRID_BAR() do {} while (0)
#define LOCAL_BAR(k, cn) do {} while (0)
#endif
    const int lo = args.ph_lo, hi = args.ph_hi;
#define IN(k) (lo <= (k) && (k) < hi)
#define SEAM(k) do { if (IN(k) && IN((k) + 1)) GRID_BAR(); } while (0)
#define SEAML(k, n, cn) do { if (IN(k) && IN((k) + 1)) LOCAL_BAR(n, cn); } while (0)

    for (int rep_ = 0; rep_ < MK_REPS(4); ++rep_) { if (rep_) GRID_BAR();
    float* MODRAW_W = rep_ ? MF : MODRAW; float* C1_W = rep_ ? MF + DEPTH * 3 * NMOD : C1; float* C2_W = rep_ ? MF + DEPTH * 3 * (NMOD + NIN) : C2;
    if (IN(0)) { PHASE_PTRS();
        LAS float* sil = (LAS float*)lds; LAS float* red = (LAS float*)(lds + 16384);
        for (int i = tid; i < 3 * D; i += NWAVES * 64) { const float s = i < D ? c_ctx[i] : cvec[i - D]; sil[i] = s * sigmoidf_(s); }
        __syncthreads();
        for (int it = vcu; it < DEPTH * 24 * 8; it += G) {
            const int l = it / 192, rem = it % 192, nc = rem >> 3, kq = rem & 7, k0 = kq * 128 + wave * 16, n0 = nc * 256 + 4 * lane;
            const float* wp = w_mod + ((size_t)l * D + k0) * NMOD + n0;
            f32x4 w[16];
#pragma unroll
            for (int kk = 0; kk < 16; ++kk) w[kk] = __builtin_nontemporal_load((const f32x4*)(wp + (size_t)kk * NMOD));
            f32x4 a0 = {0.f, 0.f, 0.f, 0.f}, a1 = a0, a2 = a0;
#pragma unroll
            for (int kk = 0; kk < 16; ++kk) { a0 += sil[k0 + kk] * w[kk]; a1 += sil[D + k0 + kk] * w[kk]; a2 += sil[2 * D + k0 + kk] * w[kk]; }
#pragma unroll
            for (int e = 0; e < 4; ++e) { red[(wave * 12 + e) * 64 + lane] = a0[e]; red[(wave * 12 + 4 + e) * 64 + lane] = a1[e]; red[(wave * 12 + 8 + e) * 64 + lane] = a2[e]; }
            __syncthreads();
            for (int o = tid; o < 12 * 64; o += NWAVES * 64) {
                float s = 0.f;
#pragma unroll
                for (int ww = 0; ww < 8; ++ww) s += red[ww * 768 + o];
                const int q = o >> 6, ln = o & 63, r = q >> 2, e = q & 3;
                atomicAdd(MODRAW_W + (size_t)(l * 3 + r) * NMOD + nc * 256 + 4 * ln + e, s);
            }
            __syncthreads();
        }
    }
    SEAM(0);

    if (IN(1)) { PHASE_PTRS();
        LAS float* scr = (LAS float*)(lds + wave * TP_BYTES);
        constexpr int I_T = I_LAYER + (DEPTH - 1) * I_HEAD;
        constexpr int I_OB = DEPTH * 16 * 4 * 8;
        constexpr int I_X = M;
        constexpr int I_KC = DEPTH * 2 * 256;
        constexpr int I_VC = DEPTH * 2 * 8 * 4;
        constexpr int I_MT = DEPTH * 3 * 6 * 4;
        constexpr int I_ALL = I_T + I_OB + I_X + I_KC + I_VC + I_MT;
        for (int it0 = gw; it0 < I_ALL; it0 += NGW) {
            int it = it0;
            if (it < I_T) {
                if (it < I_LAYER) TRANSPOSE_LAYER_ITEM(0, it, scr, lane);
                else if constexpr (I_HEAD > 0) { const int q = it - I_LAYER; TRANSPOSE_LAYER_ITEM(1 + q / I_HEAD, q % I_HEAD, scr, lane); }
                continue;
            }
            it -= I_T;
            if (it < I_OB) {
                const int l = it / 512, rem = it % 512, nch = rem >> 5, g = (rem >> 3) & 3, cc = rem & 7, n = nch * 64 + lane;
                float a[8];
#pragma unroll
                for (int c = 0; c < 8; ++c) a[c] = 0.f;
                const float* wp = w_pool + ((size_t)(l * 4 + g) * 64 + cc * 8) * 64;
                for (int d = 0; d < 64; ++d) {
                    const float wb = w_ob[((size_t)l * PW + g * 64 + d) * D + n] * pool_scale[l * PW + g * 64 + d];
#pragma unroll
                    for (int c = 0; c < 8; ++c) a[c] += wp[c * 64 + d] * wb;
                }
                u32x4 o; o.x = pk2(a[0], a[1]); o.y = pk2(a[2], a[3]); o.z = pk2(a[4], a[5]); o.w = pk2(a[6], a[7]);
                *(u32x4*)(WBR + ((size_t)l * D + n) * D + 512 + g * 64 + cc * 8) = o;
                continue;
            }
            it -= I_OB;
            if (it < I_X) {
                const int row = it, mr = row < MP ? 0 : 1 + ((row - MP) >> 10);
                const float* xr = row < MP ? x_prompt + (size_t)row * D : x_sample + (size_t)(row - MP) * D;
                float ss = 0.f;
#pragma unroll
                for (int j = 0; j < 4; ++j) {
                    const int col = 256 * j + 4 * lane;
                    const f32x4 v = *(const f32x4*)(xr + col);
                    *(f32x4*)(X + (size_t)row * D + col) = v;
                    ss += (v[0] * v[0] + v[1] * v[1]) + (v[2] * v[2] + v[3] * v[3]);
                    const f32x4 sc = *(const f32x4*)(MODRAW + (size_t)mr * NMOD + D + col) + *(const f32x4*)(b_mod + D + col);
                    const f32x4 gg = *(const f32x4*)(norm1_g + col) * (sc + 1.0f);
                    const f32x4 xs = v * gg;
                    u32x2 o; o.x = pk2(xs[0], xs[1]); o.y = pk2(xs[2], xs[3]);
                    *(u32x2*)(XG + (size_t)row * D + col) = o;
                }
                ss = wave_sum(ss);
                if (lane == 0) RSS[row] = ss;
                continue;
            }
            it -= I_X;
            if (it < I_KC) {
                const int l = it / 512, bs = (it >> 8) & 1, key = it & 255;
                const float* src = cache_k + (((size_t)(bs * DEPTH + l) * 256 + key) * 512) + 8 * lane;
                const f32x4 a = *(const f32x4*)src, b = *(const f32x4*)(src + 4);
                *(u32x4*)(KC + (((size_t)(l * 2 + bs) * 256 + key) * 512) + 8 * lane) = pk8(a, b);
                continue;
            }
            it -= I_KC;
            if (it < I_VC) {
                const int l = it / 64, bs = (it >> 5) & 1, h = (it >> 2) & 7, kb = it & 3, key = kb * 64 + lane;
                const float* src = cache_v + (((size_t)(bs * DEPTH + l) * 256 + key) * 512) + h * 64;
                bf16_t* dst = VTC + ((size_t)((l * 2 + bs) * 8 + h) * 64) * 256 + pos_of_key(key);
#pragma unroll
                for (int d4 = 0; d4 < 16; ++d4) {
                    const f32x4 v = *(const f32x4*)(src + 4 * d4);
                    const unsigned w0 = pk2(v[0], v[1]), w1 = pk2(v[2], v[3]);
                    dst[(size_t)(4 * d4 + 0) * 256] = (bf16_t)(w0 & 0xffff); dst[(size_t)(4 * d4 + 1) * 256] = (bf16_t)(w0 >> 16);
                    dst[(size_t)(4 * d4 + 2) * 256] = (bf16_t)(w1 & 0xffff); dst[(size_t)(4 * d4 + 3) * 256] = (bf16_t)(w1 >> 16);
                }
                continue;
            }
            it -= I_VC;
            {
                const int q = it & 3, which = (it >> 2) % 6, lr = it / 24, l = lr / 3, col = q * 256 + 4 * lane;
                const float* mraw = MODRAW + (size_t)lr * NMOD; const float* bm = b_mod + (size_t)l * NMOD;
                f32x4 v;
                if (which == 0) v = *(const f32x4*)(norm1_g + (size_t)l * D + col) * (*(const f32x4*)(mraw + D + col) + *(const f32x4*)(bm + D + col) + 1.0f);
                else if (which == 1) v = *(const f32x4*)(mraw + col) + *(const f32x4*)(bm + col);
                else if (which == 2) v = *(const f32x4*)(mraw + 2 * D + col) + *(const f32x4*)(bm + 2 * D + col);
                else if (which == 3) v = *(const f32x4*)(norm2_g + (size_t)l * D + col) * (*(const f32x4*)(mraw + 4 * D + col) + *(const f32x4*)(bm + 4 * D + col) + 1.0f);
                else if (which == 4) v = *(const f32x4*)(mraw + 3 * D + col) + *(const f32x4*)(bm + 3 * D + col);
                else v = *(const f32x4*)(mraw + 5 * D + col) + *(const f32x4*)(bm + 5 * D + col);
                *(f32x4*)(MODT + ((size_t)lr * 6 + which) * D + col) = v;
            }
        }
        LDS_WAIT(); __syncthreads();
    }
    }
    SEAM(1);

    for (int l = 0; l < DEPTH; ++l) {
        const int p0 = 2 + 6 * l;
        const float* modt_l = MODT + (size_t)l * 3 * 6 * D;
        for (int rep_ = 0; rep_ < MK_REPS(0); ++rep_) { if (rep_) GRID_BAR();
        if (IN(p0)) { PHASE_PTRS();
            pg8::Gemm g{XG, WIN + (size_t)l * NIN * D, D, D};
            pg8::TileOrder S; S.init(M, NIN, D, G, bx);
            EpiIn E{RSS + (size_t)(2 * l) * M, C1 + (size_t)(l * 3) * NIN, b_gate + (size_t)l * 3072, Qb, Kb, VT, PIN, CIN, GT,
                    args.out + OUT_K + (size_t)l * 256 * 512, args.out + OUT_V + (size_t)l * 256 * 512};
            pg8::gemm_phase<EpiIn, pg8::TileOrder>(lds, g, S, E);
        }
        }
        SEAM(p0);
        for (int rep_ = 0; rep_ < MK_REPS(1); ++rep_) { if (rep_) GRID_BAR();
        if (IN(p0 + 1)) { PHASE_PTRS();
            AttnPtrs AP{Qb, Kb, VT, KC + (size_t)l * 2 * 256 * 512, VTC + (size_t)l * 2 * 8 * 64 * 256, ABR};
            PcPtrs PP{PIN, CIN, w_dw + (size_t)l * CONVK * CW, b_dw + (size_t)l * CW, conv_norm_g + (size_t)l * CW, conv_norm_b + (size_t)l * CW, ABR};
            int lane_p = lane; asm volatile("" : "+v"(lane_p));
            if (vcu < 128) {
                LAS float* rpl = (LAS float*)(lds + 1024); LAS float* parts = (LAS float*)(lds + 16384);
                LAS unsigned char* kl = lds + 53248; LAS unsigned char* vl = kl + PA_K_BYTES;
                const float* rpb_l = rpb + (size_t)l * 8 * 15 * 31;
                for (int i = wave * 64 + lane_p; i < 8 * 15 * 31; i += NWAVES * 64) rpl[i] = rpb_l[i] * LOG2E;
                if (!(rep_ && MK_VAR == 1)) attn_sample_block(AP, kl, vl, rpl, parts, vcu, wave, lane_p);
                { const int pu = vcu * NWAVES + wave; if (pu < 768 && !(rep_ && (MK_VAR == 4 || MK_VAR == 5))) pool_unit(PP, pu, lane_p); }
            } else {
                LAS float* wl = (LAS float*)lds; LAS unsigned char* kl = lds + 49152; LAS unsigned char* vl = kl + PA_K_BYTES;
                const int bh = vcu - 128;
                for (int i = wave * 64 + lane_p; i < 47 * CW / 4; i += NWAVES * 64) { const int j = i / (CW / 4) - 7;
                    *(LAS f32x4*)(wl + 4 * i) = (j >= 0 && j < CONVK) ? *(const f32x4*)(PP.wdw + 4 * (i - 7 * (CW / 4))) : (f32x4){0.f, 0.f, 0.f, 0.f}; }
                { StageRegs R; attn_stage_load(R, AP.K + (size_t)((bh >> 3) * 256) * NAW + (bh & 7) * 64, AP.Vt + (size_t)(bh * 64) * 256, 256, 256, wave * 64 + lane_p); attn_stage_store(R, 256, kl, vl, wave * 64 + lane_p); }
                LDS_WAIT(); __syncthreads();
                if (!(rep_ && (MK_VAR == 2 || MK_VAR == 5))) attn_prompt_lds(AP, kl, vl, bh, wave, lane_p);
                { const int it = bh * NWAVES + wave;
                    if (it < 768) { if (!(rep_ && (MK_VAR == 3 || MK_VAR == 5))) conv_unit(PP, wl, it, lane_p); } }
                if (I_MIX > 0 && bh >= 96 && l + 1 < DEPTH && !rep_) {
                    __syncthreads();
                    LAS float* scr = (LAS float*)(lds + wave * TP_BYTES);
#pragma unroll 1
                    for (int r = I_LAYER - I_MIX + (bh - 96) * NWAVES + wave; r < I_LAYER; r += 32 * NWAVES) TRANSPOSE_LAYER_ITEM(l + 1, r, scr, lane_p);
                    LDS_WAIT();
                }
            }
            __syncthreads();
        }
        }
        SEAM(p0 + 1);
        const int t192 = (bx & 7) * 32 + (bx >> 3), pm192 = t192 >> 3, pn192 = t192 & 7;
        const bool has192 = (G == 256);
        for (int rep_ = 0; rep_ < MK_REPS(2); ++rep_) { if (rep_) GRID_BAR();
        if (IN(p0 + 2)) { PHASE_PTRS();
            EpiBranch192 E{GT, MB};
            if (has192) g192::gemm<EpiBranch192>(lds, ABR, D, WBR + (size_t)l * D * D, D, pm192, pn192, 16, E);
        }
        }
        SEAML(p0 + 2, 4 * l + 1, 0);
        for (int rep_ = 0; rep_ < MK_REPS(5); ++rep_) { if (rep_) GRID_BAR();
        if (IN(p0 + 3)) { PHASE_PTRS();
            EpiRes192 E{rep_ ? MF : X, rep_ ? ACT : XG, modt_l + 2 * D, modt_l + 3 * D, rep_ ? (float*)ABR : RSS + (size_t)(2 * l + 1) * M};
            if (has192) g192::gemm<EpiRes192>(lds, MB, D, WOUT + (size_t)l * D * D, D, pm192, pn192, 16, E);
        }
        }
        SEAML(p0 + 3, 4 * l + 2, 0);
        for (int rep_ = 0; rep_ < MK_REPS(3); ++rep_) { if (rep_) GRID_BAR();
        if (IN(p0 + 4)) { PHASE_PTRS();
            pg8::Gemm g{XG, WGU + (size_t)l * NGU * D, D, D};
            const bool bg = (I_TAIL > 0 && l + 1 < DEPTH && G == 256);
            const int nw = bg ? 232 : 256;
            pg8::TileOrderGU S; S.init(M, NGU, D, nw, bx);
            EpiGU E{RSS + (size_t)(2 * l + 1) * M, C2 + (size_t)(l * 3) * NGU, ACT};
            pg8::gemm_phase<EpiGU, pg8::TileOrderGU>(lds, g, S, E);
            if (bg && bx >= 128) {
                int lane_b = lane; asm volatile("" : "+v"(lane_b));
                LAS float* scr = (LAS float*)(lds + wave * TP_BYTES);
                const bool conv_only = bx >= nw;
                const int r0 = conv_only ? I_HEAD + (bx - 232) * NWAVES + wave : I_HEAD + I_BG1 + (bx - 128) * NWAVES + wave;
                const int r1 = conv_only ? I_HEAD + I_BG1 : I_LAYER - I_MIX, rs = conv_only ? 24 * NWAVES : 104 * NWAVES;
#pragma unroll 1
                for (int r = r0; r < r1; r += rs) TRANSPOSE_LAYER_ITEM(l + 1, r, scr, lane_b);
                LDS_WAIT(); asm volatile("s_waitcnt vmcnt(0)" ::: "memory"); __syncthreads();
                if (conv_only && tid == 0) (void)xb_add((unsigned*)(WSB + WS_CTL) + CW_BAR + XB_CONV, 1u);
            }
        }
        }
        SEAML(p0 + 4, 4 * l + 3, 0);
        for (int rep_ = 0; rep_ < MK_REPS(6); ++rep_) { if (rep_) GRID_BAR();
        if (IN(p0 + 5)) { PHASE_PTRS();
            EpiRes192 E{rep_ ? MF : X, rep_ ? MB : XG, modt_l + 5 * D, MODT + (size_t)((l + 1) % DEPTH) * 3 * 6 * D, rep_ ? (float*)ABR : RSS + (size_t)(2 * l + 2) * M};
            if (has192) g192::gemm<EpiRes192>(lds, ACT, FFN, WDN + (size_t)l * D * FFN, FFN, pm192, pn192, FFN / 64, E);
        }
        }
        SEAML(p0 + 5, 4 * l + 4, (l + 1 < DEPTH) ? 24 * (l + 1) : 0);
    }
    if (IN(NPHASE - 1)) { PHASE_PTRS();
        for (int row0 = (bx >> 3) * NWAVES + wave; row0 < M / 8; row0 += (G >> 3) * NWAVES) {
            const int row = (bx & 7) * (M / 8) + row0;
            const float rinv = 1.0f / sqrtf(RSS[(size_t)8 * M + row] * (1.0f / D) + EPS);
#pragma unroll
            for (int j = 0; j < 4; ++j) {
                const int col = 256 * j + 4 * lane;
                const f32x4 v = *(const f32x4*)(X + (size_t)row * D + col) * rinv * *(const f32x4*)(final_g + col);
                __builtin_nontemporal_store(v, (f32x4*)(args.out + OUT_Y + (size_t)row * D + col));
            }
        }
    }
#undef IN
#undef PHASE_PTRS
#undef WSB
#undef ctlf
#undef x_prompt
#undef x_sample
#undef cache_k
#undef cache_v
#undef cvec
#undef c_ctx
#undef w_mod
#undef b_mod
#undef norm1_g
#undef norm2_g
#undef w_in
#undef b_gate
#undef rpb
#undef w_oa
#undef w_pool
#undef pool_scale
#undef w_ob
#undef w_dw
#undef b_dw
#undef conv_norm_g
#undef conv_norm_b
#undef w_oc
#undef w_out
#undef w_gu
#undef w_down
#undef final_g
#undef MODRAW
#undef C1
#undef C2
#undef RSS
#undef MODT
#undef WIN
#undef WGU
#undef WDN
#undef WBR
#undef WOUT
#undef X
#undef XG
#undef Qb
#undef Kb
#undef VT
#undef KC
#undef VTC
#undef PIN
#undef CIN
#undef GT
#undef ABR
#undef MF
#undef MB
#undef ACT
#undef SEAM
#undef SEAML
}

extern "C" void kernel_launch(void* const* d_in, const int* in_sizes, int n_in, void* d_out, int out_size, void* d_ws, size_t ws_size, hipStream_t stream) {
    static int grid = 0;
    if (grid == 0) {
        if (n_in != 26 || ws_size < WS_END) { fprintf(stderr, "kernel_launch: expected 26 inputs and >= %zu bytes of workspace; got %d, %zu\n", (size_t)WS_END, n_in, ws_size); grid = -1; return; }
        int dev = 0, cus = 0;
        if (hipGetDevice(&dev) != hipSuccess || hipDeviceGetAttribute(&cus, hipDeviceAttributeMultiprocessorCount, dev) != hipSuccess) { grid = -1; return; }
        if (hipFuncSetAttribute((const void*)fwd_kernel, hipFuncAttributeMaxDynamicSharedMemorySize, LDS_BYTES) != hipSuccess) { fprintf(stderr, "kernel_launch: hipFuncSetAttribute failed\n"); grid = -1; return; }
        (void)hipGetLastError();
        grid = cus;
    }
    if (grid < 0) return;
    (void)hipMemsetAsync((char*)d_ws + WS_CTL, 0, CTL_ZERO_BYTES, stream);
    Args a{};
    for (int i = 0; i < 26; ++i) a.in[i] = (const float*)d_in[i];
    a.out = (float*)d_out; a.ws = (unsigned char*)d_ws;
#if MK_PER_PHASE
    for (int p = 0; p < NPHASE; ++p) { a.ph_lo = p; a.ph_hi = p + 1; hipLaunchKernelGGL(fwd_kernel, dim3(grid), dim3(NWAVES * 64), LDS_BYTES, stream, a); }
#else
    a.ph_lo = 0; a.ph_hi = NPHASE;
    hipLaunchKernelGGL(fwd_kernel, dim3(grid), dim3(NWAVES * 64), LDS_BYTES, stream, a);
#endif
}
```

```cpp
#include <hip/hip_runtime.h>
#include <cstdio>
#include <cstdint>

#ifndef MK_PER_PHASE
#define MK_PER_PHASE 0
#endif

#ifndef MK_REPEAT
#define MK_REPEAT 0
#endif
#define MK_REPS(bit) ((MK_REPEAT >> (bit)) & 1 ? 2 : 1)
#ifndef MK_VAR
#define MK_VAR 0
#endif

constexpr int D = 1024, MP = 4096, MS = 2048, M = MP + MS, DEPTH = 4;
constexpr int NIN = 5376, FFN = 2816, NGU = 2 * FFN, NMOD = 6 * D;
constexpr int NAW = 512, PW = 256, CW = 256, CONVK = 31;
constexpr float EPS = 1e-6f;
constexpr float LOG2E = 1.4426950408889634f;
constexpr float QSCALE = 0.125f * LOG2E;

constexpr size_t MiB = 1u << 20;
constexpr size_t WS_CTL = 0, CTL_ZERO_BYTES = 5 * MiB / 4;
constexpr int CW_BAR = 4096;
constexpr int CF_MODRAW = 16384;
constexpr int CF_C1 = CF_MODRAW + DEPTH * 3 * NMOD;
constexpr int CF_C2 = CF_C1 + DEPTH * 3 * NIN;
constexpr int CF_RSS = CF_C2 + DEPTH * 3 * NGU;
constexpr int CF_END = CF_RSS + 9 * M;
static_assert((size_t)CF_END * 4 <= CTL_ZERO_BYTES, "control region");
constexpr size_t WS_MODT = 2 * MiB;
constexpr size_t WS_WIN = 4 * MiB;
constexpr size_t WS_WGU = 46 * MiB;
constexpr size_t WS_WDN = 90 * MiB;
constexpr size_t WS_WBR = 112 * MiB;
constexpr size_t WS_WOUT = 120 * MiB;
constexpr size_t WS_X = 128 * MiB;
constexpr size_t WS_XG = 152 * MiB;
constexpr size_t WS_Q = 164 * MiB, WS_K = 170 * MiB;
constexpr size_t WS_VT = 176 * MiB;
constexpr size_t WS_KC = 182 * MiB;
constexpr size_t WS_VTC = 184 * MiB;
constexpr size_t WS_PIN = 186 * MiB;
constexpr size_t WS_CIN = 189 * MiB;
constexpr size_t WS_G = 195 * MiB;
constexpr size_t WS_ABR = 231 * MiB;
constexpr size_t WS_MF = 243 * MiB;
constexpr size_t WS_MB = 267 * MiB;
constexpr size_t WS_ACT = 279 * MiB;
constexpr size_t WS_END = 312 * MiB;
constexpr size_t VT_SAMPLE_OFF = (size_t)16 * 8 * 64 * 256;

constexpr size_t OUT_Y = 0, OUT_K = (size_t)M * D, OUT_V = OUT_K + (size_t)16 * DEPTH * 256 * 512;

#define GAS __attribute__((address_space(1)))
#define LAS __attribute__((address_space(3)))
typedef unsigned short bf16_t;
typedef short bf16x8 __attribute__((ext_vector_type(8)));
typedef float f32x4 __attribute__((ext_vector_type(4)));
typedef float f32x2 __attribute__((ext_vector_type(2)));
typedef float f32x16 __attribute__((ext_vector_type(16)));
typedef unsigned u32x4 __attribute__((ext_vector_type(4)));
typedef unsigned u32x2 __attribute__((ext_vector_type(2)));
typedef __bf16 bf16x2_t __attribute__((ext_vector_type(2)));
#define LDS_WAIT() asm volatile("s_waitcnt lgkmcnt(0)" ::: "memory")

__device__ __forceinline__ unsigned pk2(float lo, float hi) { f32x2 v = {lo, hi}; bf16x2_t b = __builtin_convertvector(v, bf16x2_t); return __builtin_bit_cast(unsigned, b); }
__device__ __forceinline__ u32x4 pk8(f32x4 a, f32x4 b) { u32x4 w; w.x = pk2(a[0], a[1]); w.y = pk2(a[2], a[3]); w.z = pk2(b[0], b[1]); w.w = pk2(b[2], b[3]); return w; }
__device__ __forceinline__ float bf_lo(unsigned w) { return __uint_as_float(w << 16); }
__device__ __forceinline__ float bf_hi(unsigned w) { return __uint_as_float(w & 0xffff0000u); }
__device__ __forceinline__ float sigmoidf_(float x) { return __builtin_amdgcn_rcpf(1.0f + __builtin_amdgcn_exp2f(-LOG2E * x)); }
__device__ __forceinline__ float wave_sum(float v) {
#pragma unroll
    for (int o = 1; o < 64; o <<= 1) v += __shfl_xor(v, o);
    return v;
}
__device__ __forceinline__ int pos_of_key(int t) { return (t & ~12) | ((t & 4) << 1) | ((t & 8) >> 1); }
__device__ __forceinline__ int mod_row_of_pm(int pm) { return pm < 16 ? 0 : 1 + ((pm - 16) >> 2); }

namespace pg8 {
constexpr int BM = 256, BK = 64, HALF = 128, HTB = HALF * BK * 2  , STAGE_BYTES = 8 * HTB, NXCD = 8, WGM = 3;
__host__ __device__ __forceinline__ int lds_byte(int r, int c) { return r * 128 + ((((c >> 3) ^ (r >> 1)) & 7) << 4) + (c & 7) * 2; }
__host__ __device__ __forceinline__ void stage_rc(int b, int& R, int& C) { R = b >> 7; C = (((b >> 4) ^ (R >> 1)) & 7) * 8; }
__host__ __device__ __forceinline__ int perm32(int rho) { const int n = rho >> 4, i = rho & 15; return 8 * (i >> 2) + 4 * n + (i & 3); }

struct Unit { int pm, pn, k0, nt, kind, half; };
struct Gemm { const bf16_t* A; const bf16_t* Bt; int lda, ldb; };

struct TileOrder {
    int nM, nN, nwg, G, c, nt;
    __device__ void init(int M_, int N_, int K_, int G_, int c_) { nM = M_ / BM; nN = N_ / BM; nwg = nM * nN; G = G_; c = c_; nt = K_ / BK; }
    __device__ bool next(int i, Unit& u) const {
        const long L = (long)i * G + c; if (L >= nwg) return false;
        int wgid = (int)L; { const int q = nwg / NXCD, r = nwg % NXCD, xcd = wgid % NXCD, off = wgid / NXCD; wgid = (xcd < r ? xcd * (q + 1) : r * (q + 1) + (xcd - r) * q) + off; }
        const int nig = WGM * nN, gid = wgid / nig, fm = gid * WGM, gsz = (nM - fm) < WGM ? (nM - fm) : WGM;
        u.pm = fm + ((wgid % nig) % gsz); u.pn = (wgid % nig) / gsz; u.k0 = 0; u.nt = nt; u.kind = 0; u.half = 0; return true;
    }
};
struct TileOrderGU {
    int nM, nN, nwg, nw, c, nt;
    __device__ void init(int M_, int N_, int K_, int nw_, int c_) { nM = M_ / BM; nN = N_ / BM; nwg = nM * nN; nw = nw_; c = c_; nt = K_ / BK; }
    __device__ __forceinline__ void done(const Unit&, int) const {}
    __device__ void tile_of(int L, Unit& u) const {
        const int wgid = (L % NXCD) * (nwg / NXCD) + L / NXCD;
        const int nig = 3 * nN, gid = wgid / nig, fm = gid * 3;
        u.pm = fm + ((wgid % nig) % 3); u.pn = (wgid % nig) / 3; u.k0 = 0; u.nt = nt; u.kind = 0;
    }
    __device__ bool next(int i, Unit& u) const {
        if (c >= nw || i > 2) return false;
        if (i < 2) { tile_of(i * nw + c, u); u.half = 0; return true; }
        const int j = c >> 3, per = (nwg - 2 * nw) / NXCD;
        if (j >= 2 * per) return false;
        tile_of(2 * nw + (j >> 1) * NXCD + (c & 7), u); u.half = 1 + (j & 1); return true;
    }
};

struct PanelOrder {
    int c, nseg, ka, na, kb, nb, kc, nc;
    __device__ bool next(int i, Unit& u) const {
        if (c >= 96 || i >= nseg) return false;
        const int T = (c & 7) * 12 + (c >> 3);
        u.pm = T >> 2; u.pn = T & 3; u.k0 = i == 0 ? ka : (i == 1 ? kb : kc); u.nt = i == 0 ? na : (i == 1 ? nb : nc); u.kind = i; u.half = 0; return true;
    }
};

template <class Epi, class Sched>
__device__ __forceinline__ void gemm_phase(LAS unsigned char* lds, const Gemm g, const Sched& S, const Epi& E) {
    int tid = threadIdx.x; asm volatile("" : "+v"(tid));
    const int wid = __builtin_amdgcn_readfirstlane(tid >> 6), lane = tid & 63, wr = wid >> 2, wc = wid & 3, fr = lane & 15, fq = lane >> 4;
    unsigned voffA[2], voffB[2];
#pragma unroll
    for (int i = 0; i < 2; ++i) { int R, C; stage_rc(tid * 16 + i * 8192, R, C); const int Rb = (R & ~31) + perm32(R & 31);
        voffA[i] = (unsigned)(R * g.lda + C) * 2u; voffB[i] = (unsigned)(Rb * g.ldb + C) * 2u; }
    const size_t kstep = (size_t)(BK * 2);
    const size_t hstepA = (size_t)HALF * g.lda * 2, hstepB = (size_t)HALF * g.ldb * 2;
    const size_t tstepA = 2 * hstepA, tstepB = 2 * hstepB;
    const unsigned ldsw = (unsigned)wid * 1024u;
    const int aoffk[2] = {lds_byte(wr * 64 + fr, fq * 8), lds_byte(wr * 64 + fr, fq * 8 + 32)}, boffk[2] = {lds_byte(wc * 32 + fr, fq * 8), lds_byte(wc * 32 + fr, fq * 8 + 32)};
#define PG8_SA(b, h) (((b) * 2 + (h)) * HTB)
#define PG8_SB(b, h) ((4 + (b) * 2 + (h)) * HTB)
#define PG8_STAGE(bufoff, gbase, voff) do { _Pragma("unroll") for (int _i = 0; _i < 2; ++_i) \
        __builtin_amdgcn_global_load_lds((const unsigned*)((const char*)(gbase) + (voff)[_i]), (LAS unsigned*)(lds + (bufoff) + ldsw + _i * 8192), 16, 0, 0); } while (0)
#define PG8_LDA(dst, b, h) do { _Pragma("unroll") for (int m = 0; m < 4; ++m) _Pragma("unroll") for (int k = 0; k < 2; ++k) dst[m][k] = *(const LAS bf16x8*)(lds + PG8_SA(b, h) + aoffk[k] + m * 2048); } while (0)
#define PG8_LDB(dst, b, h) do { _Pragma("unroll") for (int n = 0; n < 2; ++n) _Pragma("unroll") for (int k = 0; k < 2; ++k) dst[n][k] = *(const LAS bf16x8*)(lds + PG8_SB(b, h) + boffk[k] + n * 2048); } while (0)
#define PG8_MMA(ai, bj, At, Bt) do { __builtin_amdgcn_s_setprio(1); _Pragma("unroll") for (int m = 0; m < 4; ++m) _Pragma("unroll") for (int n = 0; n < 2; ++n) _Pragma("unroll") for (int k = 0; k < 2; ++k) \
        acc[ai][bj][m][n] = __builtin_amdgcn_mfma_f32_16x16x32_bf16(Bt[n][k], At[m][k], acc[ai][bj][m][n], 0, 0, 0); __builtin_amdgcn_s_setprio(0); } while (0)
#define PG8_WAIT_V(n) asm volatile("s_waitcnt vmcnt(" #n ")" ::: "memory")
#define PG8_WAIT_L(n) asm volatile("s_waitcnt lgkmcnt(" #n ")" ::: "memory")
#define PG8_BAR __builtin_amdgcn_s_barrier()
#define PG8_SCHED __builtin_amdgcn_sched_barrier(0)
    Unit cur, nxt; int ui = 0;
    if (!S.next(0, cur)) return;
    f32x4 acc[2][2][4][2];
#pragma unroll
    for (int a = 0; a < 2; ++a)
#pragma unroll
        for (int b = 0; b < 2; ++b)
#pragma unroll
            for (int m = 0; m < 4; ++m)
#pragma unroll
                for (int n = 0; n < 2; ++n) acc[a][b][m][n] = (f32x4){0.f, 0.f, 0.f, 0.f};
    bf16x8 At[4][2], B0[2][2], B1[2][2];
    const char* cA = (const char*)g.A + (size_t)cur.pm * tstepA + (size_t)cur.k0 * 2; const char* cB = (const char*)g.Bt + (size_t)cur.pn * tstepB + (size_t)cur.k0 * 2;
    PG8_STAGE(PG8_SB(0, 0), cB, voffB); PG8_STAGE(PG8_SB(0, 1), cB + hstepB, voffB); PG8_STAGE(PG8_SA(0, 0), cA, voffA); PG8_STAGE(PG8_SA(0, 1), cA + hstepA, voffA);
    if (wr == 1) PG8_BAR;
    PG8_WAIT_V(2); PG8_BAR;
    PG8_STAGE(PG8_SB(1, 0), cB + kstep, voffB); PG8_STAGE(PG8_SA(1, 0), cA + kstep, voffA); PG8_STAGE(PG8_SB(1, 1), cB + hstepB + kstep, voffB);
    PG8_WAIT_V(6); PG8_BAR;
    for (;;) {
        const bool has_next = S.next(ui + 1, nxt);
        const char* nA = has_next ? (const char*)g.A + (size_t)nxt.pm * tstepA + (size_t)nxt.k0 * 2 : cA; const char* nB = has_next ? (const char*)g.Bt + (size_t)nxt.pn * tstepB + (size_t)nxt.k0 * 2 : cB;
        const int nt = cur.nt;
        const bool do0 = cur.half != 2, do1 = cur.half != 1;
        for (int t = 0; t < nt; t += 2) {
            const bool last = (t == nt - 2);
            const char* a1 = cA + (size_t)(t + 1) * kstep;
            const char* a2 = last ? nA : cA + (size_t)(t + 2) * kstep; const char* b2 = last ? nB : cB + (size_t)(t + 2) * kstep;
            const char* a3 = a2 + kstep; const char* b3 = b2 + kstep;
            PG8_LDB(B0, 0, 0); PG8_LDB(B1, 0, 1); PG8_SCHED; PG8_LDA(At, 0, 0); PG8_STAGE(PG8_SA(1, 1), a1 + hstepA, voffA);
            PG8_WAIT_V(8); PG8_WAIT_L(0); PG8_BAR; if (do0) { PG8_MMA(0, 0, At, B0); PG8_MMA(0, 1, At, B1); } PG8_BAR; PG8_SCHED;
            PG8_LDA(At, 0, 1); PG8_STAGE(PG8_SB(0, 0), b2, voffB); PG8_STAGE(PG8_SB(0, 1), b2 + hstepB, voffB); PG8_STAGE(PG8_SA(0, 0), a2, voffA);
            PG8_WAIT_V(8); PG8_WAIT_L(0); PG8_BAR; if (do1) { PG8_MMA(1, 0, At, B0); PG8_MMA(1, 1, At, B1); } PG8_BAR; PG8_SCHED;
            PG8_LDB(B0, 1, 0); PG8_LDB(B1, 1, 1); PG8_SCHED; PG8_LDA(At, 1, 0); PG8_STAGE(PG8_SA(0, 1), a2 + hstepA, voffA);
            PG8_WAIT_V(8); PG8_WAIT_L(0); PG8_BAR; if (do0) { PG8_MMA(0, 0, At, B0); PG8_MMA(0, 1, At, B1); } PG8_BAR; PG8_SCHED;
            PG8_LDA(At, 1, 1); PG8_STAGE(PG8_SB(1, 0), b3, voffB); PG8_STAGE(PG8_SB(1, 1), b3 + hstepB, voffB); PG8_STAGE(PG8_SA(1, 0), a3, voffA);
            PG8_WAIT_V(8); PG8_WAIT_L(0); PG8_BAR; if (do1) { PG8_MMA(1, 0, At, B0); PG8_MMA(1, 1, At, B1); } PG8_BAR; PG8_SCHED;
        }
        if (wr == 0) PG8_BAR;
        E(acc, cur, wr, wc, fr, fq);
        if (!has_next) break;
#pragma unroll
        for (int a = 0; a < 2; ++a)
#pragma unroll
            for (int b = 0; b < 2; ++b)
#pragma unroll
                for (int m = 0; m < 4; ++m)
#pragma unroll
                    for (int n = 0; n < 2; ++n) acc[a][b][m][n] = (f32x4){0.f, 0.f, 0.f, 0.f};
        cur = nxt; cA = nA; cB = nB; ++ui;
        if (wr == 1) PG8_BAR;
    }
    PG8_WAIT_V(0);
    PG8_BAR;
#undef PG8_SA
#undef PG8_SB
#undef PG8_STAGE
#undef PG8_LDA
#undef PG8_LDB
#undef PG8_MMA
#undef PG8_WAIT_V
#undef PG8_WAIT_L
#undef PG8_BAR
#undef PG8_SCHED
}
}

typedef f32x4 Acc[2][2][4][2];

struct EpiIn {
    const float* rss; const float* c1; const float* bgate;
    bf16_t *Q, *K, *Vt, *Pin, *Cin, *G; float *outk, *outv;
    __device__ __forceinline__ void operator()(const Acc& acc, const pg8::Unit& u, int wr, int wc, int fr, int fq) const {
        const int pn = u.pn, pm = u.pm, mr = mod_row_of_pm(pm);
        const int cb = pn * 256 + wc * 32 + 8 * fq;
        f32x4 cv[2][2];
#pragma unroll
        for (int bj = 0; bj < 2; ++bj)
#pragma unroll
            for (int n = 0; n < 2; ++n) { cv[bj][n] = *(const f32x4*)(c1 + (size_t)mr * NIN + cb + bj * 128 + 4 * n);
                if (pn >= 9) cv[bj][n] += *(const f32x4*)(bgate + (cb - 2304) + bj * 128 + 4 * n); }
        float rinvs[2][4];
#pragma unroll
        for (int ai = 0; ai < 2; ++ai)
#pragma unroll
            for (int m = 0; m < 4; ++m) rinvs[ai][m] = rss[pm * 256 + ai * 128 + wr * 64 + m * 16 + fr];
#pragma unroll
        for (int ai = 0; ai < 2; ++ai)
#pragma unroll
            for (int m = 0; m < 4; ++m) {
                const int row = pm * 256 + ai * 128 + wr * 64 + m * 16 + fr;
                const float rinv = 1.0f / sqrtf(rinvs[ai][m] * (1.0f / D) + EPS);
#pragma unroll
                for (int bj = 0; bj < 2; ++bj) {
                    const int col = cb + bj * 128;
                    f32x4 v0 = acc[ai][bj][m][0] * rinv + cv[bj][0], v1 = acc[ai][bj][m][1] * rinv + cv[bj][1];
                    if (pn < 2) {
                        *(u32x4*)(Q + (size_t)row * NAW + col) = pk8(v0 * QSCALE, v1 * QSCALE);
                    } else if (pn < 4) {
                        const int c = col - 512;
                        *(u32x4*)(K + (size_t)row * NAW + c) = pk8(v0, v1);
                        if (pm < 16) { float* o = outk + ((size_t)(pm * DEPTH * 256 + (row & 255))) * 512 + c; __builtin_nontemporal_store(v0, (f32x4*)o); __builtin_nontemporal_store(v1, (f32x4*)(o + 4)); }
                    } else if (pn < 6) {
                        const int c = col - 1024, h = c >> 6, d = c & 63;
                        if (pm < 16) { float* o = outv + ((size_t)(pm * DEPTH * 256 + (row & 255))) * 512 + c; __builtin_nontemporal_store(v0, (f32x4*)o); __builtin_nontemporal_store(v1, (f32x4*)(o + 4)); }
                        bf16_t* vb; int L;
                        if (pm < 16) { L = 256; vb = Vt + ((size_t)((pm * 8 + h) * 64 + d)) * 256 + pos_of_key(row & 255); }
                        else { const int rs = row - MP, bs = rs >> 10; L = 1024; vb = Vt + VT_SAMPLE_OFF + ((size_t)((bs * 8 + h) * 64 + d)) * 1024 + pos_of_key(rs & 1023); }
                        const u32x4 w = pk8(v0, v1);
                        vb[0] = (bf16_t)(w.x & 0xffff); vb[(size_t)L] = (bf16_t)(w.x >> 16); vb[(size_t)2 * L] = (bf16_t)(w.y & 0xffff); vb[(size_t)3 * L] = (bf16_t)(w.y >> 16);
                        vb[(size_t)4 * L] = (bf16_t)(w.z & 0xffff); vb[(size_t)5 * L] = (bf16_t)(w.z >> 16); vb[(size_t)6 * L] = (bf16_t)(w.w & 0xffff); vb[(size_t)7 * L] = (bf16_t)(w.w >> 16);
                    } else if (pn == 6) {
                        *(u32x4*)(Pin + (size_t)row * PW + (col - 1536)) = pk8(v0, v1);
                    } else if (pn < 9) {
                        *(u32x4*)(Cin + (size_t)row * 512 + (col - 1792)) = pk8(v0, v1);
                    } else {
#pragma unroll
                        for (int e = 0; e < 4; ++e) { v0[e] = sigmoidf_(v0[e]); v1[e] = sigmoidf_(v1[e]); }
                        *(u32x4*)(G + (size_t)row * 3072 + (col - 2304)) = pk8(v0, v1);
                    }
                }
                asm volatile("" ::: "memory");
            }
    }
};

struct EpiBranch {
    const bf16_t* G; float* mf; bf16_t* mb;
    __device__ __forceinline__ void operator()(const Acc& acc, const pg8::Unit& u, int wr, int wc, int fr, int fq) const {
        const int cb = u.pn * 256 + wc * 32 + 8 * fq, kind = u.kind;
#pragma unroll
        for (int ai = 0; ai < 2; ++ai)
#pragma unroll
            for (int m = 0; m < 4; ++m) {
                const int row = u.pm * 256 + ai * 128 + wr * 64 + m * 16 + fr;
#pragma unroll
                for (int bj = 0; bj < 2; ++bj) {
                    const int col = cb + bj * 128;
                    const u32x4 gw = *(const u32x4*)(G + (size_t)row * 3072 + kind * 1024 + col);
                    f32x4 v0 = acc[ai][bj][m][0], v1 = acc[ai][bj][m][1];
                    v0[0] *= bf_lo(gw.x); v0[1] *= bf_hi(gw.x); v0[2] *= bf_lo(gw.y); v0[3] *= bf_hi(gw.y);
                    v1[0] *= bf_lo(gw.z); v1[1] *= bf_hi(gw.z); v1[2] *= bf_lo(gw.w); v1[3] *= bf_hi(gw.w);
                    float* sp = mf + (size_t)row * D + col;
                    if (kind > 0) { v0 += *(const f32x4*)sp; v1 += *(const f32x4*)(sp + 4); }
                    if (kind < 2) { *(f32x4*)sp = v0; *(f32x4*)(sp + 4) = v1; }
                    else *(u32x4*)(mb + (size_t)row * D + col) = pk8(v0, v1);
                }
                asm volatile("" ::: "memory");
            }
    }
};

struct EpiRes {
    float* x; bf16_t* xg; const float* gate; const float* gsn; float* rssn;
    __device__ __forceinline__ void operator()(const Acc& acc, const pg8::Unit& u, int wr, int wc, int fr, int fq) const {
        const int mr = mod_row_of_pm(u.pm), cb = u.pn * 256 + wc * 32 + 8 * fq;
        float ss[2][4];
#pragma unroll
        for (int ai = 0; ai < 2; ++ai)
#pragma unroll
            for (int m = 0; m < 4; ++m) ss[ai][m] = 0.f;
#pragma unroll
        for (int bj = 0; bj < 2; ++bj) {
            const int col = cb + bj * 128;
            const f32x4 gt0 = *(const f32x4*)(gate + (size_t)mr * 6 * D + col), gt1 = *(const f32x4*)(gate + (size_t)mr * 6 * D + col + 4);
            const f32x4 gs0 = *(const f32x4*)(gsn + (size_t)mr * 6 * D + col), gs1 = *(const f32x4*)(gsn + (size_t)mr * 6 * D + col + 4);
#pragma unroll
            for (int ai = 0; ai < 2; ++ai)
#pragma unroll
                for (int m = 0; m < 4; ++m) {
                    const int row = u.pm * 256 + ai * 128 + wr * 64 + m * 16 + fr;
                    float* xp = x + (size_t)row * D + col;
                    f32x4 x0 = *(const f32x4*)xp, x1 = *(const f32x4*)(xp + 4);
                    x0 += gt0 * acc[ai][bj][m][0]; x1 += gt1 * acc[ai][bj][m][1];
                    *(f32x4*)xp = x0; *(f32x4*)(xp + 4) = x1;
                    ss[ai][m] += (x0[0] * x0[0] + x0[1] * x0[1]) + (x0[2] * x0[2] + x0[3] * x0[3]) + (x1[0] * x1[0] + x1[1] * x1[1]) + (x1[2] * x1[2] + x1[3] * x1[3]);
                    *(u32x4*)(xg + (size_t)row * D + col) = pk8(x0 * gs0, x1 * gs1);
                    asm volatile("" ::: "memory");
                }
        }
#pragma unroll
        for (int ai = 0; ai < 2; ++ai)
#pragma unroll
            for (int m = 0; m < 4; ++m) {
                float s = ss[ai][m];
                s += __shfl_xor(s, 16); s += __shfl_xor(s, 32);
                if (fq == 0) atomicAdd(rssn + u.pm * 256 + ai * 128 + wr * 64 + m * 16 + fr, s);
            }
    }
};

struct EpiGU {
    const float* rss; const float* c2; bf16_t* act;
    __device__ __forceinline__ void operator()(const Acc& acc, const pg8::Unit& u, int wr, int wc, int fr, int fq) const {
        const int mr = mod_row_of_pm(u.pm), ca0 = u.pn * 128 + wc * 32 + 8 * fq;
        f32x4 ca[2], cbv[2];
#pragma unroll
        for (int n = 0; n < 2; ++n) { ca[n] = *(const f32x4*)(c2 + (size_t)mr * NGU + ca0 + 4 * n); cbv[n] = *(const f32x4*)(c2 + (size_t)mr * NGU + FFN + ca0 + 4 * n); }
        float rinvs[2][4];
#pragma unroll
        for (int ai = 0; ai < 2; ++ai)
#pragma unroll
            for (int m = 0; m < 4; ++m) rinvs[ai][m] = rss[u.pm * 256 + ai * 128 + wr * 64 + m * 16 + fr];
#pragma unroll
        for (int ai = 0; ai < 2; ++ai)
#pragma unroll
            for (int m = 0; m < 4; ++m) {
                if (u.half == 2 - ai) continue;
                const int row = u.pm * 256 + ai * 128 + wr * 64 + m * 16 + fr;
                const float rinv = 1.0f / sqrtf(rinvs[ai][m] * (1.0f / D) + EPS);
                f32x4 o[2];
#pragma unroll
                for (int n = 0; n < 2; ++n) {
                    const f32x4 a = acc[ai][0][m][n] * rinv + ca[n], b = acc[ai][1][m][n] * rinv + cbv[n];
#pragma unroll
                    for (int e = 0; e < 4; ++e) o[n][e] = a[e] * sigmoidf_(a[e]) * b[e];
                }
                *(u32x4*)(act + (size_t)row * FFN + ca0) = pk8(o[0], o[1]);
                asm volatile("" ::: "memory");
            }
    }
};

namespace g192 {
constexpr int TM = 192, TN = 128, BK = 64, ABYTES = TM * BK * 2, BBYTES = TN * BK * 2, SBYTES = ABYTES + BBYTES;
typedef f32x4 Acc6[6][2];
template <class Epi>
__device__ __forceinline__ void gemm(LAS unsigned char* lds, const bf16_t* A, int lda, const bf16_t* Bt, int ldb, int pm, int pn, int nt, const Epi& E) {
    int tid = threadIdx.x; asm volatile("" : "+v"(tid));
    const int wid = __builtin_amdgcn_readfirstlane(tid >> 6), lane = tid & 63, wr = wid >> 2, wc = wid & 3, fr = lane & 15, fq = lane >> 4;
    unsigned voffA[3], voffB[2];
#pragma unroll
    for (int i = 0; i < 3; ++i) { int R, C; pg8::stage_rc((wid + 8 * i) * 1024 + lane * 16, R, C); voffA[i] = (unsigned)(R * lda + C) * 2u; }
#pragma unroll
    for (int i = 0; i < 2; ++i) { int R, C; pg8::stage_rc((wid + 8 * i) * 1024 + lane * 16, R, C); const int Rb = (R & ~31) + pg8::perm32(R & 31); voffB[i] = (unsigned)(Rb * ldb + C) * 2u; }
    const char* gA = (const char*)(A + (size_t)pm * TM * lda); const char* gB = (const char*)(Bt + (size_t)pn * TN * ldb);
    const unsigned ldsw = (unsigned)wid * 1024u;
    const int aoffk[2] = {pg8::lds_byte(wr * 96 + fr, fq * 8), pg8::lds_byte(wr * 96 + fr, fq * 8 + 32)}, boffk[2] = {ABYTES + pg8::lds_byte(wc * 32 + fr, fq * 8), ABYTES + pg8::lds_byte(wc * 32 + fr, fq * 8 + 32)};
#define G192_STAGE(slot, t) do { \
        _Pragma("unroll") for (int _i = 0; _i < 3; ++_i) __builtin_amdgcn_global_load_lds((const unsigned*)(gA + (size_t)(t) * (BK * 2) + voffA[_i]), (LAS unsigned*)(lds + (slot) * SBYTES + ldsw + _i * 8192), 16, 0, 0); \
        _Pragma("unroll") for (int _i = 0; _i < 2; ++_i) __builtin_amdgcn_global_load_lds((const unsigned*)(gB + (size_t)(t) * (BK * 2) + voffB[_i]), (LAS unsigned*)(lds + (slot) * SBYTES + ABYTES + ldsw + _i * 8192), 16, 0, 0); } while (0)
#define G192_WAIT_V(n) asm volatile("s_waitcnt vmcnt(" #n ")" ::: "memory")
#define G192_WAIT_L(n) asm volatile("s_waitcnt lgkmcnt(" #n ")" ::: "memory")
    f32x4 acc[6][2], tot[6][2];
#pragma unroll
    for (int m = 0; m < 6; ++m)
#pragma unroll
        for (int n = 0; n < 2; ++n) { acc[m][n] = (f32x4){0.f, 0.f, 0.f, 0.f}; tot[m][n] = (f32x4){0.f, 0.f, 0.f, 0.f}; }
    G192_STAGE(0, 0); G192_STAGE(1, 1); G192_STAGE(2, 2);
    G192_WAIT_V(10); __builtin_amdgcn_s_barrier();
#pragma unroll 1
    for (int t = 0; t < nt; ++t) {
        const int slot = t & 3;
        if (t + 3 < nt) G192_STAGE((t + 3) & 3, t + 3);
        bf16x8 At[6][2], Bf[2][2];
        const LAS unsigned char* sb = lds + slot * SBYTES;
#pragma unroll
        for (int n = 0; n < 2; ++n)
#pragma unroll
            for (int k = 0; k < 2; ++k) Bf[n][k] = *(const LAS bf16x8*)(sb + boffk[k] + n * 2048);
#pragma unroll
        for (int m = 0; m < 6; ++m)
#pragma unroll
            for (int k = 0; k < 2; ++k) At[m][k] = *(const LAS bf16x8*)(sb + aoffk[k] + m * 2048);
        G192_WAIT_L(0);
        __builtin_amdgcn_s_setprio(1);
#pragma unroll
        for (int m = 0; m < 6; ++m)
#pragma unroll
            for (int n = 0; n < 2; ++n)
#pragma unroll
                for (int k = 0; k < 2; ++k) acc[m][n] = __builtin_amdgcn_mfma_f32_16x16x32_bf16(Bf[n][k], At[m][k], acc[m][n], 0, 0, 0);
        __builtin_amdgcn_s_setprio(0);
        if (Epi::BRANCH) { if (t == 7 || t == 11 || t == nt - 1) E.seg(acc, tot, t == 7 ? 0 : (t == 11 ? 1 : 2), pm, pn, wr, wc, fr, fq); }
        if (t + 3 < nt) G192_WAIT_V(10); else if (t + 2 < nt) G192_WAIT_V(5); else G192_WAIT_V(0);
        __builtin_amdgcn_s_barrier();
    }
    E(Epi::BRANCH ? tot : acc, pm, pn, wr, wc, fr, fq);
#undef G192_STAGE
#undef G192_WAIT_V
#undef G192_WAIT_L
}
}

struct EpiBranch192 {
    static constexpr bool BRANCH = true;
    const bf16_t* G; bf16_t* mb;
    __device__ __forceinline__ void seg(g192::Acc6& acc, g192::Acc6& tot, int kind, int pm, int pn, int wr, int wc, int fr, int fq) const {
        const int col = pn * 128 + wc * 32 + 8 * fq;
#pragma unroll
        for (int m = 0; m < 6; ++m) {
            const int row = pm * 192 + wr * 96 + m * 16 + fr;
            const u32x4 gw = *(const u32x4*)(G + (size_t)row * 3072 + kind * 1024 + col);
            f32x4 g0 = {bf_lo(gw.x), bf_hi(gw.x), bf_lo(gw.y), bf_hi(gw.y)}, g1 = {bf_lo(gw.z), bf_hi(gw.z), bf_lo(gw.w), bf_hi(gw.w)};
            tot[m][0] += g0 * acc[m][0]; tot[m][1] += g1 * acc[m][1];
            acc[m][0] = (f32x4){0.f, 0.f, 0.f, 0.f}; acc[m][1] = (f32x4){0.f, 0.f, 0.f, 0.f};
        }
    }
    __device__ __forceinline__ void operator()(const g192::Acc6& tot, int pm, int pn, int wr, int wc, int fr, int fq) const {
        const int col = pn * 128 + wc * 32 + 8 * fq;
#pragma unroll
        for (int m = 0; m < 6; ++m) { const int row = pm * 192 + wr * 96 + m * 16 + fr; *(u32x4*)(mb + (size_t)row * D + col) = pk8(tot[m][0], tot[m][1]); }
    }
};
struct EpiRes192 {
    static constexpr bool BRANCH = false;
    float* x; bf16_t* xg; const float* gate; const float* gsn; float* rssn;
    __device__ __forceinline__ void seg(g192::Acc6&, g192::Acc6&, int, int, int, int, int, int, int) const {}
    __device__ __forceinline__ void operator()(const g192::Acc6& acc, int pm, int pn, int wr, int wc, int fr, int fq) const {
        const int col = pn * 128 + wc * 32 + 8 * fq;
        f32x4 xv[6][2], gt[6][2], gs[6][2];
#pragma unroll
        for (int m = 0; m < 6; ++m) {
            const int row = pm * 192 + wr * 96 + m * 16 + fr;
            const int mr = row < MP ? 0 : 1 + ((row - MP) >> 10);
            const float* gp = gate + (size_t)mr * 6 * D + col; const float* sp = gsn + (size_t)mr * 6 * D + col; const float* xp = x + (size_t)row * D + col;
            xv[m][0] = *(const f32x4*)xp; xv[m][1] = *(const f32x4*)(xp + 4);
            gt[m][0] = *(const f32x4*)gp; gt[m][1] = *(const f32x4*)(gp + 4); gs[m][0] = *(const f32x4*)sp; gs[m][1] = *(const f32x4*)(sp + 4);
        }
#pragma unroll
        for (int m = 0; m < 6; ++m) {
            const int row = pm * 192 + wr * 96 + m * 16 + fr;
            float* xp = x + (size_t)row * D + col;
            const f32x4 x0 = xv[m][0] + gt[m][0] * acc[m][0], x1 = xv[m][1] + gt[m][1] * acc[m][1];
            *(f32x4*)xp = x0; *(f32x4*)(xp + 4) = x1;
            float ss = (x0[0] * x0[0] + x0[1] * x0[1]) + (x0[2] * x0[2] + x0[3] * x0[3]) + (x1[0] * x1[0] + x1[1] * x1[1]) + (x1[2] * x1[2] + x1[3] * x1[3]);
            *(u32x4*)(xg + (size_t)row * D + col) = pk8(x0 * gs[m][0], x1 * gs[m][1]);
            ss += __shfl_xor(ss, 16); ss += __shfl_xor(ss, 32);
            if (fq == 0) atomicAdd(rssn + row, ss);
        }
    }
};

struct AttnState { f32x16 o0, o1; float m, l; };
struct KVFrag { bf16x8 k[4], v[2][2]; };
__device__ __forceinline__ void attn_load(KVFrag& f, const bf16_t* kptr  , const bf16_t* vptr  , int vstride32  ) {
#pragma unroll
    for (int s = 0; s < 4; ++s) f.k[s] = *(const bf16x8*)(kptr + 16 * s);
#pragma unroll
    for (int dt = 0; dt < 2; ++dt)
#pragma unroll
        for (int ks = 0; ks < 2; ++ks) f.v[dt][ks] = *(const bf16x8*)(vptr + (size_t)dt * vstride32 + 16 * ks);
}
__device__ __forceinline__ void attn_tile(AttnState& st, const bf16x8 (&qf)[4], const KVFrag& f, bool local, const LAS float* rl, int cq, int cs, int ck0  ) {
    f32x16 s = {0.f, 0.f, 0.f, 0.f, 0.f, 0.f, 0.f, 0.f, 0.f, 0.f, 0.f, 0.f, 0.f, 0.f, 0.f, 0.f};
#pragma unroll
    for (int k = 0; k < 4; ++k) s = __builtin_amdgcn_mfma_f32_32x32x16_bf16(f.k[k], qf[k], s, 0, 0, 0);
    if (local) {
        const LAS float* rb = rl + (ck0 - cq + 15);
        const int d0 = ck0 - cs;
#pragma unroll
        for (int i = 0; i < 16; ++i) {
            const int o = (i & 3) + 8 * (i >> 2);
            const bool ok = (unsigned)(d0 + o) < 16u;
            s[i] = ok ? s[i] + rb[o] : -1e30f;
        }
    }
    float mx = fmaxf(fmaxf(s[0], s[1]), fmaxf(s[2], s[3]));
#pragma unroll
    for (int i = 4; i < 16; i += 4) mx = fmaxf(mx, fmaxf(fmaxf(s[i], s[i + 1]), fmaxf(s[i + 2], s[i + 3])));
    mx = fmaxf(mx, __shfl_xor(mx, 32));
    const float mo = st.m, mn = fmaxf(mo, mx);
    st.m = mn;
    float ls = 0.f;
#pragma unroll
    for (int i = 0; i < 16; ++i) { const float p = __builtin_amdgcn_exp2f(s[i] - mn); s[i] = p; ls += p; }
    if (__builtin_amdgcn_ballot_w64(mn > mo) != 0ull) {
        const float alpha = __builtin_amdgcn_exp2f(mo - mn);
        st.l *= alpha;
#pragma unroll
        for (int i = 0; i < 16; ++i) { st.o0[i] *= alpha; st.o1[i] *= alpha; }
    }
    st.l += ls;
    u32x4 w0, w1;
    w0.x = pk2(s[0], s[1]); w0.y = pk2(s[2], s[3]); w0.z = pk2(s[4], s[5]); w0.w = pk2(s[6], s[7]);
    w1.x = pk2(s[8], s[9]); w1.y = pk2(s[10], s[11]); w1.z = pk2(s[12], s[13]); w1.w = pk2(s[14], s[15]);
    const bf16x8 p0 = __builtin_bit_cast(bf16x8, w0), p1 = __builtin_bit_cast(bf16x8, w1);
    st.o0 = __builtin_amdgcn_mfma_f32_32x32x16_bf16(f.v[0][0], p0, st.o0, 0, 0, 0);
    st.o0 = __builtin_amdgcn_mfma_f32_32x32x16_bf16(f.v[0][1], p1, st.o0, 0, 0, 0);
    st.o1 = __builtin_amdgcn_mfma_f32_32x32x16_bf16(f.v[1][0], p0, st.o1, 0, 0, 0);
    st.o1 = __builtin_amdgcn_mfma_f32_32x32x16_bf16(f.v[1][1], p1, st.o1, 0, 0, 0);
}
__device__ __forceinline__ void attn_store(const AttnState& st, bf16_t* orow  , int hf) {
    const float lt = st.l + __shfl_xor(st.l, 32);
    const float inv = 1.0f / lt;
#pragma unroll
    for (int g = 0; g < 4; ++g) {
        u32x2 a, b;
        a.x = pk2(st.o0[4 * g] * inv, st.o0[4 * g + 1] * inv); a.y = pk2(st.o0[4 * g + 2] * inv, st.o0[4 * g + 3] * inv);
        b.x = pk2(st.o1[4 * g] * inv, st.o1[4 * g + 1] * inv); b.y = pk2(st.o1[4 * g + 2] * inv, st.o1[4 * g + 3] * inv);
        *(u32x2*)(orow + 8 * g + 4 * hf) = a;
        *(u32x2*)(orow + 32 + 8 * g + 4 * hf) = b;
    }
}
struct AttnPtrs { const bf16_t *Q, *K, *Vt, *Kc, *Vtc; bf16_t* Abr; };
constexpr int PA_K_BYTES = 256 * 128, PA_V_BYTES = 64 * 512;
struct StageRegs { u32x4 kv[4], vv[4]; };
__device__ __forceinline__ void attn_stage_load(StageRegs& R, const bf16_t* ksrc, const bf16_t* vsrc, int vld, int nkeys, int tid) {
    const int nch = nkeys * 8, sh = nkeys == 256 ? 5 : 3;
#pragma unroll
    for (int i = 0; i < 4; ++i) { int q = tid + 512 * i; q = q < nch ? q : nch - 1;
        R.kv[i] = *(const u32x4*)(ksrc + (size_t)(q >> 3) * NAW + 8 * (q & 7));
        R.vv[i] = *(const u32x4*)(vsrc + (size_t)(q >> sh) * vld + 8 * (q & ((1 << sh) - 1))); }
}
__device__ __forceinline__ void attn_stage_store(const StageRegs& R, int nkeys, LAS unsigned char* kl, LAS unsigned char* vl, int tid) {
    const int nch = nkeys * 8, sh = nkeys == 256 ? 5 : 3;
#pragma unroll
    for (int i = 0; i < 4; ++i) { const int q = tid + 512 * i; if (q < nch) {
        const int key = q >> 3, c = q & 7, d = q >> sh, cv = q & ((1 << sh) - 1);
        *(LAS u32x4*)(kl + key * 128 + ((c ^ (key & 7)) << 4)) = R.kv[i];
        *(LAS u32x4*)(vl + d * 512 + ((cv ^ (d & 15)) << 4)) = R.vv[i]; } }
}
__device__ __forceinline__ void attn_lds_frag(KVFrag& f, const LAS unsigned char* kl, const LAS unsigned char* vl, int kt, int r32, int hf) {
    const int key = 32 * kt + r32;
#pragma unroll
    for (int s = 0; s < 4; ++s) f.k[s] = *(const LAS bf16x8*)(kl + key * 128 + (((2 * s + hf) ^ (key & 7)) << 4));
#pragma unroll
    for (int dt = 0; dt < 2; ++dt)
#pragma unroll
        for (int ks = 0; ks < 2; ++ks) { const int d = 32 * dt + r32; f.v[dt][ks] = *(const LAS bf16x8*)(vl + d * 512 + (((4 * kt + 2 * ks + hf) ^ (d & 15)) << 4)); }
}
__device__ __forceinline__ void attn_prompt_lds(const AttnPtrs& P, const LAS unsigned char* kl, const LAS unsigned char* vl, int bh, int qt, int lane) {
    const int r32 = lane & 31, hf = lane >> 5, b = bh >> 3, h = bh & 7;
    const int qrow = b * 256 + qt * 32 + r32;
    bf16x8 qf[4];
#pragma unroll
    for (int s = 0; s < 4; ++s) qf[s] = *(const bf16x8*)(P.Q + (size_t)qrow * NAW + h * 64 + 16 * s + 8 * hf);
    AttnState st; st.m = -1e30f; st.l = 0.f;
#pragma unroll
    for (int i = 0; i < 16; ++i) { st.o0[i] = 0.f; st.o1[i] = 0.f; }
    KVFrag fa, fb;
    attn_lds_frag(fa, kl, vl, 0, r32, hf);
#pragma unroll 1
    for (int t = 0; t < 8; t += 2) {
        attn_lds_frag(fb, kl, vl, t + 1, r32, hf);
        attn_tile(st, qf, fa, false, nullptr, 0, 0, 0);
        if (t + 2 < 8) attn_lds_frag(fa, kl, vl, t + 2, r32, hf);
        attn_tile(st, qf, fb, false, nullptr, 0, 0, 0);
    }
    attn_store(st, P.Abr + (size_t)qrow * D + h * 64, hf);
}
constexpr int ATT_PART_FLOATS = 34 * 64;
__device__ __forceinline__ void attn_sample_block(const AttnPtrs& P, LAS unsigned char* kl, LAS unsigned char* vl, const LAS float* rpl, LAS float* parts, int blk, int wave, int lane) {
    const int r32 = lane & 31, hf = lane >> 5, tid = wave * 64 + lane;
    const int bs = blk >> 6, h = (blk >> 3) & 7, i2 = (blk & 7) * 2;
    const int u = wave >> 1, half = wave & 1, r = i2 + (u >> 1), qh = u & 1;
    const int qrow = MP + bs * 1024 + r * 64 + qh * 32 + r32;
    const int cq = qh * 32 + r32; int cs = cq - 8; cs = cs < 0 ? 0 : (cs > 48 ? 48 : cs);
    int rs = r - 4; rs = rs < 0 ? 0 : (rs > 8 ? 8 : rs);
    int rs0 = i2 - 4; rs0 = rs0 < 0 ? 0 : (rs0 > 8 ? 8 : rs0);
    int rs1 = i2 - 3; rs1 = rs1 < 0 ? 0 : (rs1 > 8 ? 8 : rs1);
    const int nstage = rs1 != rs0 ? 4 : 3;
    const bf16_t* kloc = P.K + (size_t)(MP + bs * 1024) * NAW + h * 64;
    const bf16_t* vloc = P.Vt + VT_SAMPLE_OFF + (size_t)((bs * 8 + h) * 64) * 1024;
    bf16x8 qf[4];
#pragma unroll
    for (int s = 0; s < 4; ++s) qf[s] = *(const bf16x8*)(P.Q + (size_t)qrow * NAW + h * 64 + 16 * s + 8 * hf);
    AttnState st; st.m = -1e30f; st.l = 0.f;
#pragma unroll
    for (int i = 0; i < 16; ++i) { st.o0[i] = 0.f; st.o1[i] = 0.f; }
    LAS float* part = parts + u * ATT_PART_FLOATS;
    StageRegs R;
    attn_stage_load(R, P.Kc + (size_t)(bs * 256) * NAW + h * 64, P.Vtc + (size_t)((bs * 8 + h) * 64) * 256, 256, 256, tid);
#pragma unroll 1
    for (int sg = 0; sg < nstage; ++sg) {
        if (sg) __syncthreads();
        const int row0 = rs0 + 4 * (sg - 1);
        attn_stage_store(R, sg == 3 ? 64 : 256, kl, vl, tid);
        { const int sn = sg + 1 < nstage ? sg + 1 : 1, rown = rs0 + 4 * (sn - 1);
          attn_stage_load(R, kloc + (size_t)(rown * 64) * NAW, vloc + rown * 64, 1024, sn == 3 ? 64 : 256, tid); }
        LDS_WAIT(); __syncthreads();
        KVFrag f;
        if (sg == 0) {
#pragma unroll 1
            for (int kt = 4 * half; kt < 4 * half + 4; ++kt) { attn_lds_frag(f, kl, vl, kt, r32, hf); attn_tile(st, qf, f, false, nullptr, 0, 0, 0); }
        } else {
            const int nt = sg == 3 ? 2 : 8;
#pragma unroll 1
            for (int kt = half * (nt >> 1); kt < (half + 1) * (nt >> 1); ++kt) {
                const int jr = row0 + (kt >> 1), ch = kt & 1;
                if (jr < rs || jr >= rs + 8) continue;
                attn_lds_frag(f, kl, vl, kt, r32, hf);
                attn_tile(st, qf, f, true, rpl + (h * 15 + (jr - r + 7)) * 31, cq, cs, ch * 32 + 4 * hf);
            }
        }
    }
    if (half == 1) {
#pragma unroll
        for (int i = 0; i < 16; ++i) { part[i * 64 + lane] = st.o0[i]; part[(16 + i) * 64 + lane] = st.o1[i]; }
        part[32 * 64 + lane] = st.m; part[33 * 64 + lane] = st.l;
    }
    LDS_WAIT(); __syncthreads();
    if (half == 0) {
        const float m1 = part[32 * 64 + lane], l1 = part[33 * 64 + lane];
        const float mn = fmaxf(st.m, m1), a0 = __builtin_amdgcn_exp2f(st.m - mn), a1 = __builtin_amdgcn_exp2f(m1 - mn);
        st.l = st.l * a0 + l1 * a1;
#pragma unroll
        for (int i = 0; i < 16; ++i) { st.o0[i] = st.o0[i] * a0 + part[i * 64 + lane] * a1; st.o1[i] = st.o1[i] * a0 + part[(16 + i) * 64 + lane] * a1; }
        attn_store(st, P.Abr + (size_t)qrow * D + h * 64, hf);
    }
}

struct PcPtrs { const bf16_t *Pin, *Cin; const float *wdw, *bdw, *cng, *cnb; bf16_t* Abr; };
__device__ __forceinline__ f32x4 ld_bf4(const bf16_t* p) { const u32x2 w = *(const u32x2*)p; return (f32x4){bf_lo(w.x), bf_hi(w.x), bf_lo(w.y), bf_hi(w.y)}; }
__device__ __forceinline__ f32x4 up_bf4(u32x2 w) { return (f32x4){bf_lo(w.x), bf_hi(w.x), bf_lo(w.y), bf_hi(w.y)}; }
__device__ __forceinline__ void pool_unit(const PcPtrs& P, int unit, int lane) {
    const int row0 = unit * 8;
    const int L = row0 < MP ? 256 : 1024;
    const int sb = row0 < MP ? (row0 & ~255) : MP + ((row0 - MP) & ~1023);
    const int hw = 1 << (lane >> 4);
    const int t0 = row0 - sb;
    u32x2 pv[24];
#pragma unroll
    for (int i = 0; i < 24; ++i) { int t = t0 - 8 + i; t = t < 0 ? 0 : (t > L - 1 ? L - 1 : t); pv[i] = *(const u32x2*)(P.Pin + (size_t)(sb + t) * PW + 4 * lane); }
#pragma unroll
    for (int tt = 0; tt < 8; ++tt) {
        f32x4 sum = {0.f, 0.f, 0.f, 0.f}; float cnt = 0.f;
#pragma unroll
        for (int o = -8; o < 8; ++o) {
            const int t = t0 + tt + o;
            const bool in = (o >= -hw) && (o < hw) && (t >= 0) && (t < L);
            const f32x4 v = up_bf4(pv[tt + o + 8]);
            sum += in ? v : (f32x4){0.f, 0.f, 0.f, 0.f}; cnt += in ? 1.f : 0.f;
        }
        const f32x4 r = sum * __builtin_amdgcn_rcpf(cnt) - up_bf4(pv[tt + 8]);
        u32x2 w; w.x = pk2(r[0], r[1]); w.y = pk2(r[2], r[3]);
        *(u32x2*)(P.Abr + (size_t)(row0 + tt) * D + 512 + 4 * lane) = w;
    }
}
__device__ __forceinline__ void conv_unit(const PcPtrs& P, const LAS float* wl, int unit, int lane) {
    constexpr int T = 8;
    const int row0 = unit * T;
    const int L = row0 < MP ? 256 : 1024;
    const int sb = row0 < MP ? (row0 & ~255) : MP + ((row0 - MP) & ~1023);
    const int t0 = row0 - sb;
    f32x4 acc[T];
    const f32x4 bias = *(const f32x4*)(P.bdw + 4 * lane);
#pragma unroll
    for (int tt = 0; tt < T; ++tt) acc[tt] = bias;
#pragma unroll 1
    for (int c = 0; c < 2; ++c) {
        u32x2 ar[20], gr[20];
#pragma unroll
        for (int i = 0; i < 20; ++i) {
            const int t = t0 - 15 + 20 * c + i;
            const bool ok = (t >= 0) && (t < L);
            const bf16_t* p = P.Cin + (size_t)(sb + (ok ? t : 0)) * 512 + 4 * lane;
            ar[i] = *(const u32x2*)p; gr[i] = *(const u32x2*)(p + 256);
            if (!ok) { ar[i] = (u32x2){0u, 0u}; }
        }
#pragma unroll
        for (int g4 = 0; g4 < 5; ++g4) {
            const int s0 = 20 * c + 4 * g4;
            f32x4 tp[11];
#pragma unroll
            for (int q = 0; q < 11; ++q) tp[q] = *(const LAS f32x4*)(wl + (s0 + q) * CW + 4 * lane);
#pragma unroll
            for (int i = 0; i < 4; ++i) {
                const f32x4 a = up_bf4(ar[4 * g4 + i]), g = up_bf4(gr[4 * g4 + i]);
                f32x4 hh;
#pragma unroll
                for (int e = 0; e < 4; ++e) hh[e] = a[e] * sigmoidf_(g[e]);
#pragma unroll
                for (int tt = 0; tt < T; ++tt) acc[tt] += hh * tp[i - tt + 7];
            }
            asm volatile("" ::: "memory");
        }
    }
    const f32x4 lg = *(const f32x4*)(P.cng + 4 * lane), lb = *(const f32x4*)(P.cnb + 4 * lane);
    float s1[T], s2[T];
#pragma unroll
    for (int tt = 0; tt < T; ++tt) s1[tt] = (acc[tt][0] + acc[tt][1]) + (acc[tt][2] + acc[tt][3]);
#pragma unroll
    for (int o = 1; o < 64; o <<= 1)
#pragma unroll
        for (int tt = 0; tt < T; ++tt) s1[tt] += __shfl_xor(s1[tt], o);
#pragma unroll
    for (int tt = 0; tt < T; ++tt) { const float mu = s1[tt] * (1.0f / CW); acc[tt] = acc[tt] - mu; s2[tt] = (acc[tt][0] * acc[tt][0] + acc[tt][1] * acc[tt][1]) + (acc[tt][2] * acc[tt][2] + acc[tt][3] * acc[tt][3]); }
#pragma unroll
    for (int o = 1; o < 64; o <<= 1)
#pragma unroll
        for (int tt = 0; tt < T; ++tt) s2[tt] += __shfl_xor(s2[tt], o);
#pragma unroll
    for (int tt = 0; tt < T; ++tt) {
        const float rstd = 1.0f / sqrtf(s2[tt] * (1.0f / CW) + EPS);
        f32x4 y = acc[tt] * rstd * lg + lb;
#pragma unroll
        for (int e = 0; e < 4; ++e) y[e] = y[e] * sigmoidf_(y[e]);
        u32x2 o; o.x = pk2(y[0], y[1]); o.y = pk2(y[2], y[3]);
        *(u32x2*)(P.Abr + (size_t)(row0 + tt) * D + 768 + 4 * lane) = o;
    }
}

#define XB_TMO      128
#define XB_XCNT(j)  (256  + 64 * (j))
#define XB_XSUB(j)  (1280 + 64 * (j))
#define XB_XGEN(j)  (2304 + 64 * (j))
#define XB_TOP      3328
#define XB_TOPGEN   3392
#define XB_LCNT(j)  (3456 + 64 * (j))
#define XB_MISMATCH 4480
#define XB_CONV     4544
#define XCD_BAR_WORDS 4608
#define XB_SPIN_CAP (1u << 18)
__device__ __forceinline__ unsigned xb_ld(unsigned* p)              { return __hip_atomic_load(p, __ATOMIC_RELAXED, __HIP_MEMORY_SCOPE_AGENT); }
__device__ __forceinline__ unsigned xb_add(unsigned* p, unsigned v) { return __hip_atomic_fetch_add(p, v, __ATOMIC_RELAXED, __HIP_MEMORY_SCOPE_AGENT); }
__device__ __forceinline__ unsigned xb_poll_rmw(unsigned* p) { unsigned r, z = 0u; asm volatile("global_atomic_add %0, %1, %2, off sc0\n\ts_waitcnt vmcnt(0)" : "=v"(r) : "v"(p), "v"(z) : "memory"); return r; }
__device__ __forceinline__ unsigned xb_xcc_id() { return (unsigned)__builtin_amdgcn_s_getreg((3 << 11) | 20) & 0xFu; }
#define XB_SPIN(cond, bar) do { unsigned _sp = 0; while (cond) { __builtin_amdgcn_s_sleep(1); \
    if ((++_sp & 255u) == 0u) { if (xb_ld(&(bar)[XB_TMO])) break; if (_sp > XB_SPIN_CAP) { atomicAdd(&(bar)[XB_TMO], 1u); break; } } } } while (0)
struct XcdBarrier { unsigned* bar; unsigned x; unsigned nloc, nx; };
#define XB_LOCAL_OK 0x80000000u
__device__ __forceinline__ XcdBarrier xcd_barrier_post(unsigned* bar) {
    XcdBarrier b; b.bar = bar; b.x = xb_xcc_id(); b.nloc = 0u; b.nx = 0u;
    asm volatile("" : "+s"(b.x));
    if (threadIdx.x == 0) {
        if (b.x != (blockIdx.x & 7u) || gridDim.x != 256u) { (void)xb_add(&bar[XB_MISMATCH], 1u); asm volatile("s_waitcnt vmcnt(0)" ::: "memory"); }
        (void)xb_add(&bar[XB_XCNT(b.x)], 1u);
    }
    return b;
}
__device__ __forceinline__ void xcd_barrier_complete(unsigned* bar, unsigned x, unsigned& nloc, unsigned& nx) {
    asm volatile("" : "+s"(bar));
    const unsigned G = gridDim.x * gridDim.y * gridDim.z;
    unsigned sum, cnt, mine, sp = 0u;
    for (;;) {
        sum = 0u; cnt = 0u; mine = 0u;
#pragma unroll
        for (unsigned j = 0; j < 16; ++j) { const unsigned c = xb_ld(&bar[XB_XCNT(j)]); sum += c; cnt += (c > 0u) ? 1u : 0u; mine = (j == x) ? c : mine; }
        if (sum == G) break;
        __builtin_amdgcn_s_sleep(1);
        if ((++sp & 255u) == 0u) { if (xb_ld(&bar[XB_TMO])) break; if (sp > XB_SPIN_CAP) { atomicAdd(&bar[XB_TMO], 1u); break; } }
    }
    nloc = mine > 0u ? mine : 1u; nx = cnt > 0u ? cnt : 1u;
}
__device__ __forceinline__ void xcd_barrier_t0(XcdBarrier& b) {
    {
        unsigned* bar = b.bar; asm volatile("" : "+s"(bar));
        unsigned bx_ = b.x; asm volatile("" : "+s"(bx_));
        __builtin_amdgcn_s_waitcnt(0);
        unsigned nloc = b.nloc, nx = b.nx;
        if (nloc == 0u) { xcd_barrier_complete(bar, bx_, nloc, nx); b.nloc = nloc; b.nx = nx | ((nloc == 32u && xb_ld(&bar[XB_MISMATCH]) == 0u) ? XB_LOCAL_OK : 0u); }
        nx &= ~XB_LOCAL_OK;
        const unsigned old = xb_add(&bar[XB_XSUB(bx_)], 1u);
        const unsigned gen = old / nloc;
        if (old + 1u == (gen + 1u) * nloc) {
            __builtin_amdgcn_fence(__ATOMIC_RELEASE, "agent");
            asm volatile("s_waitcnt vmcnt(0)" ::: "memory");
            const unsigned og = xb_add(&bar[XB_TOP], 1u);
            const unsigned tg = og / nx;
            if (og + 1u == (tg + 1u) * nx) xb_add(&bar[XB_TOPGEN], 1u);
            else XB_SPIN(xb_ld(&bar[XB_TOPGEN]) == tg, bar);
            __builtin_amdgcn_fence(__ATOMIC_ACQUIRE, "agent");
            xb_add(&bar[XB_XGEN(bx_)], 1u);
            asm volatile("s_waitcnt vmcnt(0)" ::: "memory");
        } else {
            XB_SPIN(xb_ld(&bar[XB_XGEN(bx_)]) == gen, bar);
            __builtin_amdgcn_fence(__ATOMIC_ACQUIRE, "agent");
            asm volatile("s_waitcnt vmcnt(0)" ::: "memory");
        }
    }
}
__device__ __forceinline__ void xcd_barrier(XcdBarrier& b) {
    asm volatile("s_waitcnt vmcnt(0)" ::: "memory");
    __syncthreads();
    if (threadIdx.x == 0) xcd_barrier_t0(b);
    b.nloc = __builtin_amdgcn_readfirstlane(b.nloc); b.nx = __builtin_amdgcn_readfirstlane(b.nx);
    __syncthreads();
}
__device__ __forceinline__ void xcd_local_barrier(XcdBarrier& b, unsigned k  , unsigned conv_need = 0u  ) {
    asm volatile("s_waitcnt vmcnt(0)" ::: "memory");
    __syncthreads();
    if (threadIdx.x == 0) {
        if (b.nx & XB_LOCAL_OK) {
            __builtin_amdgcn_s_waitcnt(0);
            unsigned* lb = b.bar; asm volatile("" : "+s"(lb));
            unsigned lx = b.x; asm volatile("" : "+s"(lx));
            unsigned* c = &lb[XB_LCNT(lx)];
            const unsigned target = k * 32u;
            (void)xb_add(c, 1u);
            XB_SPIN(xb_poll_rmw(c) < target, lb);
            if (conv_need) XB_SPIN(xb_ld(&lb[XB_CONV]) < conv_need, lb);
            __builtin_amdgcn_fence(__ATOMIC_ACQUIRE, "agent");
            asm volatile("s_waitcnt vmcnt(0)" ::: "memory");
        } else xcd_barrier_t0(b);
    }
    b.nloc = __builtin_amdgcn_readfirstlane(b.nloc); b.nx = __builtin_amdgcn_readfirstlane(b.nx);
    __syncthreads();
}

constexpr int TP_PITCH = 65, TP_BYTES = 64 * TP_PITCH * 4;
__device__ __forceinline__ void st16_wt(void* p, u32x4 v) { asm volatile("global_store_dwordx4 %0, %1, off sc1\n\ts_nop 1" :: "v"(p), "v"(v) : "memory"); }
template <bool WITH_C, bool GU_PERM, bool WT = false>
__device__ __forceinline__ void transpose_item(const float* W, int N, bf16_t* WTp, int ldt, int kcol0, LAS float* scr, int item, int lane,
                                               const float* shraw  , const float* shb  , float* csum  ) {
    const int nblk = N / 64, kb = item / nblk, nb = item % nblk, k0 = 64 * kb, n0 = 64 * nb;
    {
        const int r4 = lane >> 4, c4 = lane & 15;
        f32x4 v[16];
#pragma unroll
        for (int i = 0; i < 16; ++i) v[i] = __builtin_nontemporal_load((const f32x4*)(W + (size_t)(k0 + 4 * i + r4) * N + n0 + 4 * c4));
#pragma unroll
        for (int i = 0; i < 16; ++i) { LAS float* p = scr + (4 * i + r4) * TP_PITCH + 4 * c4; p[0] = v[i][0]; p[1] = v[i][1]; p[2] = v[i][2]; p[3] = v[i][3]; }
    }
    const int c = lane & 7, nn = lane >> 3;
    f32x4 sh[3][2];
    if (WITH_C) {
#pragma unroll
        for (int r = 0; r < 3; ++r)
#pragma unroll
            for (int h = 0; h < 2; ++h) sh[r][h] = *(const f32x4*)(shraw + (size_t)r * NMOD + k0 + 8 * c + 4 * h) + *(const f32x4*)(shb + k0 + 8 * c + 4 * h);
    }
    LDS_WAIT(); asm volatile("" ::: "memory");
#pragma unroll
    for (int j = 0; j < 8; ++j) {
        const int n = 8 * j + nn; const LAS float* s = scr + (8 * c) * TP_PITCH + n;
        float w[8];
#pragma unroll
        for (int q = 0; q < 8; ++q) w[q] = s[q * TP_PITCH];
        u32x4 o; o.x = pk2(w[0], w[1]); o.y = pk2(w[2], w[3]); o.z = pk2(w[4], w[5]); o.w = pk2(w[6], w[7]);
        int nrow = n0 + n;
        if (GU_PERM) nrow = nrow < FFN ? ((nrow >> 7) * 256 + (nrow & 127)) : (((nrow - FFN) >> 7) * 256 + 128 + ((nrow - FFN) & 127));
        if (WT) st16_wt(WTp + (size_t)nrow * ldt + kcol0 + k0 + 8 * c, o); else *(u32x4*)(WTp + (size_t)nrow * ldt + kcol0 + k0 + 8 * c) = o;
        if (WITH_C) {
            float d0 = 0.f, d1 = 0.f, d2 = 0.f;
#pragma unroll
            for (int q = 0; q < 8; ++q) { d0 += sh[0][q >> 2][q & 3] * w[q]; d1 += sh[1][q >> 2][q & 3] * w[q]; d2 += sh[2][q >> 2][q & 3] * w[q]; }
#pragma unroll
            for (int x = 1; x < 8; x <<= 1) { d0 += __shfl_xor(d0, x); d1 += __shfl_xor(d1, x); d2 += __shfl_xor(d2, x); }
            if (c == 0) { atomicAdd(csum + n0 + n, d0); atomicAdd(csum + N + n0 + n, d1); atomicAdd(csum + 2 * N + n0 + n, d2); }
        }
    }
    LDS_WAIT(); asm volatile("" ::: "memory");
}

constexpr int NWAVES = 8;
constexpr int I_IN = 16 * (NIN / 64), I_GU = 16 * (NGU / 64), I_DN = (FFN / 64) * 16, I_OUT = 16 * 16, I_OA = 8 * 16, I_OC = 4 * 16;
constexpr int I_LAYER = I_IN + I_GU + I_DN + I_OUT + I_OA + I_OC;
#ifndef MK_TAIL
#define MK_TAIL I_LAYER
#endif
constexpr int I_TAIL = MK_TAIL, I_HEAD = I_LAYER - I_TAIL;
constexpr int I_MIX = (I_TAIL >= 512) ? 384 : 0;
#ifndef MK_BG1
#define MK_BG1 1536
#endif
constexpr int I_BG1 = MK_BG1;
static_assert(I_HEAD + I_BG1 <= I_LAYER - I_MIX, "background split");
static_assert(I_HEAD == 0 && I_IN <= I_BG1, "every w_in item of the next layer belongs to the 24 converter workgroups (their tickets gate the XCD-local seam before the next in-projection)");
#define TRANSPOSE_LAYER_ITEM(l_, r0_, scr_, lane_) do { const int tl_ = (l_); int tr_ = (r0_); \
        const float* shraw1_ = MODRAW + (size_t)(tl_ * 3) * NMOD; const float* shraw2_ = MODRAW + (size_t)(tl_ * 3) * NMOD + 3 * D; \
        if (tr_ < I_IN) { transpose_item<true, false, true>(w_in + (size_t)tl_ * D * NIN, NIN, WIN + (size_t)tl_ * NIN * D, D, 0, scr_, tr_, lane_, shraw1_, b_mod + (size_t)tl_ * NMOD, C1 + (size_t)(tl_ * 3) * NIN); break; } tr_ -= I_IN; \
        if (tr_ < I_GU) { transpose_item<true, true>(w_gu + (size_t)tl_ * D * NGU, NGU, WGU + (size_t)tl_ * NGU * D, D, 0, scr_, tr_, lane_, shraw2_, b_mod + (size_t)tl_ * NMOD + 3 * D, C2 + (size_t)(tl_ * 3) * NGU); break; } tr_ -= I_GU; \
        if (tr_ < I_DN) { transpose_item<false, false>(w_down + (size_t)tl_ * FFN * D, D, WDN + (size_t)tl_ * D * FFN, FFN, 0, scr_, tr_, lane_, nullptr, nullptr, nullptr); break; } tr_ -= I_DN; \
        if (tr_ < I_OUT) { transpose_item<false, false>(w_out + (size_t)tl_ * D * D, D, WOUT + (size_t)tl_ * D * D, D, 0, scr_, tr_, lane_, nullptr, nullptr, nullptr); break; } tr_ -= I_OUT; \
        if (tr_ < I_OA) { transpose_item<false, false>(w_oa + (size_t)tl_ * NAW * D, D, WBR + (size_t)tl_ * D * D, D, 0, scr_, tr_, lane_, nullptr, nullptr, nullptr); break; } tr_ -= I_OA; \
        transpose_item<false, false>(w_oc + (size_t)tl_ * CW * D, D, WBR + (size_t)tl_ * D * D, D, 768, scr_, tr_, lane_, nullptr, nullptr, nullptr); } while (0)
constexpr int LDS_BYTES = 163840;
static_assert(8 * TP_BYTES <= LDS_BYTES, "LDS map");
constexpr int NPHASE = 2 + 6 * DEPTH + 1;

struct Args {
    const float* in[26]; float* out; unsigned char* ws; int ph_lo, ph_hi;
};

__global__ void __launch_bounds__(NWAVES * 64, 2) fwd_kernel(Args args) {
    extern __shared__ __attribute__((aligned(16))) unsigned char lds_raw[];
    LAS unsigned char* lds = (LAS unsigned char*)lds_raw;
    const int tid = threadIdx.x, lane = tid & 63, wave = __builtin_amdgcn_readfirstlane(tid >> 6);
    const int G = gridDim.x, bx = blockIdx.x;
    const int vcu = (G % 8 == 0) ? (bx % 8) * (G / 8) + bx / 8 : bx;
    const int gw = vcu * NWAVES + wave, NGW = G * NWAVES;
    typedef const Args __attribute__((address_space(4))) * ArgsP;
    ArgsP KAP = (ArgsP)__builtin_amdgcn_kernarg_segment_ptr();
#define PHASE_PTRS() asm volatile("" : "+s"(KAP))
#define WSB (KAP->ws)
#define ctlf ((float*)(WSB + WS_CTL))
#define x_prompt (KAP->in[0])
#define x_sample (KAP->in[1])
#define cache_k (KAP->in[2])
#define cache_v (KAP->in[3])
#define cvec (KAP->in[4])
#define c_ctx (KAP->in[5])
#define w_mod (KAP->in[6])
#define b_mod (KAP->in[7])
#define norm1_g (KAP->in[8])
#define norm2_g (KAP->in[9])
#define w_in (KAP->in[10])
#define b_gate (KAP->in[11])
#define rpb (KAP->in[12])
#define w_oa (KAP->in[13])
#define w_pool (KAP->in[14])
#define pool_scale (KAP->in[15])
#define w_ob (KAP->in[16])
#define w_dw (KAP->in[17])
#define b_dw (KAP->in[18])
#define conv_norm_g (KAP->in[19])
#define conv_norm_b (KAP->in[20])
#define w_oc (KAP->in[21])
#define w_out (KAP->in[22])
#define w_gu (KAP->in[23])
#define w_down (KAP->in[24])
#define final_g (KAP->in[25])
#define MODRAW (ctlf + CF_MODRAW)
#define C1 (ctlf + CF_C1)
#define C2 (ctlf + CF_C2)
#define RSS (ctlf + CF_RSS)
#define MODT ((float*)(WSB + WS_MODT))
#define WIN ((bf16_t*)(WSB + WS_WIN))
#define WGU ((bf16_t*)(WSB + WS_WGU))
#define WDN ((bf16_t*)(WSB + WS_WDN))
#define WBR ((bf16_t*)(WSB + WS_WBR))
#define WOUT ((bf16_t*)(WSB + WS_WOUT))
#define X ((float*)(WSB + WS_X))
#define XG ((bf16_t*)(WSB + WS_XG))
#define Qb ((bf16_t*)(WSB + WS_Q))
#define Kb ((bf16_t*)(WSB + WS_K))
#define VT ((bf16_t*)(WSB + WS_VT))
#define KC ((bf16_t*)(WSB + WS_KC))
#define VTC ((bf16_t*)(WSB + WS_VTC))
#define PIN ((bf16_t*)(WSB + WS_PIN))
#define CIN ((bf16_t*)(WSB + WS_CIN))
#define GT ((bf16_t*)(WSB + WS_G))
#define ABR ((bf16_t*)(WSB + WS_ABR))
#define MF ((float*)(WSB + WS_MF))
#define MB ((bf16_t*)(WSB + WS_MB))
#define ACT ((bf16_t*)(WSB + WS_ACT))

#if !MK_PER_PHASE
    XcdBarrier bar = xcd_barrier_post((unsigned*)(args.ws + WS_CTL) + CW_BAR);
#define GRID_BAR() xcd_barrier(bar)
#define LOCAL_BAR(k, cn) xcd_local_barrier(bar, (unsigned)(k), (unsigned)(cn))
#else
#define GRID_BAR() do {} while (0)
#define LOCAL_BAR(k, cn) do {} while (0)
#endif
    const int lo = args.ph_lo, hi = args.ph_hi;
#define IN(k) (lo <= (k) && (k) < hi)
#define SEAM(k) do { if (IN(k) && IN((k) + 1)) GRID_BAR(); } while (0)
#define SEAML(k, n, cn) do { if (IN(k) && IN((k) + 1)) LOCAL_BAR(n, cn); } while (0)

    for (int rep_ = 0; rep_ < MK_REPS(4); ++rep_) { if (rep_) GRID_BAR();
    float* MODRAW_W = rep_ ? MF : MODRAW; float* C1_W = rep_ ? MF + DEPTH * 3 * NMOD : C1; float* C2_W = rep_ ? MF + DEPTH * 3 * (NMOD + NIN) : C2;
    if (IN(0)) { PHASE_PTRS();
        LAS float* sil = (LAS float*)lds; LAS float* red = (LAS float*)(lds + 16384);
        for (int i = tid; i < 3 * D; i += NWAVES * 64) { const float s = i < D ? c_ctx[i] : cvec[i - D]; sil[i] = s * sigmoidf_(s); }
        __syncthreads();
        for (int it = vcu; it < DEPTH * 24 * 8; it += G) {
            const int l = it / 192, rem = it % 192, nc = rem >> 3, kq = rem & 7, k0 = kq * 128 + wave * 16, n0 = nc * 256 + 4 * lane;
            const float* wp = w_mod + ((size_t)l * D + k0) * NMOD + n0;
            f32x4 w[16];
#pragma unroll
            for (int kk = 0; kk < 16; ++kk) w[kk] = __builtin_nontemporal_load((const f32x4*)(wp + (size_t)kk * NMOD));
            f32x4 a0 = {0.f, 0.f, 0.f, 0.f}, a1 = a0, a2 = a0;
#pragma unroll
            for (int kk = 0; kk < 16; ++kk) { a0 += sil[k0 + kk] * w[kk]; a1 += sil[D + k0 + kk] * w[kk]; a2 += sil[2 * D + k0 + kk] * w[kk]; }
#pragma unroll
            for (int e = 0; e < 4; ++e) { red[(wave * 12 + e) * 64 + lane] = a0[e]; red[(wave * 12 + 4 + e) * 64 + lane] = a1[e]; red[(wave * 12 + 8 + e) * 64 + lane] = a2[e]; }
            __syncthreads();
            for (int o = tid; o < 12 * 64; o += NWAVES * 64) {
                float s = 0.f;
#pragma unroll
                for (int ww = 0; ww < 8; ++ww) s += red[ww * 768 + o];
                const int q = o >> 6, ln = o & 63, r = q >> 2, e = q & 3;
                atomicAdd(MODRAW_W + (size_t)(l * 3 + r) * NMOD + nc * 256 + 4 * ln + e, s);
            }
            __syncthreads();
        }
    }
    SEAM(0);

    if (IN(1)) { PHASE_PTRS();
        LAS float* scr = (LAS float*)(lds + wave * TP_BYTES);
        constexpr int I_T = I_LAYER + (DEPTH - 1) * I_HEAD;
        constexpr int I_OB = DEPTH * 16 * 4 * 8;
        constexpr int I_X = M;
        constexpr int I_KC = DEPTH * 2 * 256;
        constexpr int I_VC = DEPTH * 2 * 8 * 4;
        constexpr int I_MT = DEPTH * 3 * 6 * 4;
        constexpr int I_ALL = I_T + I_OB + I_X + I_KC + I_VC + I_MT;
        for (int it0 = gw; it0 < I_ALL; it0 += NGW) {
            int it = it0;
            if (it < I_T) {
                if (it < I_LAYER) TRANSPOSE_LAYER_ITEM(0, it, scr, lane);
                else if constexpr (I_HEAD > 0) { const int q = it - I_LAYER; TRANSPOSE_LAYER_ITEM(1 + q / I_HEAD, q % I_HEAD, scr, lane); }
                continue;
            }
            it -= I_T;
            if (it < I_OB) {
                const int l = it / 512, rem = it % 512, nch = rem >> 5, g = (rem >> 3) & 3, cc = rem & 7, n = nch * 64 + lane;
                float a[8];
#pragma unroll
                for (int c = 0; c < 8; ++c) a[c] = 0.f;
                const float* wp = w_pool + ((size_t)(l * 4 + g) * 64 + cc * 8) * 64;
                for (int d = 0; d < 64; ++d) {
                    const float wb = w_ob[((size_t)l * PW + g * 64 + d) * D + n] * pool_scale[l * PW + g * 64 + d];
#pragma unroll
                    for (int c = 0; c < 8; ++c) a[c] += wp[c * 64 + d] * wb;
                }
                u32x4 o; o.x = pk2(a[0], a[1]); o.y = pk2(a[2], a[3]); o.z = pk2(a[4], a[5]); o.w = pk2(a[6], a[7]);
                *(u32x4*)(WBR + ((size_t)l * D + n) * D + 512 + g * 64 + cc * 8) = o;
                continue;
            }
            it -= I_OB;
            if (it < I_X) {
                const int row = it, mr = row < MP ? 0 : 1 + ((row - MP) >> 10);
                const float* xr = row < MP ? x_prompt + (size_t)row * D : x_sample + (size_t)(row - MP) * D;
                float ss = 0.f;
#pragma unroll
                for (int j = 0; j < 4; ++j) {
                    const int col = 256 * j + 4 * lane;
                    const f32x4 v = *(const f32x4*)(xr + col);
                    *(f32x4*)(X + (size_t)row * D + col) = v;
                    ss += (v[0] * v[0] + v[1] * v[1]) + (v[2] * v[2] + v[3] * v[3]);
                    const f32x4 sc = *(const f32x4*)(MODRAW + (size_t)mr * NMOD + D + col) + *(const f32x4*)(b_mod + D + col);
                    const f32x4 gg = *(const f32x4*)(norm1_g + col) * (sc + 1.0f);
                    const f32x4 xs = v * gg;
                    u32x2 o; o.x = pk2(xs[0], xs[1]); o.y = pk2(xs[2], xs[3]);
                    *(u32x2*)(XG + (size_t)row * D + col) = o;
                }
                ss = wave_sum(ss);
                if (lane == 0) RSS[row] = ss;
                continue;
            }
            it -= I_X;
            if (it < I_KC) {
                const int l = it / 512, bs = (it >> 8) & 1, key = it & 255;
                const float* src = cache_k + (((size_t)(bs * DEPTH + l) * 256 + key) * 512) + 8 * lane;
                const f32x4 a = *(const f32x4*)src, b = *(const f32x4*)(src + 4);
                *(u32x4*)(KC + (((size_t)(l * 2 + bs) * 256 + key) * 512) + 8 * lane) = pk8(a, b);
                continue;
            }
            it -= I_KC;
            if (it < I_VC) {
                const int l = it / 64, bs = (it >> 5) & 1, h = (it >> 2) & 7, kb = it & 3, key = kb * 64 + lane;
                const float* src = cache_v + (((size_t)(bs * DEPTH + l) * 256 + key) * 512) + h * 64;
                bf16_t* dst = VTC + ((size_t)((l * 2 + bs) * 8 + h) * 64) * 256 + pos_of_key(key);
#pragma unroll
                for (int d4 = 0; d4 < 16; ++d4) {
                    const f32x4 v = *(const f32x4*)(src + 4 * d4);
                    const unsigned w0 = pk2(v[0], v[1]), w1 = pk2(v[2], v[3]);
                    dst[(size_t)(4 * d4 + 0) * 256] = (bf16_t)(w0 & 0xffff); dst[(size_t)(4 * d4 + 1) * 256] = (bf16_t)(w0 >> 16);
                    dst[(size_t)(4 * d4 + 2) * 256] = (bf16_t)(w1 & 0xffff); dst[(size_t)(4 * d4 + 3) * 256] = (bf16_t)(w1 >> 16);
                }
                continue;
            }
            it -= I_VC;
            {
                const int q = it & 3, which = (it >> 2) % 6, lr = it / 24, l = lr / 3, col = q * 256 + 4 * lane;
                const float* mraw = MODRAW + (size_t)lr * NMOD; const float* bm = b_mod + (size_t)l * NMOD;
                f32x4 v;
                if (which == 0) v = *(const f32x4*)(norm1_g + (size_t)l * D + col) * (*(const f32x4*)(mraw + D + col) + *(const f32x4*)(bm + D + col) + 1.0f);
                else if (which == 1) v = *(const f32x4*)(mraw + col) + *(const f32x4*)(bm + col);
                else if (which == 2) v = *(const f32x4*)(mraw + 2 * D + col) + *(const f32x4*)(bm + 2 * D + col);
                else if (which == 3) v = *(const f32x4*)(norm2_g + (size_t)l * D + col) * (*(const f32x4*)(mraw + 4 * D + col) + *(const f32x4*)(bm + 4 * D + col) + 1.0f);
                else if (which == 4) v = *(const f32x4*)(mraw + 3 * D + col) + *(const f32x4*)(bm + 3 * D + col);
                else v = *(const f32x4*)(mraw + 5 * D + col) + *(const f32x4*)(bm + 5 * D + col);
                *(f32x4*)(MODT + ((size_t)lr * 6 + which) * D + col) = v;
            }
        }
        LDS_WAIT(); __syncthreads();
    }
    }
    SEAM(1);

    for (int l = 0; l < DEPTH; ++l) {
        const int p0 = 2 + 6 * l;
        const float* modt_l = MODT + (size_t)l * 3 * 6 * D;
        for (int rep_ = 0; rep_ < MK_REPS(0); ++rep_) { if (rep_) GRID_BAR();
        if (IN(p0)) { PHASE_PTRS();
            pg8::Gemm g{XG, WIN + (size_t)l * NIN * D, D, D};
            pg8::TileOrder S; S.init(M, NIN, D, G, bx);
            EpiIn E{RSS + (size_t)(2 * l) * M, C1 + (size_t)(l * 3) * NIN, b_gate + (size_t)l * 3072, Qb, Kb, VT, PIN, CIN, GT,
                    args.out + OUT_K + (size_t)l * 256 * 512, args.out + OUT_V + (size_t)l * 256 * 512};
            pg8::gemm_phase<EpiIn, pg8::TileOrder>(lds, g, S, E);
        }
        }
        SEAM(p0);
        for (int rep_ = 0; rep_ < MK_REPS(1); ++rep_) { if (rep_) GRID_BAR();
        if (IN(p0 + 1)) { PHASE_PTRS();
            AttnPtrs AP{Qb, Kb, VT, KC + (size_t)l * 2 * 256 * 512, VTC + (size_t)l * 2 * 8 * 64 * 256, ABR};
            PcPtrs PP{PIN, CIN, w_dw + (size_t)l * CONVK * CW, b_dw + (size_t)l * CW, conv_norm_g + (size_t)l * CW, conv_norm_b + (size_t)l * CW, ABR};
            int lane_p = lane; asm volatile("" : "+v"(lane_p));
            if (vcu < 128) {
                LAS float* rpl = (LAS float*)(lds + 1024); LAS float* parts = (LAS float*)(lds + 16384);
                LAS unsigned char* kl = lds + 53248; LAS unsigned char* vl = kl + PA_K_BYTES;
                const float* rpb_l = rpb + (size_t)l * 8 * 15 * 31;
                for (int i = wave * 64 + lane_p; i < 8 * 15 * 31; i += NWAVES * 64) rpl[i] = rpb_l[i] * LOG2E;
                if (!(rep_ && MK_VAR == 1)) attn_sample_block(AP, kl, vl, rpl, parts, vcu, wave, lane_p);
                { const int pu = vcu * NWAVES + wave; if (pu < 768 && !(rep_ && (MK_VAR == 4 || MK_VAR == 5))) pool_unit(PP, pu, lane_p); }
            } else {
                LAS float* wl = (LAS float*)lds; LAS unsigned char* kl = lds + 49152; LAS unsigned char* vl = kl + PA_K_BYTES;
                const int bh = vcu - 128;
                for (int i = wave * 64 + lane_p; i < 47 * CW / 4; i += NWAVES * 64) { const int j = i / (CW / 4) - 7;
                    *(LAS f32x4*)(wl + 4 * i) = (j >= 0 && j < CONVK) ? *(const f32x4*)(PP.wdw + 4 * (i - 7 * (CW / 4))) : (f32x4){0.f, 0.f, 0.f, 0.f}; }
                { StageRegs R; attn_stage_load(R, AP.K + (size_t)((bh >> 3) * 256) * NAW + (bh & 7) * 64, AP.Vt + (size_t)(bh * 64) * 256, 256, 256, wave * 64 + lane_p); attn_stage_store(R, 256, kl, vl, wave * 64 + lane_p); }
                LDS_WAIT(); __syncthreads();
                if (!(rep_ && (MK_VAR == 2 || MK_VAR == 5))) attn_prompt_lds(AP, kl, vl, bh, wave, lane_p);
                { const int it = bh * NWAVES + wave;
                    if (it < 768) { if (!(rep_ && (MK_VAR == 3 || MK_VAR == 5))) conv_unit(PP, wl, it, lane_p); } }
                if (I_MIX > 0 && bh >= 96 && l + 1 < DEPTH && !rep_) {
                    __syncthreads();
                    LAS float* scr = (LAS float*)(lds + wave * TP_BYTES);
#pragma unroll 1
                    for (int r = I_LAYER - I_MIX + (bh - 96) * NWAVES + wave; r < I_LAYER; r += 32 * NWAVES) TRANSPOSE_LAYER_ITEM(l + 1, r, scr, lane_p);
                    LDS_WAIT();
                }
            }
            __syncthreads();
        }
        }
        SEAM(p0 + 1);
        const int t192 = (bx & 7) * 32 + (bx >> 3), pm192 = t192 >> 3, pn192 = t192 & 7;
        const bool has192 = (G == 256);
        for (int rep_ = 0; rep_ < MK_REPS(2); ++rep_) { if (rep_) GRID_BAR();
        if (IN(p0 + 2)) { PHASE_PTRS();
            EpiBranch192 E{GT, MB};
            if (has192) g192::gemm<EpiBranch192>(lds, ABR, D, WBR + (size_t)l * D * D, D, pm192, pn192, 16, E);
        }
        }
        SEAML(p0 + 2, 4 * l + 1, 0);
        for (int rep_ = 0; rep_ < MK_REPS(5); ++rep_) { if (rep_) GRID_BAR();
        if (IN(p0 + 3)) { PHASE_PTRS();
            EpiRes192 E{rep_ ? MF : X, rep_ ? ACT : XG, modt_l + 2 * D, modt_l + 3 * D, rep_ ? (float*)ABR : RSS + (size_t)(2 * l + 1) * M};
            if (has192) g192::gemm<EpiRes192>(lds, MB, D, WOUT + (size_t)l * D * D, D, pm192, pn192, 16, E);
        }
        }
        SEAML(p0 + 3, 4 * l + 2, 0);
        for (int rep_ = 0; rep_ < MK_REPS(3); ++rep_) { if (rep_) GRID_BAR();
        if (IN(p0 + 4)) { PHASE_PTRS();
            pg8::Gemm g{XG, WGU + (size_t)l * NGU * D, D, D};
            const bool bg = (I_TAIL > 0 && l + 1 < DEPTH && G == 256);
            const int nw = bg ? 232 : 256;
            pg8::TileOrderGU S; S.init(M, NGU, D, nw, bx);
            EpiGU E{RSS + (size_t)(2 * l + 1) * M, C2 + (size_t)(l * 3) * NGU, ACT};
            pg8::gemm_phase<EpiGU, pg8::TileOrderGU>(lds, g, S, E);
            if (bg && bx >= 128) {
                int lane_b = lane; asm volatile("" : "+v"(lane_b));
                LAS float* scr = (LAS float*)(lds + wave * TP_BYTES);
                const bool conv_only = bx >= nw;
                const int r0 = conv_only ? I_HEAD + (bx - 232) * NWAVES + wave : I_HEAD + I_BG1 + (bx - 128) * NWAVES + wave;
                const int r1 = conv_only ? I_HEAD + I_BG1 : I_LAYER - I_MIX, rs = conv_only ? 24 * NWAVES : 104 * NWAVES;
#pragma unroll 1
                for (int r = r0; r < r1; r += rs) TRANSPOSE_LAYER_ITEM(l + 1, r, scr, lane_b);
                LDS_WAIT(); asm volatile("s_waitcnt vmcnt(0)" ::: "memory"); __syncthreads();
                if (conv_only && tid == 0) (void)xb_add((unsigned*)(WSB + WS_CTL) + CW_BAR + XB_CONV, 1u);
            }
        }
        }
        SEAML(p0 + 4, 4 * l + 3, 0);
        for (int rep_ = 0; rep_ < MK_REPS(6); ++rep_) { if (rep_) GRID_BAR();
        if (IN(p0 + 5)) { PHASE_PTRS();
            EpiRes192 E{rep_ ? MF : X, rep_ ? MB : XG, modt_l + 5 * D, MODT + (size_t)((l + 1) % DEPTH) * 3 * 6 * D, rep_ ? (float*)ABR : RSS + (size_t)(2 * l + 2) * M};
            if (has192) g192::gemm<EpiRes192>(lds, ACT, FFN, WDN + (size_t)l * D * FFN, FFN, pm192, pn192, FFN / 64, E);
        }
        }
        SEAML(p0 + 5, 4 * l + 4, (l + 1 < DEPTH) ? 24 * (l + 1) : 0);
    }
    if (IN(NPHASE - 1)) { PHASE_PTRS();
        for (int row0 = (bx >> 3) * NWAVES + wave; row0 < M / 8; row0 += (G >> 3) * NWAVES) {
            const int row = (bx & 7) * (M / 8) + row0;
            const float rinv = 1.0f / sqrtf(RSS[(size_t)8 * M + row] * (1.0f / D) + EPS);
#pragma unroll
            for (int j = 0; j < 4; ++j) {
                const int col = 256 * j + 4 * lane;
                const f32x4 v = *(const f32x4*)(X + (size_t)row * D + col) * rinv * *(const f32x4*)(final_g + col);
                __builtin_nontemporal_store(v, (f32x4*)(args.out + OUT_Y + (size_t)row * D + col));
            }
        }
    }
#undef IN
#undef PHASE_PTRS
#undef WSB
#undef ctlf
#undef x_prompt
#undef x_sample
#undef cache_k
#undef cache_v
#undef cvec
#undef c_ctx
#undef w_mod
#undef b_mod
#undef norm1_g
#undef norm2_g
#undef w_in
#undef b_gate
#undef rpb
#undef w_oa
#undef w_pool
#undef pool_scale
#undef w_ob
#undef w_dw
#undef b_dw
#undef conv_norm_g
#undef conv_norm_b
#undef w_oc
#undef w_out
#undef w_gu
#undef w_down
#undef final_g
#undef MODRAW
#undef C1
#undef C2
#undef RSS
#undef MODT
#undef WIN
#undef WGU
#undef WDN
#undef WBR
#undef WOUT
#undef X
#undef XG
#undef Qb
#undef Kb
#undef VT
#undef KC
#undef VTC
#undef PIN
#undef CIN
#undef GT
#undef ABR
#undef MF
#undef MB
#undef ACT
#undef SEAM
#undef SEAML
}

extern "C" void kernel_launch(void* const* d_in, const int* in_sizes, int n_in, void* d_out, int out_size, void* d_ws, size_t ws_size, hipStream_t stream) {
    static int grid = 0;
    if (grid == 0) {
        if (n_in != 26 || ws_size < WS_END) { fprintf(stderr, "kernel_launch: expected 26 inputs and >= %zu bytes of workspace; got %d, %zu\n", (size_t)WS_END, n_in, ws_size); grid = -1; return; }
        int dev = 0, cus = 0;
        if (hipGetDevice(&dev) != hipSuccess || hipDeviceGetAttribute(&cus, hipDeviceAttributeMultiprocessorCount, dev) != hipSuccess) { grid = -1; return; }
        if (hipFuncSetAttribute((const void*)fwd_kernel, hipFuncAttributeMaxDynamicSharedMemorySize, LDS_BYTES) != hipSuccess) { fprintf(stderr, "kernel_launch: hipFuncSetAttribute failed\n"); grid = -1; return; }
        (void)hipGetLastError();
        grid = cus;
    }
    if (grid < 0) return;
    (void)hipMemsetAsync((char*)d_ws + WS_CTL, 0, CTL_ZERO_BYTES, stream);
    Args a{};
    for (int i = 0; i < 26; ++i) a.in[i] = (const float*)d_in[i];
    a.out = (float*)d_out; a.ws = (unsigned char*)d_ws;
#if MK_PER_PHASE
    for (int p = 0; p < NPHASE; ++p) { a.ph_lo = p; a.ph_hi = p + 1; hipLaunchKernelGGL(fwd_kernel, dim3(grid), dim3(NWAVES * 64), LDS_BYTES, stream, a); }
#else
    a.ph_lo = 0; a.ph_hi = NPHASE;
    hipLaunchKernelGGL(fwd_kernel, dim3(grid), dim3(NWAVES * 64), LDS_BYTES, stream, a);
#endif
}
```

```cpp
#include <hip/hip_runtime.h>
#include <cstdio>
#include <cstdint>

#ifndef MK_PER_PHASE
#define MK_PER_PHASE 0
#endif

#ifndef MK_REPEAT
#define MK_REPEAT 0
#endif
#define MK_REPS(bit) ((MK_REPEAT >> (bit)) & 1 ? 2 : 1)
#ifndef MK_VAR
#define MK_VAR 0
#endif

constexpr int D = 1024, MP = 4096, MS = 2048, M = MP + MS, DEPTH = 4;
constexpr int NIN = 5376, FFN = 2816, NGU = 2 * FFN, NMOD = 6 * D;
constexpr int NAW = 512, PW = 256, CW = 256, CONVK = 31;
constexpr float EPS = 1e-6f;
constexpr float LOG2E = 1.4426950408889634f;
constexpr float QSCALE = 0.125f * LOG2E;

constexpr size_t MiB = 1u << 20;
constexpr size_t WS_CTL = 0, CTL_ZERO_BYTES = 5 * MiB / 4;
constexpr int CW_BAR = 4096;
constexpr int CF_MODRAW = 16384;
constexpr int CF_C1 = CF_MODRAW + DEPTH * 3 * NMOD;
constexpr int CF_C2 = CF_C1 + DEPTH * 3 * NIN;
constexpr int CF_RSS = CF_C2 + DEPTH * 3 * NGU;
constexpr int CF_END = CF_RSS + 9 * M;
static_assert((size_t)CF_END * 4 <= CTL_ZERO_BYTES, "control region");
constexpr size_t WS_MODT = 2 * MiB;
constexpr size_t WS_WIN = 4 * MiB;
constexpr size_t WS_WGU = 46 * MiB;
constexpr size_t WS_WDN = 90 * MiB;
constexpr size_t WS_WBR = 112 * MiB;
constexpr size_t WS_WOUT = 120 * MiB;
constexpr size_t WS_X = 128 * MiB;
constexpr size_t WS_XG = 152 * MiB;
constexpr size_t WS_Q = 164 * MiB, WS_K = 170 * MiB;
constexpr size_t WS_VT = 176 * MiB;
constexpr size_t WS_KC = 182 * MiB;
constexpr size_t WS_VTC = 184 * MiB;
constexpr size_t WS_PIN = 186 * MiB;
constexpr size_t WS_CIN = 189 * MiB;
constexpr size_t WS_G = 195 * MiB;
constexpr size_t WS_ABR = 231 * MiB;
constexpr size_t WS_MF = 243 * MiB;
constexpr size_t WS_MB = 267 * MiB;
constexpr size_t WS_ACT = 279 * MiB;
constexpr size_t WS_END = 312 * MiB;
constexpr size_t VT_SAMPLE_OFF = (size_t)16 * 8 * 64 * 256;

constexpr size_t OUT_Y = 0, OUT_K = (size_t)M * D, OUT_V = OUT_K + (size_t)16 * DEPTH * 256 * 512;

#define GAS __attribute__((address_space(1)))
#define LAS __attribute__((address_space(3)))
typedef unsigned short bf16_t;
typedef short bf16x8 __attribute__((ext_vector_type(8)));
typedef float f32x4 __attribute__((ext_vector_type(4)));
typedef float f32x2 __attribute__((ext_vector_type(2)));
typedef float f32x16 __attribute__((ext_vector_type(16)));
typedef unsigned u32x4 __attribute__((ext_vector_type(4)));
typedef unsigned u32x2 __attribute__((ext_vector_type(2)));
typedef __bf16 bf16x2_t __attribute__((ext_vector_type(2)));
#define LDS_WAIT() asm volatile("s_waitcnt lgkmcnt(0)" ::: "memory")

__device__ __forceinline__ unsigned pk2(float lo, float hi) { f32x2 v = {lo, hi}; bf16x2_t b = __builtin_convertvector(v, bf16x2_t); return __builtin_bit_cast(unsigned, b); }
__device__ __forceinline__ u32x4 pk8(f32x4 a, f32x4 b) { u32x4 w; w.x = pk2(a[0], a[1]); w.y = pk2(a[2], a[3]); w.z = pk2(b[0], b[1]); w.w = pk2(b[2], b[3]); return w; }
__device__ __forceinline__ float bf_lo(unsigned w) { return __uint_as_float(w << 16); }
__device__ __forceinline__ float bf_hi(unsigned w) { return __uint_as_float(w & 0xffff0000u); }
__device__ __forceinline__ float sigmoidf_(float x) { return __builtin_amdgcn_rcpf(1.0f + __builtin_amdgcn_exp2f(-LOG2E * x)); }
__device__ __forceinline__ float max_xor32(float x) { const u32x2 r = __builtin_amdgcn_permlane32_swap(__float_as_uint(x), __float_as_uint(x), false, false); return fmaxf(__uint_as_float(r.x), __uint_as_float(r.y)); }
__device__ __forceinline__ float sum_xor32(float x) { const u32x2 r = __builtin_amdgcn_permlane32_swap(__float_as_uint(x), __float_as_uint(x), false, false); return __uint_as_float(r.x) + __uint_as_float(r.y); }
template <int CTRL> __device__ __forceinline__ float dpp_f(float v) { return __uint_as_float(__builtin_amdgcn_update_dpp(0u, __float_as_uint(v), CTRL, 0xf, 0xf, false)); }
__device__ __forceinline__ float sum_xor16(float x) { const u32x2 r = __builtin_amdgcn_permlane16_swap(__float_as_uint(x), __float_as_uint(x), false, false); return __uint_as_float(r.x) + __uint_as_float(r.y); }
__device__ __forceinline__ float sum8(float v) { v += dpp_f<0xB1>(v); v += dpp_f<0x4E>(v); v += dpp_f<0x141>(v); return v; }
__device__ __forceinline__ float wave_sum(float v) { v = sum8(v); v += dpp_f<0x140>(v); v = sum_xor16(v); return sum_xor32(v); }
__device__ __forceinline__ int pos_of_key(int t) { return (t & ~12) | ((t & 4) << 1) | ((t & 8) >> 1); }
__device__ __forceinline__ int mod_row_of_pm(int pm) { return pm < 16 ? 0 : 1 + ((pm - 16) >> 2); }

namespace pg8 {
constexpr int BM = 256, BK = 64, HALF = 128, HTB = HALF * BK * 2  , STAGE_BYTES = 8 * HTB, NXCD = 8, WGM = 3;
__host__ __device__ __forceinline__ int lds_byte(int r, int c) { return r * 128 + ((((c >> 3) ^ (r >> 1)) & 7) << 4) + (c & 7) * 2; }
__host__ __device__ __forceinline__ void stage_rc(int b, int& R, int& C) { R = b >> 7; C = (((b >> 4) ^ (R >> 1)) & 7) * 8; }
__host__ __device__ __forceinline__ int perm32(int rho) { const int n = rho >> 4, i = rho & 15; return 8 * (i >> 2) + 4 * n + (i & 3); }

struct Unit { int pm, pn, k0, nt, kind, half; };
struct Gemm { const bf16_t* A; const bf16_t* Bt; int lda, ldb; };

struct TileOrder {
    int nM, nN, nwg, G, c, nt;
    __device__ void init(int M_, int N_, int K_, int G_, int c_) { nM = M_ / BM; nN = N_ / BM; nwg = nM * nN; G = G_; c = c_; nt = K_ / BK; }
    __device__ bool next(int i, Unit& u) const {
        const long L = (long)i * G + c; if (L >= nwg) return false;
        int wgid = (int)L; { const int q = nwg / NXCD, r = nwg % NXCD, xcd = wgid % NXCD, off = wgid / NXCD; wgid = (xcd < r ? xcd * (q + 1) : r * (q + 1) + (xcd - r) * q) + off; }
        const int nig = WGM * nN, gid = wgid / nig, fm = gid * WGM, gsz = (nM - fm) < WGM ? (nM - fm) : WGM;
        u.pm = fm + ((wgid % nig) % gsz); u.pn = (wgid % nig) / gsz; u.k0 = 0; u.nt = nt; u.kind = 0; u.half = 0; return true;
    }
};
struct TileOrderGU {
    int nM, nN, nwg, nw, c, nt;
    __device__ void init(int M_, int N_, int K_, int nw_, int c_) { nM = M_ / BM; nN = N_ / BM; nwg = nM * nN; nw = nw_; c = c_; nt = K_ / BK; }
    __device__ __forceinline__ void done(const Unit&, int) const {}
    __device__ void tile_of(int L, Unit& u) const {
        const int wgid = (L % NXCD) * (nwg / NXCD) + L / NXCD;
        const int nig = 3 * nN, gid = wgid / nig, fm = gid * 3;
        u.pm = fm + ((wgid % nig) % 3); u.pn = (wgid % nig) / 3; u.k0 = 0; u.nt = nt; u.kind = 0;
    }
    __device__ bool next(int i, Unit& u) const {
        if (c >= nw || i > 2) return false;
        const int j = c >> 3, per = (nwg - 2 * nw) / NXCD;
        const bool hashalf = j < 2 * per;
        if (hashalf) { if (i == 0) { tile_of(2 * nw + (j >> 1) * NXCD + (c & 7), u); u.half = 1 + (j & 1); return true; } tile_of((i - 1) * nw + c, u); u.half = 0; return true; }
        if (i < 2) { tile_of(i * nw + c, u); u.half = 0; return true; }
        return false;
    }
};

struct PanelOrder {
    int c, nseg, ka, na, kb, nb, kc, nc;
    __device__ bool next(int i, Unit& u) const {
        if (c >= 96 || i >= nseg) return false;
        const int T = (c & 7) * 12 + (c >> 3);
        u.pm = T >> 2; u.pn = T & 3; u.k0 = i == 0 ? ka : (i == 1 ? kb : kc); u.nt = i == 0 ? na : (i == 1 ? nb : nc); u.kind = i; u.half = 0; return true;
    }
};

template <class Epi, class Sched>
__device__ __forceinline__ void gemm_phase(LAS unsigned char* lds, const Gemm g, const Sched& S, const Epi& E) {
    int tid = threadIdx.x; asm volatile("" : "+v"(tid));
    const int wid = __builtin_amdgcn_readfirstlane(tid >> 6), lane = tid & 63, wr = wid >> 2, wc = wid & 3, fr = lane & 15, fq = lane >> 4;
    unsigned voffA[2], voffB[2];
#pragma unroll
    for (int i = 0; i < 2; ++i) { int R, C; stage_rc(tid * 16 + i * 8192, R, C); const int Rb = (R & ~31) + perm32(R & 31);
        voffA[i] = (unsigned)(R * g.lda + C) * 2u; voffB[i] = (unsigned)(Rb * g.ldb + C) * 2u; }
    const size_t kstep = (size_t)(BK * 2);
    const size_t hstepA = (size_t)HALF * g.lda * 2, hstepB = (size_t)HALF * g.ldb * 2;
    const size_t tstepA = 2 * hstepA, tstepB = 2 * hstepB;
    const unsigned ldsw = (unsigned)wid * 1024u;
    const int aoffk[2] = {lds_byte(wr * 64 + fr, fq * 8), lds_byte(wr * 64 + fr, fq * 8 + 32)}, boffk[2] = {lds_byte(wc * 32 + fr, fq * 8), lds_byte(wc * 32 + fr, fq * 8 + 32)};
#define PG8_SA(b, h) (((b) * 2 + (h)) * HTB)
#define PG8_SB(b, h) ((4 + (b) * 2 + (h)) * HTB)
#define PG8_STAGE(bufoff, gbase, voff) do { _Pragma("unroll") for (int _i = 0; _i < 2; ++_i) \
        __builtin_amdgcn_global_load_lds((const unsigned*)((const char*)(gbase) + (voff)[_i]), (LAS unsigned*)(lds + (bufoff) + ldsw + _i * 8192), 16, 0, 0); } while (0)
#define PG8_LDA(dst, b, h) do { _Pragma("unroll") for (int m = 0; m < 4; ++m) _Pragma("unroll") for (int k = 0; k < 2; ++k) dst[m][k] = *(const LAS bf16x8*)(lds + PG8_SA(b, h) + aoffk[k] + m * 2048); } while (0)
#define PG8_LDB(dst, b, h) do { _Pragma("unroll") for (int n = 0; n < 2; ++n) _Pragma("unroll") for (int k = 0; k < 2; ++k) dst[n][k] = *(const LAS bf16x8*)(lds + PG8_SB(b, h) + boffk[k] + n * 2048); } while (0)
#define PG8_MMA(ai, bj, At, Bt) do { __builtin_amdgcn_s_setprio(1); _Pragma("unroll") for (int m = 0; m < 4; ++m) _Pragma("unroll") for (int n = 0; n < 2; ++n) _Pragma("unroll") for (int k = 0; k < 2; ++k) \
        acc[ai][bj][m][n] = __builtin_amdgcn_mfma_f32_16x16x32_bf16(Bt[n][k], At[m][k], acc[ai][bj][m][n], 0, 0, 0); __builtin_amdgcn_s_setprio(0); } while (0)
#define PG8_WAIT_V(n) asm volatile("s_waitcnt vmcnt(" #n ")" ::: "memory")
#define PG8_WAIT_L(n) asm volatile("s_waitcnt lgkmcnt(" #n ")" ::: "memory")
#define PG8_BAR __builtin_amdgcn_s_barrier()
#define PG8_SCHED __builtin_amdgcn_sched_barrier(0)
    Unit cur, nxt; int ui = 0;
    if (!S.next(0, cur)) return;
    f32x4 acc[2][2][4][2];
#pragma unroll
    for (int a = 0; a < 2; ++a)
#pragma unroll
        for (int b = 0; b < 2; ++b)
#pragma unroll
            for (int m = 0; m < 4; ++m)
#pragma unroll
                for (int n = 0; n < 2; ++n) acc[a][b][m][n] = (f32x4){0.f, 0.f, 0.f, 0.f};
    bf16x8 At[4][2], B0[2][2], B1[2][2];
    const char* cA = (const char*)g.A + (size_t)cur.pm * tstepA + (size_t)cur.k0 * 2; const char* cB = (const char*)g.Bt + (size_t)cur.pn * tstepB + (size_t)cur.k0 * 2;
    PG8_STAGE(PG8_SB(0, 0), cB, voffB); PG8_STAGE(PG8_SB(0, 1), cB + hstepB, voffB); PG8_STAGE(PG8_SA(0, 0), cA, voffA); PG8_STAGE(PG8_SA(0, 1), cA + hstepA, voffA);
    if (wr == 1) PG8_BAR;
    PG8_WAIT_V(2); PG8_BAR;
    PG8_STAGE(PG8_SB(1, 0), cB + kstep, voffB); PG8_STAGE(PG8_SA(1, 0), cA + kstep, voffA); PG8_STAGE(PG8_SB(1, 1), cB + hstepB + kstep, voffB);
    PG8_WAIT_V(6); PG8_BAR;
    for (;;) {
        const bool has_next = S.next(ui + 1, nxt);
        const char* nA = has_next ? (const char*)g.A + (size_t)nxt.pm * tstepA + (size_t)nxt.k0 * 2 : cA; const char* nB = has_next ? (const char*)g.Bt + (size_t)nxt.pn * tstepB + (size_t)nxt.k0 * 2 : cB;
        const int nt = cur.nt;
        const bool do0 = cur.half != 2, do1 = cur.half != 1;
        for (int t = 0; t < nt; t += 2) {
            const bool last = (t == nt - 2);
            const char* a1 = cA + (size_t)(t + 1) * kstep;
            const char* a2 = last ? nA : cA + (size_t)(t + 2) * kstep; const char* b2 = last ? nB : cB + (size_t)(t + 2) * kstep;
            const char* a3 = a2 + kstep; const char* b3 = b2 + kstep;
            PG8_LDB(B0, 0, 0); PG8_LDB(B1, 0, 1); PG8_SCHED; PG8_LDA(At, 0, 0); PG8_STAGE(PG8_SA(1, 1), a1 + hstepA, voffA);
            PG8_WAIT_V(8); PG8_WAIT_L(0); PG8_BAR; if (do0) { PG8_MMA(0, 0, At, B0); PG8_MMA(0, 1, At, B1); } PG8_BAR; PG8_SCHED;
            PG8_LDA(At, 0, 1); PG8_STAGE(PG8_SB(0, 0), b2, voffB); PG8_STAGE(PG8_SB(0, 1), b2 + hstepB, voffB); PG8_STAGE(PG8_SA(0, 0), a2, voffA);
            PG8_WAIT_V(8); PG8_WAIT_L(0); PG8_BAR; if (do1) { PG8_MMA(1, 0, At, B0); PG8_MMA(1, 1, At, B1); } PG8_BAR; PG8_SCHED;
            PG8_LDB(B0, 1, 0); PG8_LDB(B1, 1, 1); PG8_SCHED; PG8_LDA(At, 1, 0); PG8_STAGE(PG8_SA(0, 1), a2 + hstepA, voffA);
            PG8_WAIT_V(8); PG8_WAIT_L(0); PG8_BAR; if (do0) { PG8_MMA(0, 0, At, B0); PG8_MMA(0, 1, At, B1); } PG8_BAR; PG8_SCHED;
            PG8_LDA(At, 1, 1); PG8_STAGE(PG8_SB(1, 0), b3, voffB); PG8_STAGE(PG8_SB(1, 1), b3 + hstepB, voffB); PG8_STAGE(PG8_SA(1, 0), a3, voffA);
            PG8_WAIT_V(8); PG8_WAIT_L(0); PG8_BAR; if (do1) { PG8_MMA(1, 0, At, B0); PG8_MMA(1, 1, At, B1); } PG8_BAR; PG8_SCHED;
        }
        if (wr == 0) PG8_BAR;
        E(acc, cur, wr, wc, fr, fq);
        if (!has_next) break;
#pragma unroll
        for (int a = 0; a < 2; ++a)
#pragma unroll
            for (int b = 0; b < 2; ++b)
#pragma unroll
                for (int m = 0; m < 4; ++m)
#pragma unroll
                    for (int n = 0; n < 2; ++n) acc[a][b][m][n] = (f32x4){0.f, 0.f, 0.f, 0.f};
        cur = nxt; cA = nA; cB = nB; ++ui;
        if (wr == 1) PG8_BAR;
    }
    PG8_WAIT_V(0);
    PG8_BAR;
#undef PG8_SA
#undef PG8_SB
#undef PG8_STAGE
#undef PG8_LDA
#undef PG8_LDB
#undef PG8_MMA
#undef PG8_WAIT_V
#undef PG8_WAIT_L
#undef PG8_BAR
#undef PG8_SCHED
}
}

typedef f32x4 Acc[2][2][4][2];

struct EpiIn {
    const float* rss; const float* c1; const float* bgate;
    bf16_t *Q, *K, *Vt, *Pin, *Cin, *G; float *outk, *outv;
    __device__ __forceinline__ void operator()(const Acc& acc, const pg8::Unit& u, int wr, int wc, int fr, int fq) const {
        const int pn = u.pn, pm = u.pm, mr = mod_row_of_pm(pm);
        const int cb = pn * 256 + wc * 32 + 8 * fq;
        f32x4 cv[2][2];
#pragma unroll
        for (int bj = 0; bj < 2; ++bj)
#pragma unroll
            for (int n = 0; n < 2; ++n) { cv[bj][n] = *(const f32x4*)(c1 + (size_t)mr * NIN + cb + bj * 128 + 4 * n);
                if (pn >= 9) { cv[bj][n] += *(const f32x4*)(bgate + (cb - 2304) + bj * 128 + 4 * n); cv[bj][n] = cv[bj][n] * -LOG2E; } }
        float rinvs[2][4];
#pragma unroll
        for (int ai = 0; ai < 2; ++ai)
#pragma unroll
            for (int m = 0; m < 4; ++m) rinvs[ai][m] = rss[pm * 256 + ai * 128 + wr * 64 + m * 16 + fr];
#pragma unroll
        for (int ai = 0; ai < 2; ++ai)
#pragma unroll
            for (int m = 0; m < 4; ++m) {
                const int row = pm * 256 + ai * 128 + wr * 64 + m * 16 + fr;
                const float rinv = __builtin_amdgcn_rsqf(rinvs[ai][m] * (1.0f / D) + EPS) * (pn >= 9 ? -LOG2E : 1.0f);
#pragma unroll
                for (int bj = 0; bj < 2; ++bj) {
                    const int col = cb + bj * 128;
                    f32x4 v0 = acc[ai][bj][m][0] * rinv + cv[bj][0], v1 = acc[ai][bj][m][1] * rinv + cv[bj][1];
                    if (pn < 2) {
                        *(u32x4*)(Q + (size_t)row * NAW + col) = pk8(v0 * QSCALE, v1 * QSCALE);
                    } else if (pn < 4) {
                        const int c = col - 512;
                        *(u32x4*)(K + (size_t)row * NAW + c) = pk8(v0, v1);
                        if (pm < 16) { float* o = outk + ((size_t)(pm * DEPTH * 256 + (row & 255))) * 512 + c; __builtin_nontemporal_store(v0, (f32x4*)o); __builtin_nontemporal_store(v1, (f32x4*)(o + 4)); }
                    } else if (pn < 6) {
                        const int c = col - 1024, h = c >> 6, d = c & 63;
                        if (pm < 16) { float* o = outv + ((size_t)(pm * DEPTH * 256 + (row & 255))) * 512 + c; __builtin_nontemporal_store(v0, (f32x4*)o); __builtin_nontemporal_store(v1, (f32x4*)(o + 4)); }
                        bf16_t* vb; int L;
                        if (pm < 16) { L = 256; vb = Vt + ((size_t)((pm * 8 + h) * 64 + d)) * 256 + pos_of_key(row & 255); }
                        else { const int rs = row - MP, bs = rs >> 10; L = 1024; vb = Vt + VT_SAMPLE_OFF + ((size_t)((bs * 8 + h) * 64 + d)) * 1024 + pos_of_key(rs & 1023); }
                        const u32x4 w = pk8(v0, v1);
                        vb[0] = (bf16_t)(w.x & 0xffff); vb[(size_t)L] = (bf16_t)(w.x >> 16); vb[(size_t)2 * L] = (bf16_t)(w.y & 0xffff); vb[(size_t)3 * L] = (bf16_t)(w.y >> 16);
                        vb[(size_t)4 * L] = (bf16_t)(w.z & 0xffff); vb[(size_t)5 * L] = (bf16_t)(w.z >> 16); vb[(size_t)6 * L] = (bf16_t)(w.w & 0xffff); vb[(size_t)7 * L] = (bf16_t)(w.w >> 16);
                    } else if (pn == 6) {
                        *(u32x4*)(Pin + (size_t)row * PW + (col - 1536)) = pk8(v0, v1);
                    } else if (pn < 9) {
                        *(u32x4*)(Cin + (size_t)row * 512 + (col - 1792)) = pk8(v0, v1);
                    } else {
#pragma unroll
                        for (int e = 0; e < 4; ++e) { v0[e] = __builtin_amdgcn_rcpf(1.0f + __builtin_amdgcn_exp2f(v0[e])); v1[e] = __builtin_amdgcn_rcpf(1.0f + __builtin_amdgcn_exp2f(v1[e])); }
                        *(u32x4*)(G + (size_t)row * 3072 + (col - 2304)) = pk8(v0, v1);
                    }
                }
                asm volatile("" ::: "memory");
            }
    }
};

struct EpiBranch {
    const bf16_t* G; float* mf; bf16_t* mb;
    __device__ __forceinline__ void operator()(const Acc& acc, const pg8::Unit& u, int wr, int wc, int fr, int fq) const {
        const int cb = u.pn * 256 + wc * 32 + 8 * fq, kind = u.kind;
#pragma unroll
        for (int ai = 0; ai < 2; ++ai)
#pragma unroll
            for (int m = 0; m < 4; ++m) {
                const int row = u.pm * 256 + ai * 128 + wr * 64 + m * 16 + fr;
#pragma unroll
                for (int bj = 0; bj < 2; ++bj) {
                    const int col = cb + bj * 128;
                    const u32x4 gw = *(const u32x4*)(G + (size_t)row * 3072 + kind * 1024 + col);
                    f32x4 v0 = acc[ai][bj][m][0], v1 = acc[ai][bj][m][1];
                    v0[0] *= bf_lo(gw.x); v0[1] *= bf_hi(gw.x); v0[2] *= bf_lo(gw.y); v0[3] *= bf_hi(gw.y);
                    v1[0] *= bf_lo(gw.z); v1[1] *= bf_hi(gw.z); v1[2] *= bf_lo(gw.w); v1[3] *= bf_hi(gw.w);
                    float* sp = mf + (size_t)row * D + col;
                    if (kind > 0) { v0 += *(const f32x4*)sp; v1 += *(const f32x4*)(sp + 4); }
                    if (kind < 2) { *(f32x4*)sp = v0; *(f32x4*)(sp + 4) = v1; }
                    else *(u32x4*)(mb + (size_t)row * D + col) = pk8(v0, v1);
                }
                asm volatile("" ::: "memory");
            }
    }
};

struct EpiRes {
    float* x; bf16_t* xg; const float* gate; const float* gsn; float* rssn;
    __device__ __forceinline__ void operator()(const Acc& acc, const pg8::Unit& u, int wr, int wc, int fr, int fq) const {
        const int mr = mod_row_of_pm(u.pm), cb = u.pn * 256 + wc * 32 + 8 * fq;
        float ss[2][4];
#pragma unroll
        for (int ai = 0; ai < 2; ++ai)
#pragma unroll
            for (int m = 0; m < 4; ++m) ss[ai][m] = 0.f;
#pragma unroll
        for (int bj = 0; bj < 2; ++bj) {
            const int col = cb + bj * 128;
            const f32x4 gt0 = *(const f32x4*)(gate + (size_t)mr * 6 * D + col), gt1 = *(const f32x4*)(gate + (size_t)mr * 6 * D + col + 4);
            const f32x4 gs0 = *(const f32x4*)(gsn + (size_t)mr * 6 * D + col), gs1 = *(const f32x4*)(gsn + (size_t)mr * 6 * D + col + 4);
#pragma unroll
            for (int ai = 0; ai < 2; ++ai)
#pragma unroll
                for (int m = 0; m < 4; ++m) {
                    const int row = u.pm * 256 + ai * 128 + wr * 64 + m * 16 + fr;
                    float* xp = x + (size_t)row * D + col;
                    f32x4 x0 = *(const f32x4*)xp, x1 = *(const f32x4*)(xp + 4);
                    x0 += gt0 * acc[ai][bj][m][0]; x1 += gt1 * acc[ai][bj][m][1];
                    *(f32x4*)xp = x0; *(f32x4*)(xp + 4) = x1;
                    ss[ai][m] += (x0[0] * x0[0] + x0[1] * x0[1]) + (x0[2] * x0[2] + x0[3] * x0[3]) + (x1[0] * x1[0] + x1[1] * x1[1]) + (x1[2] * x1[2] + x1[3] * x1[3]);
                    *(u32x4*)(xg + (size_t)row * D + col) = pk8(x0 * gs0, x1 * gs1);
                    asm volatile("" ::: "memory");
                }
        }
#pragma unroll
        for (int ai = 0; ai < 2; ++ai)
#pragma unroll
            for (int m = 0; m < 4; ++m) {
                float s = ss[ai][m];
                s = sum_xor32(sum_xor16(s));
                if (fq == 0) atomicAdd(rssn + u.pm * 256 + ai * 128 + wr * 64 + m * 16 + fr, s);
            }
    }
};

struct EpiGU {
    const float* rss; const float* c2; bf16_t* act;
    __device__ __forceinline__ void operator()(const Acc& acc, const pg8::Unit& u, int wr, int wc, int fr, int fq) const {
        const int mr = mod_row_of_pm(u.pm), ca0 = u.pn * 128 + wc * 32 + 8 * fq;
        f32x4 ca[2], cbv[2];
#pragma unroll
        for (int n = 0; n < 2; ++n) { ca[n] = *(const f32x4*)(c2 + (size_t)mr * NGU + ca0 + 4 * n); cbv[n] = *(const f32x4*)(c2 + (size_t)mr * NGU + FFN + ca0 + 4 * n); }
        float rinvs[2][4];
#pragma unroll
        for (int ai = 0; ai < 2; ++ai)
#pragma unroll
            for (int m = 0; m < 4; ++m) rinvs[ai][m] = rss[u.pm * 256 + ai * 128 + wr * 64 + m * 16 + fr];
#pragma unroll
        for (int ai = 0; ai < 2; ++ai)
#pragma unroll
            for (int m = 0; m < 4; ++m) {
                if (u.half == 2 - ai) continue;
                const int row = u.pm * 256 + ai * 128 + wr * 64 + m * 16 + fr;
                const float rinv = __builtin_amdgcn_rsqf(rinvs[ai][m] * (1.0f / D) + EPS);
                f32x4 o[2];
#pragma unroll
                for (int n = 0; n < 2; ++n) {
                    const f32x4 a = acc[ai][0][m][n] * rinv + ca[n], b = acc[ai][1][m][n] * rinv + cbv[n];
#pragma unroll
                    for (int e = 0; e < 4; ++e) o[n][e] = a[e] * sigmoidf_(a[e]) * b[e];
                }
                *(u32x4*)(act + (size_t)row * FFN + ca0) = pk8(o[0], o[1]);
                asm volatile("" ::: "memory");
            }
    }
};

namespace g192 {
constexpr int TM = 192, TN = 128, BK = 64, ABYTES = TM * BK * 2, BBYTES = TN * BK * 2, SBYTES = ABYTES + BBYTES;
typedef f32x4 Acc6[6][2];
template <class Epi>
__device__ __forceinline__ void gemm(LAS unsigned char* lds, const bf16_t* A, int lda, const bf16_t* Bt, int ldb, int pm, int pn, int nt, const Epi& E) {
    int tid = threadIdx.x; asm volatile("" : "+v"(tid));
    const int wid = __builtin_amdgcn_readfirstlane(tid >> 6), lane = tid & 63, wr = wid >> 2, wc = wid & 3, fr = lane & 15, fq = lane >> 4;
    unsigned voffA[3], voffB[2];
#pragma unroll
    for (int i = 0; i < 3; ++i) { int R, C; pg8::stage_rc((wid + 8 * i) * 1024 + lane * 16, R, C); voffA[i] = (unsigned)(R * lda + C) * 2u; }
#pragma unroll
    for (int i = 0; i < 2; ++i) { int R, C; pg8::stage_rc((wid + 8 * i) * 1024 + lane * 16, R, C); const int Rb = (R & ~31) + pg8::perm32(R & 31); voffB[i] = (unsigned)(Rb * ldb + C) * 2u; }
    const char* gA = (const char*)(A + (size_t)pm * TM * lda); const char* gB = (const char*)(Bt + (size_t)pn * TN * ldb);
    const unsigned ldsw = (unsigned)wid * 1024u;
    const int aoffk[2] = {pg8::lds_byte(wr * 96 + fr, fq * 8), pg8::lds_byte(wr * 96 + fr, fq * 8 + 32)}, boffk[2] = {ABYTES + pg8::lds_byte(wc * 32 + fr, fq * 8), ABYTES + pg8::lds_byte(wc * 32 + fr, fq * 8 + 32)};
#define G192_STAGE(slot, t) do { \
        _Pragma("unroll") for (int _i = 0; _i < 3; ++_i) __builtin_amdgcn_global_load_lds((const unsigned*)(gA + (size_t)(t) * (BK * 2) + voffA[_i]), (LAS unsigned*)(lds + (slot) * SBYTES + ldsw + _i * 8192), 16, 0, 0); \
        _Pragma("unroll") for (int _i = 0; _i < 2; ++_i) __builtin_amdgcn_global_load_lds((const unsigned*)(gB + (size_t)(t) * (BK * 2) + voffB[_i]), (LAS unsigned*)(lds + (slot) * SBYTES + ABYTES + ldsw + _i * 8192), 16, 0, 0); } while (0)
#define G192_WAIT_V(n) asm volatile("s_waitcnt vmcnt(" #n ")" ::: "memory")
#define G192_WAIT_L(n) asm volatile("s_waitcnt lgkmcnt(" #n ")" ::: "memory")
    f32x4 acc[6][2], tot[6][2];
#pragma unroll
    for (int m = 0; m < 6; ++m)
#pragma unroll
        for (int n = 0; n < 2; ++n) { acc[m][n] = (f32x4){0.f, 0.f, 0.f, 0.f}; tot[m][n] = (f32x4){0.f, 0.f, 0.f, 0.f}; }
    G192_STAGE(0, 0); G192_STAGE(1, 1); G192_STAGE(2, 2);
    G192_WAIT_V(10); __builtin_amdgcn_s_barrier();
#pragma unroll 1
    for (int t = 0; t < nt; ++t) {
        const int slot = t & 3;
        bf16x8 At[6][2], Bf[2][2];
        const LAS unsigned char* sb = lds + slot * SBYTES;
#pragma unroll
        for (int n = 0; n < 2; ++n)
#pragma unroll
            for (int k = 0; k < 2; ++k) Bf[n][k] = *(const LAS bf16x8*)(sb + boffk[k] + n * 2048);
#pragma unroll
        for (int m = 0; m < 6; ++m)
#pragma unroll
            for (int k = 0; k < 2; ++k) At[m][k] = *(const LAS bf16x8*)(sb + aoffk[k] + m * 2048);
        __builtin_amdgcn_sched_barrier(0);
        if (t + 3 < nt) G192_STAGE((t + 3) & 3, t + 3);
        __builtin_amdgcn_sched_barrier(0);
        G192_WAIT_L(0);
        __builtin_amdgcn_s_setprio(1);
#pragma unroll
        for (int m = 0; m < 6; ++m)
#pragma unroll
            for (int n = 0; n < 2; ++n)
#pragma unroll
                for (int k = 0; k < 2; ++k) acc[m][n] = __builtin_amdgcn_mfma_f32_16x16x32_bf16(Bf[n][k], At[m][k], acc[m][n], 0, 0, 0);
        __builtin_amdgcn_s_setprio(0);
        if (Epi::BRANCH) { if (t == 7 || t == 11 || t == nt - 1) E.seg(acc, tot, t == 7 ? 0 : (t == 11 ? 1 : 2), pm, pn, wr, wc, fr, fq); }
        if (t + 3 < nt) G192_WAIT_V(10); else if (t + 2 < nt) G192_WAIT_V(5); else G192_WAIT_V(0);
        __builtin_amdgcn_s_barrier();
    }
    E(Epi::BRANCH ? tot : acc, pm, pn, wr, wc, fr, fq);
#undef G192_STAGE
#undef G192_WAIT_V
#undef G192_WAIT_L
}
}

struct EpiBranch192 {
    static constexpr bool BRANCH = true;
    const bf16_t* G; bf16_t* mb;
    __device__ __forceinline__ void seg(g192::Acc6& acc, g192::Acc6& tot, int kind, int pm, int pn, int wr, int wc, int fr, int fq) const {
        const int col = pn * 128 + wc * 32 + 8 * fq;
#pragma unroll
        for (int m = 0; m < 6; ++m) {
            const int row = pm * 192 + wr * 96 + m * 16 + fr;
            const u32x4 gw = *(const u32x4*)(G + (size_t)row * 3072 + kind * 1024 + col);
            f32x4 g0 = {bf_lo(gw.x), bf_hi(gw.x), bf_lo(gw.y), bf_hi(gw.y)}, g1 = {bf_lo(gw.z), bf_hi(gw.z), bf_lo(gw.w), bf_hi(gw.w)};
            tot[m][0] += g0 * acc[m][0]; tot[m][1] += g1 * acc[m][1];
            acc[m][0] = (f32x4){0.f, 0.f, 0.f, 0.f}; acc[m][1] = (f32x4){0.f, 0.f, 0.f, 0.f};
        }
    }
    __device__ __forceinline__ void operator()(const g192::Acc6& tot, int pm, int pn, int wr, int wc, int fr, int fq) const {
        const int col = pn * 128 + wc * 32 + 8 * fq;
#pragma unroll
        for (int m = 0; m < 6; ++m) { const int row = pm * 192 + wr * 96 + m * 16 + fr; *(u32x4*)(mb + (size_t)row * D + col) = pk8(tot[m][0], tot[m][1]); }
    }
};
struct EpiRes192 {
    static constexpr bool BRANCH = false;
    const float* xr0; const float* xr1;
    float* x; bf16_t* xg; const float* gate; const float* gsn; float* rssn;
    __device__ __forceinline__ void seg(g192::Acc6&, g192::Acc6&, int, int, int, int, int, int, int) const {}
    __device__ __forceinline__ void operator()(const g192::Acc6& acc, int pm, int pn, int wr, int wc, int fr, int fq) const {
        const int col = pn * 128 + wc * 32 + 8 * fq;
        f32x4 xv[6][2], gt[6][2], gs[6][2];
#pragma unroll
        for (int m = 0; m < 6; ++m) {
            const int row = pm * 192 + wr * 96 + m * 16 + fr;
            const int mr = row < MP ? 0 : 1 + ((row - MP) >> 10);
            const float* gp = gate + (size_t)mr * 6 * D + col; const float* sp = gsn + (size_t)mr * 6 * D + col; const float* xp = (row < MP ? xr0 + (size_t)row * D : xr1 + (size_t)(row - MP) * D) + col;
            xv[m][0] = *(const f32x4*)xp; xv[m][1] = *(const f32x4*)(xp + 4);
            gt[m][0] = *(const f32x4*)gp; gt[m][1] = *(const f32x4*)(gp + 4); gs[m][0] = *(const f32x4*)sp; gs[m][1] = *(const f32x4*)(sp + 4);
        }
#pragma unroll
        for (int m = 0; m < 6; ++m) {
            const int row = pm * 192 + wr * 96 + m * 16 + fr;
            float* xp = x + (size_t)row * D + col;
            const f32x4 x0 = xv[m][0] + gt[m][0] * acc[m][0], x1 = xv[m][1] + gt[m][1] * acc[m][1];
            *(f32x4*)xp = x0; *(f32x4*)(xp + 4) = x1;
            float ss = (x0[0] * x0[0] + x0[1] * x0[1]) + (x0[2] * x0[2] + x0[3] * x0[3]) + (x1[0] * x1[0] + x1[1] * x1[1]) + (x1[2] * x1[2] + x1[3] * x1[3]);
            *(u32x4*)(xg + (size_t)row * D + col) = pk8(x0 * gs[m][0], x1 * gs[m][1]);
            ss = sum_xor32(sum_xor16(ss));
            if (fq == 0) atomicAdd(rssn + row, ss);
        }
    }
};

struct EpiLast192 {
    static constexpr bool BRANCH = false;
    const float* x; const float* gate; float* rssn; LAS f32x4* park;
    __device__ __forceinline__ void seg(g192::Acc6&, g192::Acc6&, int, int, int, int, int, int, int) const {}
    __device__ __forceinline__ void operator()(const g192::Acc6& acc, int pm, int pn, int wr, int wc, int fr, int fq) const {
        const int col = pn * 128 + wc * 32 + 8 * fq;
        f32x4 xv[6][2], gt[6][2];
#pragma unroll
        for (int m = 0; m < 6; ++m) {
            const int row = pm * 192 + wr * 96 + m * 16 + fr;
            const int mr = row < MP ? 0 : 1 + ((row - MP) >> 10);
            const float* gp = gate + (size_t)mr * 6 * D + col; const float* xp = x + (size_t)row * D + col;
            xv[m][0] = *(const f32x4*)xp; xv[m][1] = *(const f32x4*)(xp + 4);
            gt[m][0] = *(const f32x4*)gp; gt[m][1] = *(const f32x4*)(gp + 4);
        }
        LAS f32x4* pk = park + (wr * 4 + wc) * 12 * 64 + fq * 16 + fr;
#pragma unroll
        for (int m = 0; m < 6; ++m) {
            const int row = pm * 192 + wr * 96 + m * 16 + fr;
            const f32x4 x0 = xv[m][0] + gt[m][0] * acc[m][0], x1 = xv[m][1] + gt[m][1] * acc[m][1];
            pk[(2 * m) * 64] = x0; pk[(2 * m + 1) * 64] = x1;
            float ss = (x0[0] * x0[0] + x0[1] * x0[1]) + (x0[2] * x0[2] + x0[3] * x0[3]) + (x1[0] * x1[0] + x1[1] * x1[1]) + (x1[2] * x1[2] + x1[3] * x1[3]);
            ss = sum_xor32(sum_xor16(ss));
            if (fq == 0) atomicAdd(rssn + row, ss);
        }
    }
};

struct AttnState { f32x16 o0, o1; float m, l; };
struct KVFrag { bf16x8 k[4], v[2][2]; };
__device__ __forceinline__ void attn_load(KVFrag& f, const bf16_t* kptr  , const bf16_t* vptr  , int vstride32  ) {
#pragma unroll
    for (int s = 0; s < 4; ++s) f.k[s] = *(const bf16x8*)(kptr + 16 * s);
#pragma unroll
    for (int dt = 0; dt < 2; ++dt)
#pragma unroll
        for (int ks = 0; ks < 2; ++ks) f.v[dt][ks] = *(const bf16x8*)(vptr + (size_t)dt * vstride32 + 16 * ks);
}
__device__ __forceinline__ void attn_tile(AttnState& st, const bf16x8 (&qf)[4], const KVFrag& f, bool local, const LAS float* rl, int cq, int cs, int ck0  ) {
    f32x16 s = {0.f, 0.f, 0.f, 0.f, 0.f, 0.f, 0.f, 0.f, 0.f, 0.f, 0.f, 0.f, 0.f, 0.f, 0.f, 0.f};
#pragma unroll
    for (int k = 0; k < 4; ++k) s = __builtin_amdgcn_mfma_f32_32x32x16_bf16(f.k[k], qf[k], s, 0, 0, 0);
    if (local) {
        const LAS float* rb = rl + (ck0 - cq + 15);
        const int d0 = ck0 - cs;
#pragma unroll
        for (int i = 0; i < 16; ++i) {
            const int o = (i & 3) + 8 * (i >> 2);
            const bool ok = (unsigned)(d0 + o) < 16u;
            s[i] = ok ? s[i] + rb[o] : -1e30f;
        }
    }
    float mx = fmaxf(fmaxf(s[0], s[1]), fmaxf(s[2], s[3]));
#pragma unroll
    for (int i = 4; i < 16; i += 4) mx = fmaxf(mx, fmaxf(fmaxf(s[i], s[i + 1]), fmaxf(s[i + 2], s[i + 3])));
    mx = max_xor32(mx);
    const float mo = st.m, mn = fmaxf(mo, mx);
    st.m = mn;
    float ls = 0.f;
#pragma unroll
    for (int i = 0; i < 16; ++i) { const float p = __builtin_amdgcn_exp2f(s[i] - mn); s[i] = p; ls += p; }
    if (__builtin_amdgcn_ballot_w64(mn > mo) != 0ull) {
        const float alpha = __builtin_amdgcn_exp2f(mo - mn);
        st.l *= alpha;
#pragma unroll
        for (int i = 0; i < 16; ++i) { st.o0[i] *= alpha; st.o1[i] *= alpha; }
    }
    st.l += ls;
    u32x4 w0, w1;
    w0.x = pk2(s[0], s[1]); w0.y = pk2(s[2], s[3]); w0.z = pk2(s[4], s[5]); w0.w = pk2(s[6], s[7]);
    w1.x = pk2(s[8], s[9]); w1.y = pk2(s[10], s[11]); w1.z = pk2(s[12], s[13]); w1.w = pk2(s[14], s[15]);
    const bf16x8 p0 = __builtin_bit_cast(bf16x8, w0), p1 = __builtin_bit_cast(bf16x8, w1);
    st.o0 = __builtin_amdgcn_mfma_f32_32x32x16_bf16(f.v[0][0], p0, st.o0, 0, 0, 0);
    st.o0 = __builtin_amdgcn_mfma_f32_32x32x16_bf16(f.v[0][1], p1, st.o0, 0, 0, 0);
    st.o1 = __builtin_amdgcn_mfma_f32_32x32x16_bf16(f.v[1][0], p0, st.o1, 0, 0, 0);
    st.o1 = __builtin_amdgcn_mfma_f32_32x32x16_bf16(f.v[1][1], p1, st.o1, 0, 0, 0);
}
__device__ __forceinline__ void attn_store(const AttnState& st, bf16_t* orow  , int hf) {
    const float lt = sum_xor32(st.l);
    const float inv = __builtin_amdgcn_rcpf(lt);
#pragma unroll
    for (int g = 0; g < 4; ++g) {
        u32x2 a, b;
        a.x = pk2(st.o0[4 * g] * inv, st.o0[4 * g + 1] * inv); a.y = pk2(st.o0[4 * g + 2] * inv, st.o0[4 * g + 3] * inv);
        b.x = pk2(st.o1[4 * g] * inv, st.o1[4 * g + 1] * inv); b.y = pk2(st.o1[4 * g + 2] * inv, st.o1[4 * g + 3] * inv);
        *(u32x2*)(orow + 8 * g + 4 * hf) = a;
        *(u32x2*)(orow + 32 + 8 * g + 4 * hf) = b;
    }
}
struct AttnPtrs { const bf16_t *Q, *K, *Vt, *Kc, *Vtc; bf16_t* Abr; };
constexpr int PA_K_BYTES = 256 * 128, PA_V_BYTES = 64 * 512;
struct StageRegs { u32x4 kv[4], vv[4]; };
__device__ __forceinline__ void attn_stage_load(StageRegs& R, const bf16_t* ksrc, const bf16_t* vsrc, int vld, int nkeys, int tid) {
    const int nch = nkeys * 8, sh = nkeys == 256 ? 5 : 3;
#pragma unroll
    for (int i = 0; i < 4; ++i) { int q = tid + 512 * i; q = q < nch ? q : nch - 1;
        R.kv[i] = *(const u32x4*)(ksrc + (size_t)(q >> 3) * NAW + 8 * (q & 7));
        R.vv[i] = *(const u32x4*)(vsrc + (size_t)(q >> sh) * vld + 8 * (q & ((1 << sh) - 1))); }
}
__device__ __forceinline__ void attn_stage_store(const StageRegs& R, int nkeys, LAS unsigned char* kl, LAS unsigned char* vl, int tid) {
    const int nch = nkeys * 8, sh = nkeys == 256 ? 5 : 3;
#pragma unroll
    for (int i = 0; i < 4; ++i) { const int q = tid + 512 * i; if (q < nch) {
        const int key = q >> 3, c = q & 7, d = q >> sh, cv = q & ((1 << sh) - 1);
        *(LAS u32x4*)(kl + key * 128 + ((c ^ (key & 7)) << 4)) = R.kv[i];
        *(LAS u32x4*)(vl + d * 512 + ((cv ^ (d & 15)) << 4)) = R.vv[i]; } }
}
__device__ __forceinline__ void attn_lds_frag(KVFrag& f, const LAS unsigned char* kl, const LAS unsigned char* vl, int kt, int r32, int hf) {
    const int key = 32 * kt + r32;
#pragma unroll
    for (int s = 0; s < 4; ++s) f.k[s] = *(const LAS bf16x8*)(kl + key * 128 + (((2 * s + hf) ^ (key & 7)) << 4));
#pragma unroll
    for (int dt = 0; dt < 2; ++dt)
#pragma unroll
        for (int ks = 0; ks < 2; ++ks) { const int d = 32 * dt + r32; f.v[dt][ks] = *(const LAS bf16x8*)(vl + d * 512 + (((4 * kt + 2 * ks + hf) ^ (d & 15)) << 4)); }
}
__device__ __forceinline__ void attn_prompt_lds(const AttnPtrs& P, const LAS unsigned char* kl, const LAS unsigned char* vl, int bh, int qt, int lane) {
    const int r32 = lane & 31, hf = lane >> 5, b = bh >> 3, h = bh & 7;
    const int qrow = b * 256 + qt * 32 + r32;
    bf16x8 qf[4];
#pragma unroll
    for (int s = 0; s < 4; ++s) qf[s] = *(const bf16x8*)(P.Q + (size_t)qrow * NAW + h * 64 + 16 * s + 8 * hf);
    AttnState st; st.m = -1e30f; st.l = 0.f;
#pragma unroll
    for (int i = 0; i < 16; ++i) { st.o0[i] = 0.f; st.o1[i] = 0.f; }
    KVFrag fa, fb;
    attn_lds_frag(fa, kl, vl, 0, r32, hf);
#pragma unroll 1
    for (int t = 0; t < 8; t += 2) {
        attn_lds_frag(fb, kl, vl, t + 1, r32, hf);
        attn_tile(st, qf, fa, false, nullptr, 0, 0, 0);
        if (t + 2 < 8) attn_lds_frag(fa, kl, vl, t + 2, r32, hf);
        attn_tile(st, qf, fb, false, nullptr, 0, 0, 0);
    }
    attn_store(st, P.Abr + (size_t)qrow * D + h * 64, hf);
}
constexpr int ATT_PART_FLOATS = 34 * 64;
__device__ __forceinline__ void attn_sample_block(const AttnPtrs& P, LAS unsigned char* kl, LAS unsigned char* vl, const LAS float* rpl, LAS float* parts, int blk, int wave, int lane) {
    const int r32 = lane & 31, hf = lane >> 5, tid = wave * 64 + lane;
    const int bs = blk >> 6, h = (blk >> 3) & 7, i2 = (blk & 7) * 2;
    const int u = wave >> 1, half = wave & 1, r = i2 + (u >> 1), qh = u & 1;
    const int qrow = MP + bs * 1024 + r * 64 + qh * 32 + r32;
    const int cq = qh * 32 + r32; int cs = cq - 8; cs = cs < 0 ? 0 : (cs > 48 ? 48 : cs);
    int rs = r - 4; rs = rs < 0 ? 0 : (rs > 8 ? 8 : rs);
    int rs0 = i2 - 4; rs0 = rs0 < 0 ? 0 : (rs0 > 8 ? 8 : rs0);
    int rs1 = i2 - 3; rs1 = rs1 < 0 ? 0 : (rs1 > 8 ? 8 : rs1);
    const int nstage = rs1 != rs0 ? 4 : 3;
    const bf16_t* kloc = P.K + (size_t)(MP + bs * 1024) * NAW + h * 64;
    const bf16_t* vloc = P.Vt + VT_SAMPLE_OFF + (size_t)((bs * 8 + h) * 64) * 1024;
    bf16x8 qf[4];
#pragma unroll
    for (int s = 0; s < 4; ++s) qf[s] = *(const bf16x8*)(P.Q + (size_t)qrow * NAW + h * 64 + 16 * s + 8 * hf);
    AttnState st; st.m = -1e30f; st.l = 0.f;
#pragma unroll
    for (int i = 0; i < 16; ++i) { st.o0[i] = 0.f; st.o1[i] = 0.f; }
    LAS float* part = parts + u * ATT_PART_FLOATS;
    StageRegs R;
    attn_stage_load(R, P.Kc + (size_t)(bs * 256) * NAW + h * 64, P.Vtc + (size_t)((bs * 8 + h) * 64) * 256, 256, 256, tid);
#pragma unroll 1
    for (int sg = 0; sg < nstage; ++sg) {
        if (sg) __syncthreads();
        const int row0 = rs0 + 4 * (sg - 1);
        attn_stage_store(R, sg == 3 ? 64 : 256, kl, vl, tid);
        { const int sn = sg + 1 < nstage ? sg + 1 : 1, rown = rs0 + 4 * (sn - 1);
          attn_stage_load(R, kloc + (size_t)(rown * 64) * NAW, vloc + rown * 64, 1024, sn == 3 ? 64 : 256, tid); }
        LDS_WAIT(); __syncthreads();
        KVFrag f;
        if (sg == 0) {
#pragma unroll 1
            for (int kt = 4 * half; kt < 4 * half + 4; ++kt) { attn_lds_frag(f, kl, vl, kt, r32, hf); attn_tile(st, qf, f, false, nullptr, 0, 0, 0); }
        } else {
            const int nt = sg == 3 ? 2 : 8;
#pragma unroll 1
            for (int kt = half * (nt >> 1); kt < (half + 1) * (nt >> 1); ++kt) {
                const int jr = row0 + (kt >> 1), ch = kt & 1;
                if (jr < rs || jr >= rs + 8) continue;
                attn_lds_frag(f, kl, vl, kt, r32, hf);
                attn_tile(st, qf, f, true, rpl + (h * 15 + (jr - r + 7)) * 31, cq, cs, ch * 32 + 4 * hf);
            }
        }
    }
    if (half == 1) {
#pragma unroll
        for (int i = 0; i < 16; ++i) { part[i * 64 + lane] = st.o0[i]; part[(16 + i) * 64 + lane] = st.o1[i]; }
        part[32 * 64 + lane] = st.m; part[33 * 64 + lane] = st.l;
    }
    LDS_WAIT(); __syncthreads();
    if (half == 0) {
        const float m1 = part[32 * 64 + lane], l1 = part[33 * 64 + lane];
        const float mn = fmaxf(st.m, m1), a0 = __builtin_amdgcn_exp2f(st.m - mn), a1 = __builtin_amdgcn_exp2f(m1 - mn);
        st.l = st.l * a0 + l1 * a1;
#pragma unroll
        for (int i = 0; i < 16; ++i) { st.o0[i] = st.o0[i] * a0 + part[i * 64 + lane] * a1; st.o1[i] = st.o1[i] * a0 + part[(16 + i) * 64 + lane] * a1; }
        attn_store(st, P.Abr + (size_t)qrow * D + h * 64, hf);
    }
}

struct PcPtrs { const bf16_t *Pin, *Cin; const float *wdw, *bdw, *cng, *cnb; bf16_t* Abr; };
__device__ __forceinline__ f32x4 ld_bf4(const bf16_t* p) { const u32x2 w = *(const u32x2*)p; return (f32x4){bf_lo(w.x), bf_hi(w.x), bf_lo(w.y), bf_hi(w.y)}; }
__device__ __forceinline__ f32x4 up_bf4(u32x2 w) { return (f32x4){bf_lo(w.x), bf_hi(w.x), bf_lo(w.y), bf_hi(w.y)}; }
__device__ __forceinline__ void pool_unit(const PcPtrs& P, int unit, int lane) {
    const int row0 = unit * 8;
    const int L = row0 < MP ? 256 : 1024;
    const int sb = row0 < MP ? (row0 & ~255) : MP + ((row0 - MP) & ~1023);
    const int g = lane >> 4, hw = 1 << g;
    const int t0 = row0 - sb;
    u32x2 pv[23];
#pragma unroll
    for (int i = 0; i < 23; ++i) { int t = t0 - 8 + i; t = t < 0 ? 0 : (t > L - 1 ? L - 1 : t); pv[i] = *(const u32x2*)(P.Pin + (size_t)(sb + t) * PW + 4 * lane); }
    f32x4 v[23];
#pragma unroll
    for (int i = 0; i < 23; ++i) { const int t = t0 - 8 + i; const bool ok = (t >= 0) && (t < L); const f32x4 u = up_bf4(pv[i]); v[i] = ok ? u : (f32x4){0.f, 0.f, 0.f, 0.f}; }
    f32x4 w1[23], w2[22], w4[20];
#pragma unroll
    for (int i = 1; i < 23; ++i) w1[i] = v[i - 1] + v[i];
#pragma unroll
    for (int i = 2; i < 22; ++i) w2[i] = w1[i - 1] + w1[i + 1];
#pragma unroll
    for (int i = 4; i < 20; ++i) w4[i] = w2[i - 2] + w2[i + 2];
#pragma unroll
    for (int tt = 0; tt < 8; ++tt) {
        const int c = tt + 8, t = t0 + tt;
        const f32x4 w8 = w4[c - 4] + w4[c + 4];
        const f32x4 s = g == 0 ? w1[c] : (g == 1 ? w2[c] : (g == 2 ? w4[c] : w8));
        const int lo = t - hw < 0 ? 0 : t - hw, hi = t + hw > L ? L : t + hw;
        const f32x4 r = s * __builtin_amdgcn_rcpf((float)(hi - lo)) - v[c];
        u32x2 w; w.x = pk2(r[0], r[1]); w.y = pk2(r[2], r[3]);
        *(u32x2*)(P.Abr + (size_t)(row0 + tt) * D + 512 + 4 * lane) = w;
    }
}
__device__ __forceinline__ void conv_unit(const PcPtrs& P, const LAS float* wl, LAS float* hl, int blk  , int wave, int lane) {
    constexpr int T = 8;
    const int rowb = blk * 64;
    const int L = rowb < MP ? 256 : 1024;
    const int sb = rowb < MP ? (rowb & ~255) : MP + ((rowb - MP) & ~1023);
    const int t0b = rowb - sb;
    __syncthreads();
    {
        u32x2 ar[12], gr[12];
#pragma unroll
        for (int i = 0; i < 12; ++i) {
            const int t = t0b - 15 + 12 * wave + i;
            const bool ok = (t >= 0) && (t < L);
            const bf16_t* p = P.Cin + (size_t)(sb + (ok ? t : 0)) * 512 + 4 * lane;
            ar[i] = *(const u32x2*)p; gr[i] = *(const u32x2*)(p + 256);
            if (!ok) { ar[i] = (u32x2){0u, 0u}; }
        }
#pragma unroll
        for (int i = 0; i < 12; ++i) {
            const f32x4 a = up_bf4(ar[i]), g = up_bf4(gr[i]);
            f32x4 hh;
#pragma unroll
            for (int e = 0; e < 4; ++e) hh[e] = a[e] * sigmoidf_(g[e]);
            *(LAS f32x4*)(hl + (12 * wave + i) * CW + 4 * lane) = hh;
        }
    }
    LDS_WAIT(); __syncthreads();
    const int row0 = rowb + T * wave;
    const LAS float* hw_ = hl + (T * wave) * CW + 4 * lane;
    f32x4 acc[T];
    const f32x4 bias = *(const f32x4*)(P.bdw + 4 * lane);
#pragma unroll
    for (int tt = 0; tt < T; ++tt) acc[tt] = bias;
#pragma unroll 1
    for (int c = 0; c < 2; ++c) {
#pragma unroll
        for (int g4 = 0; g4 < 5; ++g4) {
            const int s0 = 20 * c + 4 * g4;
            f32x4 tp[11];
#pragma unroll
            for (int q = 0; q < 11; ++q) tp[q] = *(const LAS f32x4*)(wl + (s0 + q) * CW + 4 * lane);
#pragma unroll
            for (int i = 0; i < 4; ++i) {
                const f32x4 hh = *(const LAS f32x4*)(hw_ + (s0 + i) * CW);
#pragma unroll
                for (int tt = 0; tt < T; ++tt) acc[tt] += hh * tp[i - tt + 7];
            }
            asm volatile("" ::: "memory");
        }
    }
    const f32x4 lg = *(const f32x4*)(P.cng + 4 * lane), lb = *(const f32x4*)(P.cnb + 4 * lane);
    float s1[T], s2[T];
#pragma unroll
    for (int tt = 0; tt < T; ++tt) s1[tt] = (acc[tt][0] + acc[tt][1]) + (acc[tt][2] + acc[tt][3]);
#pragma unroll
    for (int tt = 0; tt < T; ++tt) s1[tt] = wave_sum(s1[tt]);
#pragma unroll
    for (int tt = 0; tt < T; ++tt) { const float mu = s1[tt] * (1.0f / CW); acc[tt] = acc[tt] - mu; s2[tt] = (acc[tt][0] * acc[tt][0] + acc[tt][1] * acc[tt][1]) + (acc[tt][2] * acc[tt][2] + acc[tt][3] * acc[tt][3]); }
#pragma unroll
    for (int tt = 0; tt < T; ++tt) s2[tt] = wave_sum(s2[tt]);
#pragma unroll
    for (int tt = 0; tt < T; ++tt) {
        const float rstd = __builtin_amdgcn_rsqf(s2[tt] * (1.0f / CW) + EPS);
        f32x4 y = acc[tt] * rstd * lg + lb;
#pragma unroll
        for (int e = 0; e < 4; ++e) y[e] = y[e] * sigmoidf_(y[e]);
        u32x2 o; o.x = pk2(y[0], y[1]); o.y = pk2(y[2], y[3]);
        *(u32x2*)(P.Abr + (size_t)(row0 + tt) * D + 768 + 4 * lane) = o;
    }
}

#define XB_TMO      128
#define XB_XCNT(j)  (256  + 64 * (j))
#define XB_XSUB(j)  (1280 + 64 * (j))
#define XB_XGEN(j)  (2304 + 64 * (j))
#define XB_TOP      3328
#define XB_TOPGEN   3392
#define XB_LCNT(j)  (3456 + 64 * (j))
#define XB_MISMATCH 4480
#define XB_CONV     4544
#define XCD_BAR_WORDS 4608
#define XB_SPIN_CAP (1u << 18)
__device__ __forceinline__ unsigned xb_ld(unsigned* p)              { return __hip_atomic_load(p, __ATOMIC_RELAXED, __HIP_MEMORY_SCOPE_AGENT); }
__device__ __forceinline__ unsigned xb_add(unsigned* p, unsigned v) { return __hip_atomic_fetch_add(p, v, __ATOMIC_RELAXED, __HIP_MEMORY_SCOPE_AGENT); }
__device__ __forceinline__ unsigned xb_poll_rmw(unsigned* p) { unsigned r, z = 0u; asm volatile("global_atomic_add %0, %1, %2, off sc0\n\ts_waitcnt vmcnt(0)" : "=v"(r) : "v"(p), "v"(z) : "memory"); return r; }
__device__ __forceinline__ unsigned xb_xcc_id() { return (unsigned)__builtin_amdgcn_s_getreg((3 << 11) | 20) & 0xFu; }
#define XB_SPIN(cond, bar) do { unsigned _sp = 0; while (cond) { __builtin_amdgcn_s_sleep(1); \
    if ((++_sp & 255u) == 0u) { if (xb_ld(&(bar)[XB_TMO])) break; if (_sp > XB_SPIN_CAP) { atomicAdd(&(bar)[XB_TMO], 1u); break; } } } } while (0)
struct XcdBarrier { unsigned* bar; unsigned x; unsigned nloc, nx; };
#define XB_LOCAL_OK 0x80000000u
__device__ __forceinline__ XcdBarrier xcd_barrier_post(unsigned* bar) {
    XcdBarrier b; b.bar = bar; b.x = xb_xcc_id(); b.nloc = 0u; b.nx = 0u;
    asm volatile("" : "+s"(b.x));
    if (threadIdx.x == 0) {
        if (b.x != (blockIdx.x & 7u) || gridDim.x != 256u) { (void)xb_add(&bar[XB_MISMATCH], 1u); asm volatile("s_waitcnt vmcnt(0)" ::: "memory"); }
        (void)xb_add(&bar[XB_XCNT(b.x)], 1u);
    }
    return b;
}
__device__ __forceinline__ void xcd_barrier_complete(unsigned* bar, unsigned x, unsigned& nloc, unsigned& nx) {
    asm volatile("" : "+s"(bar));
    const unsigned G = gridDim.x * gridDim.y * gridDim.z;
    unsigned sum, cnt, mine, sp = 0u;
    for (;;) {
        sum = 0u; cnt = 0u; mine = 0u;
#pragma unroll
        for (unsigned j = 0; j < 16; ++j) { const unsigned c = xb_ld(&bar[XB_XCNT(j)]); sum += c; cnt += (c > 0u) ? 1u : 0u; mine = (j == x) ? c : mine; }
        if (sum == G) break;
        __builtin_amdgcn_s_sleep(1);
        if ((++sp & 255u) == 0u) { if (xb_ld(&bar[XB_TMO])) break; if (sp > XB_SPIN_CAP) { atomicAdd(&bar[XB_TMO], 1u); break; } }
    }
    nloc = mine > 0u ? mine : 1u; nx = cnt > 0u ? cnt : 1u;
}
__device__ __forceinline__ void xcd_barrier_t0(XcdBarrier& b) {
    {
        unsigned* bar = b.bar; asm volatile("" : "+s"(bar));
        unsigned bx_ = b.x; asm volatile("" : "+s"(bx_));
        __builtin_amdgcn_s_waitcnt(0);
        unsigned nloc = b.nloc, nx = b.nx;
        if (nloc == 0u) { xcd_barrier_complete(bar, bx_, nloc, nx); b.nloc = nloc; b.nx = nx | ((nloc == 32u && xb_ld(&bar[XB_MISMATCH]) == 0u) ? XB_LOCAL_OK : 0u); }
        nx &= ~XB_LOCAL_OK;
        const unsigned old = xb_add(&bar[XB_XSUB(bx_)], 1u);
        const unsigned gen = old / nloc;
        if (old + 1u == (gen + 1u) * nloc) {
            __builtin_amdgcn_fence(__ATOMIC_RELEASE, "agent");
            asm volatile("s_waitcnt vmcnt(0)" ::: "memory");
            const unsigned og = xb_add(&bar[XB_TOP], 1u);
            const unsigned tg = og / nx;
            if (og + 1u == (tg + 1u) * nx) xb_add(&bar[XB_TOPGEN], 1u);
            else XB_SPIN(xb_ld(&bar[XB_TOPGEN]) == tg, bar);
            __builtin_amdgcn_fence(__ATOMIC_ACQUIRE, "agent");
            xb_add(&bar[XB_XGEN(bx_)], 1u);
            asm volatile("s_waitcnt vmcnt(0)" ::: "memory");
        } else {
            XB_SPIN(xb_ld(&bar[XB_XGEN(bx_)]) == gen, bar);
            __builtin_amdgcn_fence(__ATOMIC_ACQUIRE, "agent");
            asm volatile("s_waitcnt vmcnt(0)" ::: "memory");
        }
    }
}
__device__ __forceinline__ void xcd_barrier(XcdBarrier& b) {
    asm volatile("s_waitcnt vmcnt(0)" ::: "memory");
    __syncthreads();
    if (threadIdx.x == 0) xcd_barrier_t0(b);
    b.nloc = __builtin_amdgcn_readfirstlane(b.nloc); b.nx = __builtin_amdgcn_readfirstlane(b.nx);
    __syncthreads();
}
__device__ __forceinline__ void xcd_local_barrier(XcdBarrier& b, unsigned k  , unsigned conv_need = 0u  ) {
    asm volatile("s_waitcnt vmcnt(0)" ::: "memory");
    __syncthreads();
    if (threadIdx.x == 0) {
        if (b.nx & XB_LOCAL_OK) {
            __builtin_amdgcn_s_waitcnt(0);
            unsigned* lb = b.bar; asm volatile("" : "+s"(lb));
            unsigned lx = b.x; asm volatile("" : "+s"(lx));
            unsigned* c = &lb[XB_LCNT(lx)];
            const unsigned target = k * 32u;
            (void)xb_add(c, 1u);
            XB_SPIN(xb_poll_rmw(c) < target, lb);
            if (conv_need) XB_SPIN(xb_ld(&lb[XB_CONV]) < conv_need, lb);
            __builtin_amdgcn_fence(__ATOMIC_ACQUIRE, "agent");
            asm volatile("s_waitcnt vmcnt(0)" ::: "memory");
        } else xcd_barrier_t0(b);
    }
    b.nloc = __builtin_amdgcn_readfirstlane(b.nloc); b.nx = __builtin_amdgcn_readfirstlane(b.nx);
    __syncthreads();
}

constexpr int TP_PITCH = 65, TP_BYTES = 64 * TP_PITCH * 4;
__device__ __forceinline__ void st16_wt(void* p, u32x4 v) { asm volatile("global_store_dwordx4 %0, %1, off sc1\n\ts_nop 1" :: "v"(p), "v"(v) : "memory"); }
template <bool WITH_C, bool GU_PERM, bool WT = false>
__device__ __forceinline__ void transpose_item(const float* W, int N, bf16_t* WTp, int ldt, int kcol0, LAS float* scr, int item, int lane,
                                               const float* shraw  , const float* shb  , float* csum  ) {
    const int nblk = N / 64, kb = item / nblk, nb = item % nblk, k0 = 64 * kb, n0 = 64 * nb;
    {
        const int r4 = lane >> 4, c4 = lane & 15;
        f32x4 v[16];
#pragma unroll
        for (int i = 0; i < 16; ++i) v[i] = __builtin_nontemporal_load((const f32x4*)(W + (size_t)(k0 + 4 * i + r4) * N + n0 + 4 * c4));
#pragma unroll
        for (int i = 0; i < 16; ++i) { LAS float* p = scr + (4 * i + r4) * TP_PITCH + 4 * c4; p[0] = v[i][0]; p[1] = v[i][1]; p[2] = v[i][2]; p[3] = v[i][3]; }
    }
    const int c = lane & 7, nn = lane >> 3;
    f32x4 sh[3][2];
    if (WITH_C) {
#pragma unroll
        for (int r = 0; r < 3; ++r)
#pragma unroll
            for (int h = 0; h < 2; ++h) sh[r][h] = *(const f32x4*)(shraw + (size_t)r * NMOD + k0 + 8 * c + 4 * h) + *(const f32x4*)(shb + k0 + 8 * c + 4 * h);
    }
    LDS_WAIT(); asm volatile("" ::: "memory");
#pragma unroll
    for (int j = 0; j < 8; ++j) {
        const int n = 8 * j + nn; const LAS float* s = scr + (8 * c) * TP_PITCH + n;
        float w[8];
#pragma unroll
        for (int q = 0; q < 8; ++q) w[q] = s[q * TP_PITCH];
        u32x4 o; o.x = pk2(w[0], w[1]); o.y = pk2(w[2], w[3]); o.z = pk2(w[4], w[5]); o.w = pk2(w[6], w[7]);
        int nrow = n0 + n;
        if (GU_PERM) nrow = nrow < FFN ? ((nrow >> 7) * 256 + (nrow & 127)) : (((nrow - FFN) >> 7) * 256 + 128 + ((nrow - FFN) & 127));
        if (WT) st16_wt(WTp + (size_t)nrow * ldt + kcol0 + k0 + 8 * c, o); else *(u32x4*)(WTp + (size_t)nrow * ldt + kcol0 + k0 + 8 * c) = o;
        if (WITH_C) {
            float d0 = 0.f, d1 = 0.f, d2 = 0.f;
#pragma unroll
            for (int q = 0; q < 8; ++q) { d0 += sh[0][q >> 2][q & 3] * w[q]; d1 += sh[1][q >> 2][q & 3] * w[q]; d2 += sh[2][q >> 2][q & 3] * w[q]; }
            d0 = sum8(d0); d1 = sum8(d1); d2 = sum8(d2);
            if (c == 0) { atomicAdd(csum + n0 + n, d0); atomicAdd(csum + N + n0 + n, d1); atomicAdd(csum + 2 * N + n0 + n, d2); }
        }
    }
    LDS_WAIT(); asm volatile("" ::: "memory");
}

constexpr int NWAVES = 8;
constexpr int I_IN = 16 * (NIN / 64), I_GU = 16 * (NGU / 64), I_DN = (FFN / 64) * 16, I_OUT = 16 * 16, I_OA = 8 * 16, I_OC = 4 * 16;
constexpr int I_LAYER = I_IN + I_GU + I_DN + I_OUT + I_OA + I_OC;
#ifndef MK_TAIL
#define MK_TAIL I_LAYER
#endif
constexpr int I_TAIL = MK_TAIL, I_HEAD = I_LAYER - I_TAIL;
constexpr int I_MIX = (I_TAIL >= 512) ? 384 : 0;
#ifndef MK_BG1
#define MK_BG1 1536
#endif
constexpr int I_BG1 = MK_BG1;
static_assert(I_HEAD + I_BG1 <= I_LAYER - I_MIX, "background split");
static_assert(I_HEAD == 0 && I_IN <= I_BG1, "every w_in item of the next layer belongs to the 24 converter workgroups (their tickets gate the XCD-local seam before the next in-projection)");
#define TRANSPOSE_LAYER_ITEM(l_, r0_, scr_, lane_) do { const int tl_ = (l_); int tr_ = (r0_); \
        const float* shraw1_ = MODRAW + (size_t)(tl_ * 3) * NMOD; const float* shraw2_ = MODRAW + (size_t)(tl_ * 3) * NMOD + 3 * D; \
        if (tr_ < I_IN) { transpose_item<true, false, true>(w_in + (size_t)tl_ * D * NIN, NIN, WIN + (size_t)tl_ * NIN * D, D, 0, scr_, tr_, lane_, shraw1_, b_mod + (size_t)tl_ * NMOD, C1 + (size_t)(tl_ * 3) * NIN); break; } tr_ -= I_IN; \
        if (tr_ < I_GU) { transpose_item<true, true>(w_gu + (size_t)tl_ * D * NGU, NGU, WGU + (size_t)tl_ * NGU * D, D, 0, scr_, tr_, lane_, shraw2_, b_mod + (size_t)tl_ * NMOD + 3 * D, C2 + (size_t)(tl_ * 3) * NGU); break; } tr_ -= I_GU; \
        if (tr_ < I_DN) { transpose_item<false, false>(w_down + (size_t)tl_ * FFN * D, D, WDN + (size_t)tl_ * D * FFN, FFN, 0, scr_, tr_, lane_, nullptr, nullptr, nullptr); break; } tr_ -= I_DN; \
        if (tr_ < I_OUT) { transpose_item<false, false>(w_out + (size_t)tl_ * D * D, D, WOUT + (size_t)tl_ * D * D, D, 0, scr_, tr_, lane_, nullptr, nullptr, nullptr); break; } tr_ -= I_OUT; \
        if (tr_ < I_OA) { transpose_item<false, false>(w_oa + (size_t)tl_ * NAW * D, D, WBR + (size_t)tl_ * D * D, D, 0, scr_, tr_, lane_, nullptr, nullptr, nullptr); break; } tr_ -= I_OA; \
        transpose_item<false, false>(w_oc + (size_t)tl_ * CW * D, D, WBR + (size_t)tl_ * D * D, D, 768, scr_, tr_, lane_, nullptr, nullptr, nullptr); } while (0)
constexpr int LDS_BYTES = 163840;
static_assert(8 * TP_BYTES <= LDS_BYTES, "LDS map");
constexpr int NPHASE = 2 + 6 * DEPTH + 1;

struct Args {
    const float* in[26]; float* out; unsigned char* ws; int ph_lo, ph_hi;
};

__global__ void __launch_bounds__(NWAVES * 64, 2) fwd_kernel(Args args) {
    extern __shared__ __attribute__((aligned(16))) unsigned char lds_raw[];
    LAS unsigned char* lds = (LAS unsigned char*)lds_raw;
    const int tid = threadIdx.x, lane = tid & 63, wave = __builtin_amdgcn_readfirstlane(tid >> 6);
    const int G = gridDim.x, bx = blockIdx.x;
    const int vcu = (G % 8 == 0) ? (bx % 8) * (G / 8) + bx / 8 : bx;
    const int gw = vcu * NWAVES + wave, NGW = G * NWAVES;
    typedef const Args __attribute__((address_space(4))) * ArgsP;
    ArgsP KAP = (ArgsP)__builtin_amdgcn_kernarg_segment_ptr();
#define PHASE_PTRS() asm volatile("" : "+s"(KAP))
#define WSB (KAP->ws)
#define ctlf ((float*)(WSB + WS_CTL))
#define x_prompt (KAP->in[0])
#define x_sample (KAP->in[1])
#define cache_k (KAP->in[2])
#define cache_v (KAP->in[3])
#define cvec (KAP->in[4])
#define c_ctx (KAP->in[5])
#define w_mod (KAP->in[6])
#define b_mod (KAP->in[7])
#define norm1_g (KAP->in[8])
#define norm2_g (KAP->in[9])
#define w_in (KAP->in[10])
#define b_gate (KAP->in[11])
#define rpb (KAP->in[12])
#define w_oa (KAP->in[13])
#define w_pool (KAP->in[14])
#define pool_scale (KAP->in[15])
#define w_ob (KAP->in[16])
#define w_dw (KAP->in[17])
#define b_dw (KAP->in[18])
#define conv_norm_g (KAP->in[19])
#define conv_norm_b (KAP->in[20])
#define w_oc (KAP->in[21])
#define w_out (KAP->in[22])
#define w_gu (KAP->in[23])
#define w_down (KAP->in[24])
#define final_g (KAP->in[25])
#define MODRAW (ctlf + CF_MODRAW)
#define C1 (ctlf + CF_C1)
#define C2 (ctlf + CF_C2)
#define RSS (ctlf + CF_RSS)
#define MODT ((float*)(WSB + WS_MODT))
#define WIN ((bf16_t*)(WSB + WS_WIN))
#define WGU ((bf16_t*)(WSB + WS_WGU))
#define WDN ((bf16_t*)(WSB + WS_WDN))
#define WBR ((bf16_t*)(WSB + WS_WBR))
#define WOUT ((bf16_t*)(WSB + WS_WOUT))
#define X ((float*)(WSB + WS_X))
#define XG ((bf16_t*)(WSB + WS_XG))
#define Qb ((bf16_t*)(WSB + WS_Q))
#define Kb ((bf16_t*)(WSB + WS_K))
#define VT ((bf16_t*)(WSB + WS_VT))
#define KC ((bf16_t*)(WSB + WS_KC))
#define VTC ((bf16_t*)(WSB + WS_VTC))
#define PIN ((bf16_t*)(WSB + WS_PIN))
#define CIN ((bf16_t*)(WSB + WS_CIN))
#define GT ((bf16_t*)(WSB + WS_G))
#define ABR ((bf16_t*)(WSB + WS_ABR))
#define MF ((float*)(WSB + WS_MF))
#define MB ((bf16_t*)(WSB + WS_MB))
#define ACT ((bf16_t*)(WSB + WS_ACT))

#if !MK_PER_PHASE
    XcdBarrier bar = xcd_barrier_post((unsigned*)(args.ws + WS_CTL) + CW_BAR);
#define GRID_BAR() xcd_barrier(bar)
#define LOCAL_BAR(k, cn) xcd_local_barrier(bar, (unsigned)(k), (unsigned)(cn))
#else
#define GRID_BAR() do {} while (0)
#define LOCAL_BAR(k, cn) do {} while (0)
#endif
    const int lo = args.ph_lo, hi = args.ph_hi;
#define IN(k) (lo <= (k) && (k) < hi)
#define SEAM(k) do { if (IN(k) && IN((k) + 1)) GRID_BAR(); } while (0)
#define SEAML(k, n, cn) do { if (IN(k) && IN((k) + 1)) LOCAL_BAR(n, cn); } while (0)

    for (int rep_ = 0; rep_ < MK_REPS(4); ++rep_) { if (rep_) GRID_BAR();
    float* MODRAW_W = rep_ ? MF : MODRAW; float* C1_W = rep_ ? MF + DEPTH * 3 * NMOD : C1; float* C2_W = rep_ ? MF + DEPTH * 3 * (NMOD + NIN) : C2;
    if (IN(0)) { PHASE_PTRS();
        LAS float* sil = (LAS float*)lds; LAS float* red = (LAS float*)(lds + 16384);
        for (int i = tid; i < 3 * D; i += NWAVES * 64) { const float s = i < D ? c_ctx[i] : cvec[i - D]; sil[i] = s * sigmoidf_(s); }
        __syncthreads();
        for (int it = vcu; it < DEPTH * 32 * 2; it += G) {
            const int c = it >> 1, kh = it & 1, l = c >> 5, n0 = (c & 31) * 192, k0 = kh * 512 + wave * 64;
            const float* wp = w_mod + ((size_t)l * D + k0) * NMOD + n0 + 4 * lane;
            f32x4 a0 = {0.f, 0.f, 0.f, 0.f}, a1 = a0, a2 = a0;
            if (lane < 48) {
#pragma unroll 1
                for (int r4 = 0; r4 < 64; r4 += 16) {
                    f32x4 w[16];
#pragma unroll
                    for (int kk = 0; kk < 16; ++kk) w[kk] = __builtin_nontemporal_load((const f32x4*)(wp + (size_t)(r4 + kk) * NMOD));
#pragma unroll
                    for (int kk = 0; kk < 16; ++kk) { a0 += sil[k0 + r4 + kk] * w[kk]; a1 += sil[D + k0 + r4 + kk] * w[kk]; a2 += sil[2 * D + k0 + r4 + kk] * w[kk]; }
                }
            }
#pragma unroll
            for (int e = 0; e < 4; ++e) { red[(wave * 12 + e) * 64 + lane] = a0[e]; red[(wave * 12 + 4 + e) * 64 + lane] = a1[e]; red[(wave * 12 + 8 + e) * 64 + lane] = a2[e]; }
            __syncthreads();
            for (int o = tid; o < 12 * 64; o += NWAVES * 64) {
                float s = 0.f;
#pragma unroll
                for (int ww = 0; ww < 8; ++ww) s += red[ww * 768 + o];
                const int q = o >> 6, ln = o & 63, r = q >> 2, e = q & 3;
                if (ln < 48) atomicAdd(MODRAW_W + (size_t)(l * 3 + r) * NMOD + n0 + 4 * ln + e, s);
            }
            __syncthreads();
        }
    }
    SEAM(0);

    if (IN(1)) { PHASE_PTRS();
        LAS float* scr = (LAS float*)(lds + wave * TP_BYTES);
        constexpr int I_T = I_LAYER + (DEPTH - 1) * I_HEAD;
        constexpr int I_OB = DEPTH * 16 * 4 * 8;
        constexpr int I_X = M;
        constexpr int I_KC = DEPTH * 2 * 256;
        constexpr int I_VC = DEPTH * 2 * 8 * 4;
        constexpr int I_MT = DEPTH * 3 * 6 * 4;
        constexpr int I_ALL = I_T + I_OB + I_X + I_KC + I_VC + I_MT;
        for (int it0 = gw; it0 < I_ALL; it0 += NGW) {
            int it = it0;
            if (it < I_T) {
                if (it < I_LAYER) TRANSPOSE_LAYER_ITEM(0, it, scr, lane);
                else if constexpr (I_HEAD > 0) { const int q = it - I_LAYER; TRANSPOSE_LAYER_ITEM(1 + q / I_HEAD, q % I_HEAD, scr, lane); }
                continue;
            }
            it -= I_T;
            if (it < I_OB) {
                const int l = it / 512, rem = it % 512, nch = rem >> 5, g = (rem >> 3) & 3, cc = rem & 7, n = nch * 64 + lane;
                float a[8];
#pragma unroll
                for (int c = 0; c < 8; ++c) a[c] = 0.f;
                const float* wp = w_pool + ((size_t)(l * 4 + g) * 64 + cc * 8) * 64;
                for (int d = 0; d < 64; ++d) {
                    const float wb = w_ob[((size_t)l * PW + g * 64 + d) * D + n] * pool_scale[l * PW + g * 64 + d];
#pragma unroll
                    for (int c = 0; c < 8; ++c) a[c] += wp[c * 64 + d] * wb;
                }
                u32x4 o; o.x = pk2(a[0], a[1]); o.y = pk2(a[2], a[3]); o.z = pk2(a[4], a[5]); o.w = pk2(a[6], a[7]);
                *(u32x4*)(WBR + ((size_t)l * D + n) * D + 512 + g * 64 + cc * 8) = o;
                continue;
            }
            it -= I_OB;
            if (it < I_X) {
                const int row = it, mr = row < MP ? 0 : 1 + ((row - MP) >> 10);
                const float* xr = row < MP ? x_prompt + (size_t)row * D : x_sample + (size_t)(row - MP) * D;
                float ss = 0.f;
#pragma unroll
                for (int j = 0; j < 4; ++j) {
                    const int col = 256 * j + 4 * lane;
                    const f32x4 v = *(const f32x4*)(xr + col);
                    ss += (v[0] * v[0] + v[1] * v[1]) + (v[2] * v[2] + v[3] * v[3]);
                    const f32x4 sc = *(const f32x4*)(MODRAW + (size_t)mr * NMOD + D + col) + *(const f32x4*)(b_mod + D + col);
                    const f32x4 gg = *(const f32x4*)(norm1_g + col) * (sc + 1.0f);
                    const f32x4 xs = v * gg;
                    u32x2 o; o.x = pk2(xs[0], xs[1]); o.y = pk2(xs[2], xs[3]);
                    *(u32x2*)(XG + (size_t)row * D + col) = o;
                }
                ss = wave_sum(ss);
                if (lane == 0) RSS[row] = ss;
                continue;
            }
            it -= I_X;
            if (it < I_KC) {
                const int l = it / 512, bs = (it >> 8) & 1, key = it & 255;
                const float* src = cache_k + (((size_t)(bs * DEPTH + l) * 256 + key) * 512) + 8 * lane;
                const f32x4 a = *(const f32x4*)src, b = *(const f32x4*)(src + 4);
                *(u32x4*)(KC + (((size_t)(l * 2 + bs) * 256 + key) * 512) + 8 * lane) = pk8(a, b);
                continue;
            }
            it -= I_KC;
            if (it < I_VC) {
                const int l = it / 64, bs = (it >> 5) & 1, h = (it >> 2) & 7, kb = it & 3, key = kb * 64 + lane;
                const float* src = cache_v + (((size_t)(bs * DEPTH + l) * 256 + key) * 512) + h * 64;
                bf16_t* dst = VTC + ((size_t)((l * 2 + bs) * 8 + h) * 64) * 256 + pos_of_key(key);
#pragma unroll
                for (int d4 = 0; d4 < 16; ++d4) {
                    const f32x4 v = *(const f32x4*)(src + 4 * d4);
                    const unsigned w0 = pk2(v[0], v[1]), w1 = pk2(v[2], v[3]);
                    dst[(size_t)(4 * d4 + 0) * 256] = (bf16_t)(w0 & 0xffff); dst[(size_t)(4 * d4 + 1) * 256] = (bf16_t)(w0 >> 16);
                    dst[(size_t)(4 * d4 + 2) * 256] = (bf16_t)(w1 & 0xffff); dst[(size_t)(4 * d4 + 3) * 256] = (bf16_t)(w1 >> 16);
                }
                continue;
            }
            it -= I_VC;
            {
                const int q = it & 3, which = (it >> 2) % 6, lr = it / 24, l = lr / 3, col = q * 256 + 4 * lane;
                const float* mraw = MODRAW + (size_t)lr * NMOD; const float* bm = b_mod + (size_t)l * NMOD;
                f32x4 v;
                if (which == 0) v = *(const f32x4*)(norm1_g + (size_t)l * D + col) * (*(const f32x4*)(mraw + D + col) + *(const f32x4*)(bm + D + col) + 1.0f);
                else if (which == 1) v = *(const f32x4*)(mraw + col) + *(const f32x4*)(bm + col);
                else if (which == 2) v = *(const f32x4*)(mraw + 2 * D + col) + *(const f32x4*)(bm + 2 * D + col);
                else if (which == 3) v = *(const f32x4*)(norm2_g + (size_t)l * D + col) * (*(const f32x4*)(mraw + 4 * D + col) + *(const f32x4*)(bm + 4 * D + col) + 1.0f);
                else if (which == 4) v = *(const f32x4*)(mraw + 3 * D + col) + *(const f32x4*)(bm + 3 * D + col);
                else v = *(const f32x4*)(mraw + 5 * D + col) + *(const f32x4*)(bm + 5 * D + col);
                *(f32x4*)(MODT + ((size_t)lr * 6 + which) * D + col) = v;
            }
        }
        LDS_WAIT(); __syncthreads();
    }
    }
    SEAM(1);

    for (int l = 0; l < DEPTH; ++l) {
        const int p0 = 2 + 6 * l;
        const float* modt_l = MODT + (size_t)l * 3 * 6 * D;
        for (int rep_ = 0; rep_ < MK_REPS(0); ++rep_) { if (rep_) GRID_BAR();
        if (IN(p0)) { PHASE_PTRS();
            pg8::Gemm g{XG, WIN + (size_t)l * NIN * D, D, D};
            pg8::TileOrder S; S.init(M, NIN, D, G, bx);
            EpiIn E{RSS + (size_t)(2 * l) * M, C1 + (size_t)(l * 3) * NIN, b_gate + (size_t)l * 3072, Qb, Kb, VT, PIN, CIN, GT,
                    args.out + OUT_K + (size_t)l * 256 * 512, args.out + OUT_V + (size_t)l * 256 * 512};
            pg8::gemm_phase<EpiIn, pg8::TileOrder>(lds, g, S, E);
        }
        }
        SEAM(p0);
        for (int rep_ = 0; rep_ < MK_REPS(1); ++rep_) { if (rep_) GRID_BAR();
        if (IN(p0 + 1)) { PHASE_PTRS();
            AttnPtrs AP{Qb, Kb, VT, KC + (size_t)l * 2 * 256 * 512, VTC + (size_t)l * 2 * 8 * 64 * 256, ABR};
            PcPtrs PP{PIN, CIN, w_dw + (size_t)l * CONVK * CW, b_dw + (size_t)l * CW, conv_norm_g + (size_t)l * CW, conv_norm_b + (size_t)l * CW, ABR};
            int lane_p = lane; asm volatile("" : "+v"(lane_p));
            if (vcu < 128) {
                LAS float* rpl = (LAS float*)(lds + 1024); LAS float* parts = (LAS float*)(lds + 16384);
                LAS unsigned char* kl = lds + 53248; LAS unsigned char* vl = kl + PA_K_BYTES;
                const float* rpb_l = rpb + (size_t)l * 8 * 15 * 31;
                for (int i = wave * 64 + lane_p; i < 8 * 15 * 31; i += NWAVES * 64) rpl[i] = rpb_l[i] * LOG2E;
                if (!(rep_ && MK_VAR == 1)) attn_sample_block(AP, kl, vl, rpl, parts, vcu, wave, lane_p);
                { const int pu = vcu * NWAVES + wave; if (pu < 768 && !(rep_ && (MK_VAR == 4 || MK_VAR == 5))) pool_unit(PP, pu, lane_p); }
            } else {
                LAS float* wl = (LAS float*)lds; LAS unsigned char* kl = lds + 49152; LAS unsigned char* vl = kl + PA_K_BYTES;
                const int bh = vcu - 128;
                for (int i = wave * 64 + lane_p; i < 47 * CW / 4; i += NWAVES * 64) { const int j = i / (CW / 4) - 7;
                    *(LAS f32x4*)(wl + 4 * i) = (j >= 0 && j < CONVK) ? *(const f32x4*)(PP.wdw + 4 * (i - 7 * (CW / 4))) : (f32x4){0.f, 0.f, 0.f, 0.f}; }
                { StageRegs R; attn_stage_load(R, AP.K + (size_t)((bh >> 3) * 256) * NAW + (bh & 7) * 64, AP.Vt + (size_t)(bh * 64) * 256, 256, 256, wave * 64 + lane_p); attn_stage_store(R, 256, kl, vl, wave * 64 + lane_p); }
                LDS_WAIT(); __syncthreads();
                if (!(rep_ && (MK_VAR == 2 || MK_VAR == 5))) attn_prompt_lds(AP, kl, vl, bh, wave, lane_p);
                { const int it = bh * NWAVES + wave;
                    if (it < 768) { if (!(rep_ && (MK_VAR == 3 || MK_VAR == 5))) conv_unit(PP, wl, (LAS float*)(lds + 49152), bh, wave, lane_p); } }
                if (I_MIX > 0 && bh >= 96 && l + 1 < DEPTH && !rep_) {
                    __syncthreads();
                    LAS float* scr = (LAS float*)(lds + wave * TP_BYTES);
#pragma unroll 1
                    for (int r = I_LAYER - I_MIX + (bh - 96) * NWAVES + wave; r < I_LAYER; r += 32 * NWAVES) TRANSPOSE_LAYER_ITEM(l + 1, r, scr, lane_p);
                    LDS_WAIT();
                }
            }
            __syncthreads();
        }
        }
        SEAM(p0 + 1);
        const int t192 = (bx & 7) * 32 + (bx >> 3), pm192 = t192 >> 3, pn192 = t192 & 7;
        const bool has192 = (G == 256);
        const bool fuse_last = has192 && MK_REPEAT == 0 && IN(NPHASE - 2) && IN(NPHASE - 1);
        for (int rep_ = 0; rep_ < MK_REPS(2); ++rep_) { if (rep_) GRID_BAR();
        if (IN(p0 + 2)) { PHASE_PTRS();
            EpiBranch192 E{GT, MB};
            if (has192) g192::gemm<EpiBranch192>(lds, ABR, D, WBR + (size_t)l * D * D, D, pm192, pn192, 16, E);
        }
        }
        SEAML(p0 + 2, 4 * l + 1, 0);
        for (int rep_ = 0; rep_ < MK_REPS(5); ++rep_) { if (rep_) GRID_BAR();
        if (IN(p0 + 3)) { PHASE_PTRS();
            const float* xr0 = l == 0 ? x_prompt : X; const float* xr1 = l == 0 ? x_sample : X + (size_t)MP * D;
            EpiRes192 E{xr0, xr1, X, XG, modt_l + 2 * D, modt_l + 3 * D, RSS + (size_t)(2 * l + 1) * M};
            if (has192) g192::gemm<EpiRes192>(lds, MB, D, WOUT + (size_t)l * D * D, D, pm192, pn192, 16, E);
        }
        }
        SEAML(p0 + 3, 4 * l + 2, 0);
        for (int rep_ = 0; rep_ < MK_REPS(3); ++rep_) { if (rep_) GRID_BAR();
        if (IN(p0 + 4)) { PHASE_PTRS();
            pg8::Gemm g{XG, WGU + (size_t)l * NGU * D, D, D};
            const bool bg = (I_TAIL > 0 && l + 1 < DEPTH && G == 256);
            const int nw = bg ? 232 : 256;
            pg8::TileOrderGU S; S.init(M, NGU, D, nw, bx);
            EpiGU E{RSS + (size_t)(2 * l + 1) * M, C2 + (size_t)(l * 3) * NGU, ACT};
            pg8::gemm_phase<EpiGU, pg8::TileOrderGU>(lds, g, S, E);
            if (bg && bx >= 128) {
                int lane_b = lane; asm volatile("" : "+v"(lane_b));
                LAS float* scr = (LAS float*)(lds + wave * TP_BYTES);
                const bool conv_only = bx >= nw;
                const int r0 = conv_only ? I_HEAD + (bx - 232) * NWAVES + wave : I_HEAD + I_BG1 + (bx - 128) * NWAVES + wave;
                const int r1 = conv_only ? I_HEAD + I_BG1 : I_LAYER - I_MIX, rs = conv_only ? 24 * NWAVES : 104 * NWAVES;
#pragma unroll 1
                for (int r = r0; r < r1; r += rs) TRANSPOSE_LAYER_ITEM(l + 1, r, scr, lane_b);
                LDS_WAIT(); asm volatile("s_waitcnt vmcnt(0)" ::: "memory"); __syncthreads();
                if (conv_only && tid == 0) (void)xb_add((unsigned*)(WSB + WS_CTL) + CW_BAR + XB_CONV, 1u);
            }
        }
        }
        SEAML(p0 + 4, 4 * l + 3, 0);
        for (int rep_ = 0; rep_ < MK_REPS(6); ++rep_) { if (rep_) GRID_BAR();
        if (IN(p0 + 5)) { PHASE_PTRS();
            if (l + 1 == DEPTH && fuse_last) {
                EpiLast192 E{X, modt_l + 5 * D, RSS + (size_t)(2 * l + 2) * M, (LAS f32x4*)lds};
                g192::gemm<EpiLast192>(lds, ACT, FFN, WDN + (size_t)l * D * FFN, FFN, pm192, pn192, FFN / 64, E);
            } else {
                EpiRes192 E{X, X + (size_t)MP * D, X, XG, modt_l + 5 * D, MODT + (size_t)((l + 1) % DEPTH) * 3 * 6 * D, RSS + (size_t)(2 * l + 2) * M};
                if (has192) g192::gemm<EpiRes192>(lds, ACT, FFN, WDN + (size_t)l * D * FFN, FFN, pm192, pn192, FFN / 64, E);
            }
        }
        }
        SEAML(p0 + 5, 4 * l + 4, (l + 1 < DEPTH) ? 24 * (l + 1) : 0);
    }
    if (IN(NPHASE - 1) && G == 256 && MK_REPEAT == 0 && IN(NPHASE - 2)) { PHASE_PTRS();
        int lane_f = lane; asm volatile("" : "+v"(lane_f));
        const int t192 = (bx & 7) * 32 + (bx >> 3), pm192 = t192 >> 3, pn192 = t192 & 7, wr = wave >> 2, wc = wave & 3, fr = lane_f & 15, fq = lane_f >> 4;
        const int col = pn192 * 128 + wc * 32 + 8 * fq;
        const f32x4 g0 = *(const f32x4*)(final_g + col), g1 = *(const f32x4*)(final_g + col + 4);
        const LAS f32x4* pk = (const LAS f32x4*)lds + wave * 12 * 64 + lane_f;
        float ss[6];
#pragma unroll
        for (int m = 0; m < 6; ++m) ss[m] = RSS[(size_t)8 * M + pm192 * 192 + wr * 96 + m * 16 + fr];
#pragma unroll
        for (int m = 0; m < 6; ++m) {
            const int row = pm192 * 192 + wr * 96 + m * 16 + fr;
            const float rinv = __builtin_amdgcn_rsqf(ss[m] * (1.0f / D) + EPS);
            float* yp = args.out + OUT_Y + (size_t)row * D + col;
            __builtin_nontemporal_store(pk[(2 * m) * 64] * rinv * g0, (f32x4*)yp); __builtin_nontemporal_store(pk[(2 * m + 1) * 64] * rinv * g1, (f32x4*)(yp + 4));
        }
    } else
    if (IN(NPHASE - 1)) { PHASE_PTRS();
        for (int row0 = (bx >> 3) * NWAVES + wave; row0 < M / 8; row0 += (G >> 3) * NWAVES) {
            const int row = (bx & 7) * (M / 8) + row0;
            const float rinv = __builtin_amdgcn_rsqf(RSS[(size_t)8 * M + row] * (1.0f / D) + EPS);
#pragma unroll
            for (int j = 0; j < 4; ++j) {
                const int col = 256 * j + 4 * lane;
                const f32x4 v = *(const f32x4*)(X + (size_t)row * D + col) * rinv * *(const f32x4*)(final_g + col);
                __builtin_nontemporal_store(v, (f32x4*)(args.out + OUT_Y + (size_t)row * D + col));
            }
        }
    }
#undef IN
#undef PHASE_PTRS
#undef WSB
#undef ctlf
#undef x_prompt
#undef x_sample
#undef cache_k
#undef cache_v
#undef cvec
#undef c_ctx
#undef w_mod
#undef b_mod
#undef norm1_g
#undef norm2_g
#undef w_in
#undef b_gate
#undef rpb
#undef w_oa
#undef w_pool
#undef pool_scale
#undef w_ob
#undef w_dw
#undef b_dw
#undef conv_norm_g
#undef conv_norm_b
#undef w_oc
#undef w_out
#undef w_gu
#undef w_down
#undef final_g
#undef MODRAW
#undef C1
#undef C2
#undef RSS
#undef MODT
#undef WIN
#undef WGU
#undef WDN
#undef WBR
#undef WOUT
#undef X
#undef XG
#undef Qb
#undef Kb
#undef VT
#undef KC
#undef VTC
#undef PIN
#undef CIN
#undef GT
#undef ABR
#undef MF
#undef MB
#undef ACT
#undef SEAM
#undef SEAML
}

extern "C" void kernel_launch(void* const* d_in, const int* in_sizes, int n_in, void* d_out, int out_size, void* d_ws, size_t ws_size, hipStream_t stream) {
    static int grid = 0;
    if (grid == 0) {
        if (n_in != 26 || ws_size < WS_END) { fprintf(stderr, "kernel_launch: expected 26 inputs and >= %zu bytes of workspace; got %d, %zu\n", (size_t)WS_END, n_in, ws_size); grid = -1; return; }
        int dev = 0, cus = 0;
        if (hipGetDevice(&dev) != hipSuccess || hipDeviceGetAttribute(&cus, hipDeviceAttributeMultiprocessorCount, dev) != hipSuccess) { grid = -1; return; }
        if (hipFuncSetAttribute((const void*)fwd_kernel, hipFuncAttributeMaxDynamicSharedMemorySize, LDS_BYTES) != hipSuccess) { fprintf(stderr, "kernel_launch: hipFuncSetAttribute failed\n"); grid = -1; return; }
        (void)hipGetLastError();
        grid = cus;
    }
    if (grid < 0) return;
    (void)hipMemsetAsync((char*)d_ws + WS_CTL, 0, CTL_ZERO_BYTES, stream);
    Args a{};
    for (int i = 0; i < 26; ++i) a.in[i] = (const float*)d_in[i];
    a.out = (float*)d_out; a.ws = (unsigned char*)d_ws;
#if MK_PER_PHASE
    for (int p = 0; p < NPHASE; ++p) { a.ph_lo = p; a.ph_hi = p + 1; hipLaunchKernelGGL(fwd_kernel, dim3(grid), dim3(NWAVES * 64), LDS_BYTES, stream, a); }
#else
    a.ph_lo = 0; a.ph_hi = NPHASE;
    hipLaunchKernelGGL(fwd_kernel, dim3(grid), dim3(NWAVES * 64), LDS_BYTES, stream, a);
#endif
}
```
